# Optimizing an MI355X kernel written in HIP

```python
import jax, jax.numpy as jnp
from jax import lax
import numpy as np

D_MODEL = 2048
BATCH = 8
SEQ = 2048
DEPTH = 1

RET_HEADS = 8
RET_HEAD_DIM = D_MODEL // 16
RET_WIDTH = RET_HEADS * RET_HEAD_DIM
CHUNK = 128
ROPE_THETA = 10000.0
LRU_WIDTH = D_MODEL // 2
LRU_BLOCKS = 8
LRU_BLOCK_DIM = LRU_WIDTH // LRU_BLOCKS
CONV_WIDTH = 4
LRU_C = 8.0
MIX_WIDTH = RET_WIDTH + LRU_WIDTH
IN_WIDTH = 4 * RET_WIDTH + 2 * LRU_WIDTH
N_EXPERTS = 64
N_GROUPS = 8
EXPERTS_PER_GROUP = N_EXPERTS // N_GROUPS
TOPK_GROUPS = 4
TOP_K = 8
EXPERT_HIDDEN = D_MODEL // 4
ROUTED_SCALE = 2.5
MOE_BLOCK = 256
EPS = 1e-6

kernel_name = "hymba_style_retention_rglru_moe_adaln"


def rmsnorm(x, g):
    x32 = x.astype(jnp.float32)
    y = x32 * lax.rsqrt(jnp.mean(x32 * x32, axis=-1, keepdims=True) + EPS)
    return (y * g.astype(jnp.float32)).astype(x.dtype)


def rope(t, positions):
    dh = t.shape[-1]
    inv_freq = 1.0 / (ROPE_THETA ** (jnp.arange(0, dh, 2, dtype=jnp.float32) / dh))
    ang = positions.astype(jnp.float32)[..., None] * inv_freq
    cos = jnp.cos(ang)[:, :, None, :]
    sin = jnp.sin(ang)[:, :, None, :]
    t1, t2 = jnp.split(t, 2, axis=-1)
    return jnp.concatenate([t1 * cos - t2 * sin, t2 * cos + t1 * sin], axis=-1)


def retention_chunkwise(q, k, v):
    b, s, h, dh = q.shape
    n = s // CHUNK
    lg = jnp.log1p(-jnp.exp2(-5.0 - jnp.arange(h, dtype=jnp.float32)))
    q = q.reshape(b, n, CHUNK, h, dh)
    k = k.reshape(b, n, CHUNK, h, dh)
    v = v.reshape(b, n, CHUNK, h, dh)
    idx = jnp.arange(CHUNK, dtype=jnp.float32)
    diff = idx[:, None] - idx[None, :]
    intra = jnp.where(diff >= 0, jnp.exp(lg[:, None, None] * jnp.maximum(diff, 0.0)), 0.0)
    scores = jnp.einsum('bnchd,bnmhd->bnhcm', q, k) * intra
    inner = jnp.einsum('bnhcm,bnmhe->bnche', scores, v)
    k_dec = jnp.exp(lg[None, :] * (CHUNK - 1.0 - idx)[:, None])
    kv = jnp.einsum('bnmhd,bnmhe->bnhde', k * k_dec[None, None, :, :, None], v)
    chunk_dec = jnp.exp(lg * CHUNK)[None, :, None, None]

    def step(state, kv_i):
        return chunk_dec * state + kv_i, state

    _, r_prev = lax.scan(step, jnp.zeros((b, h, dh, dh), jnp.float32), jnp.moveaxis(kv, 1, 0))
    r_prev = jnp.moveaxis(r_prev, 0, 1)
    q_dec = jnp.exp(lg[None, :] * (idx + 1.0)[:, None])
    cross = jnp.einsum('bnchd,bnhde->bnche', q * q_dec[None, None, :, :, None], r_prev)
    return (inner + cross).reshape(b, s, h, dh)


def causal_dwconv(x, w, bias):
    s = x.shape[1]
    xp = jnp.pad(x, ((0, 0), (CONV_WIDTH - 1, 0), (0, 0)))
    y = bias
    for tap in range(CONV_WIDTH):
        y = y + xp[:, tap:tap + s] * w[tap]
    return y


def rg_lru(xc, w_a, b_a, w_x, b_x, lam):
    b, s, wd = xc.shape
    xb = xc.reshape(b, s, LRU_BLOCKS, LRU_BLOCK_DIM)
    r = jax.nn.sigmoid(jnp.einsum('bsgi,gij->bsgj', xb, w_a).reshape(b, s, wd) + b_a)
    i = jax.nn.sigmoid(jnp.einsum('bsgi,gij->bsgj', xb, w_x).reshape(b, s, wd) + b_x)
    log_a = -LRU_C * r * jax.nn.softplus(-lam)
    a = jnp.exp(log_a)
    bt = jnp.sqrt(-jnp.expm1(2.0 * log_a)) * (i * xc)

    def combine(p, q):
        return p[0] * q[0], q[0] * p[1] + q[1]

    _, hs = lax.associative_scan(combine, (a, bt), axis=1)
    return hs


def mixer(h, positions, w_in, w_conv, b_conv, w_rg_a, b_rg_a, w_rg_x, b_rg_x, lam, beta_ret, beta_lru, w_out):
    b, s, _ = h.shape
    proj = h @ w_in
    rw, lw = RET_WIDTH, LRU_WIDTH
    q = proj[..., 0:rw].reshape(b, s, RET_HEADS, RET_HEAD_DIM)
    k = proj[..., rw:2 * rw].reshape(b, s, RET_HEADS, RET_HEAD_DIM)
    v = proj[..., 2 * rw:3 * rw].reshape(b, s, RET_HEADS, RET_HEAD_DIM)
    g = proj[..., 3 * rw:4 * rw]
    xr = proj[..., 4 * rw:4 * rw + lw]
    yr = proj[..., 4 * rw + lw:4 * rw + 2 * lw]
    q = rope(q.astype(jnp.float32), positions) * (RET_HEAD_DIM ** -0.5)
    k = rope(k.astype(jnp.float32), positions)
    o = retention_chunkwise(q, k, v.astype(jnp.float32))
    mu = jnp.mean(o, axis=-1, keepdims=True)
    oc = o - mu
    o = oc * lax.rsqrt(jnp.mean(oc * oc, axis=-1, keepdims=True) + EPS)
    ret = jax.nn.silu(g.astype(jnp.float32)) * o.reshape(b, s, rw)
    xc = causal_dwconv(xr.astype(jnp.float32), w_conv, b_conv)
    lru = rg_lru(xc, w_rg_a, b_rg_a, w_rg_x, b_rg_x, lam) * jax.nn.gelu(yr.astype(jnp.float32), approximate=True)
    ret = rmsnorm(ret, beta_ret).astype(h.dtype)
    lru = rmsnorm(lru, beta_lru).astype(h.dtype)
    return jnp.concatenate([ret, lru], axis=-1) @ w_out


def swiglu(t, w_io, w_down):
    gu = t @ w_io
    gate, up = jnp.split(gu, 2, axis=-1)
    return (jax.nn.silu(gate) * up) @ w_down


def moe(h, w_router, b_router, w_exp_in, w_exp_out, w_sh_in, w_sh_out):
    b, s, d = h.shape
    t = b * s
    hf = h.reshape(t, d)
    scores = jax.nn.sigmoid((hf @ w_router).astype(jnp.float32))
    biased = scores + b_router.astype(jnp.float32)
    grp = biased.reshape(t, N_GROUPS, EXPERTS_PER_GROUP)
    grp_score = lax.top_k(grp, 2)[0].sum(-1)
    _, grp_idx = lax.top_k(grp_score, TOPK_GROUPS)
    grp_mask = jax.nn.one_hot(grp_idx, N_GROUPS).sum(1) > 0
    exp_mask = jnp.repeat(grp_mask, EXPERTS_PER_GROUP, axis=1)
    masked = jnp.where(exp_mask, biased, -jnp.inf)
    _, eidx = lax.top_k(masked, TOP_K)
    wsel = jnp.take_along_axis(scores, eidx, axis=1)
    wsel = wsel / jnp.sum(wsel, axis=-1, keepdims=True) * ROUTED_SCALE
    a_n = t * TOP_K
    flat_e = eidx.reshape(a_n)
    flat_t = jnp.repeat(jnp.arange(t, dtype=jnp.int32), TOP_K)
    flat_w = wsel.reshape(a_n)
    order = jnp.argsort(flat_e, stable=True)
    se, st, sw = flat_e[order], flat_t[order], flat_w[order]
    counts = jnp.bincount(flat_e, length=N_EXPERTS)
    starts = jnp.cumsum(counts) - counts
    pcounts = (counts + MOE_BLOCK - 1) // MOE_BLOCK * MOE_BLOCK
    pends = jnp.cumsum(pcounts)
    pstarts = pends - pcounts
    dest = pstarts[se] + jnp.arange(a_n, dtype=jnp.int32) - starts[se]
    n_rows = (a_n + MOE_BLOCK - 1) // MOE_BLOCK * MOE_BLOCK + N_EXPERTS * MOE_BLOCK
    n_blocks = n_rows // MOE_BLOCK
    row_tok = jnp.full((n_rows,), t, jnp.int32).at[dest].set(st)
    row_w = jnp.zeros((n_rows,), jnp.float32).at[dest].set(sw)
    blk_e = jnp.minimum(jnp.searchsorted(pends, jnp.arange(n_blocks, dtype=jnp.int32) * MOE_BLOCK, side='right'), N_EXPERTS - 1)
    hpad = jnp.concatenate([hf, jnp.zeros((1, d), hf.dtype)], axis=0)

    def expert_block(args):
        tok, wt, e = args
        out = swiglu(hpad[tok], w_exp_in[e], w_exp_out[e])
        return out.astype(jnp.float32) * wt[:, None]

    yb = lax.map(expert_block, (row_tok.reshape(n_blocks, MOE_BLOCK), row_w.reshape(n_blocks, MOE_BLOCK), blk_e))
    routed = jnp.zeros((t + 1, d), jnp.float32).at[row_tok].add(yb.reshape(n_rows, d))[:t]
    shared = swiglu(hf, w_sh_in, w_sh_out).astype(jnp.float32)
    return (routed + shared).astype(h.dtype).reshape(b, s, d)


def setup_inputs(seed: int = 0) -> dict:
    key = jax.random.key(seed)
    ks = jax.random.split(key, 28)
    f32 = jnp.float32
    nrm = lambda k, shape, scale: jax.random.normal(k, shape, f32) * scale
    a0 = jax.random.uniform(ks[13], (DEPTH, LRU_WIDTH), f32, 0.9, 0.999)
    return {
        'x': nrm(ks[0], (BATCH, SEQ, D_MODEL), 1.0),
        'c': nrm(ks[1], (BATCH, D_MODEL), 1.0),
        'positions': jnp.arange(SEQ, dtype=jnp.int32)[None, :] + jax.random.randint(ks[2], (BATCH, 1), 0, 4096, jnp.int32),
        'w_ada': nrm(ks[3], (DEPTH, D_MODEL, 6 * D_MODEL), 0.5 * D_MODEL ** -0.5),
        'b_ada': nrm(ks[4], (DEPTH, 6 * D_MODEL), 0.02),
        'g_mix': 1.0 + nrm(ks[5], (DEPTH, D_MODEL), 0.02),
        'w_in': nrm(ks[6], (DEPTH, D_MODEL, IN_WIDTH), D_MODEL ** -0.5),
        'w_conv': nrm(ks[7], (DEPTH, CONV_WIDTH, LRU_WIDTH), CONV_WIDTH ** -0.5),
        'b_conv': nrm(ks[8], (DEPTH, LRU_WIDTH), 0.02),
        'w_rg_a': nrm(ks[9], (DEPTH, LRU_BLOCKS, LRU_BLOCK_DIM, LRU_BLOCK_DIM), LRU_BLOCK_DIM ** -0.5),
        'b_rg_a': nrm(ks[10], (DEPTH, LRU_WIDTH), 0.02),
        'w_rg_x': nrm(ks[11], (DEPTH, LRU_BLOCKS, LRU_BLOCK_DIM, LRU_BLOCK_DIM), LRU_BLOCK_DIM ** -0.5),
        'b_rg_x': nrm(ks[12], (DEPTH, LRU_WIDTH), 0.02),
        'lam': jnp.log(a0) - jnp.log1p(-a0),
        'beta_ret': 1.0 + nrm(ks[14], (DEPTH, RET_WIDTH), 0.02),
        'beta_lru': 1.0 + nrm(ks[15], (DEPTH, LRU_WIDTH), 0.02),
        'w_out': nrm(ks[16], (DEPTH, MIX_WIDTH, D_MODEL), MIX_WIDTH ** -0.5),
        'g_moe': 1.0 + nrm(ks[17], (DEPTH, D_MODEL), 0.02),
        'w_router': nrm(ks[18], (DEPTH, D_MODEL, N_EXPERTS), D_MODEL ** -0.5),
        'b_router': nrm(ks[19], (DEPTH, N_EXPERTS), 0.01),
        'w_exp_in': nrm(ks[20], (DEPTH, N_EXPERTS, D_MODEL, 2 * EXPERT_HIDDEN), D_MODEL ** -0.5),
        'w_exp_out': nrm(ks[21], (DEPTH, N_EXPERTS, EXPERT_HIDDEN, D_MODEL), EXPERT_HIDDEN ** -0.5),
        'w_sh_in': nrm(ks[22], (DEPTH, D_MODEL, 2 * EXPERT_HIDDEN), D_MODEL ** -0.5),
        'w_sh_out': nrm(ks[23], (DEPTH, EXPERT_HIDDEN, D_MODEL), EXPERT_HIDDEN ** -0.5),
        'g_final': 1.0 + nrm(ks[24], (D_MODEL,), 0.02),
    }


def reference(x, c, positions, w_ada, b_ada, g_mix, w_in, w_conv, b_conv, w_rg_a, b_rg_a, w_rg_x, b_rg_x, lam, beta_ret, beta_lru, w_out, g_moe, w_router, b_router, w_exp_in, w_exp_out, w_sh_in, w_sh_out, g_final):
    cs = jax.nn.silu(c)
    for l in range(DEPTH):
        mod = (cs @ w_ada[l] + b_ada[l]).reshape(c.shape[0], 6, 1, D_MODEL)
        sh1, sc1, gt1, sh2, sc2, gt2 = mod[:, 0], mod[:, 1], mod[:, 2], mod[:, 3], mod[:, 4], mod[:, 5]
        h = rmsnorm(x, g_mix[l]) * (1.0 + sc1) + sh1
        x = x + gt1 * mixer(h, positions, w_in[l], w_conv[l], b_conv[l], w_rg_a[l], b_rg_a[l], w_rg_x[l], b_rg_x[l], lam[l], beta_ret[l], beta_lru[l], w_out[l])
        h = rmsnorm(x, g_moe[l]) * (1.0 + sc2) + sh2
        x = x + gt2 * moe(h, w_router[l], b_router[l], w_exp_in[l], w_exp_out[l], w_sh_in[l], w_sh_out[l])
    return rmsnorm(x, g_final)
```

```cpp
#include <hip/hip_runtime.h>
#include <cstdio>
#include <cstdint>

#ifndef PROBE_PHASE
#define PROBE_PHASE -1
#endif
#ifndef N_LAUNCHES
#define N_LAUNCHES 1
#endif

#define LAS __attribute__((address_space(3)))
typedef unsigned short bf16;
typedef short bf16x8 __attribute__((ext_vector_type(8)));
typedef float f32x4 __attribute__((ext_vector_type(4)));
typedef float f32x2 __attribute__((ext_vector_type(2)));
typedef unsigned u32x4 __attribute__((ext_vector_type(4)));
typedef unsigned u32x2 __attribute__((ext_vector_type(2)));
typedef int i32x4 __attribute__((ext_vector_type(4)));
typedef int i32x8 __attribute__((ext_vector_type(8)));

constexpr int NB = 8, SEQ = 2048, DM = 2048, T = NB * SEQ;
constexpr int NIN = 6144, RW = 1024, LW = 1024, NE = 64, EH = 512, TOPK = 8;
constexpr int NR_ROUTED = T * TOPK + NE * 256;
constexpr int NR = NR_ROUTED + T;
constexpr int NWAVES = 8;
constexpr float EPS = 1e-6f;
constexpr float SC_H8 = 16.0f, SC_WEI = 64.0f, SC_ACT = 8.0f, SC_WEO = 4.0f, SC_Y = 32.0f;

constexpr size_t MiB = 1u << 20;
constexpr size_t WS_CTL = 0, CTL_ZERO_BYTES = 2 * MiB;
constexpr size_t WS_MOD = 1 * MiB;
constexpr size_t WS_ROPE = 2 * MiB;
constexpr size_t WS_WIN = 10 * MiB;
constexpr size_t WS_WOUT = 34 * MiB;
constexpr size_t WS_WR = 42 * MiB;
constexpr size_t WS_WA = WS_WR + 256 * 1024;
constexpr size_t WS_WX = WS_WA + 256 * 1024;
constexpr size_t WS_WEI = 44 * MiB;
constexpr size_t WS_H8 = 176 * MiB;
constexpr size_t WS_WEO = 304 * MiB;
constexpr size_t WS_H = 434 * MiB;
constexpr size_t WS_X1 = 500 * MiB;
constexpr size_t WS_EIDX = 628 * MiB;
constexpr size_t WS_WSEL = WS_EIDX + 512 * 1024;
constexpr size_t WS_SLOT = WS_WSEL + 512 * 1024;
constexpr size_t WS_DEST = WS_SLOT + 512 * 1024;
constexpr size_t WS_RTOK = WS_DEST + 512 * 1024;
constexpr size_t WS_RW = WS_RTOK + 640 * 1024;
constexpr size_t WS_AGGA = 632 * MiB;
constexpr size_t WS_AGGB = WS_AGGA + 512 * 1024;
constexpr size_t WS_ACT = 634 * MiB;
constexpr size_t WS_PROJ = 794 * MiB;
constexpr size_t WS_RETO = 986 * MiB;
constexpr size_t WS_HLOC = 1050 * MiB;
constexpr size_t WS_PLOC = 1082 * MiB;
constexpr size_t WS_CAT = 1114 * MiB;
constexpr size_t WS_Y = 794 * MiB;
constexpr size_t WS_TOKOF = 1434 * MiB;
constexpr size_t WS_END = 1438 * MiB;
constexpr int CW_BAR = 4096;
constexpr int CW_CNT = 8192;
constexpr int CW_MODCNT = 16384;

constexpr int RING_BYTES = 131072;
constexpr int LDS_BYTES = 147456;
constexpr int TT_OFF = 137216;
constexpr int MISC_OFF = LDS_BYTES - 256;
static_assert(TT_OFF + (2 * 704 + 80 + 68) * 4 <= MISC_OFF, "LDS map");
constexpr int MAXTILES = 704;

__device__ __forceinline__ unsigned pk2(float lo, float hi) { unsigned r; asm volatile("v_cvt_pk_bf16_f32 %0, %1, %2" : "=v"(r) : "v"(lo), "v"(hi)); return r; }
__device__ __forceinline__ bf16 f2bf(float f) { unsigned u = __float_as_uint(f); u += 0x7FFFu + ((u >> 16) & 1u); return (bf16)(u >> 16); }
__device__ __forceinline__ float bf2f(bf16 b) { return __uint_as_float(((unsigned)b) << 16); }
__device__ __forceinline__ float bflo(unsigned w) { return __uint_as_float(w << 16); }
__device__ __forceinline__ float bfhi(unsigned w) { return __uint_as_float(w & 0xffff0000u); }
__device__ __forceinline__ float wave_sum(float v) {
#pragma unroll
    for (int o = 1; o < 64; o <<= 1) v += __shfl_xor(v, o);
    return v;
}
__device__ __forceinline__ float sigmoidf_(float x) { return 1.0f / (1.0f + __expf(-x)); }
__device__ __forceinline__ float siluf_(float x) { return x / (1.0f + __expf(-x)); }
__device__ __forceinline__ float gelu_tanh_(float x) { const float u = 0.7978845608028654f * (x + 0.044715f * x * x * x); const float e = __expf(2.0f * u); const float th = 1.0f - 2.0f / (e + 1.0f); return 0.5f * x * (1.0f + th); }
__device__ __forceinline__ unsigned ld_agent(const unsigned* p) { return __hip_atomic_load(p, __ATOMIC_RELAXED, __HIP_MEMORY_SCOPE_AGENT); }
__device__ __forceinline__ int ld_agent_i(const int* p) { return (int)__hip_atomic_load((const unsigned*)p, __ATOMIC_RELAXED, __HIP_MEMORY_SCOPE_AGENT); }
__device__ __forceinline__ float clamp448(float x) { return __builtin_amdgcn_fmed3f(x, -448.0f, 448.0f); }
__device__ __forceinline__ unsigned pk4_fp8(float a, float b, float c, float d) { int w = 0; w = __builtin_amdgcn_cvt_pk_fp8_f32(clamp448(a), clamp448(b), w, false); w = __builtin_amdgcn_cvt_pk_fp8_f32(clamp448(c), clamp448(d), w, true); return (unsigned)w; }
#define LDS_WAIT() asm volatile("s_waitcnt lgkmcnt(0)" ::: "memory")
#define VM_WAIT() asm volatile("s_waitcnt vmcnt(0)" ::: "memory")

#define XB_TMO      128
#define XB_XCNT(j)  (256  + 64 * (j))
#define XB_XSUB(j)  (1280 + 64 * (j))
#define XB_XGEN(j)  (2304 + 64 * (j))
#define XB_TOP      3328
#define XB_TOPGEN   3392
#define XCD_BAR_WORDS 3456
#define XB_SPIN_CAP (1u << 18)
__device__ __forceinline__ unsigned xb_ld(unsigned* p)              { return __hip_atomic_load(p, __ATOMIC_RELAXED, __HIP_MEMORY_SCOPE_AGENT); }
__device__ __forceinline__ unsigned xb_add(unsigned* p, unsigned v) { return __hip_atomic_fetch_add(p, v, __ATOMIC_RELAXED, __HIP_MEMORY_SCOPE_AGENT); }
__device__ __forceinline__ unsigned xb_xcc_id() { return (unsigned)__builtin_amdgcn_s_getreg((3 << 11) | 20) & 0xFu; }
#define XB_SPIN(cond, bar) do { unsigned _sp = 0; while (cond) { __builtin_amdgcn_s_sleep(1); \
    if ((++_sp & 255u) == 0u) { if (xb_ld(&(bar)[XB_TMO])) break; if (_sp > XB_SPIN_CAP) { atomicAdd(&(bar)[XB_TMO], 1u); break; } } } } while (0)
struct XcdBarrier { unsigned* bar; unsigned x; volatile LAS unsigned* st; };
__device__ __forceinline__ XcdBarrier xcd_barrier_post(unsigned* bar, volatile LAS unsigned* st) {
    XcdBarrier b; b.bar = bar; b.x = xb_xcc_id(); b.st = st;
    if (threadIdx.x == 0) (void)xb_add(&bar[XB_XCNT(b.x)], 1u);
    return b;
}
__device__ __forceinline__ void xcd_barrier_complete(unsigned* bar, unsigned x, unsigned& nloc, unsigned& nx) {
    const unsigned G = gridDim.x * gridDim.y * gridDim.z;
    unsigned sum, cnt, mine, sp = 0u;
    for (;;) {
        sum = 0u; cnt = 0u; mine = 0u;
#pragma unroll
        for (unsigned j = 0; j < 16; ++j) { const unsigned c = xb_ld(&bar[XB_XCNT(j)]); sum += c; cnt += (c > 0u) ? 1u : 0u; mine = (j == x) ? c : mine; }
        if (sum == G) break;
        __builtin_amdgcn_s_sleep(1);
        if ((++sp & 255u) == 0u) { if (xb_ld(&bar[XB_TMO])) break; if (sp > XB_SPIN_CAP) { atomicAdd(&bar[XB_TMO], 1u); break; } }
    }
    nloc = mine > 0u ? mine : 1u; nx = cnt > 0u ? cnt : 1u;
}
__device__ __forceinline__ void xcd_barrier(const XcdBarrier& b) {
    asm volatile("s_waitcnt vmcnt(0)" ::: "memory");
    __syncthreads();
    if (threadIdx.x == 0) {
        unsigned* bar = b.bar;
        __builtin_amdgcn_s_waitcnt(0);
        unsigned nloc = b.st[0], nx = b.st[1];
        if (nloc == 0u) { xcd_barrier_complete(bar, b.x, nloc, nx); b.st[0] = nloc; b.st[1] = nx; }
        const unsigned old = xb_add(&bar[XB_XSUB(b.x)], 1u);
        const unsigned gen = old / nloc;
        if (old + 1u == (gen + 1u) * nloc) {
            __builtin_amdgcn_fence(__ATOMIC_RELEASE, "agent");
            asm volatile("s_waitcnt vmcnt(0)" ::: "memory");
            const unsigned og = xb_add(&bar[XB_TOP], 1u);
            const unsigned tg = og / nx;
            if (og + 1u == (tg + 1u) * nx) xb_add(&bar[XB_TOPGEN], 1u);
            else XB_SPIN(xb_ld(&bar[XB_TOPGEN]) == tg, bar);
            __builtin_amdgcn_fence(__ATOMIC_ACQUIRE, "agent");
            xb_add(&bar[XB_XGEN(b.x)], 1u);
            asm volatile("s_waitcnt vmcnt(0)" ::: "memory");
        } else {
            XB_SPIN(xb_ld(&bar[XB_XGEN(b.x)]) == gen, bar);
            __builtin_amdgcn_fence(__ATOMIC_ACQUIRE, "agent");
            asm volatile("s_waitcnt vmcnt(0)" ::: "memory");
        }
    }
    __syncthreads();
}

namespace g8 {
constexpr int BM = 256, BK = 64, HALF = 128, HTB = HALF * BK * 2, NXCD = 8, WGM = 8;
__device__ __forceinline__ int lds_byte(int r, int c) { const int st = (r >> 4) * 2 + (c >> 5), rr = r & 15, cc = c & 31, ob = rr * 64 + cc * 2; return st * 1024 + (ob ^ (((ob >> 9) & 1) << 5)); }
__device__ __forceinline__ void stage_rc(int b, int& R, int& C) { const int st = b / 1024, sb = b % 1024, swz = sb ^ (((sb >> 9) & 1) << 5); R = (st >> 1) * 16 + swz / 64; C = (st & 1) * 32 + (swz % 64) / 2; }
__device__ __forceinline__ int perm32(int rho) { const int n = rho >> 4, i = rho & 15; return 8 * (i >> 2) + 4 * n + (i & 3); }

struct Unit { const char* A; const char* B; unsigned vA0[2], vA1[2]; int r0, pn, e, rend; };

template <class Epi, class Sched, bool F8 = false>
__device__ __forceinline__ void gemm_phase(LAS unsigned char* lds, const int pitch, const Sched& S, const Epi& E) {
    const int tid = threadIdx.x, wid = __builtin_amdgcn_readfirstlane(tid >> 6), lane = tid & 63, wr = wid >> 2, wc = wid & 3, fr = lane & 15, fq = lane >> 4;
    const int nt = pitch / 128;
    unsigned voffB[2], voffB1[2];
#pragma unroll
    for (int i = 0; i < 2; ++i) { int R, C; stage_rc(tid * 16 + i * 8192, R, C); const int p = perm32(R & 31);
        if constexpr (Epi::P16) { const int base = 64 * (R >> 5) + 16 * (p >> 3) + (p & 7); voffB[i] = (unsigned)(base * pitch + C * 2); voffB1[i] = (unsigned)((base + 8) * pitch + C * 2); }
        else { const int Rb = Epi::PERM ? ((R & ~31) + p) : R; voffB[i] = (unsigned)(Rb * pitch + C * 2); voffB1[i] = voffB[i] + (unsigned)(HALF * pitch); } }
    const size_t kstep = 128;
    const size_t hstepB = (size_t)HALF * pitch;
    const unsigned ldsw = (unsigned)wid * 1024u;
    const int aoff = lds_byte(wr * 64 + fr, fq * 8), boff = lds_byte(wc * 32 + fr, fq * 8);
#define G8_SA(b, h) (((b) * 2 + (h)) * HTB)
#define G8_SB(b, h) ((4 + (b) * 2 + (h)) * HTB)
#define G8_STAGE(bufoff, gbase, voff) do { _Pragma("unroll") for (int _i = 0; _i < 2; ++_i) \
        __builtin_amdgcn_global_load_lds((const unsigned*)((const char*)(gbase) + (voff)[_i]), (LAS unsigned*)(lds + (bufoff) + ldsw + _i * 8192), 16, 0, 0); } while (0)
#define G8_LDA(dst, b, h) do { _Pragma("unroll") for (int m = 0; m < 4; ++m) _Pragma("unroll") for (int k = 0; k < 2; ++k) dst[m][k] = *(const LAS bf16x8*)(lds + G8_SA(b, h) + aoff + m * 2048 + k * 1024); } while (0)
#define G8_LDB(dst, b, h) do { _Pragma("unroll") for (int n = 0; n < 2; ++n) _Pragma("unroll") for (int k = 0; k < 2; ++k) dst[n][k] = *(const LAS bf16x8*)(lds + G8_SB(b, h) + boff + n * 2048 + k * 1024); } while (0)
#define G8_CAT(x) __builtin_shufflevector(__builtin_bit_cast(i32x4, x[0]), __builtin_bit_cast(i32x4, x[1]), 0, 1, 2, 3, 4, 5, 6, 7)
#define G8_MMA(ai, bj, At, Bt) do { __builtin_amdgcn_s_setprio(1); _Pragma("unroll") for (int m = 0; m < 4; ++m) _Pragma("unroll") for (int n = 0; n < 2; ++n) { \
        if constexpr (F8) acc[ai][bj][m][n] = __builtin_amdgcn_mfma_scale_f32_16x16x128_f8f6f4(G8_CAT(Bt[n]), G8_CAT(At[m]), acc[ai][bj][m][n], 0, 0, 0, 0x7f7f7f7f, 0, 0x7f7f7f7f); \
        else { _Pragma("unroll") for (int k = 0; k < 2; ++k) acc[ai][bj][m][n] = __builtin_amdgcn_mfma_f32_16x16x32_bf16(Bt[n][k], At[m][k], acc[ai][bj][m][n], 0, 0, 0); } } \
        __builtin_amdgcn_s_setprio(0); } while (0)
#define G8_WAIT_V(n) asm volatile("s_waitcnt vmcnt(" #n ")" ::: "memory")
#define G8_WAIT_L(n) asm volatile("s_waitcnt lgkmcnt(" #n ")" ::: "memory")
#define G8_BAR __builtin_amdgcn_s_barrier()
#define G8_SCHED __builtin_amdgcn_sched_barrier(0)
    Unit cur, nxt; int ui = 0;
    if (!S.next(0, cur)) return;
    f32x4 acc[2][2][4][2];
#pragma unroll
    for (int a = 0; a < 2; ++a)
#pragma unroll
        for (int b = 0; b < 2; ++b)
#pragma unroll
            for (int m = 0; m < 4; ++m)
#pragma unroll
                for (int n = 0; n < 2; ++n) acc[a][b][m][n] = (f32x4){0.f, 0.f, 0.f, 0.f};
    bf16x8 At[4][2], B0[2][2], B1[2][2];
    const char* cA = cur.A; const char* cB = cur.B;
    G8_STAGE(G8_SB(0, 0), cB, voffB); G8_STAGE(G8_SB(0, 1), cB, voffB1); G8_STAGE(G8_SA(0, 0), cA, cur.vA0); G8_STAGE(G8_SA(0, 1), cA, cur.vA1);
    if (wr == 1) G8_BAR;
    G8_WAIT_V(2); G8_BAR;
    G8_STAGE(G8_SB(1, 0), cB + kstep, voffB); G8_STAGE(G8_SA(1, 0), cA + kstep, cur.vA0); G8_STAGE(G8_SB(1, 1), cB + kstep, voffB1);
    G8_WAIT_V(6); G8_BAR;
    for (;;) {
        const bool has_next = S.next(ui + 1, nxt);
        if (!has_next) nxt = cur;
        const char* nA = nxt.A; const char* nB = nxt.B;
#pragma unroll 1
        for (int t = 0; t < nt; t += 2) {
            const bool last = (t == nt - 2);
            const char* a1 = cA + (size_t)(t + 1) * kstep;
            const char* a2 = last ? nA : cA + (size_t)(t + 2) * kstep; const char* b2 = last ? nB : cB + (size_t)(t + 2) * kstep;
            const char* a3 = a2 + kstep; const char* b3 = b2 + kstep;
            G8_LDB(B0, 0, 0); G8_LDB(B1, 0, 1); G8_SCHED; G8_LDA(At, 0, 0); G8_STAGE(G8_SA(1, 1), a1, cur.vA1);
            if (last) { cur.vA0[0] = nxt.vA0[0]; cur.vA0[1] = nxt.vA0[1]; cur.vA1[0] = nxt.vA1[0]; cur.vA1[1] = nxt.vA1[1]; }
            G8_WAIT_V(8); G8_WAIT_L(0); G8_BAR; G8_MMA(0, 0, At, B0); G8_MMA(0, 1, At, B1); G8_BAR; G8_SCHED;
            G8_LDA(At, 0, 1); G8_STAGE(G8_SB(0, 0), b2, voffB); G8_STAGE(G8_SB(0, 1), b2, voffB1); G8_STAGE(G8_SA(0, 0), a2, cur.vA0);
            G8_WAIT_V(8); G8_WAIT_L(0); G8_BAR; G8_MMA(1, 0, At, B0); G8_MMA(1, 1, At, B1); G8_BAR; G8_SCHED;
            G8_LDB(B0, 1, 0); G8_LDB(B1, 1, 1); G8_SCHED; G8_LDA(At, 1, 0); G8_STAGE(G8_SA(0, 1), a2, cur.vA1);
            G8_WAIT_V(8); G8_WAIT_L(0); G8_BAR; G8_MMA(0, 0, At, B0); G8_MMA(0, 1, At, B1); G8_BAR; G8_SCHED;
            G8_LDA(At, 1, 1); G8_STAGE(G8_SB(1, 0), b3, voffB); G8_STAGE(G8_SB(1, 1), b3, voffB1); G8_STAGE(G8_SA(1, 0), a3, cur.vA0);
            G8_WAIT_V(8); G8_WAIT_L(0); G8_BAR; G8_MMA(1, 0, At, B0); G8_MMA(1, 1, At, B1); G8_BAR; G8_SCHED;
        }
        if (wr == 0) G8_BAR;
        E(acc, cur, wr, wc, fr, fq);
        if (!has_next) break;
#pragma unroll
        for (int a = 0; a < 2; ++a)
#pragma unroll
            for (int b = 0; b < 2; ++b)
#pragma unroll
                for (int m = 0; m < 4; ++m)
#pragma unroll
                    for (int n = 0; n < 2; ++n) acc[a][b][m][n] = (f32x4){0.f, 0.f, 0.f, 0.f};
        cur = nxt; cA = nA; cB = nB; ++ui;
        if (wr == 1) G8_BAR;
    }
    G8_WAIT_V(0);
    G8_BAR;
#undef G8_SA
#undef G8_SB
#undef G8_STAGE
#undef G8_LDA
#undef G8_CAT
#undef G8_LDB
#undef G8_MMA
#undef G8_WAIT_V
#undef G8_WAIT_L
#undef G8_BAR
#undef G8_SCHED
}

struct DenseOrder {
    const char* A; const char* Bt; int pitch; int nM, nN, nwg, G, c;
    __device__ void init(const void* A_, const void* Bt_, int M, int N, int pitch_, int G_, int c_) { A = (const char*)A_; Bt = (const char*)Bt_; pitch = pitch_; nM = M / BM; nN = N / BM; nwg = nM * nN; G = G_; c = c_; }
    __device__ __forceinline__ bool next(int i, Unit& u) const {
        const long L = (long)i * G + c; if (L >= nwg) return false;
        int R[2], C[2]; stage_rc((int)threadIdx.x * 16, R[0], C[0]); stage_rc((int)threadIdx.x * 16 + 8192, R[1], C[1]);
        int wgid = (int)L; { const int q = nwg / NXCD, r = nwg % NXCD, xcd = wgid % NXCD, off = wgid / NXCD; wgid = (xcd < r ? xcd * (q + 1) : r * (q + 1) + (xcd - r) * q) + off; }
        const int nig = WGM * nN, gid = wgid / nig, fm = gid * WGM, gsz = (nM - fm) < WGM ? (nM - fm) : WGM;
        const int pm = fm + ((wgid % nig) % gsz), pn = (wgid % nig) / gsz;
        u.A = A + (size_t)pm * BM * pitch; u.B = Bt + (size_t)pn * BM * pitch;
#pragma unroll
        for (int j = 0; j < 2; ++j) { u.vA0[j] = (unsigned)(R[j] * pitch + C[j] * 2); u.vA1[j] = (unsigned)((R[j] + HALF) * pitch + C[j] * 2); }
        u.r0 = pm * BM; u.pn = pn; u.e = 0; u.rend = 0; return true;
    }
};
}

struct Args { const void* in[25]; float* out; unsigned char* ws; int ph_lo, ph_hi; };
struct Ctx {
    LAS unsigned char* lds; unsigned char* ws; const void* const* in; float* out;
    int tid, lane, wave, vcu, G;
};

__device__ __forceinline__ void p0_adaln(Ctx& F) {
    LAS float* sc = (LAS float*)F.lds;
    LAS float* red = (LAS float*)(F.lds + 65536);
    const float* cvec = (const float*)F.in[1]; const float* wada = (const float*)F.in[3]; const float* bada = (const float*)F.in[4]; float* mod = (float*)(F.ws + WS_MOD);
    __syncthreads();
    for (int i = F.tid; i < NB * DM; i += NWAVES * 64) sc[i] = siluf_(cvec[i]);
    __syncthreads();
    for (int cb = F.vcu; cb < 6 * DM / 48; cb += F.G) {
        const int n0 = cb * 48, l = F.lane < 48 ? F.lane : 47, k0 = F.wave * 256;
        float acc[8];
#pragma unroll
        for (int b = 0; b < 8; ++b) acc[b] = 0.f;
        const float* col = wada + (size_t)k0 * (6 * DM) + n0 + l;
#pragma unroll 1
        for (int kk = 0; kk < 256; kk += 32) { float wv[32];
#pragma unroll
            for (int u = 0; u < 32; ++u) wv[u] = col[(size_t)(kk + u) * (6 * DM)];
#pragma unroll
            for (int u = 0; u < 32; ++u)
#pragma unroll
                for (int b = 0; b < 8; ++b) acc[b] += sc[b * DM + k0 + kk + u] * wv[u]; }
        if (F.lane < 48) {
#pragma unroll
            for (int b = 0; b < 8; ++b) red[(F.wave * 8 + b) * 48 + F.lane] = acc[b]; }
        __syncthreads();
        if (F.tid < 384) { const int b = F.tid / 48, cc = F.tid % 48; float s = bada[n0 + cc];
#pragma unroll
            for (int w = 0; w < 8; ++w) s += red[(w * 8 + b) * 48 + cc];
            __hip_atomic_store(mod + (size_t)b * 6 * DM + n0 + cc, s, __ATOMIC_RELAXED, __HIP_MEMORY_SCOPE_AGENT); }
        VM_WAIT();
        __syncthreads();
    }
    if (F.tid == 0) __hip_atomic_fetch_add((unsigned*)(F.ws + WS_CTL) + CW_MODCNT, 1u, __ATOMIC_RELAXED, __HIP_MEMORY_SCOPE_AGENT);
}
__device__ __forceinline__ void p0_wait_mod(Ctx& F) {
    if (F.tid == 0) { unsigned* ctl = (unsigned*)(F.ws + WS_CTL); unsigned sp = 0u;
        while (ld_agent(ctl + CW_MODCNT) < (unsigned)F.G) { __builtin_amdgcn_s_sleep(2); if (++sp > (1u << 20)) { atomicAdd(ctl + CW_BAR + XB_TMO, 1u); break; } }
        __builtin_amdgcn_fence(__ATOMIC_ACQUIRE, "agent");
        asm volatile("s_waitcnt vmcnt(0)" ::: "memory"); }
    __syncthreads();
}
template <bool F8>
__device__ __forceinline__ void p0_transpose_item(const float* W, int K, int N, void* WT, int out_row0, int k0, int n0, float scale, LAS float* scr, int lane) {
    f32x4 v[16];
#pragma unroll
    for (int i = 0; i < 16; ++i) v[i] = *(const f32x4*)(W + (size_t)(k0 + 4 * i + (lane >> 4)) * N + n0 + 4 * (lane & 15));
#pragma unroll
    for (int i = 0; i < 16; ++i) { LAS float* d = scr + (4 * i + (lane >> 4)) * 65 + 4 * (lane & 15); d[0] = v[i].x; d[1] = v[i].y; d[2] = v[i].z; d[3] = v[i].w; }
    LDS_WAIT(); asm volatile("" ::: "memory");
    if (!F8) {
        const int c = lane & 7;
#pragma unroll
        for (int j = 0; j < 8; ++j) { const int n = (lane >> 3) + 8 * j; const LAS float* s = scr + (8 * c) * 65 + n;
            u32x4 o; o.x = pk2(s[0 * 65], s[1 * 65]); o.y = pk2(s[2 * 65], s[3 * 65]); o.z = pk2(s[4 * 65], s[5 * 65]); o.w = pk2(s[6 * 65], s[7 * 65]);
            *(u32x4*)((bf16*)WT + (size_t)(out_row0 + n) * K + k0 + 8 * c) = o; }
    } else {
        const int c = lane & 3;
#pragma unroll
        for (int j = 0; j < 4; ++j) { const int n = (lane >> 2) + 16 * j; const LAS float* s = scr + (16 * c) * 65 + n; int o[4];
#pragma unroll
            for (int q = 0; q < 4; ++q) { int wv = 0; wv = __builtin_amdgcn_cvt_pk_fp8_f32(s[(4 * q) * 65] * scale, s[(4 * q + 1) * 65] * scale, wv, false); wv = __builtin_amdgcn_cvt_pk_fp8_f32(s[(4 * q + 2) * 65] * scale, s[(4 * q + 3) * 65] * scale, wv, true); o[q] = wv; }
            *(u32x4*)((unsigned char*)WT + (size_t)(out_row0 + n) * K + k0 + 16 * c) = (u32x4){(unsigned)o[0], (unsigned)o[1], (unsigned)o[2], (unsigned)o[3]}; }
    }
    LDS_WAIT(); asm volatile("" ::: "memory");
}
struct CvItem { const float* src; unsigned char* dst; int N, K; float scale; };
__device__ __forceinline__ CvItem cv_decode(const void* const* in, unsigned char* ws, int r) {
    constexpr int I_EI = 32 * 16, I_EO = 8 * 32; CvItem c;
    if (r < 65 * I_EI) { const int e = r / I_EI, q = r % I_EI, kb = q / 16, nb = q % 16, n0 = 64 * nb, j = n0 & 511, up = n0 >> 9;
        const float* W = (e < 64) ? (const float*)in[20] + (size_t)e * DM * 1024 : (const float*)in[22];
        c.src = W + (size_t)(64 * kb) * 1024 + n0; c.N = 1024; c.K = DM; c.scale = SC_WEI;
        c.dst = ws + WS_WEI + (size_t)e * 1024 * DM + (size_t)((j >> 7) * 256 + up * 128 + (j & 127)) * DM + 64 * kb; }
    else { r -= 65 * I_EI; const int e = r / I_EO, q = r % I_EO, kb = q / 32, nb = q % 32;
        const float* W = (e < 64) ? (const float*)in[21] + (size_t)e * EH * DM : (const float*)in[23];
        c.src = W + (size_t)(64 * kb) * DM + 64 * nb; c.N = DM; c.K = EH; c.scale = SC_WEO;
        c.dst = ws + WS_WEO + (size_t)e * DM * EH + (size_t)(64 * nb) * EH + 64 * kb; }
    return c;
}
__device__ __forceinline__ void p2_convert_experts(Ctx& F) {
    const int gw = F.vcu * NWAVES + F.wave, NGW = F.G * NWAVES, lane = F.lane, li = lane & 15, lg = lane >> 4;
    constexpr int NCV = 65 * (32 * 16 + 8 * 32);
    int it = gw; CvItem cur; f32x4 v[16];
    const int krow = 16 * (li >> 2) + (li & 3);
#define CV_LOAD(c) do { _Pragma("unroll") for (int nh = 0; nh < 2; ++nh) _Pragma("unroll") for (int q = 0; q < 4; ++q) { const float* p_ = (c).src + (size_t)(krow + 4 * q) * (c).N + 32 * nh + 8 * lg; \
        v[(nh * 4 + q) * 2] = *(const f32x4*)p_; v[(nh * 4 + q) * 2 + 1] = *(const f32x4*)(p_ + 4); } } while (0)
    if (it < NCV) { cur = cv_decode(F.in, F.ws, it); CV_LOAD(cur); }
    while (it < NCV) {
        bf16x8 a[2][4];
#pragma unroll
        for (int nh = 0; nh < 2; ++nh)
#pragma unroll
            for (int q = 0; q < 4; ++q) { const f32x4 lo = v[(nh * 4 + q) * 2], hi = v[(nh * 4 + q) * 2 + 1];
                const u32x4 pk = (u32x4){pk2(lo.x, lo.y), pk2(lo.z, lo.w), pk2(hi.x, hi.y), pk2(hi.z, hi.w)}; a[nh][q] = __builtin_bit_cast(bf16x8, pk); }
        const CvItem me = cur; const int nit = it + NGW;
        if (nit < NCV) { cur = cv_decode(F.in, F.ws, nit); CV_LOAD(cur); }
        const unsigned sbits = (unsigned)f2bf(me.scale);
#pragma unroll
        for (int h = 0; h < 2; ++h) {
            u32x4 sel = (u32x4){0u, 0u, 0u, 0u}; { const int d = 16 * h + li - 8 * lg; if (d >= 0 && d < 8) { const unsigned wv = (d & 1) ? (sbits << 16) : sbits; if ((d >> 1) == 0) sel.x = wv; else if ((d >> 1) == 1) sel.y = wv; else if ((d >> 1) == 2) sel.z = wv; else sel.w = wv; } }
            const bf16x8 bs = __builtin_bit_cast(bf16x8, sel);
#pragma unroll
            for (int nh = 0; nh < 2; ++nh) { unsigned o[4];
#pragma unroll
                for (int q = 0; q < 4; ++q) { const f32x4 d = __builtin_amdgcn_mfma_f32_16x16x32_bf16(a[nh][q], bs, (f32x4){0.f, 0.f, 0.f, 0.f}, 0, 0, 0); o[q] = pk4_fp8(d[0], d[1], d[2], d[3]); }
                *(u32x4*)(me.dst + (size_t)(32 * nh + 16 * h + li) * me.K + 16 * lg) = (u32x4){o[0], o[1], o[2], o[3]}; }
        }
        it = nit;
    }
#undef CV_LOAD
}
__device__ __forceinline__ void p0_prologue(Ctx& F) {
    LAS float* scr = (LAS float*)(F.lds + F.wave * 16640);
    const int gw = F.vcu * NWAVES + F.wave, NGW = F.G * NWAVES, lane = F.lane;
    unsigned char* ws = F.ws;
    constexpr int I_IN = 32 * 96, I_OUT = 32 * 32, I_R = 32 * 1, I_G = 2 * 2;
    constexpr int NTR = I_IN + I_OUT + I_R + 16 * I_G;
    for (int it = gw; it < NTR; it += NGW) {
        int r = it;
        if (r < I_IN) { const int kb = r / 96, nb = r % 96; p0_transpose_item<false>((const float*)F.in[6], DM, NIN, ws + WS_WIN, 64 * nb, 64 * kb, 64 * nb, 1.f, scr, lane); continue; } r -= I_IN;
        if (r < I_OUT) { const int kb = r / 32, nb = r % 32; p0_transpose_item<false>((const float*)F.in[16], DM, DM, ws + WS_WOUT, 64 * nb, 64 * kb, 64 * nb, 1.f, scr, lane); continue; } r -= I_OUT;
        if (r < I_R) { const int kb = r; p0_transpose_item<false>((const float*)F.in[18], DM, NE, ws + WS_WR, 0, 64 * kb, 0, 1.f, scr, lane); continue; } r -= I_R;
        { const int m = r / I_G, q = r % I_G, kb = q / 2, nb = q % 2, g = m & 7;
          const float* W = ((m < 8) ? (const float*)F.in[9] : (const float*)F.in[11]) + (size_t)g * 128 * 128;
          p0_transpose_item<false>(W, 128, 128, (bf16*)(ws + (m < 8 ? WS_WA : WS_WX)) + (size_t)g * 128 * 128, 64 * nb, 64 * kb, 64 * nb, 1.f, scr, lane); }
    }
    {
        const int* pos = (const int*)F.in[2]; f32x2* rt = (f32x2*)(ws + WS_ROPE);
        for (int it = gw; it < T * 64 / 512; it += NGW) {
#pragma unroll 1
            for (int q = 0; q < 8; ++q) { const int idx = it * 512 + q * 64 + lane, t = idx >> 6, i = idx & 63;
                const double inv = exp(-9.210340371976184 * (double)i / 64.0); const double ang = (double)pos[t] * inv; double sn, cs; sincos(ang, &sn, &cs);
                rt[idx] = (f32x2){(float)cs, (float)sn}; }
        }
    }
    if (gw == 0) { u32x4* z = (u32x4*)((bf16*)(ws + WS_H) + (size_t)T * DM); for (int i = lane; i < DM * 2 / 16; i += 64) z[i] = (u32x4){0u, 0u, 0u, 0u};
        u32x4* z8 = (u32x4*)(ws + WS_H8 + (size_t)T * DM); for (int i = lane; i < DM / 16; i += 64) z8[i] = (u32x4){0u, 0u, 0u, 0u}; }
}

template <bool W8, bool INBF>
__device__ __forceinline__ void norm_mod_row(const void* xrow_, const float* g, const float* sc, const float* sh, bf16* orow, unsigned char* orow8, int lane) {
    f32x4 v[4][2]; float ss = 0.f;
#pragma unroll
    for (int j = 0; j < 4; ++j) {
        if constexpr (INBF) { const u32x4 w = *(const u32x4*)((const bf16*)xrow_ + 8 * lane + 512 * j); v[j][0] = (f32x4){bflo(w.x), bfhi(w.x), bflo(w.y), bfhi(w.y)}; v[j][1] = (f32x4){bflo(w.z), bfhi(w.z), bflo(w.w), bfhi(w.w)}; }
        else { v[j][0] = *(const f32x4*)((const float*)xrow_ + 8 * lane + 512 * j); v[j][1] = *(const f32x4*)((const float*)xrow_ + 8 * lane + 512 * j + 4); }
#pragma unroll
        for (int h = 0; h < 2; ++h) ss += (v[j][h].x * v[j][h].x + v[j][h].y * v[j][h].y) + (v[j][h].z * v[j][h].z + v[j][h].w * v[j][h].w); }
    const float rstd = rsqrtf(wave_sum(ss) * (1.0f / DM) + EPS);
#pragma unroll
    for (int j = 0; j < 4; ++j) { f32x4 o[2];
#pragma unroll
        for (int h = 0; h < 2; ++h) { const int c = 8 * lane + 512 * j + 4 * h; const f32x4 gg = *(const f32x4*)(g + c), s1 = *(const f32x4*)(sc + c), s0 = *(const f32x4*)(sh + c);
            o[h] = (v[j][h] * rstd * gg) * (s1 + 1.0f) + s0; }
        u32x4 w; w.x = pk2(o[0].x, o[0].y); w.y = pk2(o[0].z, o[0].w); w.z = pk2(o[1].x, o[1].y); w.w = pk2(o[1].z, o[1].w);
        *(u32x4*)(orow + 8 * lane + 512 * j) = w;
        if constexpr (W8) { u32x2 w8; w8.x = pk4_fp8(o[0].x * SC_H8, o[0].y * SC_H8, o[0].z * SC_H8, o[0].w * SC_H8); w8.y = pk4_fp8(o[1].x * SC_H8, o[1].y * SC_H8, o[1].z * SC_H8, o[1].w * SC_H8); *(u32x2*)(orow8 + 8 * lane + 512 * j) = w8; } }
}
__device__ __forceinline__ void p1_norm(Ctx& F) {
    const int gw = F.vcu * NWAVES + F.wave, NGW = F.G * NWAVES;
    const float* x = (const float*)F.in[0]; const float* g = (const float*)F.in[5]; const float* mod = (const float*)(F.ws + WS_MOD); bf16* h = (bf16*)(F.ws + WS_H);
    for (int m = gw; m < T; m += NGW) { const int b = m / SEQ; norm_mod_row<false, false>(x + (size_t)m * DM, g, mod + (size_t)b * 6 * DM + DM, mod + (size_t)b * 6 * DM, h + (size_t)m * DM, nullptr, F.lane); }
}

struct EpiProj {
    static constexpr bool PERM = true, P16 = false;
    bf16* O;
    __device__ __forceinline__ void operator()(const f32x4 (&acc)[2][2][4][2], const g8::Unit& u, int wr, int wc, int fr, int fq) const {
        const int row0 = u.r0 + wr * 64 + fr, col0 = u.pn * 256 + wc * 32 + 8 * fq;
#pragma unroll
        for (int ai = 0; ai < 2; ++ai)
#pragma unroll
            for (int m = 0; m < 4; ++m) { bf16* rowp = O + (size_t)(row0 + ai * 128 + m * 16) * NIN + col0;
#pragma unroll
                for (int bj = 0; bj < 2; ++bj) { const f32x4 v0 = acc[ai][bj][m][0], v1 = acc[ai][bj][m][1];
                    u32x4 w; w.x = pk2(v0[0], v0[1]); w.y = pk2(v0[2], v0[3]); w.z = pk2(v1[0], v1[1]); w.w = pk2(v1[2], v1[3]);
                    *(u32x4*)(rowp + bj * 128) = w; } }
    }
};
struct EpiWout {
    static constexpr bool PERM = true, P16 = false;
    const float* x; const float* mod; bf16* x1;
    __device__ __forceinline__ void operator()(const f32x4 (&acc)[2][2][4][2], const g8::Unit& u, int wr, int wc, int fr, int fq) const {
        const int row0 = u.r0 + wr * 64 + fr, col0 = u.pn * 256 + wc * 32 + 8 * fq; const int b = u.r0 / SEQ;
        const float* gt = mod + (size_t)b * 6 * DM + 2 * DM;
        f32x4 gv[2][2];
#pragma unroll
        for (int bj = 0; bj < 2; ++bj)
#pragma unroll
            for (int n = 0; n < 2; ++n) gv[bj][n] = *(const f32x4*)(gt + col0 + bj * 128 + n * 4);
#pragma unroll
        for (int ai = 0; ai < 2; ++ai)
#pragma unroll
            for (int m = 0; m < 4; ++m) { const size_t off = (size_t)(row0 + ai * 128 + m * 16) * DM + col0;
#pragma unroll
                for (int bj = 0; bj < 2; ++bj) { const f32x4 v0 = *(const f32x4*)(x + off + bj * 128) + gv[bj][0] * acc[ai][bj][m][0], v1 = *(const f32x4*)(x + off + bj * 128 + 4) + gv[bj][1] * acc[ai][bj][m][1];
                    u32x4 w; w.x = pk2(v0[0], v0[1]); w.y = pk2(v0[2], v0[3]); w.z = pk2(v1[0], v1[1]); w.w = pk2(v1[2], v1[3]);
                    *(u32x4*)(x1 + off + bj * 128) = w; }
                asm volatile("" ::: "memory"); }
    }
};
struct EpiSwiglu {
    static constexpr bool PERM = true, P16 = false;
    unsigned char* act;
    __device__ __forceinline__ void operator()(const f32x4 (&acc)[2][2][4][2], const g8::Unit& u, int wr, int wc, int fr, int fq) const {
        const int row0 = u.r0 + wr * 64 + fr, col0 = u.pn * 128 + wc * 32 + 8 * fq;
#pragma unroll
        for (int ai = 0; ai < 2; ++ai)
#pragma unroll
            for (int m = 0; m < 4; ++m) { float o[8];
#pragma unroll
                for (int n = 0; n < 2; ++n)
#pragma unroll
                    for (int j = 0; j < 4; ++j) { const float g = acc[ai][0][m][n][j] * (1.0f / (SC_H8 * SC_WEI)), up = acc[ai][1][m][n][j] * (SC_ACT / (SC_H8 * SC_WEI)); o[4 * n + j] = g * __builtin_amdgcn_rcpf(1.0f + __expf(-g)) * up; }
                u32x2 w; w.x = pk4_fp8(o[0], o[1], o[2], o[3]); w.y = pk4_fp8(o[4], o[5], o[6], o[7]);
                *(u32x2*)(act + (size_t)(row0 + ai * 128 + m * 16) * EH + col0) = w; }
    }
};
struct EpiDown {
    static constexpr bool PERM = true, P16 = true;
    unsigned char* y;
    __device__ __forceinline__ void operator()(const f32x4 (&acc)[2][2][4][2], const g8::Unit& u, int wr, int wc, int fr, int fq) const {
        const int row0 = u.r0 + wr * 64 + fr, col0 = u.pn * 256 + wc * 64 + 16 * fq; constexpr float sc = SC_Y / (SC_ACT * SC_WEO); static_assert(sc == 1.0f, "scales chosen so that y needs no multiply");
#pragma unroll
        for (int ai = 0; ai < 2; ++ai)
#pragma unroll
            for (int m = 0; m < 4; ++m) { u32x4 w;
                { const f32x4 v0 = acc[ai][0][m][0], v1 = acc[ai][0][m][1], v2 = acc[ai][1][m][0], v3 = acc[ai][1][m][1];
                  w.x = pk4_fp8(v0[0], v0[1], v0[2], v0[3]); w.y = pk4_fp8(v1[0], v1[1], v1[2], v1[3]); w.z = pk4_fp8(v2[0], v2[1], v2[2], v2[3]); w.w = pk4_fp8(v3[0], v3[1], v3[2], v3[3]); }
                *(u32x4*)(y + (size_t)(row0 + ai * 128 + m * 16) * DM + col0) = w; }
    }
};

struct MoeTables { LAS int* row0; LAS int* te; LAS int* pend; LAS int* tp; };
__device__ __forceinline__ MoeTables moe_tables(Ctx& F) { MoeTables M; M.row0 = (LAS int*)(F.lds + TT_OFF); M.te = M.row0 + MAXTILES; M.pend = M.te + MAXTILES; M.tp = M.pend + 80; return M; }
__device__ __forceinline__ int moe_build_tables(Ctx& F) {
    MoeTables M = moe_tables(F);
    const unsigned* cnt = (const unsigned*)(F.ws + WS_CTL) + CW_CNT;
    __syncthreads();
    if (F.tid < NE) M.row0[F.tid] = (int)ld_agent(cnt + 32 * F.tid);
    __syncthreads();
    if (F.tid == 0) { int tiles = 0;
        for (int e = 0; e < NE; ++e) { const int c = M.row0[e]; M.tp[e] = tiles; M.pend[e] = tiles * 256 + c; tiles += (c + 255) >> 8; }
        M.tp[NE] = NR_ROUTED / 256; M.pend[NE] = NR; M.tp[NE + 1] = NR_ROUTED / 256 + T / 256; M.tp[NE + 2] = tiles; }
    __syncthreads();
    const int rt = M.tp[NE + 2];
    for (int tau = F.tid; tau < rt; tau += NWAVES * 64) { int e = 0; while (e + 1 < NE && M.tp[e + 1] <= tau) ++e; M.te[tau] = e; M.row0[tau] = tau * 256; }
    for (int s = F.tid; s < T / 256; s += NWAVES * 64) { M.te[rt + s] = NE; M.row0[rt + s] = NR_ROUTED + s * 256; }
    __syncthreads();
    return rt + T / 256;
}
template <int PHASE>
struct MoeOrder {
    MoeTables M; const char* A; const char* W; const int* row_tok; int U, CH, x, j;
    static constexpr int NPN = (PHASE == 1) ? 4 : 8;
    __device__ void init(Ctx& F, int ntiles) { M = moe_tables(F); U = ntiles * NPN; CH = (U + 7) / 8; x = F.vcu / (F.G / 8); j = F.vcu % (F.G / 8);
        A = (const char*)(F.ws + (PHASE == 1 ? WS_H8 : WS_ACT)); W = (const char*)(F.ws + (PHASE == 1 ? WS_WEI : WS_WEO)); row_tok = (const int*)(F.ws + WS_TOKOF); }
    __device__ __forceinline__ bool next(int i, g8::Unit& u) const {
        const int q = i * 32 + j; const int L = x * CH + q; if (q >= CH || L >= U) return false;
        int R[2], C[2]; g8::stage_rc((int)threadIdx.x * 16, R[0], C[0]); g8::stage_rc((int)threadIdx.x * 16 + 8192, R[1], C[1]);
        const int tile = L / NPN, pn = L % NPN;
        const int e = __builtin_amdgcn_readfirstlane(M.te[tile]), r0 = __builtin_amdgcn_readfirstlane(M.row0[tile]), rend = __builtin_amdgcn_readfirstlane(M.pend[e]);
        u.r0 = r0; u.pn = pn; u.e = e; u.rend = rend; u.A = A;
        if (PHASE == 1) {
            u.B = W + ((size_t)e * 1024 + (size_t)pn * 256) * DM;
#pragma unroll
            for (int k = 0; k < 2; ++k) { const int ra = r0 + R[k], rb = ra + 128; int ta, tb;
                if (e == NE) { ta = ra - NR_ROUTED; tb = rb - NR_ROUTED; }
                else { const int ps_ = __builtin_amdgcn_readfirstlane(M.tp[e]) * 256; const int* tk = row_tok + (size_t)e * T - ps_; ta = (ra < rend) ? ld_agent_i(tk + ra) : T; tb = (rb < rend) ? ld_agent_i(tk + rb) : T; }
                u.vA0[k] = (unsigned)(ta * DM + C[k] * 2); u.vA1[k] = (unsigned)(tb * DM + C[k] * 2); }
        } else {
            u.B = W + ((size_t)e * DM + (size_t)pn * 256) * EH;
#pragma unroll
            for (int k = 0; k < 2; ++k) { u.vA0[k] = (unsigned)((r0 + R[k]) * EH + C[k] * 2); u.vA1[k] = (unsigned)((r0 + R[k] + 128) * EH + C[k] * 2); }
        }
        asm volatile("" : "+v"(u.vA0[0]), "+v"(u.vA0[1]), "+v"(u.vA1[0]), "+v"(u.vA1[1]));
        return true;
    }
};

constexpr int LP = 136;
__device__ __forceinline__ void ret_item(Ctx& F, int item) {
    const int tid = F.tid, lane = F.lane, w = F.wave, fr = lane & 15, fq = lane >> 4;
    const int b = item >> 5, h = (item >> 2) & 7, eb = item & 3;
    LAS bf16* qL = (LAS bf16*)(F.lds); LAS bf16* kL = qL + 128 * LP; LAS bf16* kTL = kL + 128 * LP; LAS bf16* vTL = kTL + 128 * LP; LAS bf16* STL = vTL + 32 * LP;
    const bf16* proj = (const bf16*)(F.ws + WS_PROJ); const f32x2* rope = (const f32x2*)(F.ws + WS_ROPE); float* reto = (float*)(F.ws + WS_RETO);
    const float lg = log1pf(-exp2f(-5.0f - (float)h)), lg2 = lg * 1.4426950408889634f, dec = __expf(lg * 128.0f);
    f32x4 st[2] = {(f32x4){0.f, 0.f, 0.f, 0.f}, (f32x4){0.f, 0.f, 0.f, 0.f}};
    __syncthreads();
    for (int i = tid; i < 32 * LP; i += NWAVES * 64) STL[i] = 0;
    const int r = tid >> 2, qd = tid & 3, j0 = 16 * qd;
    const float kdec = exp2f(lg2 * (float)(127 - r));
    u32x4 q1[2], q2[2], k1[2], k2[2], vv; f32x2 cs[16];
#define RET_LOAD(nn) do { const bf16* p_ = proj + (size_t)(b * SEQ + (nn) * 128 + r) * NIN + h * 128; const f32x2* c_ = rope + (size_t)(b * SEQ + (nn) * 128 + r) * 64 + j0; \
        q1[0] = *(const u32x4*)(p_ + j0); q1[1] = *(const u32x4*)(p_ + j0 + 8); q2[0] = *(const u32x4*)(p_ + 64 + j0); q2[1] = *(const u32x4*)(p_ + 64 + j0 + 8); \
        k1[0] = *(const u32x4*)(p_ + RW + j0); k1[1] = *(const u32x4*)(p_ + RW + j0 + 8); k2[0] = *(const u32x4*)(p_ + RW + 64 + j0); k2[1] = *(const u32x4*)(p_ + RW + 64 + j0 + 8); \
        vv = *(const u32x4*)(p_ + 2 * RW + eb * 32 + qd * 8); \
        _Pragma("unroll") for (int jj_ = 0; jj_ < 16; ++jj_) cs[jj_] = c_[jj_]; } while (0)
    RET_LOAD(0);
#pragma unroll 1
    for (int n = 0; n < 16; ++n) {
        const int t0 = b * SEQ + n * 128;
        __syncthreads();
        {
#pragma unroll
            for (int hh = 0; hh < 2; ++hh) { unsigned oq1[4], oq2[4], ok1[4], ok2[4];
#pragma unroll
                for (int c = 0; c < 4; ++c) { float a[2], bq[2], ka[2], kb[2];
#pragma unroll
                    for (int z = 0; z < 2; ++z) { const int jj = hh * 8 + c * 2 + z; const f32x2 sc = cs[jj];
                        const float x1 = z ? bfhi(q1[hh][c]) : bflo(q1[hh][c]), x2 = z ? bfhi(q2[hh][c]) : bflo(q2[hh][c]);
                        const float y1 = z ? bfhi(k1[hh][c]) : bflo(k1[hh][c]), y2 = z ? bfhi(k2[hh][c]) : bflo(k2[hh][c]);
                        a[z] = (x1 * sc.x - x2 * sc.y) * 0.08838834764831845f; bq[z] = (x2 * sc.x + x1 * sc.y) * 0.08838834764831845f;
                        ka[z] = y1 * sc.x - y2 * sc.y; kb[z] = y2 * sc.x + y1 * sc.y;
                        kTL[(j0 + jj) * LP + r] = f2bf(ka[z] * kdec); kTL[(64 + j0 + jj) * LP + r] = f2bf(kb[z] * kdec); }
                    oq1[c] = pk2(a[0], a[1]); oq2[c] = pk2(bq[0], bq[1]); ok1[c] = pk2(ka[0], ka[1]); ok2[c] = pk2(kb[0], kb[1]); }
                *(LAS u32x4*)(qL + r * LP + j0 + hh * 8) = (u32x4){oq1[0], oq1[1], oq1[2], oq1[3]}; *(LAS u32x4*)(qL + r * LP + 64 + j0 + hh * 8) = (u32x4){oq2[0], oq2[1], oq2[2], oq2[3]};
                *(LAS u32x4*)(kL + r * LP + j0 + hh * 8) = (u32x4){ok1[0], ok1[1], ok1[2], ok1[3]}; *(LAS u32x4*)(kL + r * LP + 64 + j0 + hh * 8) = (u32x4){ok2[0], ok2[1], ok2[2], ok2[3]}; }
#pragma unroll
            for (int c = 0; c < 4; ++c) { vTL[(qd * 8 + 2 * c) * LP + r] = (bf16)(vv[c] & 0xffffu); vTL[(qd * 8 + 2 * c + 1) * LP + r] = (bf16)(vv[c] >> 16); }
        }
        if (n + 1 < 16) RET_LOAD(n + 1);
        __syncthreads();
        f32x4 sacc[8];
#pragma unroll
        for (int mt = 0; mt < 8; ++mt) sacc[mt] = (f32x4){0.f, 0.f, 0.f, 0.f};
#pragma unroll
        for (int ks = 0; ks < 4; ++ks) { const bf16x8 bq = *(const LAS bf16x8*)(qL + (16 * w + fr) * LP + 32 * ks + 8 * fq);
#pragma unroll
            for (int mt = 0; mt < 8; ++mt) { const bf16x8 ak = *(const LAS bf16x8*)(kL + (16 * mt + fr) * LP + 32 * ks + 8 * fq); sacc[mt] = __builtin_amdgcn_mfma_f32_16x16x32_bf16(ak, bq, sacc[mt], 0, 0, 0); } }
        const int c = 16 * w + fr;
        bf16x8 pb[4];
#pragma unroll
        for (int sk = 0; sk < 4; ++sk) { unsigned pw[4];
#pragma unroll
            for (int hlf = 0; hlf < 2; ++hlf) { const int mt = 2 * sk + hlf; float pv[4];
#pragma unroll
                for (int rr = 0; rr < 4; ++rr) { const int m = 16 * mt + 4 * fq + rr; pv[rr] = (c >= m) ? sacc[mt][rr] * exp2f(lg2 * (float)(c - m)) : 0.f; }
                pw[2 * hlf] = pk2(pv[0], pv[1]); pw[2 * hlf + 1] = pk2(pv[2], pv[3]); }
            pb[sk] = __builtin_bit_cast(bf16x8, (u32x4){pw[0], pw[1], pw[2], pw[3]}); }
        f32x4 oi[2], oc[2];
#pragma unroll
        for (int et = 0; et < 2; ++et) { oi[et] = (f32x4){0.f, 0.f, 0.f, 0.f}; oc[et] = (f32x4){0.f, 0.f, 0.f, 0.f}; }
#pragma unroll
        for (int ks = 0; ks < 4; ++ks) { const bf16x8 bq = *(const LAS bf16x8*)(qL + (16 * w + fr) * LP + 32 * ks + 8 * fq);
#pragma unroll
            for (int et = 0; et < 2; ++et) { const u32x2 v0 = *(const LAS u32x2*)(vTL + (16 * et + fr) * LP + 32 * ks + 4 * fq), v1 = *(const LAS u32x2*)(vTL + (16 * et + fr) * LP + 32 * ks + 16 + 4 * fq);
                const bf16x8 av = __builtin_bit_cast(bf16x8, (u32x4){v0.x, v0.y, v1.x, v1.y}); const bf16x8 as = *(const LAS bf16x8*)(STL + (16 * et + fr) * LP + 32 * ks + 8 * fq);
                oi[et] = __builtin_amdgcn_mfma_f32_16x16x32_bf16(av, pb[ks], oi[et], 0, 0, 0); oc[et] = __builtin_amdgcn_mfma_f32_16x16x32_bf16(as, bq, oc[et], 0, 0, 0); } }
        { const float qd = exp2f(lg2 * (float)(c + 1));
#pragma unroll
          for (int et = 0; et < 2; ++et) *(f32x4*)(reto + (size_t)(t0 + c) * RW + h * 128 + eb * 32 + 16 * et + 4 * fq) = oi[et] + oc[et] * qd; }
        __syncthreads();
#pragma unroll
        for (int et = 0; et < 2; ++et) st[et] = st[et] * dec;
#pragma unroll
        for (int ks = 0; ks < 4; ++ks) { const bf16x8 bk = *(const LAS bf16x8*)(kTL + (16 * w + fr) * LP + 32 * ks + 8 * fq);
#pragma unroll
            for (int et = 0; et < 2; ++et) { const bf16x8 av = *(const LAS bf16x8*)(vTL + (16 * et + fr) * LP + 32 * ks + 8 * fq); st[et] = __builtin_amdgcn_mfma_f32_16x16x32_bf16(av, bk, st[et], 0, 0, 0); } }
#pragma unroll
        for (int et = 0; et < 2; ++et)
#pragma unroll
            for (int rr = 0; rr < 4; ++rr) STL[(16 * et + 4 * fq + rr) * LP + 16 * w + fr] = f2bf(st[et][rr]);
    }
#undef RET_LOAD
    __syncthreads();
}

struct LruIn { bf16x8 bA[4], bX[4]; unsigned xr[19]; f32x2 w0, w1, w2, w3, bc; float bav, bxv, lamv; };
__device__ __forceinline__ void lru_issue(Ctx& F, int item, LruIn& L) {
    const int lane = F.lane, w = F.wave, fr = lane & 15, fq = lane >> 4;
    const int b = item >> 7, n = (item >> 3) & 15, g = item & 7; const int ch = g * 128 + 2 * lane;
    const bf16* Wa = (const bf16*)(F.ws + WS_WA) + (size_t)g * 128 * 128 + (size_t)(16 * w + fr) * 128 + 8 * fq; const bf16* Wx = (const bf16*)(F.ws + WS_WX) + (size_t)g * 128 * 128 + (size_t)(16 * w + fr) * 128 + 8 * fq;
#pragma unroll
    for (int ks = 0; ks < 4; ++ks) { L.bA[ks] = *(const bf16x8*)(Wa + 32 * ks); L.bX[ks] = *(const bf16x8*)(Wx + 32 * ks); }
    const float* wconv = (const float*)F.in[7];
    L.w0 = *(const f32x2*)(wconv + ch); L.w1 = *(const f32x2*)(wconv + LW + ch); L.w2 = *(const f32x2*)(wconv + 2 * LW + ch); L.w3 = *(const f32x2*)(wconv + 3 * LW + ch); L.bc = *(const f32x2*)((const float*)F.in[8] + ch);
    const int cj = g * 128 + 16 * w + fr; L.bav = ((const float*)F.in[10])[cj]; L.bxv = ((const float*)F.in[12])[cj]; L.lamv = ((const float*)F.in[13])[cj];
    const int s0 = n * 128 + 16 * w; const bf16* p = (const bf16*)(F.ws + WS_PROJ) + (size_t)(b * SEQ) * NIN + 4 * RW + ch;
#pragma unroll
    for (int i = 0; i < 19; ++i) { const int sp = s0 - 3 + i; L.xr[i] = (sp >= 0) ? *(const unsigned*)(p + (size_t)sp * NIN) : 0u; }
}
__device__ __forceinline__ void lru_body(Ctx& F, int item, const LruIn& L) {
    const int lane = F.lane, w = F.wave, fr = lane & 15, fq = lane >> 4;
    const int b = item >> 7, n = (item >> 3) & 15, g = item & 7;
    LAS bf16* xcL = (LAS bf16*)(F.lds); LAS float* aL = (LAS float*)(F.lds + 34816); LAS bf16* mL = (LAS bf16*)(F.lds + 34816 + 65536); LAS float* segA = (LAS float*)(F.lds + 34816 + 65536 + 32768); LAS float* segB = segA + 1024;
    const int cp = lane, sg = w, ch = g * 128 + 2 * cp;
    float xc[16][2];
#pragma unroll
    for (int i = 0; i < 16; ++i) {
        xc[i][0] = L.bc.x + L.w0.x * bflo(L.xr[i]) + L.w1.x * bflo(L.xr[i + 1]) + L.w2.x * bflo(L.xr[i + 2]) + L.w3.x * bflo(L.xr[i + 3]);
        xc[i][1] = L.bc.y + L.w0.y * bfhi(L.xr[i]) + L.w1.y * bfhi(L.xr[i + 1]) + L.w2.y * bfhi(L.xr[i + 2]) + L.w3.y * bfhi(L.xr[i + 3]);
        *(LAS unsigned*)(xcL + (16 * sg + i) * LP + 2 * cp) = pk2(xc[i][0], xc[i][1]); }
    __syncthreads();
    {
        const int j = 16 * w + fr; const float bav = L.bav, bxv = L.bxv, sp8 = -8.0f * log1pf(__expf(-L.lamv));
#pragma unroll 2
        for (int tt = 0; tt < 8; ++tt) { f32x4 ra = (f32x4){0.f, 0.f, 0.f, 0.f}, rx = (f32x4){0.f, 0.f, 0.f, 0.f};
#pragma unroll
            for (int ks = 0; ks < 4; ++ks) { const bf16x8 a = *(const LAS bf16x8*)(xcL + (16 * tt + fr) * LP + 32 * ks + 8 * fq);
                ra = __builtin_amdgcn_mfma_f32_16x16x32_bf16(a, L.bA[ks], ra, 0, 0, 0); rx = __builtin_amdgcn_mfma_f32_16x16x32_bf16(a, L.bX[ks], rx, 0, 0, 0); }
#pragma unroll
            for (int rr = 0; rr < 4; ++rr) { const int t = 16 * tt + 4 * fq + rr;
                const float rgt = __builtin_amdgcn_rcpf(1.0f + __expf(-(ra[rr] + bav))), igt = __builtin_amdgcn_rcpf(1.0f + __expf(-(rx[rr] + bxv)));
                const float av = __expf(sp8 * rgt); const float mu = sqrtf(fmaxf(1.0f - av * av, 0.f)) * igt;
                aL[t * 128 + j] = av; mL[t * 128 + j] = f2bf(mu); } }
    }
    __syncthreads();
    {
        float h0 = 0.f, h1 = 0.f, P0 = 1.f, P1 = 1.f;
#pragma unroll
        for (int i = 0; i < 16; ++i) { const int t = 16 * sg + i; const f32x2 av = *(const LAS f32x2*)(aL + t * 128 + 2 * cp); const unsigned mw = *(const LAS unsigned*)(mL + t * 128 + 2 * cp);
            h0 = av.x * h0 + bflo(mw) * xc[i][0]; h1 = av.y * h1 + bfhi(mw) * xc[i][1]; P0 *= av.x; P1 *= av.y; }
        *(LAS f32x2*)(segA + sg * 128 + 2 * cp) = (f32x2){P0, P1}; *(LAS f32x2*)(segB + sg * 128 + 2 * cp) = (f32x2){h0, h1};
    }
    __syncthreads();
    {
        float c0 = 0.f, c1 = 0.f, Q0 = 1.f, Q1 = 1.f;
        for (int s = 0; s < sg; ++s) { const f32x2 A = *(const LAS f32x2*)(segA + s * 128 + 2 * cp), Bv = *(const LAS f32x2*)(segB + s * 128 + 2 * cp); c0 = A.x * c0 + Bv.x; c1 = A.y * c1 + Bv.y; Q0 *= A.x; Q1 *= A.y; }
        bf16* hl = (bf16*)(F.ws + WS_HLOC) + (size_t)(b * SEQ + n * 128 + 16 * sg) * LW + ch; bf16* pl = (bf16*)(F.ws + WS_PLOC) + (size_t)(b * SEQ + n * 128 + 16 * sg) * LW + ch;
        float h0 = c0, h1 = c1, P0 = Q0, P1 = Q1;
#pragma unroll
        for (int i = 0; i < 16; ++i) { const int t = 16 * sg + i; const f32x2 av = *(const LAS f32x2*)(aL + t * 128 + 2 * cp); const unsigned mw = *(const LAS unsigned*)(mL + t * 128 + 2 * cp);
            h0 = av.x * h0 + bflo(mw) * xc[i][0]; h1 = av.y * h1 + bfhi(mw) * xc[i][1]; P0 *= av.x; P1 *= av.y;
            *(unsigned*)(hl + (size_t)i * LW) = pk2(h0, h1); *(unsigned*)(pl + (size_t)i * LW) = pk2(P0, P1); }
        if (sg == 7) { *(f32x2*)((float*)(F.ws + WS_AGGA) + (size_t)(b * 16 + n) * LW + ch) = (f32x2){P0, P1}; *(f32x2*)((float*)(F.ws + WS_AGGB) + (size_t)(b * 16 + n) * LW + ch) = (f32x2){h0, h1}; }
    }
    __syncthreads();
}

__device__ __forceinline__ void p4_item(Ctx& F, int item) {
    const int tid = F.tid, lane = F.lane, w = F.wave;
    const int b = item >> 5, n = (item & 31) >> 1;
    LAS float* carry = (LAS float*)F.lds;
    const float* aggA = (const float*)(F.ws + WS_AGGA); const float* aggB = (const float*)(F.ws + WS_AGGB);
    __syncthreads();
#pragma unroll
    for (int q = 0; q < 2; ++q) { const int ch = tid + 512 * q; float cin = 0.f;
        for (int jn = 0; jn < n; ++jn) cin = aggA[(size_t)(b * 16 + jn) * LW + ch] * cin + aggB[(size_t)(b * 16 + jn) * LW + ch];
        carry[ch] = cin; }
    __syncthreads();
    const bf16* proj = (const bf16*)(F.ws + WS_PROJ); const float* reto = (const float*)(F.ws + WS_RETO); const bf16* hl = (const bf16*)(F.ws + WS_HLOC); const bf16* pl = (const bf16*)(F.ws + WS_PLOC);
    bf16* cat = (bf16*)(F.ws + WS_CAT); const int c0 = 16 * lane;
    float beta_r[16], beta_l[16], cr[16];
#pragma unroll
    for (int q = 0; q < 4; ++q) { const f32x4 a = *(const f32x4*)((const float*)F.in[14] + c0 + 4 * q), bq = *(const f32x4*)((const float*)F.in[15] + c0 + 4 * q); const f32x4 cq = *(const LAS f32x4*)(carry + c0 + 4 * q);
        beta_r[4 * q] = a.x; beta_r[4 * q + 1] = a.y; beta_r[4 * q + 2] = a.z; beta_r[4 * q + 3] = a.w; beta_l[4 * q] = bq.x; beta_l[4 * q + 1] = bq.y; beta_l[4 * q + 2] = bq.z; beta_l[4 * q + 3] = bq.w;
        cr[4 * q] = cq.x; cr[4 * q + 1] = cq.y; cr[4 * q + 2] = cq.z; cr[4 * q + 3] = cq.w; }
#pragma unroll 2
    for (int rr = 0; rr < 8; ++rr) {
        const int t = item * 64 + 8 * w + rr;
        {
            float o[16];
#pragma unroll
            for (int q = 0; q < 4; ++q) { const f32x4 v = *(const f32x4*)(reto + (size_t)t * RW + c0 + 4 * q); o[4 * q] = v.x; o[4 * q + 1] = v.y; o[4 * q + 2] = v.z; o[4 * q + 3] = v.w; }
            float s = 0.f;
#pragma unroll
            for (int q = 0; q < 16; ++q) s += o[q];
            s += __shfl_xor(s, 1); s += __shfl_xor(s, 2); s += __shfl_xor(s, 4);
            const float mu = s * (1.0f / 128.0f); float vq = 0.f;
#pragma unroll
            for (int q = 0; q < 16; ++q) { o[q] -= mu; vq += o[q] * o[q]; }
            vq += __shfl_xor(vq, 1); vq += __shfl_xor(vq, 2); vq += __shfl_xor(vq, 4);
            const float rs = rsqrtf(vq * (1.0f / 128.0f) + EPS);
            const u32x4 g0 = *(const u32x4*)(proj + (size_t)t * NIN + 3 * RW + c0), g1 = *(const u32x4*)(proj + (size_t)t * NIN + 3 * RW + c0 + 8);
            float ss = 0.f;
#pragma unroll
            for (int q = 0; q < 8; ++q) { const unsigned gw_ = (q < 4) ? g0[q & 3] : g1[q & 3]; const float ga = bflo(gw_), gb = bfhi(gw_);
                o[2 * q] = siluf_(ga) * (o[2 * q] * rs); o[2 * q + 1] = siluf_(gb) * (o[2 * q + 1] * rs); ss += o[2 * q] * o[2 * q] + o[2 * q + 1] * o[2 * q + 1]; }
            const float rstd = rsqrtf(wave_sum(ss) * (1.0f / RW) + EPS);
            u32x4 w0, w1;
#pragma unroll
            for (int q = 0; q < 4; ++q) { w0[q] = pk2(o[2 * q] * rstd * beta_r[2 * q], o[2 * q + 1] * rstd * beta_r[2 * q + 1]); w1[q] = pk2(o[8 + 2 * q] * rstd * beta_r[8 + 2 * q], o[9 + 2 * q] * rstd * beta_r[9 + 2 * q]); }
            *(u32x4*)(cat + (size_t)t * DM + c0) = w0; *(u32x4*)(cat + (size_t)t * DM + c0 + 8) = w1;
        }
        {
            const u32x4 h0 = *(const u32x4*)(hl + (size_t)t * LW + c0), h1 = *(const u32x4*)(hl + (size_t)t * LW + c0 + 8), p0 = *(const u32x4*)(pl + (size_t)t * LW + c0), p1 = *(const u32x4*)(pl + (size_t)t * LW + c0 + 8);
            const u32x4 y0 = *(const u32x4*)(proj + (size_t)t * NIN + 5 * RW + c0), y1 = *(const u32x4*)(proj + (size_t)t * NIN + 5 * RW + c0 + 8);
            float o[16]; float ss = 0.f;
#pragma unroll
            for (int q = 0; q < 8; ++q) { const unsigned hw = (q < 4) ? h0[q & 3] : h1[q & 3], pw = (q < 4) ? p0[q & 3] : p1[q & 3], yw = (q < 4) ? y0[q & 3] : y1[q & 3];
                const float ha = bflo(hw) + bflo(pw) * cr[2 * q], hb = bfhi(hw) + bfhi(pw) * cr[2 * q + 1];
                o[2 * q] = ha * gelu_tanh_(bflo(yw)); o[2 * q + 1] = hb * gelu_tanh_(bfhi(yw)); ss += o[2 * q] * o[2 * q] + o[2 * q + 1] * o[2 * q + 1]; }
            const float rstd = rsqrtf(wave_sum(ss) * (1.0f / LW) + EPS);
            u32x4 w0, w1;
#pragma unroll
            for (int q = 0; q < 4; ++q) { w0[q] = pk2(o[2 * q] * rstd * beta_l[2 * q], o[2 * q + 1] * rstd * beta_l[2 * q + 1]); w1[q] = pk2(o[8 + 2 * q] * rstd * beta_l[8 + 2 * q], o[9 + 2 * q] * rstd * beta_l[9 + 2 * q]); }
            *(u32x4*)(cat + (size_t)t * DM + RW + c0) = w0; *(u32x4*)(cat + (size_t)t * DM + RW + c0 + 8) = w1;
        }
    }
    __syncthreads();
}

constexpr int HAP = 2056;
template <bool DRY> __device__ __forceinline__ void p6_item(Ctx& F, int item) {
    const int tid = F.tid, lane = F.lane, w = F.wave, fr = lane & 15, fq = lane >> 4;
    const int t0 = item * 64, b = t0 / SEQ;
    LAS bf16* hA = (LAS bf16*)F.lds;
    LAS float* lgt = (LAS float*)(F.lds + 16 * HAP * 2);
    LAS unsigned char* selE = (LAS unsigned char*)(F.lds + 16 * HAP * 2 + 8 * 16 * 65 * 4); LAS unsigned char* selL = selE + 512; LAS unsigned* wcnt = (LAS unsigned*)(selL + 512); LAS unsigned* gb = wcnt + 512;
    const bf16* x1 = (const bf16*)(F.ws + WS_X1); const float* mod = (const float*)(F.ws + WS_MOD) + (size_t)b * 6 * DM; bf16* h2 = (bf16*)(F.ws + WS_H); unsigned char* h8 = F.ws + WS_H8;
    const bf16* Wr = (const bf16*)(F.ws + WS_WR);
    int* eidx = (int*)(F.ws + WS_EIDX); float* wsel = (float*)(F.ws + WS_WSEL); int* slot = (int*)(F.ws + (DRY ? WS_DEST : WS_SLOT)); unsigned* cnt = (unsigned*)(F.ws + WS_CTL) + CW_CNT + (DRY ? 4096 : 0);
    f32x4 gg[4][2];
#pragma unroll
    for (int j = 0; j < 4; ++j)
#pragma unroll
        for (int h = 0; h < 2; ++h) { const int c = 8 * lane + 512 * j + 4 * h; gg[j][h] = *(const f32x4*)((const float*)F.in[17] + c) * (*(const f32x4*)(mod + 4 * DM + c) + 1.0f); }
    const float brl = ((const float*)F.in[19])[lane]; const int g = lane >> 3;
    unsigned lc = 0u;
    bf16x8 bw[2][4];
#pragma unroll
    for (int ks = 0; ks < 2; ++ks)
#pragma unroll
        for (int et = 0; et < 4; ++et) bw[ks][et] = *(const bf16x8*)(Wr + (size_t)(16 * et + fr) * DM + 256 * w + 32 * ks + 8 * fq);
    u32x4 xq[2][4];
#pragma unroll
    for (int i = 0; i < 2; ++i)
#pragma unroll
        for (int j = 0; j < 4; ++j) xq[i][j] = *(const u32x4*)(x1 + (size_t)(t0 + 2 * w + i) * DM + 8 * lane + 512 * j);
    __syncthreads();
#pragma unroll 1
    for (int ps = 0; ps < 4; ++ps) {
#pragma unroll
        for (int i = 0; i < 2; ++i) { const int rl = 2 * w + i, t = t0 + 16 * ps + rl;
            f32x4 v[4][2]; float ss = 0.f;
#pragma unroll
            for (int j = 0; j < 4; ++j) { const u32x4 xw = xq[i][j]; v[j][0] = (f32x4){bflo(xw.x), bfhi(xw.x), bflo(xw.y), bfhi(xw.y)}; v[j][1] = (f32x4){bflo(xw.z), bfhi(xw.z), bflo(xw.w), bfhi(xw.w)};
#pragma unroll
                for (int h = 0; h < 2; ++h) ss += (v[j][h].x * v[j][h].x + v[j][h].y * v[j][h].y) + (v[j][h].z * v[j][h].z + v[j][h].w * v[j][h].w); }
            const float rstd = rsqrtf(wave_sum(ss) * (1.0f / DM) + EPS);
#pragma unroll
            for (int j = 0; j < 4; ++j) { const f32x4 o0 = v[j][0] * rstd * gg[j][0] + *(const f32x4*)(mod + 3 * DM + 8 * lane + 512 * j), o1 = v[j][1] * rstd * gg[j][1] + *(const f32x4*)(mod + 3 * DM + 8 * lane + 512 * j + 4);
                u32x4 wv; wv.x = pk2(o0.x, o0.y); wv.y = pk2(o0.z, o0.w); wv.z = pk2(o1.x, o1.y); wv.w = pk2(o1.z, o1.w);
                *(LAS u32x4*)(hA + rl * HAP + 8 * lane + 512 * j) = wv;
                u32x2 w8; w8.x = pk4_fp8(o0.x * SC_H8, o0.y * SC_H8, o0.z * SC_H8, o0.w * SC_H8); w8.y = pk4_fp8(o1.x * SC_H8, o1.y * SC_H8, o1.z * SC_H8, o1.w * SC_H8);
                *(u32x2*)(h8 + (size_t)t * DM + 8 * lane + 512 * j) = w8; }
            __builtin_amdgcn_sched_barrier(0); }
        __syncthreads();
        {
            f32x4 acc[4];
#pragma unroll
            for (int et = 0; et < 4; ++et) acc[et] = (f32x4){0.f, 0.f, 0.f, 0.f};
            bf16x8 bw2[6][4];
#pragma unroll
            for (int ks = 0; ks < 6; ++ks)
#pragma unroll
                for (int et = 0; et < 4; ++et) bw2[ks][et] = *(const bf16x8*)(Wr + (size_t)(16 * et + fr) * DM + 256 * w + 64 + 32 * ks + 8 * fq);
#pragma unroll
            for (int ks = 0; ks < 2; ++ks) { const bf16x8 a = *(const LAS bf16x8*)(hA + fr * HAP + 256 * w + 32 * ks + 8 * fq);
#pragma unroll
                for (int et = 0; et < 4; ++et) acc[et] = __builtin_amdgcn_mfma_f32_16x16x32_bf16(a, bw[ks][et], acc[et], 0, 0, 0); }
#pragma unroll
            for (int ks = 0; ks < 6; ++ks) { const bf16x8 a = *(const LAS bf16x8*)(hA + fr * HAP + 256 * w + 64 + 32 * ks + 8 * fq);
#pragma unroll
                for (int et = 0; et < 4; ++et) acc[et] = __builtin_amdgcn_mfma_f32_16x16x32_bf16(a, bw2[ks][et], acc[et], 0, 0, 0); }
#pragma unroll
            for (int et = 0; et < 4; ++et)
#pragma unroll
                for (int rr = 0; rr < 4; ++rr) lgt[(w * 16 + 4 * fq + rr) * 65 + 16 * et + fr] = acc[et][rr];
        }
        __syncthreads();
        if (ps + 1 < 4) {
#pragma unroll
            for (int i = 0; i < 2; ++i)
#pragma unroll
                for (int j = 0; j < 4; ++j) xq[i][j] = *(const u32x4*)(x1 + (size_t)(t0 + 16 * (ps + 1) + 2 * w + i) * DM + 8 * lane + 512 * j); }
#pragma unroll 1
        for (int i = 0; i < 2; ++i) {
            const int tl = 2 * w + i, tt = 16 * ps + tl; float z = 0.f;
#pragma unroll
            for (int w2 = 0; w2 < 8; ++w2) z += lgt[(w2 * 16 + tl) * 65 + lane];
            const float s = sigmoidf_(z); const float bsc = s + brl;
            float m1 = bsc; m1 = fmaxf(m1, __shfl_xor(m1, 1)); m1 = fmaxf(m1, __shfl_xor(m1, 2)); m1 = fmaxf(m1, __shfl_xor(m1, 4));
            const unsigned long long eq = __ballot(bsc == m1); const unsigned gm = (unsigned)(eq >> (8 * g)) & 0xffu;
            const bool first = (lane & 7) == (__builtin_ctz(gm | 0x100u) & 7);
            float m2 = first ? -3.0e38f : bsc; m2 = fmaxf(m2, __shfl_xor(m2, 1)); m2 = fmaxf(m2, __shfl_xor(m2, 2)); m2 = fmaxf(m2, __shfl_xor(m2, 4));
            const float gs = m1 + m2;
            int rank_g = 0;
#pragma unroll
            for (int g2 = 0; g2 < 8; ++g2) { const float o = __int_as_float(__builtin_amdgcn_readlane(__float_as_int(gs), 8 * g2)); rank_g += (o > gs || (o == gs && g2 < g)) ? 1 : 0; }
            const bool selg = rank_g < 4;
            const float key = selg ? bsc : -3.0e38f;
            int rank = 0;
#pragma unroll
            for (int e2 = 0; e2 < 64; ++e2) { const float o = __int_as_float(__builtin_amdgcn_readlane(__float_as_int(key), e2)); rank += (o > key || (o == key && e2 < lane)) ? 1 : 0; }
            const bool chosen = selg && rank < 8;
            const float wsum = wave_sum(chosen ? s : 0.f);
            if (chosen) { const int t = t0 + tt; eidx[t * 8 + rank] = lane; wsel[t * 8 + rank] = s * (2.5f / wsum); selE[tt * 8 + rank] = (unsigned char)lane; selL[tt * 8 + rank] = (unsigned char)lc; }
            lc += chosen ? 1u : 0u;
        }
        __syncthreads();
    }
    wcnt[w * 64 + lane] = lc;
    __syncthreads();
    if (w == 0) { unsigned tot = 0u;
#pragma unroll
        for (int w2 = 0; w2 < 8; ++w2) tot += wcnt[w2 * 64 + lane];
        gb[lane] = tot ? __hip_atomic_fetch_add(cnt + 32 * lane, tot, __ATOMIC_RELAXED, __HIP_MEMORY_SCOPE_AGENT) : 0u; }
    __syncthreads();
    { const int tok = tid >> 3, k = tid & 7, e = selE[tok * 8 + k], wt = (tok & 15) >> 1; unsigned off = gb[e] + selL[tok * 8 + k];
        for (int w2 = 0; w2 < wt; ++w2) off += wcnt[w2 * 64 + e];
        slot[(t0 + tok) * 8 + k] = (int)off; if (!DRY) ((int*)(F.ws + WS_TOKOF))[(size_t)e * T + off] = t0 + tok; }
    __syncthreads();
}

__device__ __forceinline__ void p7_scatter(Ctx& F) {
    LAS int* ps = (LAS int*)F.lds; const unsigned* cnt = (const unsigned*)(F.ws + WS_CTL) + CW_CNT;
    __syncthreads();
    if (F.tid < NE) ps[64 + F.tid] = (((int)ld_agent(cnt + 32 * F.tid) + 255) >> 8) << 8;
    __syncthreads();
    if (F.tid < NE) { int acc = 0; for (int e = 0; e < F.tid; ++e) acc += ps[64 + e]; ps[F.tid] = acc; }
    __syncthreads();
    const int* eidx = (const int*)(F.ws + WS_EIDX); const int* slot = (const int*)(F.ws + WS_SLOT);
    int* dest = (int*)(F.ws + WS_DEST); int* rtok = (int*)(F.ws + WS_RTOK);
    for (int a = F.vcu * NWAVES * 64 + F.tid; a < T * TOPK; a += F.G * NWAVES * 64) { const int e = eidx[a]; const int d = ps[e] + slot[a]; dest[a] = d; rtok[d] = a >> 3; }
    __syncthreads();
}

__device__ __forceinline__ void p10_final(Ctx& F) {
    const int gw = F.vcu * NWAVES + F.wave, NGW = F.G * NWAVES, lane = F.lane;
    const bf16* x1 = (const bf16*)(F.ws + WS_X1); const unsigned char* y = F.ws + WS_Y; const int* eidx = (const int*)(F.ws + WS_EIDX); const int* slot = (const int*)(F.ws + WS_SLOT); const float* wsel = (const float*)(F.ws + WS_WSEL); const float* gf = (const float*)F.in[24];
    LAS int* ps = (LAS int*)F.lds; const unsigned* cnt = (const unsigned*)(F.ws + WS_CTL) + CW_CNT;
    __syncthreads();
    if (F.tid < NE) ps[64 + F.tid] = (((int)ld_agent(cnt + 32 * F.tid) + 255) >> 8) << 8;
    __syncthreads();
    if (F.tid < NE) { int acc = 0; for (int e = 0; e < F.tid; ++e) acc += ps[64 + e]; ps[F.tid] = acc; }
    __syncthreads();
    for (int t = gw; t < T; t += NGW) { const int b = t / SEQ; const float* gt2 = (const float*)(F.ws + WS_MOD) + (size_t)b * 6 * DM + 5 * DM;
        int rows[9]; float wk[9];
#pragma unroll
        for (int k = 0; k < 8; ++k) { rows[k] = ps[ld_agent_i(eidx + t * 8 + k)] + ld_agent_i(slot + t * 8 + k); wk[k] = wsel[t * 8 + k] * (1.0f / SC_Y); }
        rows[8] = NR_ROUTED + t; wk[8] = 1.0f / SC_Y;
        float ss = 0.f; f32x4 v[4][2];
#pragma unroll
        for (int j = 0; j < 4; ++j) { const int c = 8 * lane + 512 * j; float s[8];
#pragma unroll
            for (int q = 0; q < 8; ++q) s[q] = 0.f;
#pragma unroll
            for (int k = 0; k < 9; ++k) { const u32x2 yv = *(const u32x2*)(y + (size_t)rows[k] * DM + c);
#pragma unroll
                for (int q = 0; q < 2; ++q) { const f32x2 lo = __builtin_amdgcn_cvt_pk_f32_fp8((int)yv[q], false), hi = __builtin_amdgcn_cvt_pk_f32_fp8((int)yv[q], true);
                    s[4 * q] += wk[k] * lo.x; s[4 * q + 1] += wk[k] * lo.y; s[4 * q + 2] += wk[k] * hi.x; s[4 * q + 3] += wk[k] * hi.y; } }
            const u32x4 xw = *(const u32x4*)(x1 + (size_t)t * DM + c);
#pragma unroll
            for (int hh = 0; hh < 2; ++hh) { const f32x4 xv = hh ? (f32x4){bflo(xw.z), bfhi(xw.z), bflo(xw.w), bfhi(xw.w)} : (f32x4){bflo(xw.x), bfhi(xw.x), bflo(xw.y), bfhi(xw.y)}, gv = *(const f32x4*)(gt2 + c + 4 * hh);
                v[j][hh] = xv + gv * (f32x4){s[4 * hh], s[4 * hh + 1], s[4 * hh + 2], s[4 * hh + 3]};
                ss += (v[j][hh].x * v[j][hh].x + v[j][hh].y * v[j][hh].y) + (v[j][hh].z * v[j][hh].z + v[j][hh].w * v[j][hh].w); } }
        const float rstd = rsqrtf(wave_sum(ss) * (1.0f / DM) + EPS);
#pragma unroll
        for (int j = 0; j < 4; ++j)
#pragma unroll
            for (int hh = 0; hh < 2; ++hh) { const int c = 8 * lane + 512 * j + 4 * hh; *(f32x4*)(F.out + (size_t)t * DM + c) = v[j][hh] * rstd * *(const f32x4*)(gf + c); }
    }
}

__global__ void __launch_bounds__(NWAVES * 64, 2) fwd_kernel(Args args) {
    extern __shared__ __attribute__((aligned(16))) unsigned char lds_raw[];
    Ctx F;
    F.lds = (LAS unsigned char*)lds_raw; F.ws = args.ws; F.in = args.in; F.out = args.out;
    F.tid = threadIdx.x; F.lane = F.tid & 63; F.wave = __builtin_amdgcn_readfirstlane(F.tid >> 6);
    F.G = gridDim.x; { const int bx = blockIdx.x; F.vcu = (F.G % 8 == 0) ? (bx % 8) * (F.G / 8) + bx / 8 : bx; }
    if (F.tid < 16) ((LAS unsigned*)(F.lds + MISC_OFF))[F.tid] = 0u;
    __syncthreads();
    unsigned* ctl = (unsigned*)(F.ws + WS_CTL);
#if N_LAUNCHES == 1
    XcdBarrier bar = xcd_barrier_post(ctl + CW_BAR, (volatile LAS unsigned*)(F.lds + MISC_OFF));
#define GRID_BAR() xcd_barrier(bar)
#else
#define GRID_BAR() do { } while (0)
#endif
    const int lo = args.ph_lo, hi = args.ph_hi;
#define IN(k) (lo <= (k) && (k) < hi)
#define BOTH(k) (IN(k) && IN((k) + 1))
    const int NIT = F.G;

#define REP(k) _Pragma("unroll") for (int rep_ = 0; rep_ < ((PROBE_PHASE == (k)) ? 2 : 1); ++rep_)
    if (IN(0)) { p0_adaln(F); p0_prologue(F); if (BOTH(0)) p0_wait_mod(F); }
    if (IN(1)) { REP(1) { p1_norm(F); } if (BOTH(1)) GRID_BAR(); if (PROBE_PHASE == 100) { GRID_BAR(); GRID_BAR(); GRID_BAR(); GRID_BAR(); } }
    if (IN(2)) {
        if (F.vcu & 1) p2_convert_experts(F);
        REP(2) {
        g8::DenseOrder S; S.init(F.ws + WS_H, F.ws + WS_WIN, T, NIN, DM * 2, F.G, (int)blockIdx.x);
        EpiProj E{(bf16*)(F.ws + WS_PROJ)};
        g8::gemm_phase<EpiProj, g8::DenseOrder>(F.lds, DM * 2, S, E);
        }
        if (!(F.vcu & 1)) p2_convert_experts(F);
        if (BOTH(2)) GRID_BAR();
    }
    if (IN(3)) {
        for (int it = F.vcu; it < NB * 8 * 4 * ((PROBE_PHASE == 31) ? 2 : 1); it += NIT) ret_item(F, it & 255);
        {
            LruIn La, Lb; int it = F.vcu; const int NL = NB * 16 * 8;
            __syncthreads();
            if (it < NL) lru_issue(F, it, La);
            while (it < NL) {
                if (it + NIT < NL) lru_issue(F, it + NIT, Lb);
                lru_body(F, it, La); it += NIT;
                if (it >= NL) break;
                if (it + NIT < NL) lru_issue(F, it + NIT, La);
                lru_body(F, it, Lb); it += NIT;
            }
        }
        if (BOTH(3)) GRID_BAR();
    }
    if (IN(4)) { REP(4) { for (int it = F.vcu; it < T / 64; it += NIT) p4_item(F, it); } if (BOTH(4)) GRID_BAR(); }
    if (IN(5)) {
        REP(5) {
        g8::DenseOrder S; S.init(F.ws + WS_CAT, F.ws + WS_WOUT, T, DM, DM * 2, F.G, (int)blockIdx.x);
        EpiWout E{(const float*)F.in[0], (const float*)(F.ws + WS_MOD), (bf16*)(F.ws + WS_X1)};
        g8::gemm_phase<EpiWout, g8::DenseOrder>(F.lds, DM * 2, S, E);
        }
        if (BOTH(5)) GRID_BAR();
    }
    if (IN(6)) { for (int it = F.vcu; it < T / 64; it += NIT) p6_item<false>(F, it); if (PROBE_PHASE == 6) { for (int it = F.vcu; it < T / 64; it += NIT) p6_item<true>(F, it); } if (BOTH(6)) GRID_BAR(); }
    if (IN(8)) {
        REP(8) {
        const int ntiles = moe_build_tables(F);
        MoeOrder<1> S; S.init(F, ntiles);
        EpiSwiglu E{F.ws + WS_ACT};
        g8::gemm_phase<EpiSwiglu, MoeOrder<1>, true>(F.lds, DM, S, E);
        }
        if (BOTH(8)) GRID_BAR();
    }
    if (IN(9)) {
        REP(9) {
        const int ntiles = moe_build_tables(F);
        MoeOrder<2> S; S.init(F, ntiles);
        EpiDown E{F.ws + WS_Y};
        g8::gemm_phase<EpiDown, MoeOrder<2>, true>(F.lds, EH, S, E);
        }
        if (BOTH(9)) GRID_BAR();
    }
    if (IN(10)) { REP(10) { p10_final(F); } }
#undef REP
#undef IN
#undef BOTH
}

extern "C" void kernel_launch(void* const* d_in, const int* in_sizes, int n_in, void* d_out, int out_size, void* d_ws, size_t ws_size, hipStream_t stream) {
    static int grid = 0;
    if (grid == 0) {
        if (n_in != 25 || out_size != T * DM || ws_size < WS_END) { fprintf(stderr, "kernel_launch: unexpected problem (n_in %d, out %d, ws %zu)\n", n_in, out_size, ws_size); grid = -1; return; }
        int dev = 0, cus = 0, per_cu = 0;
        if (hipGetDevice(&dev) != hipSuccess || hipDeviceGetAttribute(&cus, hipDeviceAttributeMultiprocessorCount, dev) != hipSuccess) { grid = -1; return; }
        if (hipFuncSetAttribute((const void*)fwd_kernel, hipFuncAttributeMaxDynamicSharedMemorySize, LDS_BYTES) != hipSuccess) { fprintf(stderr, "kernel_launch: hipFuncSetAttribute failed\n"); grid = -1; return; }
        if (hipOccupancyMaxActiveBlocksPerMultiprocessor(&per_cu, (const void*)fwd_kernel, NWAVES * 64, LDS_BYTES) != hipSuccess || per_cu < 1) { fprintf(stderr, "kernel_launch: occupancy query says %d\n", per_cu); }
        (void)hipGetLastError();
        grid = cus;
    }
    if (grid < 0) return;
    (void)hipMemsetAsync((char*)d_ws + WS_CTL, 0, CTL_ZERO_BYTES, stream);
    Args a{};
    for (int i = 0; i < 25; ++i) a.in[i] = d_in[i];
    a.out = (float*)d_out; a.ws = (unsigned char*)d_ws;
#if N_LAUNCHES == 1
    a.ph_lo = 0; a.ph_hi = 11;
    hipLaunchKernelGGL(fwd_kernel, dim3(grid), dim3(NWAVES * 64), LDS_BYTES, stream, a);
#else
    for (int p = 0; p < 11; ++p) { a.ph_lo = p; a.ph_hi = p + 1; hipLaunchKernelGGL(fwd_kernel, dim3(grid), dim3(NWAVES * 64), LDS_BYTES, stream, a); }
#endif
}
```

```cpp
#include <hip/hip_runtime.h>
#include <cstdio>
#include <cstdint>

#ifndef PROBE_PHASE
#define PROBE_PHASE -1
#endif
#ifndef N_LAUNCHES
#define N_LAUNCHES 1
#endif

#define LAS __attribute__((address_space(3)))
typedef unsigned short bf16;
typedef short bf16x8 __attribute__((ext_vector_type(8)));
typedef float f32x4 __attribute__((ext_vector_type(4)));
typedef float f32x2 __attribute__((ext_vector_type(2)));
typedef unsigned u32x4 __attribute__((ext_vector_type(4)));
typedef unsigned u32x2 __attribute__((ext_vector_type(2)));
typedef int i32x4 __attribute__((ext_vector_type(4)));
typedef int i32x8 __attribute__((ext_vector_type(8)));

constexpr int NB = 8, SEQ = 2048, DM = 2048, T = NB * SEQ;
constexpr int NIN = 6144, RW = 1024, LW = 1024, NE = 64, EH = 512, TOPK = 8;
constexpr int NR_ROUTED = T * TOPK + NE * 256;
constexpr int NR = NR_ROUTED + T;
constexpr int NWAVES = 8;
constexpr float EPS = 1e-6f;
constexpr float SC_H8 = 16.0f, SC_WEI = 64.0f, SC_ACT = 8.0f, SC_WEO = 4.0f, SC_Y = 32.0f;

constexpr size_t MiB = 1u << 20;
constexpr size_t WS_CTL = 0, CTL_ZERO_BYTES = 2 * MiB;
constexpr size_t WS_MOD = 1 * MiB;
constexpr size_t WS_ROPE = 2 * MiB;
constexpr size_t WS_WIN = 10 * MiB;
constexpr size_t WS_WOUT = 34 * MiB;
constexpr size_t WS_WR = 42 * MiB;
constexpr size_t WS_WA = WS_WR + 256 * 1024;
constexpr size_t WS_WX = WS_WA + 256 * 1024;
constexpr size_t WS_WEI = 44 * MiB;
constexpr size_t WS_H8 = 176 * MiB;
constexpr size_t WS_WEO = 304 * MiB;
constexpr size_t WS_H = 434 * MiB;
constexpr size_t WS_X1 = 500 * MiB;
constexpr size_t WS_EIDX = 628 * MiB;
constexpr size_t WS_WSEL = WS_EIDX + 512 * 1024;
constexpr size_t WS_SLOT = WS_WSEL + 512 * 1024;
constexpr size_t WS_DEST = WS_SLOT + 512 * 1024;
constexpr size_t WS_RTOK = WS_DEST + 512 * 1024;
constexpr size_t WS_RW = WS_RTOK + 640 * 1024;
constexpr size_t WS_AGGA = 632 * MiB;
constexpr size_t WS_AGGB = WS_AGGA + 512 * 1024;
constexpr size_t WS_ACT = 634 * MiB;
constexpr size_t WS_PROJ = 794 * MiB;
constexpr size_t WS_RETO = 986 * MiB;
constexpr size_t WS_HLOC = 1050 * MiB;
constexpr size_t WS_PLOC = 1082 * MiB;
constexpr size_t WS_CAT = 1114 * MiB;
constexpr size_t WS_Y = 794 * MiB;
constexpr size_t WS_TOKOF = 1434 * MiB;
constexpr size_t WS_END = 1438 * MiB;
constexpr int CW_BAR = 4096;
constexpr int CW_CNT = 8192;
constexpr int CW_MODCNT = 16384;

constexpr int RING_BYTES = 131072;
constexpr int LDS_BYTES = 147456;
constexpr int TT_OFF = 137216;
constexpr int MISC_OFF = LDS_BYTES - 256;
static_assert(TT_OFF + (2 * 704 + 80 + 68) * 4 <= MISC_OFF, "LDS map");
constexpr int MAXTILES = 704;

__device__ __forceinline__ unsigned pk2(float lo, float hi) { unsigned r; asm volatile("v_cvt_pk_bf16_f32 %0, %1, %2" : "=v"(r) : "v"(lo), "v"(hi)); return r; }
__device__ __forceinline__ bf16 f2bf(float f) { unsigned u = __float_as_uint(f); u += 0x7FFFu + ((u >> 16) & 1u); return (bf16)(u >> 16); }
__device__ __forceinline__ float bf2f(bf16 b) { return __uint_as_float(((unsigned)b) << 16); }
__device__ __forceinline__ float bflo(unsigned w) { return __uint_as_float(w << 16); }
__device__ __forceinline__ float bfhi(unsigned w) { return __uint_as_float(w & 0xffff0000u); }
__device__ __forceinline__ float wave_sum(float v) {
#pragma unroll
    for (int o = 1; o < 64; o <<= 1) v += __shfl_xor(v, o);
    return v;
}
__device__ __forceinline__ float sigmoidf_(float x) { return 1.0f / (1.0f + __expf(-x)); }
__device__ __forceinline__ float siluf_(float x) { return x / (1.0f + __expf(-x)); }
__device__ __forceinline__ float gelu_tanh_(float x) { const float u = 0.7978845608028654f * (x + 0.044715f * x * x * x); const float e = __expf(2.0f * u); const float th = 1.0f - 2.0f / (e + 1.0f); return 0.5f * x * (1.0f + th); }
__device__ __forceinline__ unsigned ld_agent(const unsigned* p) { return __hip_atomic_load(p, __ATOMIC_RELAXED, __HIP_MEMORY_SCOPE_AGENT); }
__device__ __forceinline__ int ld_agent_i(const int* p) { return (int)__hip_atomic_load((const unsigned*)p, __ATOMIC_RELAXED, __HIP_MEMORY_SCOPE_AGENT); }
__device__ __forceinline__ float clamp448(float x) { return __builtin_amdgcn_fmed3f(x, -448.0f, 448.0f); }
__device__ __forceinline__ unsigned pk4_fp8(float a, float b, float c, float d) { int w = 0; w = __builtin_amdgcn_cvt_pk_fp8_f32(clamp448(a), clamp448(b), w, false); w = __builtin_amdgcn_cvt_pk_fp8_f32(clamp448(c), clamp448(d), w, true); return (unsigned)w; }
#define LDS_WAIT() asm volatile("s_waitcnt lgkmcnt(0)" ::: "memory")
#define VM_WAIT() asm volatile("s_waitcnt vmcnt(0)" ::: "memory")

#define XB_TMO      128
#define XB_XCNT(j)  (256  + 64 * (j))
#define XB_XSUB(j)  (1280 + 64 * (j))
#define XB_XGEN(j)  (2304 + 64 * (j))
#define XB_TOP      3328
#define XB_TOPGEN   3392
#define XCD_BAR_WORDS 3456
#define XB_SPIN_CAP (1u << 18)
__device__ __forceinline__ unsigned xb_ld(unsigned* p)              { return __hip_atomic_load(p, __ATOMIC_RELAXED, __HIP_MEMORY_SCOPE_AGENT); }
__device__ __forceinline__ unsigned xb_add(unsigned* p, unsigned v) { return __hip_atomic_fetch_add(p, v, __ATOMIC_RELAXED, __HIP_MEMORY_SCOPE_AGENT); }
__device__ __forceinline__ unsigned xb_xcc_id() { return (unsigned)__builtin_amdgcn_s_getreg((3 << 11) | 20) & 0xFu; }
#define XB_SPIN(cond, bar) do { unsigned _sp = 0; while (cond) { __builtin_amdgcn_s_sleep(1); \
    if ((++_sp & 255u) == 0u) { if (xb_ld(&(bar)[XB_TMO])) break; if (_sp > XB_SPIN_CAP) { atomicAdd(&(bar)[XB_TMO], 1u); break; } } } } while (0)
struct XcdBarrier { unsigned* bar; unsigned x; volatile LAS unsigned* st; };
__device__ __forceinline__ XcdBarrier xcd_barrier_post(unsigned* bar, volatile LAS unsigned* st) {
    XcdBarrier b; b.bar = bar; b.x = xb_xcc_id(); b.st = st;
    if (threadIdx.x == 0) (void)xb_add(&bar[XB_XCNT(b.x)], 1u);
    return b;
}
__device__ __forceinline__ void xcd_barrier_complete(unsigned* bar, unsigned x, unsigned& nloc, unsigned& nx) {
    const unsigned G = gridDim.x * gridDim.y * gridDim.z;
    unsigned sum, cnt, mine, sp = 0u;
    for (;;) {
        sum = 0u; cnt = 0u; mine = 0u;
#pragma unroll
        for (unsigned j = 0; j < 16; ++j) { const unsigned c = xb_ld(&bar[XB_XCNT(j)]); sum += c; cnt += (c > 0u) ? 1u : 0u; mine = (j == x) ? c : mine; }
        if (sum == G) break;
        __builtin_amdgcn_s_sleep(1);
        if ((++sp & 255u) == 0u) { if (xb_ld(&bar[XB_TMO])) break; if (sp > XB_SPIN_CAP) { atomicAdd(&bar[XB_TMO], 1u); break; } }
    }
    nloc = mine > 0u ? mine : 1u; nx = cnt > 0u ? cnt : 1u;
}
__device__ __forceinline__ void xcd_barrier(const XcdBarrier& b) {
    asm volatile("s_waitcnt vmcnt(0)" ::: "memory");
    __syncthreads();
    if (threadIdx.x == 0) {
        unsigned* bar = b.bar;
        __builtin_amdgcn_s_waitcnt(0);
        unsigned nloc = b.st[0], nx = b.st[1];
        if (nloc == 0u) { xcd_barrier_complete(bar, b.x, nloc, nx); b.st[0] = nloc; b.st[1] = nx; }
        const unsigned old = xb_add(&bar[XB_XSUB(b.x)], 1u);
        const unsigned gen = old / nloc;
        if (old + 1u == (gen + 1u) * nloc) {
            __builtin_amdgcn_fence(__ATOMIC_RELEASE, "agent");
            asm volatile("s_waitcnt vmcnt(0)" ::: "memory");
            const unsigned og = xb_add(&bar[XB_TOP], 1u);
            const unsigned tg = og / nx;
            if (og + 1u == (tg + 1u) * nx) xb_add(&bar[XB_TOPGEN], 1u);
            else XB_SPIN(xb_ld(&bar[XB_TOPGEN]) == tg, bar);
            __builtin_amdgcn_fence(__ATOMIC_ACQUIRE, "agent");
            xb_add(&bar[XB_XGEN(b.x)], 1u);
            asm volatile("s_waitcnt vmcnt(0)" ::: "memory");
        } else {
            XB_SPIN(xb_ld(&bar[XB_XGEN(b.x)]) == gen, bar);
            __builtin_amdgcn_fence(__ATOMIC_ACQUIRE, "agent");
            asm volatile("s_waitcnt vmcnt(0)" ::: "memory");
        }
    }
    __syncthreads();
}

namespace g8 {
constexpr int BM = 256, BK = 64, HALF = 128, HTB = HALF * BK * 2, NXCD = 8, WGM = 8;
__device__ __forceinline__ int lds_byte(int r, int c) { const int st = (r >> 4) * 2 + (c >> 5), rr = r & 15, cc = c & 31, ob = rr * 64 + cc * 2; return st * 1024 + (ob ^ (((ob >> 9) & 1) << 5)); }
__device__ __forceinline__ void stage_rc(int b, int& R, int& C) { const int st = b / 1024, sb = b % 1024, swz = sb ^ (((sb >> 9) & 1) << 5); R = (st >> 1) * 16 + swz / 64; C = (st & 1) * 32 + (swz % 64) / 2; }
__device__ __forceinline__ int perm32(int rho) { const int n = rho >> 4, i = rho & 15; return 8 * (i >> 2) + 4 * n + (i & 3); }

struct Unit { const char* A; const char* B; unsigned vA0[2], vA1[2]; int r0, pn, e, rend; };

template <class Epi, class Sched, bool F8 = false>
__device__ __forceinline__ void gemm_phase(LAS unsigned char* lds, const int pitch, const Sched& S, const Epi& E) {
    const int tid = threadIdx.x, wid = __builtin_amdgcn_readfirstlane(tid >> 6), lane = tid & 63, wr = wid >> 2, wc = wid & 3, fr = lane & 15, fq = lane >> 4;
    const int nt = pitch / 128;
    unsigned voffB[2], voffB1[2];
#pragma unroll
    for (int i = 0; i < 2; ++i) { int R, C; stage_rc(tid * 16 + i * 8192, R, C); const int p = perm32(R & 31);
        if constexpr (Epi::P16) { const int base = 64 * (R >> 5) + 16 * (p >> 3) + (p & 7); voffB[i] = (unsigned)(base * pitch + C * 2); voffB1[i] = (unsigned)((base + 8) * pitch + C * 2); }
        else { const int Rb = Epi::PERM ? ((R & ~31) + p) : R; voffB[i] = (unsigned)(Rb * pitch + C * 2); voffB1[i] = voffB[i] + (unsigned)(HALF * pitch); } }
    const size_t kstep = 128;
    const size_t hstepB = (size_t)HALF * pitch;
    const unsigned ldsw = (unsigned)wid * 1024u;
    const int aoff = lds_byte(wr * 64 + fr, fq * 8), boff = lds_byte(wc * 32 + fr, fq * 8);
#define G8_SA(b, h) (((b) * 2 + (h)) * HTB)
#define G8_SB(b, h) ((4 + (b) * 2 + (h)) * HTB)
#define G8_STAGE(bufoff, gbase, voff) do { _Pragma("unroll") for (int _i = 0; _i < 2; ++_i) \
        __builtin_amdgcn_global_load_lds((const unsigned*)((const char*)(gbase) + (voff)[_i]), (LAS unsigned*)(lds + (bufoff) + ldsw + _i * 8192), 16, 0, 0); } while (0)
#define G8_LDA(dst, b, h) do { _Pragma("unroll") for (int m = 0; m < 4; ++m) _Pragma("unroll") for (int k = 0; k < 2; ++k) dst[m][k] = *(const LAS bf16x8*)(lds + G8_SA(b, h) + aoff + m * 2048 + k * 1024); } while (0)
#define G8_LDB(dst, b, h) do { _Pragma("unroll") for (int n = 0; n < 2; ++n) _Pragma("unroll") for (int k = 0; k < 2; ++k) dst[n][k] = *(const LAS bf16x8*)(lds + G8_SB(b, h) + boff + n * 2048 + k * 1024); } while (0)
#define G8_CAT(x) __builtin_shufflevector(__builtin_bit_cast(i32x4, x[0]), __builtin_bit_cast(i32x4, x[1]), 0, 1, 2, 3, 4, 5, 6, 7)
#define G8_MMA(ai, bj, At, Bt) do { __builtin_amdgcn_s_setprio(1); _Pragma("unroll") for (int m = 0; m < 4; ++m) _Pragma("unroll") for (int n = 0; n < 2; ++n) { \
        if constexpr (F8) acc[ai][bj][m][n] = __builtin_amdgcn_mfma_scale_f32_16x16x128_f8f6f4(G8_CAT(Bt[n]), G8_CAT(At[m]), acc[ai][bj][m][n], 0, 0, 0, 0x7f7f7f7f, 0, 0x7f7f7f7f); \
        else { _Pragma("unroll") for (int k = 0; k < 2; ++k) acc[ai][bj][m][n] = __builtin_amdgcn_mfma_f32_16x16x32_bf16(Bt[n][k], At[m][k], acc[ai][bj][m][n], 0, 0, 0); } } \
        __builtin_amdgcn_s_setprio(0); } while (0)
#define G8_WAIT_V(n) asm volatile("s_waitcnt vmcnt(" #n ")" ::: "memory")
#define G8_WAIT_L(n) asm volatile("s_waitcnt lgkmcnt(" #n ")" ::: "memory")
#define G8_BAR __builtin_amdgcn_s_barrier()
#define G8_SCHED __builtin_amdgcn_sched_barrier(0)
    Unit cur, nxt; int ui = 0;
    if (!S.next(0, cur)) return;
    f32x4 acc[2][2][4][2];
#pragma unroll
    for (int a = 0; a < 2; ++a)
#pragma unroll
        for (int b = 0; b < 2; ++b)
#pragma unroll
            for (int m = 0; m < 4; ++m)
#pragma unroll
                for (int n = 0; n < 2; ++n) acc[a][b][m][n] = (f32x4){0.f, 0.f, 0.f, 0.f};
    bf16x8 At[4][2], B0[2][2], B1[2][2];
    const char* cA = cur.A; const char* cB = cur.B;
    G8_STAGE(G8_SB(0, 0), cB, voffB); G8_STAGE(G8_SB(0, 1), cB, voffB1); G8_STAGE(G8_SA(0, 0), cA, cur.vA0); G8_STAGE(G8_SA(0, 1), cA, cur.vA1);
    if (wr == 1) G8_BAR;
    G8_WAIT_V(2); G8_BAR;
    G8_STAGE(G8_SB(1, 0), cB + kstep, voffB); G8_STAGE(G8_SA(1, 0), cA + kstep, cur.vA0); G8_STAGE(G8_SB(1, 1), cB + kstep, voffB1);
    G8_WAIT_V(6); G8_BAR;
    for (;;) {
        const bool has_next = S.next(ui + 1, nxt);
        if (!has_next) nxt = cur;
        const char* nA = nxt.A; const char* nB = nxt.B;
#pragma unroll 1
        for (int t = 0; t < nt; t += 2) {
            const bool last = (t == nt - 2);
            const char* a1 = cA + (size_t)(t + 1) * kstep;
            const char* a2 = last ? nA : cA + (size_t)(t + 2) * kstep; const char* b2 = last ? nB : cB + (size_t)(t + 2) * kstep;
            const char* a3 = a2 + kstep; const char* b3 = b2 + kstep;
            G8_LDB(B0, 0, 0); G8_LDB(B1, 0, 1); G8_SCHED; G8_LDA(At, 0, 0); G8_STAGE(G8_SA(1, 1), a1, cur.vA1);
            if (last) { cur.vA0[0] = nxt.vA0[0]; cur.vA0[1] = nxt.vA0[1]; cur.vA1[0] = nxt.vA1[0]; cur.vA1[1] = nxt.vA1[1]; }
            G8_WAIT_V(8); G8_WAIT_L(0); G8_BAR; G8_MMA(0, 0, At, B0); G8_MMA(0, 1, At, B1); G8_BAR; G8_SCHED;
            G8_LDA(At, 0, 1); G8_STAGE(G8_SB(0, 0), b2, voffB); G8_STAGE(G8_SB(0, 1), b2, voffB1); G8_STAGE(G8_SA(0, 0), a2, cur.vA0);
            G8_WAIT_V(8); G8_WAIT_L(0); G8_BAR; G8_MMA(1, 0, At, B0); G8_MMA(1, 1, At, B1); G8_BAR; G8_SCHED;
            G8_LDB(B0, 1, 0); G8_LDB(B1, 1, 1); G8_SCHED; G8_LDA(At, 1, 0); G8_STAGE(G8_SA(0, 1), a2, cur.vA1);
            G8_WAIT_V(8); G8_WAIT_L(0); G8_BAR; G8_MMA(0, 0, At, B0); G8_MMA(0, 1, At, B1); G8_BAR; G8_SCHED;
            G8_LDA(At, 1, 1); G8_STAGE(G8_SB(1, 0), b3, voffB); G8_STAGE(G8_SB(1, 1), b3, voffB1); G8_STAGE(G8_SA(1, 0), a3, cur.vA0);
            G8_WAIT_V(8); G8_WAIT_L(0); G8_BAR; G8_MMA(1, 0, At, B0); G8_MMA(1, 1, At, B1); G8_BAR; G8_SCHED;
        }
        if (wr == 0) G8_BAR;
        E(acc, cur, wr, wc, fr, fq);
        if (!has_next) break;
#pragma unroll
        for (int a = 0; a < 2; ++a)
#pragma unroll
            for (int b = 0; b < 2; ++b)
#pragma unroll
                for (int m = 0; m < 4; ++m)
#pragma unroll
                    for (int n = 0; n < 2; ++n) acc[a][b][m][n] = (f32x4){0.f, 0.f, 0.f, 0.f};
        cur = nxt; cA = nA; cB = nB; ++ui;
        if (wr == 1) G8_BAR;
    }
    G8_WAIT_V(0);
    G8_BAR;
#undef G8_SA
#undef G8_SB
#undef G8_STAGE
#undef G8_LDA
#undef G8_CAT
#undef G8_LDB
#undef G8_MMA
#undef G8_WAIT_V
#undef G8_WAIT_L
#undef G8_BAR
#undef G8_SCHED
}

struct DenseOrder {
    const char* A; const char* Bt; int pitch; int nM, nN, nwg, G, c;
    __device__ void init(const void* A_, const void* Bt_, int M, int N, int pitch_, int G_, int c_) { A = (const char*)A_; Bt = (const char*)Bt_; pitch = pitch_; nM = M / BM; nN = N / BM; nwg = nM * nN; G = G_; c = c_; }
    __device__ __forceinline__ bool next(int i, Unit& u) const {
        const long L = (long)i * G + c; if (L >= nwg) return false;
        int R[2], C[2]; stage_rc((int)threadIdx.x * 16, R[0], C[0]); stage_rc((int)threadIdx.x * 16 + 8192, R[1], C[1]);
        int wgid = (int)L; { const int q = nwg / NXCD, r = nwg % NXCD, xcd = wgid % NXCD, off = wgid / NXCD; wgid = (xcd < r ? xcd * (q + 1) : r * (q + 1) + (xcd - r) * q) + off; }
        const int nig = WGM * nN, gid = wgid / nig, fm = gid * WGM, gsz = (nM - fm) < WGM ? (nM - fm) : WGM;
        const int pm = fm + ((wgid % nig) % gsz), pn = (wgid % nig) / gsz;
        u.A = A + (size_t)pm * BM * pitch; u.B = Bt + (size_t)pn * BM * pitch;
#pragma unroll
        for (int j = 0; j < 2; ++j) { u.vA0[j] = (unsigned)(R[j] * pitch + C[j] * 2); u.vA1[j] = (unsigned)((R[j] + HALF) * pitch + C[j] * 2); }
        u.r0 = pm * BM; u.pn = pn; u.e = 0; u.rend = 0; return true;
    }
};
}

struct Args { const void* in[25]; float* out; unsigned char* ws; int ph_lo, ph_hi; };
struct Ctx {
    LAS unsigned char* lds; unsigned char* ws; const void* const* in; float* out;
    int tid, lane, wave, vcu, G;
};

__device__ __forceinline__ void p0_adaln(Ctx& F) {
    LAS float* sc = (LAS float*)F.lds;
    LAS float* red = (LAS float*)(F.lds + 65536);
    const float* cvec = (const float*)F.in[1]; const float* wada = (const float*)F.in[3]; const float* bada = (const float*)F.in[4]; float* mod = (float*)(F.ws + WS_MOD);
    __syncthreads();
    for (int i = F.tid; i < NB * DM; i += NWAVES * 64) sc[i] = siluf_(cvec[i]);
    __syncthreads();
    for (int cb = F.vcu; cb < 6 * DM / 48; cb += F.G) {
        const int n0 = cb * 48, l = F.lane < 48 ? F.lane : 47, k0 = F.wave * 256;
        float acc[8];
#pragma unroll
        for (int b = 0; b < 8; ++b) acc[b] = 0.f;
        const float* col = wada + (size_t)k0 * (6 * DM) + n0 + l;
#pragma unroll 1
        for (int kk = 0; kk < 256; kk += 32) { float wv[32];
#pragma unroll
            for (int u = 0; u < 32; ++u) wv[u] = col[(size_t)(kk + u) * (6 * DM)];
#pragma unroll
            for (int u = 0; u < 32; ++u)
#pragma unroll
                for (int b = 0; b < 8; ++b) acc[b] += sc[b * DM + k0 + kk + u] * wv[u]; }
        if (F.lane < 48) {
#pragma unroll
            for (int b = 0; b < 8; ++b) red[(F.wave * 8 + b) * 48 + F.lane] = acc[b]; }
        __syncthreads();
        if (F.tid < 384) { const int b = F.tid / 48, cc = F.tid % 48; float s = bada[n0 + cc];
#pragma unroll
            for (int w = 0; w < 8; ++w) s += red[(w * 8 + b) * 48 + cc];
            __hip_atomic_store(mod + (size_t)b * 6 * DM + n0 + cc, s, __ATOMIC_RELAXED, __HIP_MEMORY_SCOPE_AGENT); }
        VM_WAIT();
        __syncthreads();
    }
    if (F.tid == 0) __hip_atomic_fetch_add((unsigned*)(F.ws + WS_CTL) + CW_MODCNT, 1u, __ATOMIC_RELAXED, __HIP_MEMORY_SCOPE_AGENT);
}
__device__ __forceinline__ void p0_wait_mod(Ctx& F) {
    if (F.tid == 0) { unsigned* ctl = (unsigned*)(F.ws + WS_CTL); unsigned sp = 0u;
        while (ld_agent(ctl + CW_MODCNT) < (unsigned)F.G) { __builtin_amdgcn_s_sleep(2); if (++sp > (1u << 20)) { atomicAdd(ctl + CW_BAR + XB_TMO, 1u); break; } }
        __builtin_amdgcn_fence(__ATOMIC_ACQUIRE, "agent");
        asm volatile("s_waitcnt vmcnt(0)" ::: "memory"); }
    __syncthreads();
}
template <bool F8>
__device__ __forceinline__ void p0_transpose_item(const float* W, int K, int N, void* WT, int out_row0, int k0, int n0, float scale, LAS float* scr, int lane) {
    f32x4 v[16];
#pragma unroll
    for (int i = 0; i < 16; ++i) v[i] = *(const f32x4*)(W + (size_t)(k0 + 4 * i + (lane >> 4)) * N + n0 + 4 * (lane & 15));
#pragma unroll
    for (int i = 0; i < 16; ++i) { LAS float* d = scr + (4 * i + (lane >> 4)) * 65 + 4 * (lane & 15); d[0] = v[i].x; d[1] = v[i].y; d[2] = v[i].z; d[3] = v[i].w; }
    LDS_WAIT(); asm volatile("" ::: "memory");
    if (!F8) {
        const int c = lane & 7;
#pragma unroll
        for (int j = 0; j < 8; ++j) { const int n = (lane >> 3) + 8 * j; const LAS float* s = scr + (8 * c) * 65 + n;
            u32x4 o; o.x = pk2(s[0 * 65], s[1 * 65]); o.y = pk2(s[2 * 65], s[3 * 65]); o.z = pk2(s[4 * 65], s[5 * 65]); o.w = pk2(s[6 * 65], s[7 * 65]);
            *(u32x4*)((bf16*)WT + (size_t)(out_row0 + n) * K + k0 + 8 * c) = o; }
    } else {
        const int c = lane & 3;
#pragma unroll
        for (int j = 0; j < 4; ++j) { const int n = (lane >> 2) + 16 * j; const LAS float* s = scr + (16 * c) * 65 + n; int o[4];
#pragma unroll
            for (int q = 0; q < 4; ++q) { int wv = 0; wv = __builtin_amdgcn_cvt_pk_fp8_f32(s[(4 * q) * 65] * scale, s[(4 * q + 1) * 65] * scale, wv, false); wv = __builtin_amdgcn_cvt_pk_fp8_f32(s[(4 * q + 2) * 65] * scale, s[(4 * q + 3) * 65] * scale, wv, true); o[q] = wv; }
            *(u32x4*)((unsigned char*)WT + (size_t)(out_row0 + n) * K + k0 + 16 * c) = (u32x4){(unsigned)o[0], (unsigned)o[1], (unsigned)o[2], (unsigned)o[3]}; }
    }
    LDS_WAIT(); asm volatile("" ::: "memory");
}
struct CvItem { const float* src; unsigned char* dst; int N, K; float scale; };
__device__ __forceinline__ CvItem cv_decode(const void* const* in, unsigned char* ws, int r) {
    constexpr int I_EI = 32 * 16, I_EO = 8 * 32; CvItem c;
    if (r < 65 * I_EI) { const int e = r / I_EI, q = r % I_EI, kb = q / 16, nb = q % 16, n0 = 64 * nb, j = n0 & 511, up = n0 >> 9;
        const float* W = (e < 64) ? (const float*)in[20] + (size_t)e * DM * 1024 : (const float*)in[22];
        c.src = W + (size_t)(64 * kb) * 1024 + n0; c.N = 1024; c.K = DM; c.scale = SC_WEI;
        c.dst = ws + WS_WEI + (size_t)e * 1024 * DM + (size_t)((j >> 7) * 256 + up * 128 + (j & 127)) * DM + 64 * kb; }
    else { r -= 65 * I_EI; const int e = r / I_EO, q = r % I_EO, kb = q / 32, nb = q % 32;
        const float* W = (e < 64) ? (const float*)in[21] + (size_t)e * EH * DM : (const float*)in[23];
        c.src = W + (size_t)(64 * kb) * DM + 64 * nb; c.N = DM; c.K = EH; c.scale = SC_WEO;
        c.dst = ws + WS_WEO + (size_t)e * DM * EH + (size_t)(64 * nb) * EH + 64 * kb; }
    return c;
}
__device__ __forceinline__ void p2_convert_experts(Ctx& F) {
    const int gw = F.vcu * NWAVES + F.wave, NGW = F.G * NWAVES, lane = F.lane, li = lane & 15, lg = lane >> 4;
    constexpr int NCV = 65 * (32 * 16 + 8 * 32);
    int it = gw; CvItem cur; f32x4 v[16];
    const int krow = 16 * (li >> 2) + (li & 3);
#define CV_LOAD(c) do { _Pragma("unroll") for (int nh = 0; nh < 2; ++nh) _Pragma("unroll") for (int q = 0; q < 4; ++q) { const float* p_ = (c).src + (size_t)(krow + 4 * q) * (c).N + 32 * nh + 8 * lg; \
        v[(nh * 4 + q) * 2] = *(const f32x4*)p_; v[(nh * 4 + q) * 2 + 1] = *(const f32x4*)(p_ + 4); } } while (0)
    if (it < NCV) { cur = cv_decode(F.in, F.ws, it); CV_LOAD(cur); }
    while (it < NCV) {
        bf16x8 a[2][4];
#pragma unroll
        for (int nh = 0; nh < 2; ++nh)
#pragma unroll
            for (int q = 0; q < 4; ++q) { const f32x4 lo = v[(nh * 4 + q) * 2], hi = v[(nh * 4 + q) * 2 + 1];
                const u32x4 pk = (u32x4){pk2(lo.x, lo.y), pk2(lo.z, lo.w), pk2(hi.x, hi.y), pk2(hi.z, hi.w)}; a[nh][q] = __builtin_bit_cast(bf16x8, pk); }
        const CvItem me = cur; const int nit = it + NGW;
        if (nit < NCV) { cur = cv_decode(F.in, F.ws, nit); CV_LOAD(cur); }
        const unsigned sbits = (unsigned)f2bf(me.scale);
#pragma unroll
        for (int h = 0; h < 2; ++h) {
            u32x4 sel = (u32x4){0u, 0u, 0u, 0u}; { const int d = 16 * h + li - 8 * lg; if (d >= 0 && d < 8) { const unsigned wv = (d & 1) ? (sbits << 16) : sbits; if ((d >> 1) == 0) sel.x = wv; else if ((d >> 1) == 1) sel.y = wv; else if ((d >> 1) == 2) sel.z = wv; else sel.w = wv; } }
            const bf16x8 bs = __builtin_bit_cast(bf16x8, sel);
#pragma unroll
            for (int nh = 0; nh < 2; ++nh) { unsigned o[4];
#pragma unroll
                for (int q = 0; q < 4; ++q) { const f32x4 d = __builtin_amdgcn_mfma_f32_16x16x32_bf16(a[nh][q], bs, (f32x4){0.f, 0.f, 0.f, 0.f}, 0, 0, 0); o[q] = pk4_fp8(d[0], d[1], d[2], d[3]); }
                *(u32x4*)(me.dst + (size_t)(32 * nh + 16 * h + li) * me.K + 16 * lg) = (u32x4){o[0], o[1], o[2], o[3]}; }
        }
        it = nit;
    }
#undef CV_LOAD
}
__device__ __forceinline__ void p0_prologue(Ctx& F) {
    LAS float* scr = (LAS float*)(F.lds + F.wave * 16640);
    const int gw = F.vcu * NWAVES + F.wave, NGW = F.G * NWAVES, lane = F.lane;
    unsigned char* ws = F.ws;
    constexpr int I_IN = 32 * 96, I_OUT = 32 * 32, I_R = 32 * 1, I_G = 2 * 2;
    constexpr int NTR = I_IN + I_OUT + I_R + 16 * I_G;
    for (int it = gw; it < NTR; it += NGW) {
        int r = it;
        if (r < I_IN) { const int kb = r / 96, nb = r % 96; p0_transpose_item<false>((const float*)F.in[6], DM, NIN, ws + WS_WIN, 64 * nb, 64 * kb, 64 * nb, 1.f, scr, lane); continue; } r -= I_IN;
        if (r < I_OUT) { const int kb = r / 32, nb = r % 32; p0_transpose_item<false>((const float*)F.in[16], DM, DM, ws + WS_WOUT, 64 * nb, 64 * kb, 64 * nb, 1.f, scr, lane); continue; } r -= I_OUT;
        if (r < I_R) { const int kb = r; p0_transpose_item<false>((const float*)F.in[18], DM, NE, ws + WS_WR, 0, 64 * kb, 0, 1.f, scr, lane); continue; } r -= I_R;
        { const int m = r / I_G, q = r % I_G, kb = q / 2, nb = q % 2, g = m & 7;
          const float* W = ((m < 8) ? (const float*)F.in[9] : (const float*)F.in[11]) + (size_t)g * 128 * 128;
          p0_transpose_item<false>(W, 128, 128, (bf16*)(ws + (m < 8 ? WS_WA : WS_WX)) + (size_t)g * 128 * 128, 64 * nb, 64 * kb, 64 * nb, 1.f, scr, lane); }
    }
    {
        const int* pos = (const int*)F.in[2]; f32x2* rt = (f32x2*)(ws + WS_ROPE);
        for (int it = gw; it < T * 64 / 512; it += NGW) {
#pragma unroll 1
            for (int q = 0; q < 8; ++q) { const int idx = it * 512 + q * 64 + lane, t = idx >> 6, i = idx & 63;
                const double inv = exp(-9.210340371976184 * (double)i / 64.0); const double ang = (double)pos[t] * inv; double sn, cs; sincos(ang, &sn, &cs);
                rt[idx] = (f32x2){(float)cs, (float)sn}; }
        }
    }
    if (gw == 0) { u32x4* z = (u32x4*)((bf16*)(ws + WS_H) + (size_t)T * DM); for (int i = lane; i < DM * 2 / 16; i += 64) z[i] = (u32x4){0u, 0u, 0u, 0u};
        u32x4* z8 = (u32x4*)(ws + WS_H8 + (size_t)T * DM); for (int i = lane; i < DM / 16; i += 64) z8[i] = (u32x4){0u, 0u, 0u, 0u}; }
}

template <bool W8, bool INBF>
__device__ __forceinline__ void norm_mod_row(const void* xrow_, const float* g, const float* sc, const float* sh, bf16* orow, unsigned char* orow8, int lane) {
    f32x4 v[4][2]; float ss = 0.f;
#pragma unroll
    for (int j = 0; j < 4; ++j) {
        if constexpr (INBF) { const u32x4 w = *(const u32x4*)((const bf16*)xrow_ + 8 * lane + 512 * j); v[j][0] = (f32x4){bflo(w.x), bfhi(w.x), bflo(w.y), bfhi(w.y)}; v[j][1] = (f32x4){bflo(w.z), bfhi(w.z), bflo(w.w), bfhi(w.w)}; }
        else { v[j][0] = *(const f32x4*)((const float*)xrow_ + 8 * lane + 512 * j); v[j][1] = *(const f32x4*)((const float*)xrow_ + 8 * lane + 512 * j + 4); }
#pragma unroll
        for (int h = 0; h < 2; ++h) ss += (v[j][h].x * v[j][h].x + v[j][h].y * v[j][h].y) + (v[j][h].z * v[j][h].z + v[j][h].w * v[j][h].w); }
    const float rstd = rsqrtf(wave_sum(ss) * (1.0f / DM) + EPS);
#pragma unroll
    for (int j = 0; j < 4; ++j) { f32x4 o[2];
#pragma unroll
        for (int h = 0; h < 2; ++h) { const int c = 8 * lane + 512 * j + 4 * h; const f32x4 gg = *(const f32x4*)(g + c), s1 = *(const f32x4*)(sc + c), s0 = *(const f32x4*)(sh + c);
            o[h] = (v[j][h] * rstd * gg) * (s1 + 1.0f) + s0; }
        u32x4 w; w.x = pk2(o[0].x, o[0].y); w.y = pk2(o[0].z, o[0].w); w.z = pk2(o[1].x, o[1].y); w.w = pk2(o[1].z, o[1].w);
        *(u32x4*)(orow + 8 * lane + 512 * j) = w;
        if constexpr (W8) { u32x2 w8; w8.x = pk4_fp8(o[0].x * SC_H8, o[0].y * SC_H8, o[0].z * SC_H8, o[0].w * SC_H8); w8.y = pk4_fp8(o[1].x * SC_H8, o[1].y * SC_H8, o[1].z * SC_H8, o[1].w * SC_H8); *(u32x2*)(orow8 + 8 * lane + 512 * j) = w8; } }
}
__device__ __forceinline__ void p1_norm(Ctx& F) {
    const int gw = F.vcu * NWAVES + F.wave, NGW = F.G * NWAVES;
    const float* x = (const float*)F.in[0]; const float* g = (const float*)F.in[5]; const float* mod = (const float*)(F.ws + WS_MOD); bf16* h = (bf16*)(F.ws + WS_H);
    for (int m = gw; m < T; m += NGW) { const int b = m / SEQ; norm_mod_row<false, false>(x + (size_t)m * DM, g, mod + (size_t)b * 6 * DM + DM, mod + (size_t)b * 6 * DM, h + (size_t)m * DM, nullptr, F.lane); }
}

struct EpiProj {
    static constexpr bool PERM = true, P16 = false;
    bf16* O;
    __device__ __forceinline__ void operator()(const f32x4 (&acc)[2][2][4][2], const g8::Unit& u, int wr, int wc, int fr, int fq) const {
        const int row0 = u.r0 + wr * 64 + fr, col0 = u.pn * 256 + wc * 32 + 8 * fq;
#pragma unroll
        for (int ai = 0; ai < 2; ++ai)
#pragma unroll
            for (int m = 0; m < 4; ++m) { bf16* rowp = O + (size_t)(row0 + ai * 128 + m * 16) * NIN + col0;
#pragma unroll
                for (int bj = 0; bj < 2; ++bj) { const f32x4 v0 = acc[ai][bj][m][0], v1 = acc[ai][bj][m][1];
                    u32x4 w; w.x = pk2(v0[0], v0[1]); w.y = pk2(v0[2], v0[3]); w.z = pk2(v1[0], v1[1]); w.w = pk2(v1[2], v1[3]);
                    *(u32x4*)(rowp + bj * 128) = w; } }
    }
};
struct EpiWout {
    static constexpr bool PERM = true, P16 = false;
    const float* x; const float* mod; bf16* x1;
    __device__ __forceinline__ void operator()(const f32x4 (&acc)[2][2][4][2], const g8::Unit& u, int wr, int wc, int fr, int fq) const {
        const int row0 = u.r0 + wr * 64 + fr, col0 = u.pn * 256 + wc * 32 + 8 * fq; const int b = u.r0 / SEQ;
        const float* gt = mod + (size_t)b * 6 * DM + 2 * DM;
        f32x4 gv[2][2];
#pragma unroll
        for (int bj = 0; bj < 2; ++bj)
#pragma unroll
            for (int n = 0; n < 2; ++n) gv[bj][n] = *(const f32x4*)(gt + col0 + bj * 128 + n * 4);
#pragma unroll
        for (int ai = 0; ai < 2; ++ai)
#pragma unroll
            for (int m = 0; m < 4; ++m) { const size_t off = (size_t)(row0 + ai * 128 + m * 16) * DM + col0;
#pragma unroll
                for (int bj = 0; bj < 2; ++bj) { const f32x4 v0 = *(const f32x4*)(x + off + bj * 128) + gv[bj][0] * acc[ai][bj][m][0], v1 = *(const f32x4*)(x + off + bj * 128 + 4) + gv[bj][1] * acc[ai][bj][m][1];
                    u32x4 w; w.x = pk2(v0[0], v0[1]); w.y = pk2(v0[2], v0[3]); w.z = pk2(v1[0], v1[1]); w.w = pk2(v1[2], v1[3]);
                    *(u32x4*)(x1 + off + bj * 128) = w; }
                asm volatile("" ::: "memory"); }
    }
};
struct EpiSwiglu {
    static constexpr bool PERM = true, P16 = false;
    unsigned char* act;
    __device__ __forceinline__ void operator()(const f32x4 (&acc)[2][2][4][2], const g8::Unit& u, int wr, int wc, int fr, int fq) const {
        const int row0 = u.r0 + wr * 64 + fr, col0 = u.pn * 128 + wc * 32 + 8 * fq;
#pragma unroll
        for (int ai = 0; ai < 2; ++ai)
#pragma unroll
            for (int m = 0; m < 4; ++m) { float o[8];
#pragma unroll
                for (int n = 0; n < 2; ++n)
#pragma unroll
                    for (int j = 0; j < 4; ++j) { const float g = acc[ai][0][m][n][j] * (1.0f / (SC_H8 * SC_WEI)), up = acc[ai][1][m][n][j] * (SC_ACT / (SC_H8 * SC_WEI)); o[4 * n + j] = g * __builtin_amdgcn_rcpf(1.0f + __expf(-g)) * up; }
                u32x2 w; w.x = pk4_fp8(o[0], o[1], o[2], o[3]); w.y = pk4_fp8(o[4], o[5], o[6], o[7]);
                *(u32x2*)(act + (size_t)(row0 + ai * 128 + m * 16) * EH + col0) = w; }
    }
};
struct EpiDown {
    static constexpr bool PERM = true, P16 = true;
    unsigned char* y;
    __device__ __forceinline__ void operator()(const f32x4 (&acc)[2][2][4][2], const g8::Unit& u, int wr, int wc, int fr, int fq) const {
        const int row0 = u.r0 + wr * 64 + fr, col0 = u.pn * 256 + wc * 64 + 16 * fq; constexpr float sc = SC_Y / (SC_ACT * SC_WEO); static_assert(sc == 1.0f, "scales chosen so that y needs no multiply");
#pragma unroll
        for (int ai = 0; ai < 2; ++ai)
#pragma unroll
            for (int m = 0; m < 4; ++m) { u32x4 w;
                { const f32x4 v0 = acc[ai][0][m][0], v1 = acc[ai][0][m][1], v2 = acc[ai][1][m][0], v3 = acc[ai][1][m][1];
                  w.x = pk4_fp8(v0[0], v0[1], v0[2], v0[3]); w.y = pk4_fp8(v1[0], v1[1], v1[2], v1[3]); w.z = pk4_fp8(v2[0], v2[1], v2[2], v2[3]); w.w = pk4_fp8(v3[0], v3[1], v3[2], v3[3]); }
                *(u32x4*)(y + (size_t)(row0 + ai * 128 + m * 16) * DM + col0) = w; }
    }
};

struct MoeTables { LAS int* row0; LAS int* te; LAS int* pend; LAS int* tp; };
__device__ __forceinline__ MoeTables moe_tables(Ctx& F) { MoeTables M; M.row0 = (LAS int*)(F.lds + TT_OFF); M.te = M.row0 + MAXTILES; M.pend = M.te + MAXTILES; M.tp = M.pend + 80; return M; }
__device__ __forceinline__ int moe_build_tables(Ctx& F) {
    MoeTables M = moe_tables(F);
    const unsigned* cnt = (const unsigned*)(F.ws + WS_CTL) + CW_CNT;
    __syncthreads();
    if (F.tid < NE) M.row0[F.tid] = (int)ld_agent(cnt + 32 * F.tid);
    __syncthreads();
    if (F.tid == 0) { int tiles = 0;
        for (int e = 0; e < NE; ++e) { const int c = M.row0[e]; M.tp[e] = tiles; M.pend[e] = tiles * 256 + c; tiles += (c + 255) >> 8; }
        M.tp[NE] = NR_ROUTED / 256; M.pend[NE] = NR; M.tp[NE + 1] = NR_ROUTED / 256 + T / 256; M.tp[NE + 2] = tiles; }
    __syncthreads();
    const int rt = M.tp[NE + 2];
    for (int tau = F.tid; tau < rt; tau += NWAVES * 64) { int e = 0; while (e + 1 < NE && M.tp[e + 1] <= tau) ++e; M.te[tau] = e; M.row0[tau] = tau * 256; }
    for (int s = F.tid; s < T / 256; s += NWAVES * 64) { M.te[rt + s] = NE; M.row0[rt + s] = NR_ROUTED + s * 256; }
    __syncthreads();
    return rt + T / 256;
}
template <int PHASE>
struct MoeOrder {
    MoeTables M; const char* A; const char* W; const int* row_tok; int U, CH, x, j;
    static constexpr int NPN = (PHASE == 1) ? 4 : 8;
    __device__ void init(Ctx& F, int ntiles) { M = moe_tables(F); U = ntiles * NPN; CH = (U + 7) / 8; x = F.vcu / (F.G / 8); j = F.vcu % (F.G / 8);
        A = (const char*)(F.ws + (PHASE == 1 ? WS_H8 : WS_ACT)); W = (const char*)(F.ws + (PHASE == 1 ? WS_WEI : WS_WEO)); row_tok = (const int*)(F.ws + WS_TOKOF); }
    __device__ __forceinline__ bool next(int i, g8::Unit& u) const {
        const int q = i * 32 + j; const int L = x * CH + q; if (q >= CH || L >= U) return false;
        int R[2], C[2]; g8::stage_rc((int)threadIdx.x * 16, R[0], C[0]); g8::stage_rc((int)threadIdx.x * 16 + 8192, R[1], C[1]);
        const int tile = L / NPN, pn = L % NPN;
        const int e = __builtin_amdgcn_readfirstlane(M.te[tile]), r0 = __builtin_amdgcn_readfirstlane(M.row0[tile]), rend = __builtin_amdgcn_readfirstlane(M.pend[e]);
        u.r0 = r0; u.pn = pn; u.e = e; u.rend = rend; u.A = A;
        if (PHASE == 1) {
            u.B = W + ((size_t)e * 1024 + (size_t)pn * 256) * DM;
#pragma unroll
            for (int k = 0; k < 2; ++k) { const int ra = r0 + R[k], rb = ra + 128; int ta, tb;
                if (e == NE) { ta = ra - NR_ROUTED; tb = rb - NR_ROUTED; }
                else { const int ps_ = __builtin_amdgcn_readfirstlane(M.tp[e]) * 256; const int* tk = row_tok + (size_t)e * T - ps_; ta = (ra < rend) ? ld_agent_i(tk + ra) : T; tb = (rb < rend) ? ld_agent_i(tk + rb) : T; }
                u.vA0[k] = (unsigned)(ta * DM + C[k] * 2); u.vA1[k] = (unsigned)(tb * DM + C[k] * 2); }
        } else {
            u.B = W + ((size_t)e * DM + (size_t)pn * 256) * EH;
#pragma unroll
            for (int k = 0; k < 2; ++k) { u.vA0[k] = (unsigned)((r0 + R[k]) * EH + C[k] * 2); u.vA1[k] = (unsigned)((r0 + R[k] + 128) * EH + C[k] * 2); }
        }
        asm volatile("" : "+v"(u.vA0[0]), "+v"(u.vA0[1]), "+v"(u.vA1[0]), "+v"(u.vA1[1]));
        return true;
    }
};

constexpr int LP = 136;
__device__ __forceinline__ void ret_item(Ctx& F, int item) {
    const int tid = F.tid, lane = F.lane, w = F.wave, fr = lane & 15, fq = lane >> 4;
    const int b = item >> 5, h = (item >> 2) & 7, eb = item & 3;
    LAS bf16* qL = (LAS bf16*)(F.lds); LAS bf16* kL = qL + 128 * LP; LAS bf16* kTL = kL + 128 * LP; LAS bf16* vTL = kTL + 128 * LP; LAS bf16* STL = vTL + 32 * LP;
    const bf16* proj = (const bf16*)(F.ws + WS_PROJ); const f32x2* rope = (const f32x2*)(F.ws + WS_ROPE); float* reto = (float*)(F.ws + WS_RETO);
    const float lg = log1pf(-exp2f(-5.0f - (float)h)), lg2 = lg * 1.4426950408889634f, dec = __expf(lg * 128.0f);
    f32x4 st[2] = {(f32x4){0.f, 0.f, 0.f, 0.f}, (f32x4){0.f, 0.f, 0.f, 0.f}};
    __syncthreads();
    for (int i = tid; i < 32 * LP; i += NWAVES * 64) STL[i] = 0;
    const int r = tid >> 2, qd = tid & 3, j0 = 16 * qd;
    const float kdec = exp2f(lg2 * (float)(127 - r));
    u32x4 q1[2], q2[2], k1[2], k2[2], vv; f32x2 cs[16];
#define RET_LOAD(nn) do { const bf16* p_ = proj + (size_t)(b * SEQ + (nn) * 128 + r) * NIN + h * 128; const f32x2* c_ = rope + (size_t)(b * SEQ + (nn) * 128 + r) * 64 + j0; \
        q1[0] = *(const u32x4*)(p_ + j0); q1[1] = *(const u32x4*)(p_ + j0 + 8); q2[0] = *(const u32x4*)(p_ + 64 + j0); q2[1] = *(const u32x4*)(p_ + 64 + j0 + 8); \
        k1[0] = *(const u32x4*)(p_ + RW + j0); k1[1] = *(const u32x4*)(p_ + RW + j0 + 8); k2[0] = *(const u32x4*)(p_ + RW + 64 + j0); k2[1] = *(const u32x4*)(p_ + RW + 64 + j0 + 8); \
        vv = *(const u32x4*)(p_ + 2 * RW + eb * 32 + qd * 8); \
        _Pragma("unroll") for (int jj_ = 0; jj_ < 16; ++jj_) cs[jj_] = c_[jj_]; } while (0)
    RET_LOAD(0);
#pragma unroll 1
    for (int n = 0; n < 16; ++n) {
        const int t0 = b * SEQ + n * 128;
        __syncthreads();
        {
#pragma unroll
            for (int hh = 0; hh < 2; ++hh) { unsigned oq1[4], oq2[4], ok1[4], ok2[4];
#pragma unroll
                for (int c = 0; c < 4; ++c) { float a[2], bq[2], ka[2], kb[2];
#pragma unroll
                    for (int z = 0; z < 2; ++z) { const int jj = hh * 8 + c * 2 + z; const f32x2 sc = cs[jj];
                        const float x1 = z ? bfhi(q1[hh][c]) : bflo(q1[hh][c]), x2 = z ? bfhi(q2[hh][c]) : bflo(q2[hh][c]);
                        const float y1 = z ? bfhi(k1[hh][c]) : bflo(k1[hh][c]), y2 = z ? bfhi(k2[hh][c]) : bflo(k2[hh][c]);
                        a[z] = (x1 * sc.x - x2 * sc.y) * 0.08838834764831845f; bq[z] = (x2 * sc.x + x1 * sc.y) * 0.08838834764831845f;
                        ka[z] = y1 * sc.x - y2 * sc.y; kb[z] = y2 * sc.x + y1 * sc.y;
                        kTL[(j0 + jj) * LP + r] = f2bf(ka[z] * kdec); kTL[(64 + j0 + jj) * LP + r] = f2bf(kb[z] * kdec); }
                    oq1[c] = pk2(a[0], a[1]); oq2[c] = pk2(bq[0], bq[1]); ok1[c] = pk2(ka[0], ka[1]); ok2[c] = pk2(kb[0], kb[1]); }
                *(LAS u32x4*)(qL + r * LP + j0 + hh * 8) = (u32x4){oq1[0], oq1[1], oq1[2], oq1[3]}; *(LAS u32x4*)(qL + r * LP + 64 + j0 + hh * 8) = (u32x4){oq2[0], oq2[1], oq2[2], oq2[3]};
                *(LAS u32x4*)(kL + r * LP + j0 + hh * 8) = (u32x4){ok1[0], ok1[1], ok1[2], ok1[3]}; *(LAS u32x4*)(kL + r * LP + 64 + j0 + hh * 8) = (u32x4){ok2[0], ok2[1], ok2[2], ok2[3]}; }
#pragma unroll
            for (int c = 0; c < 4; ++c) { vTL[(qd * 8 + 2 * c) * LP + r] = (bf16)(vv[c] & 0xffffu); vTL[(qd * 8 + 2 * c + 1) * LP + r] = (bf16)(vv[c] >> 16); }
        }
        if (n + 1 < 16) RET_LOAD(n + 1);
        __syncthreads();
        f32x4 sacc[8];
#pragma unroll
        for (int mt = 0; mt < 8; ++mt) sacc[mt] = (f32x4){0.f, 0.f, 0.f, 0.f};
#pragma unroll
        for (int ks = 0; ks < 4; ++ks) { const bf16x8 bq = *(const LAS bf16x8*)(qL + (16 * w + fr) * LP + 32 * ks + 8 * fq);
#pragma unroll
            for (int mt = 0; mt < 8; ++mt) { const bf16x8 ak = *(const LAS bf16x8*)(kL + (16 * mt + fr) * LP + 32 * ks + 8 * fq); sacc[mt] = __builtin_amdgcn_mfma_f32_16x16x32_bf16(ak, bq, sacc[mt], 0, 0, 0); } }
        const int c = 16 * w + fr;
        bf16x8 pb[4];
#pragma unroll
        for (int sk = 0; sk < 4; ++sk) { unsigned pw[4];
#pragma unroll
            for (int hlf = 0; hlf < 2; ++hlf) { const int mt = 2 * sk + hlf; float pv[4];
#pragma unroll
                for (int rr = 0; rr < 4; ++rr) { const int m = 16 * mt + 4 * fq + rr; pv[rr] = (c >= m) ? sacc[mt][rr] * exp2f(lg2 * (float)(c - m)) : 0.f; }
                pw[2 * hlf] = pk2(pv[0], pv[1]); pw[2 * hlf + 1] = pk2(pv[2], pv[3]); }
            pb[sk] = __builtin_bit_cast(bf16x8, (u32x4){pw[0], pw[1], pw[2], pw[3]}); }
        f32x4 oi[2], oc[2];
#pragma unroll
        for (int et = 0; et < 2; ++et) { oi[et] = (f32x4){0.f, 0.f, 0.f, 0.f}; oc[et] = (f32x4){0.f, 0.f, 0.f, 0.f}; }
#pragma unroll
        for (int ks = 0; ks < 4; ++ks) { const bf16x8 bq = *(const LAS bf16x8*)(qL + (16 * w + fr) * LP + 32 * ks + 8 * fq);
#pragma unroll
            for (int et = 0; et < 2; ++et) { const u32x2 v0 = *(const LAS u32x2*)(vTL + (16 * et + fr) * LP + 32 * ks + 4 * fq), v1 = *(const LAS u32x2*)(vTL + (16 * et + fr) * LP + 32 * ks + 16 + 4 * fq);
                const bf16x8 av = __builtin_bit_cast(bf16x8, (u32x4){v0.x, v0.y, v1.x, v1.y}); const bf16x8 as = *(const LAS bf16x8*)(STL + (16 * et + fr) * LP + 32 * ks + 8 * fq);
                oi[et] = __builtin_amdgcn_mfma_f32_16x16x32_bf16(av, pb[ks], oi[et], 0, 0, 0); oc[et] = __builtin_amdgcn_mfma_f32_16x16x32_bf16(as, bq, oc[et], 0, 0, 0); } }
        { const float qd = exp2f(lg2 * (float)(c + 1));
#pragma unroll
          for (int et = 0; et < 2; ++et) *(f32x4*)(reto + (size_t)(t0 + c) * RW + h * 128 + eb * 32 + 16 * et + 4 * fq) = oi[et] + oc[et] * qd; }
        __syncthreads();
#pragma unroll
        for (int et = 0; et < 2; ++et) st[et] = st[et] * dec;
#pragma unroll
        for (int ks = 0; ks < 4; ++ks) { const bf16x8 bk = *(const LAS bf16x8*)(kTL + (16 * w + fr) * LP + 32 * ks + 8 * fq);
#pragma unroll
            for (int et = 0; et < 2; ++et) { const bf16x8 av = *(const LAS bf16x8*)(vTL + (16 * et + fr) * LP + 32 * ks + 8 * fq); st[et] = __builtin_amdgcn_mfma_f32_16x16x32_bf16(av, bk, st[et], 0, 0, 0); } }
#pragma unroll
        for (int et = 0; et < 2; ++et)
#pragma unroll
            for (int rr = 0; rr < 4; ++rr) STL[(16 * et + 4 * fq + rr) * LP + 16 * w + fr] = f2bf(st[et][rr]);
    }
#undef RET_LOAD
    __syncthreads();
}

struct LruIn { bf16x8 bA[4], bX[4]; unsigned xr[19]; f32x2 w0, w1, w2, w3, bc; float bav, bxv, lamv; };
__device__ __forceinline__ void lru_issue(Ctx& F, int item, LruIn& L) {
    const int lane = F.lane, w = F.wave, fr = lane & 15, fq = lane >> 4;
    const int b = item >> 7, n = (item >> 3) & 15, g = item & 7; const int ch = g * 128 + 2 * lane;
    const bf16* Wa = (const bf16*)(F.ws + WS_WA) + (size_t)g * 128 * 128 + (size_t)(16 * w + fr) * 128 + 8 * fq; const bf16* Wx = (const bf16*)(F.ws + WS_WX) + (size_t)g * 128 * 128 + (size_t)(16 * w + fr) * 128 + 8 * fq;
#pragma unroll
    for (int ks = 0; ks < 4; ++ks) { L.bA[ks] = *(const bf16x8*)(Wa + 32 * ks); L.bX[ks] = *(const bf16x8*)(Wx + 32 * ks); }
    const float* wconv = (const float*)F.in[7];
    L.w0 = *(const f32x2*)(wconv + ch); L.w1 = *(const f32x2*)(wconv + LW + ch); L.w2 = *(const f32x2*)(wconv + 2 * LW + ch); L.w3 = *(const f32x2*)(wconv + 3 * LW + ch); L.bc = *(const f32x2*)((const float*)F.in[8] + ch);
    const int cj = g * 128 + 16 * w + fr; L.bav = ((const float*)F.in[10])[cj]; L.bxv = ((const float*)F.in[12])[cj]; L.lamv = ((const float*)F.in[13])[cj];
    const int s0 = n * 128 + 16 * w; const bf16* p = (const bf16*)(F.ws + WS_PROJ) + (size_t)(b * SEQ) * NIN + 4 * RW + ch;
#pragma unroll
    for (int i = 0; i < 19; ++i) { const int sp = s0 - 3 + i; L.xr[i] = (sp >= 0) ? *(const unsigned*)(p + (size_t)sp * NIN) : 0u; }
}
__device__ __forceinline__ void lru_body(Ctx& F, int item, const LruIn& L) {
    const int lane = F.lane, w = F.wave, fr = lane & 15, fq = lane >> 4;
    const int b = item >> 7, n = (item >> 3) & 15, g = item & 7;
    LAS bf16* xcL = (LAS bf16*)(F.lds); LAS float* aL = (LAS float*)(F.lds + 34816); LAS bf16* mL = (LAS bf16*)(F.lds + 34816 + 65536); LAS float* segA = (LAS float*)(F.lds + 34816 + 65536 + 32768); LAS float* segB = segA + 1024;
    const int cp = lane, sg = w, ch = g * 128 + 2 * cp;
    float xc[16][2];
#pragma unroll
    for (int i = 0; i < 16; ++i) {
        xc[i][0] = L.bc.x + L.w0.x * bflo(L.xr[i]) + L.w1.x * bflo(L.xr[i + 1]) + L.w2.x * bflo(L.xr[i + 2]) + L.w3.x * bflo(L.xr[i + 3]);
        xc[i][1] = L.bc.y + L.w0.y * bfhi(L.xr[i]) + L.w1.y * bfhi(L.xr[i + 1]) + L.w2.y * bfhi(L.xr[i + 2]) + L.w3.y * bfhi(L.xr[i + 3]);
        *(LAS unsigned*)(xcL + (16 * sg + i) * LP + 2 * cp) = pk2(xc[i][0], xc[i][1]); }
    __syncthreads();
    {
        const int j = 16 * w + fr; const float bav = L.bav, bxv = L.bxv, sp8 = -8.0f * log1pf(__expf(-L.lamv));
#pragma unroll 2
        for (int tt = 0; tt < 8; ++tt) { f32x4 ra = (f32x4){0.f, 0.f, 0.f, 0.f}, rx = (f32x4){0.f, 0.f, 0.f, 0.f};
#pragma unroll
            for (int ks = 0; ks < 4; ++ks) { const bf16x8 a = *(const LAS bf16x8*)(xcL + (16 * tt + fr) * LP + 32 * ks + 8 * fq);
                ra = __builtin_amdgcn_mfma_f32_16x16x32_bf16(a, L.bA[ks], ra, 0, 0, 0); rx = __builtin_amdgcn_mfma_f32_16x16x32_bf16(a, L.bX[ks], rx, 0, 0, 0); }
#pragma unroll
            for (int rr = 0; rr < 4; ++rr) { const int t = 16 * tt + 4 * fq + rr;
                const float rgt = __builtin_amdgcn_rcpf(1.0f + __expf(-(ra[rr] + bav))), igt = __builtin_amdgcn_rcpf(1.0f + __expf(-(rx[rr] + bxv)));
                const float av = __expf(sp8 * rgt); const float mu = sqrtf(fmaxf(1.0f - av * av, 0.f)) * igt;
                aL[t * 128 + j] = av; mL[t * 128 + j] = f2bf(mu); } }
    }
    __syncthreads();
    {
        float h0 = 0.f, h1 = 0.f, P0 = 1.f, P1 = 1.f;
#pragma unroll
        for (int i = 0; i < 16; ++i) { const int t = 16 * sg + i; const f32x2 av = *(const LAS f32x2*)(aL + t * 128 + 2 * cp); const unsigned mw = *(const LAS unsigned*)(mL + t * 128 + 2 * cp);
            h0 = av.x * h0 + bflo(mw) * xc[i][0]; h1 = av.y * h1 + bfhi(mw) * xc[i][1]; P0 *= av.x; P1 *= av.y; }
        *(LAS f32x2*)(segA + sg * 128 + 2 * cp) = (f32x2){P0, P1}; *(LAS f32x2*)(segB + sg * 128 + 2 * cp) = (f32x2){h0, h1};
    }
    __syncthreads();
    {
        float c0 = 0.f, c1 = 0.f, Q0 = 1.f, Q1 = 1.f;
        for (int s = 0; s < sg; ++s) { const f32x2 A = *(const LAS f32x2*)(segA + s * 128 + 2 * cp), Bv = *(const LAS f32x2*)(segB + s * 128 + 2 * cp); c0 = A.x * c0 + Bv.x; c1 = A.y * c1 + Bv.y; Q0 *= A.x; Q1 *= A.y; }
        bf16* hl = (bf16*)(F.ws + WS_HLOC) + (size_t)(b * SEQ + n * 128 + 16 * sg) * LW + ch; bf16* pl = (bf16*)(F.ws + WS_PLOC) + (size_t)(b * SEQ + n * 128 + 16 * sg) * LW + ch;
        float h0 = c0, h1 = c1, P0 = Q0, P1 = Q1;
#pragma unroll
        for (int i = 0; i < 16; ++i) { const int t = 16 * sg + i; const f32x2 av = *(const LAS f32x2*)(aL + t * 128 + 2 * cp); const unsigned mw = *(const LAS unsigned*)(mL + t * 128 + 2 * cp);
            h0 = av.x * h0 + bflo(mw) * xc[i][0]; h1 = av.y * h1 + bfhi(mw) * xc[i][1]; P0 *= av.x; P1 *= av.y;
            *(unsigned*)(hl + (size_t)i * LW) = pk2(h0, h1); *(unsigned*)(pl + (size_t)i * LW) = pk2(P0, P1); }
        if (sg == 7) { *(f32x2*)((float*)(F.ws + WS_AGGA) + (size_t)(b * 16 + n) * LW + ch) = (f32x2){P0, P1}; *(f32x2*)((float*)(F.ws + WS_AGGB) + (size_t)(b * 16 + n) * LW + ch) = (f32x2){h0, h1}; }
    }
    __syncthreads();
}

__device__ __forceinline__ void p4_item(Ctx& F, int item) {
    const int tid = F.tid, lane = F.lane, w = F.wave;
    const int b = item >> 5, n = (item & 31) >> 1;
    LAS float* carry = (LAS float*)F.lds;
    const float* aggA = (const float*)(F.ws + WS_AGGA); const float* aggB = (const float*)(F.ws + WS_AGGB);
    __syncthreads();
#pragma unroll
    for (int q = 0; q < 2; ++q) { const int ch = tid + 512 * q; float cin = 0.f;
        for (int jn = 0; jn < n; ++jn) cin = aggA[(size_t)(b * 16 + jn) * LW + ch] * cin + aggB[(size_t)(b * 16 + jn) * LW + ch];
        carry[ch] = cin; }
    __syncthreads();
    const bf16* proj = (const bf16*)(F.ws + WS_PROJ); const float* reto = (const float*)(F.ws + WS_RETO); const bf16* hl = (const bf16*)(F.ws + WS_HLOC); const bf16* pl = (const bf16*)(F.ws + WS_PLOC);
    bf16* cat = (bf16*)(F.ws + WS_CAT); const int c0 = 16 * lane;
    float beta_r[16], beta_l[16], cr[16];
#pragma unroll
    for (int q = 0; q < 4; ++q) { const f32x4 a = *(const f32x4*)((const float*)F.in[14] + c0 + 4 * q), bq = *(const f32x4*)((const float*)F.in[15] + c0 + 4 * q); const f32x4 cq = *(const LAS f32x4*)(carry + c0 + 4 * q);
        beta_r[4 * q] = a.x; beta_r[4 * q + 1] = a.y; beta_r[4 * q + 2] = a.z; beta_r[4 * q + 3] = a.w; beta_l[4 * q] = bq.x; beta_l[4 * q + 1] = bq.y; beta_l[4 * q + 2] = bq.z; beta_l[4 * q + 3] = bq.w;
        cr[4 * q] = cq.x; cr[4 * q + 1] = cq.y; cr[4 * q + 2] = cq.z; cr[4 * q + 3] = cq.w; }
#pragma unroll 2
    for (int rr = 0; rr < 8; ++rr) {
        const int t = item * 64 + 8 * w + rr;
        {
            float o[16];
#pragma unroll
            for (int q = 0; q < 4; ++q) { const f32x4 v = *(const f32x4*)(reto + (size_t)t * RW + c0 + 4 * q); o[4 * q] = v.x; o[4 * q + 1] = v.y; o[4 * q + 2] = v.z; o[4 * q + 3] = v.w; }
            float s = 0.f;
#pragma unroll
            for (int q = 0; q < 16; ++q) s += o[q];
            s += __shfl_xor(s, 1); s += __shfl_xor(s, 2); s += __shfl_xor(s, 4);
            const float mu = s * (1.0f / 128.0f); float vq = 0.f;
#pragma unroll
            for (int q = 0; q < 16; ++q) { o[q] -= mu; vq += o[q] * o[q]; }
            vq += __shfl_xor(vq, 1); vq += __shfl_xor(vq, 2); vq += __shfl_xor(vq, 4);
            const float rs = rsqrtf(vq * (1.0f / 128.0f) + EPS);
            const u32x4 g0 = *(const u32x4*)(proj + (size_t)t * NIN + 3 * RW + c0), g1 = *(const u32x4*)(proj + (size_t)t * NIN + 3 * RW + c0 + 8);
            float ss = 0.f;
#pragma unroll
            for (int q = 0; q < 8; ++q) { const unsigned gw_ = (q < 4) ? g0[q & 3] : g1[q & 3]; const float ga = bflo(gw_), gb = bfhi(gw_);
                o[2 * q] = siluf_(ga) * (o[2 * q] * rs); o[2 * q + 1] = siluf_(gb) * (o[2 * q + 1] * rs); ss += o[2 * q] * o[2 * q] + o[2 * q + 1] * o[2 * q + 1]; }
            const float rstd = rsqrtf(wave_sum(ss) * (1.0f / RW) + EPS);
            u32x4 w0, w1;
#pragma unroll
            for (int q = 0; q < 4; ++q) { w0[q] = pk2(o[2 * q] * rstd * beta_r[2 * q], o[2 * q + 1] * rstd * beta_r[2 * q + 1]); w1[q] = pk2(o[8 + 2 * q] * rstd * beta_r[8 + 2 * q], o[9 + 2 * q] * rstd * beta_r[9 + 2 * q]); }
            *(u32x4*)(cat + (size_t)t * DM + c0) = w0; *(u32x4*)(cat + (size_t)t * DM + c0 + 8) = w1;
        }
        {
            const u32x4 h0 = *(const u32x4*)(hl + (size_t)t * LW + c0), h1 = *(const u32x4*)(hl + (size_t)t * LW + c0 + 8), p0 = *(const u32x4*)(pl + (size_t)t * LW + c0), p1 = *(const u32x4*)(pl + (size_t)t * LW + c0 + 8);
            const u32x4 y0 = *(const u32x4*)(proj + (size_t)t * NIN + 5 * RW + c0), y1 = *(const u32x4*)(proj + (size_t)t * NIN + 5 * RW + c0 + 8);
            float o[16]; float ss = 0.f;
#pragma unroll
            for (int q = 0; q < 8; ++q) { const unsigned hw = (q < 4) ? h0[q & 3] : h1[q & 3], pw = (q < 4) ? p0[q & 3] : p1[q & 3], yw = (q < 4) ? y0[q & 3] : y1[q & 3];
                const float ha = bflo(hw) + bflo(pw) * cr[2 * q], hb = bfhi(hw) + bfhi(pw) * cr[2 * q + 1];
                o[2 * q] = ha * gelu_tanh_(bflo(yw)); o[2 * q + 1] = hb * gelu_tanh_(bfhi(yw)); ss += o[2 * q] * o[2 * q] + o[2 * q + 1] * o[2 * q + 1]; }
            const float rstd = rsqrtf(wave_sum(ss) * (1.0f / LW) + EPS);
            u32x4 w0, w1;
#pragma unroll
            for (int q = 0; q < 4; ++q) { w0[q] = pk2(o[2 * q] * rstd * beta_l[2 * q], o[2 * q + 1] * rstd * beta_l[2 * q + 1]); w1[q] = pk2(o[8 + 2 * q] * rstd * beta_l[8 + 2 * q], o[9 + 2 * q] * rstd * beta_l[9 + 2 * q]); }
            *(u32x4*)(cat + (size_t)t * DM + RW + c0) = w0; *(u32x4*)(cat + (size_t)t * DM + RW + c0 + 8) = w1;
        }
    }
    __syncthreads();
}

constexpr int HAP = 2056;
template <bool DRY> __device__ __forceinline__ void p6_item(Ctx& F, int item) {
    const int tid = F.tid, lane = F.lane, w = F.wave, fr = lane & 15, fq = lane >> 4;
    const int t0 = item * 64, b = t0 / SEQ;
    LAS bf16* hA = (LAS bf16*)F.lds;
    LAS float* lgt = (LAS float*)(F.lds + 16 * HAP * 2);
    LAS unsigned char* selE = (LAS unsigned char*)(F.lds + 16 * HAP * 2 + 8 * 16 * 65 * 4); LAS unsigned char* selL = selE + 512; LAS unsigned* wcnt = (LAS unsigned*)(selL + 512); LAS unsigned* gb = wcnt + 512;
    const bf16* x1 = (const bf16*)(F.ws + WS_X1); const float* mod = (const float*)(F.ws + WS_MOD) + (size_t)b * 6 * DM; bf16* h2 = (bf16*)(F.ws + WS_H); unsigned char* h8 = F.ws + WS_H8;
    const bf16* Wr = (const bf16*)(F.ws + WS_WR);
    int* eidx = (int*)(F.ws + WS_EIDX); float* wsel = (float*)(F.ws + WS_WSEL); int* slot = (int*)(F.ws + (DRY ? WS_DEST : WS_SLOT)); unsigned* cnt = (unsigned*)(F.ws + WS_CTL) + CW_CNT + (DRY ? 4096 : 0);
    f32x4 gg[4][2];
#pragma unroll
    for (int j = 0; j < 4; ++j)
#pragma unroll
        for (int h = 0; h < 2; ++h) { const int c = 8 * lane + 512 * j + 4 * h; gg[j][h] = *(const f32x4*)((const float*)F.in[17] + c) * (*(const f32x4*)(mod + 4 * DM + c) + 1.0f); }
    const float brl = ((const float*)F.in[19])[lane]; const int g = lane >> 3;
    unsigned lc = 0u;
    bf16x8 bw[2][4];
#pragma unroll
    for (int ks = 0; ks < 2; ++ks)
#pragma unroll
        for (int et = 0; et < 4; ++et) bw[ks][et] = *(const bf16x8*)(Wr + (size_t)(16 * et + fr) * DM + 256 * w + 32 * ks + 8 * fq);
    u32x4 xq[2][4];
#pragma unroll
    for (int i = 0; i < 2; ++i)
#pragma unroll
        for (int j = 0; j < 4; ++j) xq[i][j] = *(const u32x4*)(x1 + (size_t)(t0 + 2 * w + i) * DM + 8 * lane + 512 * j);
    __syncthreads();
#pragma unroll 1
    for (int ps = 0; ps < 4; ++ps) {
#pragma unroll
        for (int i = 0; i < 2; ++i) { const int rl = 2 * w + i, t = t0 + 16 * ps + rl;
            f32x4 v[4][2]; float ss = 0.f;
#pragma unroll
            for (int j = 0; j < 4; ++j) { const u32x4 xw = xq[i][j]; v[j][0] = (f32x4){bflo(xw.x), bfhi(xw.x), bflo(xw.y), bfhi(xw.y)}; v[j][1] = (f32x4){bflo(xw.z), bfhi(xw.z), bflo(xw.w), bfhi(xw.w)};
#pragma unroll
                for (int h = 0; h < 2; ++h) ss += (v[j][h].x * v[j][h].x + v[j][h].y * v[j][h].y) + (v[j][h].z * v[j][h].z + v[j][h].w * v[j][h].w); }
            const float rstd = rsqrtf(wave_sum(ss) * (1.0f / DM) + EPS);
#pragma unroll
            for (int j = 0; j < 4; ++j) { const f32x4 o0 = v[j][0] * rstd * gg[j][0] + *(const f32x4*)(mod + 3 * DM + 8 * lane + 512 * j), o1 = v[j][1] * rstd * gg[j][1] + *(const f32x4*)(mod + 3 * DM + 8 * lane + 512 * j + 4);
                u32x4 wv; wv.x = pk2(o0.x, o0.y); wv.y = pk2(o0.z, o0.w); wv.z = pk2(o1.x, o1.y); wv.w = pk2(o1.z, o1.w);
                *(LAS u32x4*)(hA + rl * HAP + 8 * lane + 512 * j) = wv;
                u32x2 w8; w8.x = pk4_fp8(o0.x * SC_H8, o0.y * SC_H8, o0.z * SC_H8, o0.w * SC_H8); w8.y = pk4_fp8(o1.x * SC_H8, o1.y * SC_H8, o1.z * SC_H8, o1.w * SC_H8);
                *(u32x2*)(h8 + (size_t)t * DM + 8 * lane + 512 * j) = w8; }
            __builtin_amdgcn_sched_barrier(0); }
        __syncthreads();
        {
            f32x4 acc[4];
#pragma unroll
            for (int et = 0; et < 4; ++et) acc[et] = (f32x4){0.f, 0.f, 0.f, 0.f};
            bf16x8 bw2[6][4];
#pragma unroll
            for (int ks = 0; ks < 6; ++ks)
#pragma unroll
                for (int et = 0; et < 4; ++et) bw2[ks][et] = *(const bf16x8*)(Wr + (size_t)(16 * et + fr) * DM + 256 * w + 64 + 32 * ks + 8 * fq);
#pragma unroll
            for (int ks = 0; ks < 2; ++ks) { const bf16x8 a = *(const LAS bf16x8*)(hA + fr * HAP + 256 * w + 32 * ks + 8 * fq);
#pragma unroll
                for (int et = 0; et < 4; ++et) acc[et] = __builtin_amdgcn_mfma_f32_16x16x32_bf16(a, bw[ks][et], acc[et], 0, 0, 0); }
#pragma unroll
            for (int ks = 0; ks < 6; ++ks) { const bf16x8 a = *(const LAS bf16x8*)(hA + fr * HAP + 256 * w + 64 + 32 * ks + 8 * fq);
#pragma unroll
                for (int et = 0; et < 4; ++et) acc[et] = __builtin_amdgcn_mfma_f32_16x16x32_bf16(a, bw2[ks][et], acc[et], 0, 0, 0); }
#pragma unroll
            for (int et = 0; et < 4; ++et)
#pragma unroll
                for (int rr = 0; rr < 4; ++rr) lgt[(w * 16 + 4 * fq + rr) * 65 + 16 * et + fr] = acc[et][rr];
        }
        __syncthreads();
        if (ps + 1 < 4) {
#pragma unroll
            for (int i = 0; i < 2; ++i)
#pragma unroll
                for (int j = 0; j < 4; ++j) xq[i][j] = *(const u32x4*)(x1 + (size_t)(t0 + 16 * (ps + 1) + 2 * w + i) * DM + 8 * lane + 512 * j); }
#pragma unroll 1
        for (int i = 0; i < 2; ++i) {
            const int tl = 2 * w + i, tt = 16 * ps + tl; float z = 0.f;
#pragma unroll
            for (int w2 = 0; w2 < 8; ++w2) z += lgt[(w2 * 16 + tl) * 65 + lane];
            const float s = sigmoidf_(z); const float bsc = s + brl;
            float m1 = bsc; m1 = fmaxf(m1, __shfl_xor(m1, 1)); m1 = fmaxf(m1, __shfl_xor(m1, 2)); m1 = fmaxf(m1, __shfl_xor(m1, 4));
            const unsigned long long eq = __ballot(bsc == m1); const unsigned gm = (unsigned)(eq >> (8 * g)) & 0xffu;
            const bool first = (lane & 7) == (__builtin_ctz(gm | 0x100u) & 7);
            float m2 = first ? -3.0e38f : bsc; m2 = fmaxf(m2, __shfl_xor(m2, 1)); m2 = fmaxf(m2, __shfl_xor(m2, 2)); m2 = fmaxf(m2, __shfl_xor(m2, 4));
            const float gs = m1 + m2;
            int rank_g = 0;
#pragma unroll
            for (int g2 = 0; g2 < 8; ++g2) { const float o = __int_as_float(__builtin_amdgcn_readlane(__float_as_int(gs), 8 * g2)); rank_g += (o > gs || (o == gs && g2 < g)) ? 1 : 0; }
            const bool selg = rank_g < 4;
            const float key = selg ? bsc : -3.0e38f;
            int rank = 0;
#pragma unroll
            for (int e2 = 0; e2 < 64; ++e2) { const float o = __int_as_float(__builtin_amdgcn_readlane(__float_as_int(key), e2)); rank += (o > key || (o == key && e2 < lane)) ? 1 : 0; }
            const bool chosen = selg && rank < 8;
            const float wsum = wave_sum(chosen ? s : 0.f);
            if (chosen) { const int t = t0 + tt; eidx[t * 8 + rank] = lane; wsel[t * 8 + rank] = s * (2.5f / wsum); selE[tt * 8 + rank] = (unsigned char)lane; selL[tt * 8 + rank] = (unsigned char)lc; }
            lc += chosen ? 1u : 0u;
        }
        __syncthreads();
    }
    wcnt[w * 64 + lane] = lc;
    __syncthreads();
    if (w == 0) { unsigned tot = 0u;
#pragma unroll
        for (int w2 = 0; w2 < 8; ++w2) tot += wcnt[w2 * 64 + lane];
        gb[lane] = tot ? __hip_atomic_fetch_add(cnt + 32 * lane, tot, __ATOMIC_RELAXED, __HIP_MEMORY_SCOPE_AGENT) : 0u; }
    __syncthreads();
    { const int tok = tid >> 3, k = tid & 7, e = selE[tok * 8 + k], wt = (tok & 15) >> 1; unsigned off = gb[e] + selL[tok * 8 + k];
        for (int w2 = 0; w2 < wt; ++w2) off += wcnt[w2 * 64 + e];
        slot[(t0 + tok) * 8 + k] = (int)off; if (!DRY) ((int*)(F.ws + WS_TOKOF))[(size_t)e * T + off] = t0 + tok; }
    __syncthreads();
}

__device__ __forceinline__ void p10_final(Ctx& F, bool have_tables) {
    const int gw = F.vcu * NWAVES + F.wave, NGW = F.G * NWAVES, lane = F.lane;
    const bf16* x1 = (const bf16*)(F.ws + WS_X1); const unsigned char* y = F.ws + WS_Y; const int* eidx = (const int*)(F.ws + WS_EIDX); const int* slot = (const int*)(F.ws + WS_SLOT); const float* wsel = (const float*)(F.ws + WS_WSEL); const float* gf = (const float*)F.in[24];
    LAS int* ps = (LAS int*)F.lds; const unsigned* cnt = (const unsigned*)(F.ws + WS_CTL) + CW_CNT;
    __syncthreads();
    if (have_tables) { if (F.tid < NE) ps[F.tid] = moe_tables(F).tp[F.tid] * 256; }
    else { if (F.tid < NE) ps[64 + F.tid] = (((int)ld_agent(cnt + 32 * F.tid) + 255) >> 8) << 8;
        __syncthreads();
        if (F.tid < NE) { int acc = 0; for (int e = 0; e < F.tid; ++e) acc += ps[64 + e]; ps[F.tid] = acc; } }
    __syncthreads();
    for (int t = gw; t < T; t += NGW) { const int b = t / SEQ; const float* gt2 = (const float*)(F.ws + WS_MOD) + (size_t)b * 6 * DM + 5 * DM;
        int rows[9]; float wk[9];
#pragma unroll
        for (int k = 0; k < 8; ++k) { rows[k] = ps[ld_agent_i(eidx + t * 8 + k)] + ld_agent_i(slot + t * 8 + k); wk[k] = wsel[t * 8 + k] * (1.0f / SC_Y); }
        rows[8] = NR_ROUTED + t; wk[8] = 1.0f / SC_Y;
        float ss = 0.f; f32x4 v[4][2];
#pragma unroll
        for (int j = 0; j < 4; ++j) { const int c = 8 * lane + 512 * j; float s[8];
#pragma unroll
            for (int q = 0; q < 8; ++q) s[q] = 0.f;
#pragma unroll
            for (int k = 0; k < 9; ++k) { const u32x2 yv = *(const u32x2*)(y + (size_t)rows[k] * DM + c);
#pragma unroll
                for (int q = 0; q < 2; ++q) { const f32x2 lo = __builtin_amdgcn_cvt_pk_f32_fp8((int)yv[q], false), hi = __builtin_amdgcn_cvt_pk_f32_fp8((int)yv[q], true);
                    s[4 * q] += wk[k] * lo.x; s[4 * q + 1] += wk[k] * lo.y; s[4 * q + 2] += wk[k] * hi.x; s[4 * q + 3] += wk[k] * hi.y; } }
            const u32x4 xw = *(const u32x4*)(x1 + (size_t)t * DM + c);
#pragma unroll
            for (int hh = 0; hh < 2; ++hh) { const f32x4 xv = hh ? (f32x4){bflo(xw.z), bfhi(xw.z), bflo(xw.w), bfhi(xw.w)} : (f32x4){bflo(xw.x), bfhi(xw.x), bflo(xw.y), bfhi(xw.y)}, gv = *(const f32x4*)(gt2 + c + 4 * hh);
                v[j][hh] = xv + gv * (f32x4){s[4 * hh], s[4 * hh + 1], s[4 * hh + 2], s[4 * hh + 3]};
                ss += (v[j][hh].x * v[j][hh].x + v[j][hh].y * v[j][hh].y) + (v[j][hh].z * v[j][hh].z + v[j][hh].w * v[j][hh].w); } }
        const float rstd = rsqrtf(wave_sum(ss) * (1.0f / DM) + EPS);
#pragma unroll
        for (int j = 0; j < 4; ++j)
#pragma unroll
            for (int hh = 0; hh < 2; ++hh) { const int c = 8 * lane + 512 * j + 4 * hh; *(f32x4*)(F.out + (size_t)t * DM + c) = v[j][hh] * rstd * *(const f32x4*)(gf + c); }
    }
}

__global__ void __launch_bounds__(NWAVES * 64, 2) fwd_kernel(Args args) {
    extern __shared__ __attribute__((aligned(16))) unsigned char lds_raw[];
    Ctx F;
    F.lds = (LAS unsigned char*)lds_raw; F.ws = args.ws; F.in = args.in; F.out = args.out;
    F.tid = threadIdx.x; F.lane = F.tid & 63; F.wave = __builtin_amdgcn_readfirstlane(F.tid >> 6);
    F.G = gridDim.x; { const int bx = blockIdx.x; F.vcu = (F.G % 8 == 0) ? (bx % 8) * (F.G / 8) + bx / 8 : bx; }
    if (F.tid < 16) ((LAS unsigned*)(F.lds + MISC_OFF))[F.tid] = 0u;
    __syncthreads();
    unsigned* ctl = (unsigned*)(F.ws + WS_CTL);
#if N_LAUNCHES == 1
    XcdBarrier bar = xcd_barrier_post(ctl + CW_BAR, (volatile LAS unsigned*)(F.lds + MISC_OFF));
#define GRID_BAR() xcd_barrier(bar)
#else
#define GRID_BAR() do { } while (0)
#endif
    const int lo = args.ph_lo, hi = args.ph_hi;
#define IN(k) (lo <= (k) && (k) < hi)
#define BOTH(k) (IN(k) && IN((k) + 1))
    const int NIT = F.G;

#define REP(k) _Pragma("unroll") for (int rep_ = 0; rep_ < ((PROBE_PHASE == (k)) ? 2 : 1); ++rep_)
    if (IN(0)) { p0_adaln(F); p0_prologue(F); if (BOTH(0)) p0_wait_mod(F); }
    if (IN(1)) { REP(1) { p1_norm(F); } if (BOTH(1)) GRID_BAR(); if (PROBE_PHASE == 100) { GRID_BAR(); GRID_BAR(); GRID_BAR(); GRID_BAR(); } }
    if (IN(2)) {
        if (F.vcu & 1) p2_convert_experts(F);
        REP(2) {
        g8::DenseOrder S; S.init(F.ws + WS_H, F.ws + WS_WIN, T, NIN, DM * 2, F.G, (int)blockIdx.x);
        EpiProj E{(bf16*)(F.ws + WS_PROJ)};
        g8::gemm_phase<EpiProj, g8::DenseOrder>(F.lds, DM * 2, S, E);
        }
        if (!(F.vcu & 1)) p2_convert_experts(F);
        if (BOTH(2)) GRID_BAR();
    }
    if (IN(3)) {
        for (int it = F.vcu; it < NB * 8 * 4 * ((PROBE_PHASE == 31) ? 2 : 1); it += NIT) ret_item(F, it & 255);
        {
            LruIn La, Lb; int it = F.vcu; const int NL = NB * 16 * 8;
            __syncthreads();
            if (it < NL) lru_issue(F, it, La);
            while (it < NL) {
                if (it + NIT < NL) lru_issue(F, it + NIT, Lb);
                lru_body(F, it, La); it += NIT;
                if (it >= NL) break;
                if (it + NIT < NL) lru_issue(F, it + NIT, La);
                lru_body(F, it, Lb); it += NIT;
            }
        }
        if (BOTH(3)) GRID_BAR();
    }
    if (IN(4)) { REP(4) { for (int it = F.vcu; it < T / 64; it += NIT) p4_item(F, it); } if (BOTH(4)) GRID_BAR(); }
    if (IN(5)) {
        REP(5) {
        g8::DenseOrder S; S.init(F.ws + WS_CAT, F.ws + WS_WOUT, T, DM, DM * 2, F.G, (int)blockIdx.x);
        EpiWout E{(const float*)F.in[0], (const float*)(F.ws + WS_MOD), (bf16*)(F.ws + WS_X1)};
        g8::gemm_phase<EpiWout, g8::DenseOrder>(F.lds, DM * 2, S, E);
        }
        if (BOTH(5)) GRID_BAR();
    }
    if (IN(6)) { for (int it = F.vcu; it < T / 64; it += NIT) p6_item<false>(F, it); if (PROBE_PHASE == 6) { for (int it = F.vcu; it < T / 64; it += NIT) p6_item<true>(F, it); } if (BOTH(6)) GRID_BAR(); }
    int ntiles = 0;
    if (IN(8)) {
        REP(8) {
        ntiles = moe_build_tables(F);
        MoeOrder<1> S; S.init(F, ntiles);
        EpiSwiglu E{F.ws + WS_ACT};
        g8::gemm_phase<EpiSwiglu, MoeOrder<1>, true>(F.lds, DM, S, E);
        }
        if (BOTH(8)) GRID_BAR();
    }
    if (IN(9)) {
        REP(9) {
        if (!IN(8)) ntiles = moe_build_tables(F);
        MoeOrder<2> S; S.init(F, ntiles);
        EpiDown E{F.ws + WS_Y};
        g8::gemm_phase<EpiDown, MoeOrder<2>, true>(F.lds, EH, S, E);
        }
        if (BOTH(9)) GRID_BAR();
    }
    if (IN(10)) { REP(10) { p10_final(F, IN(8)); } }
#undef REP
#undef IN
#undef BOTH
}

extern "C" void kernel_launch(void* const* d_in, const int* in_sizes, int n_in, void* d_out, int out_size, void* d_ws, size_t ws_size, hipStream_t stream) {
    static int grid = 0;
    if (grid == 0) {
        if (n_in != 25 || out_size != T * DM || ws_size < WS_END) { fprintf(stderr, "kernel_launch: unexpected problem (n_in %d, out %d, ws %zu)\n", n_in, out_size, ws_size); grid = -1; return; }
        int dev = 0, cus = 0, per_cu = 0;
        if (hipGetDevice(&dev) != hipSuccess || hipDeviceGetAttribute(&cus, hipDeviceAttributeMultiprocessorCount, dev) != hipSuccess) { grid = -1; return; }
        if (hipFuncSetAttribute((const void*)fwd_kernel, hipFuncAttributeMaxDynamicSharedMemorySize, LDS_BYTES) != hipSuccess) { fprintf(stderr, "kernel_launch: hipFuncSetAttribute failed\n"); grid = -1; return; }
        if (hipOccupancyMaxActiveBlocksPerMultiprocessor(&per_cu, (const void*)fwd_kernel, NWAVES * 64, LDS_BYTES) != hipSuccess || per_cu < 1) { fprintf(stderr, "kernel_launch: occupancy query says %d\n", per_cu); }
        (void)hipGetLastError();
        grid = cus;
    }
    if (grid < 0) return;
    (void)hipMemsetAsync((char*)d_ws + WS_CTL, 0, CTL_ZERO_BYTES, stream);
    Args a{};
    for (int i = 0; i < 25; ++i) a.in[i] = d_in[i];
    a.out = (float*)d_out; a.ws = (unsigned char*)d_ws;
#if N_LAUNCHES == 1
    a.ph_lo = 0; a.ph_hi = 11;
    hipLaunchKernelGGL(fwd_kernel, dim3(grid), dim3(NWAVES * 64), LDS_BYTES, stream, a);
#else
    for (int p = 0; p < 11; ++p) { a.ph_lo = p; a.ph_hi = p + 1; hipLaunchKernelGGL(fwd_kernel, dim3(grid), dim3(NWAVES * 64), LDS_BYTES, stream, a); }
#endif
}
```

```cpp
#include <hip/hip_runtime.h>
#include <cstdio>
#include <cstdint>

#ifndef PROBE_PHASE
#define PROBE_PHASE -1
#endif
#ifndef N_LAUNCHES
#define N_LAUNCHES 1
#endif

#define LAS __attribute__((address_space(3)))
typedef unsigned short bf16;
typedef short bf16x8 __attribute__((ext_vector_type(8)));
typedef float f32x4 __attribute__((ext_vector_type(4)));
typedef float f32x2 __attribute__((ext_vector_type(2)));
typedef unsigned u32x4 __attribute__((ext_vector_type(4)));
typedef unsigned u32x2 __attribute__((ext_vector_type(2)));
typedef int i32x4 __attribute__((ext_vector_type(4)));
typedef int i32x8 __attribute__((ext_vector_type(8)));

constexpr int NB = 8, SEQ = 2048, DM = 2048, T = NB * SEQ;
constexpr int NIN = 6144, RW = 1024, LW = 1024, NE = 64, EH = 512, TOPK = 8;
constexpr int NR_ROUTED = T * TOPK + NE * 256;
constexpr int NR = NR_ROUTED + T;
constexpr int NWAVES = 8;
constexpr float EPS = 1e-6f;
constexpr float SC_H8 = 16.0f, SC_WEI = 64.0f, SC_ACT = 8.0f, SC_WEO = 4.0f, SC_Y = 32.0f;

constexpr size_t MiB = 1u << 20;
constexpr size_t WS_CTL = 0, CTL_ZERO_BYTES = 2 * MiB;
constexpr size_t WS_MOD = 1 * MiB;
constexpr size_t WS_ROPE = 2 * MiB;
constexpr size_t WS_WIN = 10 * MiB;
constexpr size_t WS_WOUT = 34 * MiB;
constexpr size_t WS_WR = 42 * MiB;
constexpr size_t WS_WA = WS_WR + 256 * 1024;
constexpr size_t WS_WX = WS_WA + 256 * 1024;
constexpr size_t WS_WEI = 44 * MiB;
constexpr size_t WS_H8 = 176 * MiB;
constexpr size_t WS_WEO = 304 * MiB;
constexpr size_t WS_H = 434 * MiB;
constexpr size_t WS_X1 = 500 * MiB;
constexpr size_t WS_EIDX = 628 * MiB;
constexpr size_t WS_WSEL = WS_EIDX + 512 * 1024;
constexpr size_t WS_SLOT = WS_WSEL + 512 * 1024;
constexpr size_t WS_DEST = WS_SLOT + 512 * 1024;
constexpr size_t WS_RTOK = WS_DEST + 512 * 1024;
constexpr size_t WS_RW = WS_RTOK + 640 * 1024;
constexpr size_t WS_AGGA = 632 * MiB;
constexpr size_t WS_AGGB = WS_AGGA + 512 * 1024;
constexpr size_t WS_ACT = 634 * MiB;
constexpr size_t WS_PROJ = 794 * MiB;
constexpr size_t WS_RETO = 986 * MiB;
constexpr size_t WS_HLOC = 1050 * MiB;
constexpr size_t WS_PLOC = 1082 * MiB;
constexpr size_t WS_CAT = 1114 * MiB;
constexpr size_t WS_Y = 794 * MiB;
constexpr size_t WS_TOKOF = 1434 * MiB;
constexpr size_t WS_END = 1438 * MiB;
constexpr int CW_BAR = 4096;
constexpr int CW_CNT = 8192;
constexpr int CW_MODCNT = 16384;

constexpr int RING_BYTES = 131072;
constexpr int LDS_BYTES = 147456;
constexpr int TT_OFF = 137216;
constexpr int MISC_OFF = LDS_BYTES - 256;
static_assert(TT_OFF + (2 * 704 + 80 + 68) * 4 <= MISC_OFF, "LDS map");
constexpr int MAXTILES = 704;

__device__ __forceinline__ unsigned pk2(float lo, float hi) { unsigned r; asm volatile("v_cvt_pk_bf16_f32 %0, %1, %2" : "=v"(r) : "v"(lo), "v"(hi)); return r; }
typedef __bf16 bf16x2_t __attribute__((ext_vector_type(2)));
__device__ __forceinline__ unsigned pk2c(float lo, float hi) { const bf16x2_t r = __builtin_convertvector((f32x2){lo, hi}, bf16x2_t); return __builtin_bit_cast(unsigned, r); }
__device__ __forceinline__ bf16 f2bf(float f) { return __builtin_bit_cast(bf16, (__bf16)f); }
__device__ __forceinline__ float bf2f(bf16 b) { return __uint_as_float(((unsigned)b) << 16); }
__device__ __forceinline__ float bflo(unsigned w) { return __uint_as_float(w << 16); }
__device__ __forceinline__ float bfhi(unsigned w) { return __uint_as_float(w & 0xffff0000u); }
__device__ __forceinline__ float wave_sum(float v) {
#pragma unroll
    for (int o = 1; o < 64; o <<= 1) v += __shfl_xor(v, o);
    return v;
}
__device__ __forceinline__ float sigmoidf_(float x) { return __builtin_amdgcn_rcpf(1.0f + __expf(-x)); }
__device__ __forceinline__ float siluf_(float x) { return x * __builtin_amdgcn_rcpf(1.0f + __expf(-x)); }
__device__ __forceinline__ float gelu_tanh_(float x) { const float u = 0.7978845608028654f * (x + 0.044715f * x * x * x); const float e = __expf(2.0f * u); const float th = 1.0f - 2.0f * __builtin_amdgcn_rcpf(e + 1.0f); return 0.5f * x * (1.0f + th); }
__device__ __forceinline__ unsigned ld_agent(const unsigned* p) { return __hip_atomic_load(p, __ATOMIC_RELAXED, __HIP_MEMORY_SCOPE_AGENT); }
__device__ __forceinline__ int ld_agent_i(const int* p) { return (int)__hip_atomic_load((const unsigned*)p, __ATOMIC_RELAXED, __HIP_MEMORY_SCOPE_AGENT); }
__device__ __forceinline__ float clamp448(float x) { return __builtin_amdgcn_fmed3f(x, -448.0f, 448.0f); }
__device__ __forceinline__ unsigned pk4_fp8(float a, float b, float c, float d) { int w = 0; w = __builtin_amdgcn_cvt_pk_fp8_f32(clamp448(a), clamp448(b), w, false); w = __builtin_amdgcn_cvt_pk_fp8_f32(clamp448(c), clamp448(d), w, true); return (unsigned)w; }
#define LDS_WAIT() asm volatile("s_waitcnt lgkmcnt(0)" ::: "memory")
#define VM_WAIT() asm volatile("s_waitcnt vmcnt(0)" ::: "memory")

#define XB_TMO      128
#define XB_XCNT(j)  (256  + 64 * (j))
#define XB_XSUB(j)  (1280 + 64 * (j))
#define XB_XGEN(j)  (2304 + 64 * (j))
#define XB_TOP      3328
#define XB_TOPGEN   3392
#define XCD_BAR_WORDS 3456
#define XB_SPIN_CAP (1u << 18)
__device__ __forceinline__ unsigned xb_ld(unsigned* p)              { return __hip_atomic_load(p, __ATOMIC_RELAXED, __HIP_MEMORY_SCOPE_AGENT); }
__device__ __forceinline__ unsigned xb_add(unsigned* p, unsigned v) { return __hip_atomic_fetch_add(p, v, __ATOMIC_RELAXED, __HIP_MEMORY_SCOPE_AGENT); }
__device__ __forceinline__ unsigned xb_xcc_id() { return (unsigned)__builtin_amdgcn_s_getreg((3 << 11) | 20) & 0xFu; }
#define XB_SPIN(cond, bar) do { unsigned _sp = 0; while (cond) { __builtin_amdgcn_s_sleep(1); \
    if ((++_sp & 255u) == 0u) { if (xb_ld(&(bar)[XB_TMO])) break; if (_sp > XB_SPIN_CAP) { atomicAdd(&(bar)[XB_TMO], 1u); break; } } } } while (0)
struct XcdBarrier { unsigned* bar; unsigned x; volatile LAS unsigned* st; };
__device__ __forceinline__ XcdBarrier xcd_barrier_post(unsigned* bar, volatile LAS unsigned* st) {
    XcdBarrier b; b.bar = bar; b.x = xb_xcc_id(); b.st = st;
    if (threadIdx.x == 0) (void)xb_add(&bar[XB_XCNT(b.x)], 1u);
    return b;
}
__device__ __forceinline__ void xcd_barrier_complete(unsigned* bar, unsigned x, unsigned& nloc, unsigned& nx) {
    const unsigned G = gridDim.x * gridDim.y * gridDim.z;
    unsigned sum, cnt, mine, sp = 0u;
    for (;;) {
        sum = 0u; cnt = 0u; mine = 0u;
#pragma unroll
        for (unsigned j = 0; j < 16; ++j) { const unsigned c = xb_ld(&bar[XB_XCNT(j)]); sum += c; cnt += (c > 0u) ? 1u : 0u; mine = (j == x) ? c : mine; }
        if (sum == G) break;
        __builtin_amdgcn_s_sleep(1);
        if ((++sp & 255u) == 0u) { if (xb_ld(&bar[XB_TMO])) break; if (sp > XB_SPIN_CAP) { atomicAdd(&bar[XB_TMO], 1u); break; } }
    }
    nloc = mine > 0u ? mine : 1u; nx = cnt > 0u ? cnt : 1u;
}
__device__ __forceinline__ void xcd_barrier(const XcdBarrier& b) {
    asm volatile("s_waitcnt vmcnt(0)" ::: "memory");
    __syncthreads();
    if (threadIdx.x == 0) {
        unsigned* bar = b.bar;
        __builtin_amdgcn_s_waitcnt(0);
        unsigned nloc = b.st[0], nx = b.st[1];
        if (nloc == 0u) { xcd_barrier_complete(bar, b.x, nloc, nx); b.st[0] = nloc; b.st[1] = nx; }
        const unsigned old = xb_add(&bar[XB_XSUB(b.x)], 1u);
        const unsigned gen = old / nloc;
        if (old + 1u == (gen + 1u) * nloc) {
            __builtin_amdgcn_fence(__ATOMIC_RELEASE, "agent");
            asm volatile("s_waitcnt vmcnt(0)" ::: "memory");
            const unsigned og = xb_add(&bar[XB_TOP], 1u);
            const unsigned tg = og / nx;
            if (og + 1u == (tg + 1u) * nx) xb_add(&bar[XB_TOPGEN], 1u);
            else XB_SPIN(xb_ld(&bar[XB_TOPGEN]) == tg, bar);
            __builtin_amdgcn_fence(__ATOMIC_ACQUIRE, "agent");
            xb_add(&bar[XB_XGEN(b.x)], 1u);
            asm volatile("s_waitcnt vmcnt(0)" ::: "memory");
        } else {
            XB_SPIN(xb_ld(&bar[XB_XGEN(b.x)]) == gen, bar);
            __builtin_amdgcn_fence(__ATOMIC_ACQUIRE, "agent");
            asm volatile("s_waitcnt vmcnt(0)" ::: "memory");
        }
    }
    __syncthreads();
}

namespace g8 {
constexpr int BM = 256, BK = 64, HALF = 128, HTB = HALF * BK * 2, NXCD = 8, WGM = 8;
__device__ __forceinline__ int lds_byte(int r, int c) { const int st = (r >> 4) * 2 + (c >> 5), rr = r & 15, cc = c & 31, ob = rr * 64 + cc * 2; return st * 1024 + (ob ^ (((ob >> 9) & 1) << 5)); }
__device__ __forceinline__ void stage_rc(int b, int& R, int& C) { const int st = b / 1024, sb = b % 1024, swz = sb ^ (((sb >> 9) & 1) << 5); R = (st >> 1) * 16 + swz / 64; C = (st & 1) * 32 + (swz % 64) / 2; }
__device__ __forceinline__ int perm32(int rho) { const int n = rho >> 4, i = rho & 15; return 8 * (i >> 2) + 4 * n + (i & 3); }

struct Unit { const char* A; const char* B; unsigned vA0[2], vA1[2]; int r0, pn, e, rend; };

template <class Epi, class Sched, bool F8 = false>
__device__ __forceinline__ void gemm_phase(LAS unsigned char* lds, const int pitch, const Sched& S, const Epi& E) {
    const int tid = threadIdx.x, wid = __builtin_amdgcn_readfirstlane(tid >> 6), lane = tid & 63, wr = wid >> 2, wc = wid & 3, fr = lane & 15, fq = lane >> 4;
    const int nt = pitch / 128;
    unsigned voffB[2], voffB1[2];
#pragma unroll
    for (int i = 0; i < 2; ++i) { int R, C; stage_rc(tid * 16 + i * 8192, R, C); const int p = perm32(R & 31);
        if constexpr (Epi::P16) { const int base = 64 * (R >> 5) + 16 * (p >> 3) + (p & 7); voffB[i] = (unsigned)(base * pitch + C * 2); voffB1[i] = (unsigned)((base + 8) * pitch + C * 2); }
        else { const int Rb = Epi::PERM ? ((R & ~31) + p) : R; voffB[i] = (unsigned)(Rb * pitch + C * 2); voffB1[i] = voffB[i] + (unsigned)(HALF * pitch); } }
    const size_t kstep = 128;
    const size_t hstepB = (size_t)HALF * pitch;
    const unsigned ldsw = (unsigned)wid * 1024u;
    const int aoff = lds_byte(wr * 64 + fr, fq * 8), boff = lds_byte(wc * 32 + fr, fq * 8);
#define G8_SA(b, h) (((b) * 2 + (h)) * HTB)
#define G8_SB(b, h) ((4 + (b) * 2 + (h)) * HTB)
#define G8_STAGE(bufoff, gbase, voff) do { _Pragma("unroll") for (int _i = 0; _i < 2; ++_i) \
        __builtin_amdgcn_global_load_lds((const unsigned*)((const char*)(gbase) + (voff)[_i]), (LAS unsigned*)(lds + (bufoff) + ldsw + _i * 8192), 16, 0, 0); } while (0)
#define G8_LDA(dst, b, h) do { _Pragma("unroll") for (int m = 0; m < 4; ++m) _Pragma("unroll") for (int k = 0; k < 2; ++k) dst[m][k] = *(const LAS bf16x8*)(lds + G8_SA(b, h) + aoff + m * 2048 + k * 1024); } while (0)
#define G8_LDB(dst, b, h) do { _Pragma("unroll") for (int n = 0; n < 2; ++n) _Pragma("unroll") for (int k = 0; k < 2; ++k) dst[n][k] = *(const LAS bf16x8*)(lds + G8_SB(b, h) + boff + n * 2048 + k * 1024); } while (0)
#define G8_CAT(x) __builtin_shufflevector(__builtin_bit_cast(i32x4, x[0]), __builtin_bit_cast(i32x4, x[1]), 0, 1, 2, 3, 4, 5, 6, 7)
#define G8_MMA(ai, bj, At, Bt) do { __builtin_amdgcn_s_setprio(1); _Pragma("unroll") for (int m = 0; m < 4; ++m) _Pragma("unroll") for (int n = 0; n < 2; ++n) { \
        if constexpr (F8) acc[ai][bj][m][n] = __builtin_amdgcn_mfma_scale_f32_16x16x128_f8f6f4(G8_CAT(Bt[n]), G8_CAT(At[m]), acc[ai][bj][m][n], 0, 0, 0, 0x7f7f7f7f, 0, 0x7f7f7f7f); \
        else { _Pragma("unroll") for (int k = 0; k < 2; ++k) acc[ai][bj][m][n] = __builtin_amdgcn_mfma_f32_16x16x32_bf16(Bt[n][k], At[m][k], acc[ai][bj][m][n], 0, 0, 0); } } \
        __builtin_amdgcn_s_setprio(0); } while (0)
#define G8_WAIT_V(n) asm volatile("s_waitcnt vmcnt(" #n ")" ::: "memory")
#define G8_WAIT_L(n) asm volatile("s_waitcnt lgkmcnt(" #n ")" ::: "memory")
#define G8_BAR __builtin_amdgcn_s_barrier()
#define G8_SCHED __builtin_amdgcn_sched_barrier(0)
    Unit cur, nxt; int ui = 0;
    if (!S.next(0, cur)) return;
    f32x4 acc[2][2][4][2];
#pragma unroll
    for (int a = 0; a < 2; ++a)
#pragma unroll
        for (int b = 0; b < 2; ++b)
#pragma unroll
            for (int m = 0; m < 4; ++m)
#pragma unroll
                for (int n = 0; n < 2; ++n) acc[a][b][m][n] = (f32x4){0.f, 0.f, 0.f, 0.f};
    bf16x8 At[4][2], B0[2][2], B1[2][2];
    const char* cA = cur.A; const char* cB = cur.B;
    G8_STAGE(G8_SB(0, 0), cB, voffB); G8_STAGE(G8_SB(0, 1), cB, voffB1); G8_STAGE(G8_SA(0, 0), cA, cur.vA0); G8_STAGE(G8_SA(0, 1), cA, cur.vA1);
    if (wr == 1) G8_BAR;
    G8_WAIT_V(2); G8_BAR;
    G8_STAGE(G8_SB(1, 0), cB + kstep, voffB); G8_STAGE(G8_SA(1, 0), cA + kstep, cur.vA0); G8_STAGE(G8_SB(1, 1), cB + kstep, voffB1);
    G8_WAIT_V(6); G8_BAR;
    for (;;) {
        const bool has_next = S.next(ui + 1, nxt);
        if (!has_next) nxt = cur;
        const char* nA = nxt.A; const char* nB = nxt.B;
#pragma unroll 1
        for (int t = 0; t < nt; t += 2) {
            const bool last = (t == nt - 2);
            const char* a1 = cA + (size_t)(t + 1) * kstep;
            const char* a2 = last ? nA : cA + (size_t)(t + 2) * kstep; const char* b2 = last ? nB : cB + (size_t)(t + 2) * kstep;
            const char* a3 = a2 + kstep; const char* b3 = b2 + kstep;
            G8_LDB(B0, 0, 0); G8_LDB(B1, 0, 1); G8_SCHED; G8_LDA(At, 0, 0); G8_STAGE(G8_SA(1, 1), a1, cur.vA1);
            if (last) { cur.vA0[0] = nxt.vA0[0]; cur.vA0[1] = nxt.vA0[1]; cur.vA1[0] = nxt.vA1[0]; cur.vA1[1] = nxt.vA1[1]; }
            G8_WAIT_V(8); G8_WAIT_L(0); G8_BAR; G8_MMA(0, 0, At, B0); G8_MMA(0, 1, At, B1); G8_BAR; G8_SCHED;
            G8_LDA(At, 0, 1); G8_STAGE(G8_SB(0, 0), b2, voffB); G8_STAGE(G8_SB(0, 1), b2, voffB1); G8_STAGE(G8_SA(0, 0), a2, cur.vA0);
            G8_WAIT_V(8); G8_WAIT_L(0); G8_BAR; G8_MMA(1, 0, At, B0); G8_MMA(1, 1, At, B1); G8_BAR; G8_SCHED;
            G8_LDB(B0, 1, 0); G8_LDB(B1, 1, 1); G8_SCHED; G8_LDA(At, 1, 0); G8_STAGE(G8_SA(0, 1), a2, cur.vA1);
            G8_WAIT_V(8); G8_WAIT_L(0); G8_BAR; G8_MMA(0, 0, At, B0); G8_MMA(0, 1, At, B1); G8_BAR; G8_SCHED;
            G8_LDA(At, 1, 1); G8_STAGE(G8_SB(1, 0), b3, voffB); G8_STAGE(G8_SB(1, 1), b3, voffB1); G8_STAGE(G8_SA(1, 0), a3, cur.vA0);
            G8_WAIT_V(8); G8_WAIT_L(0); G8_BAR; G8_MMA(1, 0, At, B0); G8_MMA(1, 1, At, B1); G8_BAR; G8_SCHED;
        }
        if (wr == 0) G8_BAR;
        E(acc, cur, wr, wc, fr, fq);
        if (!has_next) break;
#pragma unroll
        for (int a = 0; a < 2; ++a)
#pragma unroll
            for (int b = 0; b < 2; ++b)
#pragma unroll
                for (int m = 0; m < 4; ++m)
#pragma unroll
                    for (int n = 0; n < 2; ++n) acc[a][b][m][n] = (f32x4){0.f, 0.f, 0.f, 0.f};
        cur = nxt; cA = nA; cB = nB; ++ui;
        if (wr == 1) G8_BAR;
    }
    G8_WAIT_V(0);
    G8_BAR;
#undef G8_SA
#undef G8_SB
#undef G8_STAGE
#undef G8_LDA
#undef G8_CAT
#undef G8_LDB
#undef G8_MMA
#undef G8_WAIT_V
#undef G8_WAIT_L
#undef G8_BAR
#undef G8_SCHED
}

struct DenseOrder {
    const char* A; const char* Bt; int pitch; int nM, nN, nwg, G, c;
    __device__ void init(const void* A_, const void* Bt_, int M, int N, int pitch_, int G_, int c_) { A = (const char*)A_; Bt = (const char*)Bt_; pitch = pitch_; nM = M / BM; nN = N / BM; nwg = nM * nN; G = G_; c = c_; }
    __device__ __forceinline__ bool next(int i, Unit& u) const {
        const long L = (long)i * G + c; if (L >= nwg) return false;
        int R[2], C[2]; stage_rc((int)threadIdx.x * 16, R[0], C[0]); stage_rc((int)threadIdx.x * 16 + 8192, R[1], C[1]);
        int wgid = (int)L; { const int q = nwg / NXCD, r = nwg % NXCD, xcd = wgid % NXCD, off = wgid / NXCD; wgid = (xcd < r ? xcd * (q + 1) : r * (q + 1) + (xcd - r) * q) + off; }
        const int nig = WGM * nN, gid = wgid / nig, fm = gid * WGM, gsz = (nM - fm) < WGM ? (nM - fm) : WGM;
        const int pm = fm + ((wgid % nig) % gsz), pn = (wgid % nig) / gsz;
        u.A = A + (size_t)pm * BM * pitch; u.B = Bt + (size_t)pn * BM * pitch;
#pragma unroll
        for (int j = 0; j < 2; ++j) { u.vA0[j] = (unsigned)(R[j] * pitch + C[j] * 2); u.vA1[j] = (unsigned)((R[j] + HALF) * pitch + C[j] * 2); }
        u.r0 = pm * BM; u.pn = pn; u.e = 0; u.rend = 0; return true;
    }
};
}

struct Args { const void* in[25]; float* out; unsigned char* ws; int ph_lo, ph_hi; };
struct Ctx {
    LAS unsigned char* lds; unsigned char* ws; const void* const* in; float* out;
    int tid, lane, wave, vcu, G;
};

__device__ __forceinline__ void p0_adaln(Ctx& F) {
    LAS float* sc = (LAS float*)F.lds;
    LAS float* red = (LAS float*)(F.lds + 65536);
    const float* cvec = (const float*)F.in[1]; const float* wada = (const float*)F.in[3]; const float* bada = (const float*)F.in[4]; float* mod = (float*)(F.ws + WS_MOD);
    __syncthreads();
    for (int i = F.tid; i < NB * DM; i += NWAVES * 64) sc[i] = siluf_(cvec[i]);
    __syncthreads();
    for (int cb = F.vcu; cb < 6 * DM / 48; cb += F.G) {
        const int n0 = cb * 48, l = F.lane < 48 ? F.lane : 47, k0 = F.wave * 256;
        float acc[8];
#pragma unroll
        for (int b = 0; b < 8; ++b) acc[b] = 0.f;
        const float* col = wada + (size_t)k0 * (6 * DM) + n0 + l;
#pragma unroll 1
        for (int kk = 0; kk < 256; kk += 32) { float wv[32];
#pragma unroll
            for (int u = 0; u < 32; ++u) wv[u] = col[(size_t)(kk + u) * (6 * DM)];
#pragma unroll
            for (int u = 0; u < 32; ++u)
#pragma unroll
                for (int b = 0; b < 8; ++b) acc[b] += sc[b * DM + k0 + kk + u] * wv[u]; }
        if (F.lane < 48) {
#pragma unroll
            for (int b = 0; b < 8; ++b) red[(F.wave * 8 + b) * 48 + F.lane] = acc[b]; }
        __syncthreads();
        if (F.tid < 384) { const int b = F.tid / 48, cc = F.tid % 48; float s = bada[n0 + cc];
#pragma unroll
            for (int w = 0; w < 8; ++w) s += red[(w * 8 + b) * 48 + cc];
            __hip_atomic_store(mod + (size_t)b * 6 * DM + n0 + cc, s, __ATOMIC_RELAXED, __HIP_MEMORY_SCOPE_AGENT); }
        VM_WAIT();
        __syncthreads();
    }
    if (F.tid == 0) __hip_atomic_fetch_add((unsigned*)(F.ws + WS_CTL) + CW_MODCNT, 1u, __ATOMIC_RELAXED, __HIP_MEMORY_SCOPE_AGENT);
}
__device__ __forceinline__ void p0_wait_mod(Ctx& F) {
    if (F.tid == 0) { unsigned* ctl = (unsigned*)(F.ws + WS_CTL); unsigned sp = 0u;
        while (ld_agent(ctl + CW_MODCNT) < (unsigned)F.G) { __builtin_amdgcn_s_sleep(2); if (++sp > (1u << 20)) { atomicAdd(ctl + CW_BAR + XB_TMO, 1u); break; } }
        __builtin_amdgcn_fence(__ATOMIC_ACQUIRE, "agent");
        asm volatile("s_waitcnt vmcnt(0)" ::: "memory"); }
    __syncthreads();
}
template <bool F8>
__device__ __forceinline__ void p0_transpose_item(const float* W, int K, int N, void* WT, int out_row0, int k0, int n0, float scale, LAS float* scr, int lane) {
    f32x4 v[16];
#pragma unroll
    for (int i = 0; i < 16; ++i) v[i] = *(const f32x4*)(W + (size_t)(k0 + 4 * i + (lane >> 4)) * N + n0 + 4 * (lane & 15));
#pragma unroll
    for (int i = 0; i < 16; ++i) { LAS float* d = scr + (4 * i + (lane >> 4)) * 65 + 4 * (lane & 15); d[0] = v[i].x; d[1] = v[i].y; d[2] = v[i].z; d[3] = v[i].w; }
    LDS_WAIT(); asm volatile("" ::: "memory");
    if (!F8) {
        const int c = lane & 7;
#pragma unroll
        for (int j = 0; j < 8; ++j) { const int n = (lane >> 3) + 8 * j; const LAS float* s = scr + (8 * c) * 65 + n;
            u32x4 o; o.x = pk2(s[0 * 65], s[1 * 65]); o.y = pk2(s[2 * 65], s[3 * 65]); o.z = pk2(s[4 * 65], s[5 * 65]); o.w = pk2(s[6 * 65], s[7 * 65]);
            *(u32x4*)((bf16*)WT + (size_t)(out_row0 + n) * K + k0 + 8 * c) = o; }
    } else {
        const int c = lane & 3;
#pragma unroll
        for (int j = 0; j < 4; ++j) { const int n = (lane >> 2) + 16 * j; const LAS float* s = scr + (16 * c) * 65 + n; int o[4];
#pragma unroll
            for (int q = 0; q < 4; ++q) { int wv = 0; wv = __builtin_amdgcn_cvt_pk_fp8_f32(s[(4 * q) * 65] * scale, s[(4 * q + 1) * 65] * scale, wv, false); wv = __builtin_amdgcn_cvt_pk_fp8_f32(s[(4 * q + 2) * 65] * scale, s[(4 * q + 3) * 65] * scale, wv, true); o[q] = wv; }
            *(u32x4*)((unsigned char*)WT + (size_t)(out_row0 + n) * K + k0 + 16 * c) = (u32x4){(unsigned)o[0], (unsigned)o[1], (unsigned)o[2], (unsigned)o[3]}; }
    }
    LDS_WAIT(); asm volatile("" ::: "memory");
}
struct CvItem { const float* src; unsigned char* dst; int N, K; float scale; };
__device__ __forceinline__ CvItem cv_decode(const void* const* in, unsigned char* ws, int r) {
    constexpr int I_EI = 32 * 16, I_EO = 8 * 32; CvItem c;
    if (r < 65 * I_EI) { const int e = r / I_EI, q = r % I_EI, kb = q / 16, nb = q % 16, n0 = 64 * nb, j = n0 & 511, up = n0 >> 9;
        const float* W = (e < 64) ? (const float*)in[20] + (size_t)e * DM * 1024 : (const float*)in[22];
        c.src = W + (size_t)(64 * kb) * 1024 + n0; c.N = 1024; c.K = DM; c.scale = SC_WEI;
        c.dst = ws + WS_WEI + (size_t)e * 1024 * DM + (size_t)((j >> 7) * 256 + up * 128 + (j & 127)) * DM + 64 * kb; }
    else { r -= 65 * I_EI; const int e = r / I_EO, q = r % I_EO, kb = q / 32, nb = q % 32;
        const float* W = (e < 64) ? (const float*)in[21] + (size_t)e * EH * DM : (const float*)in[23];
        c.src = W + (size_t)(64 * kb) * DM + 64 * nb; c.N = DM; c.K = EH; c.scale = SC_WEO;
        c.dst = ws + WS_WEO + (size_t)e * DM * EH + (size_t)(64 * nb) * EH + 64 * kb; }
    return c;
}
__device__ __forceinline__ void p2_convert_experts(Ctx& F) {
    const int gw = F.vcu * NWAVES + F.wave, NGW = F.G * NWAVES, lane = F.lane, li = lane & 15, lg = lane >> 4;
    constexpr int NCV = 65 * (32 * 16 + 8 * 32);
    int it = gw; CvItem cur; f32x4 v[16];
    const int krow = 16 * (li >> 2) + (li & 3);
#define CV_LOAD(c) do { _Pragma("unroll") for (int nh = 0; nh < 2; ++nh) _Pragma("unroll") for (int q = 0; q < 4; ++q) { const float* p_ = (c).src + (size_t)(krow + 4 * q) * (c).N + 32 * nh + 8 * lg; \
        v[(nh * 4 + q) * 2] = *(const f32x4*)p_; v[(nh * 4 + q) * 2 + 1] = *(const f32x4*)(p_ + 4); } } while (0)
    if (it < NCV) { cur = cv_decode(F.in, F.ws, it); CV_LOAD(cur); }
    while (it < NCV) {
        bf16x8 a[2][4];
#pragma unroll
        for (int nh = 0; nh < 2; ++nh)
#pragma unroll
            for (int q = 0; q < 4; ++q) { const f32x4 lo = v[(nh * 4 + q) * 2], hi = v[(nh * 4 + q) * 2 + 1];
                const u32x4 pk = (u32x4){pk2c(lo.x, lo.y), pk2c(lo.z, lo.w), pk2c(hi.x, hi.y), pk2c(hi.z, hi.w)}; a[nh][q] = __builtin_bit_cast(bf16x8, pk); }
        const CvItem me = cur; const int nit = it + NGW;
        if (nit < NCV) { cur = cv_decode(F.in, F.ws, nit); CV_LOAD(cur); }
        const unsigned sbits = (unsigned)f2bf(me.scale);
#pragma unroll
        for (int h = 0; h < 2; ++h) {
            u32x4 sel = (u32x4){0u, 0u, 0u, 0u}; { const int d = 16 * h + li - 8 * lg; if (d >= 0 && d < 8) { const unsigned wv = (d & 1) ? (sbits << 16) : sbits; if ((d >> 1) == 0) sel.x = wv; else if ((d >> 1) == 1) sel.y = wv; else if ((d >> 1) == 2) sel.z = wv; else sel.w = wv; } }
            const bf16x8 bs = __builtin_bit_cast(bf16x8, sel);
#pragma unroll
            for (int nh = 0; nh < 2; ++nh) { unsigned o[4];
#pragma unroll
                for (int q = 0; q < 4; ++q) { const f32x4 d = __builtin_amdgcn_mfma_f32_16x16x32_bf16(a[nh][q], bs, (f32x4){0.f, 0.f, 0.f, 0.f}, 0, 0, 0); o[q] = pk4_fp8(d[0], d[1], d[2], d[3]); }
                *(u32x4*)(me.dst + (size_t)(32 * nh + 16 * h + li) * me.K + 16 * lg) = (u32x4){o[0], o[1], o[2], o[3]}; }
        }
        it = nit;
    }
#undef CV_LOAD
}
__device__ __forceinline__ void p0_prologue(Ctx& F) {
    LAS float* scr = (LAS float*)(F.lds + F.wave * 16640);
    const int gw = F.vcu * NWAVES + F.wave, NGW = F.G * NWAVES, lane = F.lane;
    unsigned char* ws = F.ws;
    constexpr int I_IN = 32 * 96, I_OUT = 32 * 32, I_R = 32 * 1, I_G = 2 * 2;
    constexpr int NTR = I_IN + I_OUT + I_R + 16 * I_G;
    for (int it = gw; it < NTR; it += NGW) {
        int r = it;
        if (r < I_IN) { const int kb = r / 96, nb = r % 96; p0_transpose_item<false>((const float*)F.in[6], DM, NIN, ws + WS_WIN, 64 * nb, 64 * kb, 64 * nb, 1.f, scr, lane); continue; } r -= I_IN;
        if (r < I_OUT) { const int kb = r / 32, nb = r % 32; p0_transpose_item<false>((const float*)F.in[16], DM, DM, ws + WS_WOUT, 64 * nb, 64 * kb, 64 * nb, 1.f, scr, lane); continue; } r -= I_OUT;
        if (r < I_R) { const int kb = r; p0_transpose_item<false>((const float*)F.in[18], DM, NE, ws + WS_WR, 0, 64 * kb, 0, 1.f, scr, lane); continue; } r -= I_R;
        { const int m = r / I_G, q = r % I_G, kb = q / 2, nb = q % 2, g = m & 7;
          const float* W = ((m < 8) ? (const float*)F.in[9] : (const float*)F.in[11]) + (size_t)g * 128 * 128;
          p0_transpose_item<false>(W, 128, 128, (bf16*)(ws + (m < 8 ? WS_WA : WS_WX)) + (size_t)g * 128 * 128, 64 * nb, 64 * kb, 64 * nb, 1.f, scr, lane); }
    }
    {
        const int* pos = (const int*)F.in[2]; f32x2* rt = (f32x2*)(ws + WS_ROPE);
        for (int it = gw; it < T * 64 / 512; it += NGW) {
#pragma unroll 1
            for (int q = 0; q < 8; ++q) { const int idx = it * 512 + q * 64 + lane, t = idx >> 6, i = idx & 63;
                const double inv = exp(-9.210340371976184 * (double)i / 64.0); const double ang = (double)pos[t] * inv; double sn, cs; sincos(ang, &sn, &cs);
                rt[idx] = (f32x2){(float)cs, (float)sn}; }
        }
    }
    if (gw == 0) { u32x4* z = (u32x4*)((bf16*)(ws + WS_H) + (size_t)T * DM); for (int i = lane; i < DM * 2 / 16; i += 64) z[i] = (u32x4){0u, 0u, 0u, 0u};
        u32x4* z8 = (u32x4*)(ws + WS_H8 + (size_t)T * DM); for (int i = lane; i < DM / 16; i += 64) z8[i] = (u32x4){0u, 0u, 0u, 0u}; }
}

template <bool W8, bool INBF>
__device__ __forceinline__ void norm_mod_row(const void* xrow_, const float* g, const float* sc, const float* sh, bf16* orow, unsigned char* orow8, int lane) {
    f32x4 v[4][2]; float ss = 0.f;
#pragma unroll
    for (int j = 0; j < 4; ++j) {
        if constexpr (INBF) { const u32x4 w = *(const u32x4*)((const bf16*)xrow_ + 8 * lane + 512 * j); v[j][0] = (f32x4){bflo(w.x), bfhi(w.x), bflo(w.y), bfhi(w.y)}; v[j][1] = (f32x4){bflo(w.z), bfhi(w.z), bflo(w.w), bfhi(w.w)}; }
        else { v[j][0] = *(const f32x4*)((const float*)xrow_ + 8 * lane + 512 * j); v[j][1] = *(const f32x4*)((const float*)xrow_ + 8 * lane + 512 * j + 4); }
#pragma unroll
        for (int h = 0; h < 2; ++h) ss += (v[j][h].x * v[j][h].x + v[j][h].y * v[j][h].y) + (v[j][h].z * v[j][h].z + v[j][h].w * v[j][h].w); }
    const float rstd = rsqrtf(wave_sum(ss) * (1.0f / DM) + EPS);
#pragma unroll
    for (int j = 0; j < 4; ++j) { f32x4 o[2];
#pragma unroll
        for (int h = 0; h < 2; ++h) { const int c = 8 * lane + 512 * j + 4 * h; const f32x4 gg = *(const f32x4*)(g + c), s1 = *(const f32x4*)(sc + c), s0 = *(const f32x4*)(sh + c);
            o[h] = (v[j][h] * rstd * gg) * (s1 + 1.0f) + s0; }
        u32x4 w; w.x = pk2(o[0].x, o[0].y); w.y = pk2(o[0].z, o[0].w); w.z = pk2(o[1].x, o[1].y); w.w = pk2(o[1].z, o[1].w);
        *(u32x4*)(orow + 8 * lane + 512 * j) = w;
        if constexpr (W8) { u32x2 w8; w8.x = pk4_fp8(o[0].x * SC_H8, o[0].y * SC_H8, o[0].z * SC_H8, o[0].w * SC_H8); w8.y = pk4_fp8(o[1].x * SC_H8, o[1].y * SC_H8, o[1].z * SC_H8, o[1].w * SC_H8); *(u32x2*)(orow8 + 8 * lane + 512 * j) = w8; } }
}
__device__ __forceinline__ void p1_norm(Ctx& F) {
    const int gw = F.vcu * NWAVES + F.wave, NGW = F.G * NWAVES;
    const float* x = (const float*)F.in[0]; const float* g = (const float*)F.in[5]; const float* mod = (const float*)(F.ws + WS_MOD); bf16* h = (bf16*)(F.ws + WS_H);
    for (int m = gw; m < T; m += NGW) { const int b = m / SEQ; norm_mod_row<false, false>(x + (size_t)m * DM, g, mod + (size_t)b * 6 * DM + DM, mod + (size_t)b * 6 * DM, h + (size_t)m * DM, nullptr, F.lane); }
}

struct EpiProj {
    static constexpr bool PERM = true, P16 = false;
    bf16* O;
    __device__ __forceinline__ void operator()(const f32x4 (&acc)[2][2][4][2], const g8::Unit& u, int wr, int wc, int fr, int fq) const {
        const int row0 = u.r0 + wr * 64 + fr, col0 = u.pn * 256 + wc * 32 + 8 * fq;
#pragma unroll
        for (int ai = 0; ai < 2; ++ai)
#pragma unroll
            for (int m = 0; m < 4; ++m) { bf16* rowp = O + (size_t)(row0 + ai * 128 + m * 16) * NIN + col0;
#pragma unroll
                for (int bj = 0; bj < 2; ++bj) { const f32x4 v0 = acc[ai][bj][m][0], v1 = acc[ai][bj][m][1];
                    u32x4 w; w.x = pk2c(v0[0], v0[1]); w.y = pk2c(v0[2], v0[3]); w.z = pk2c(v1[0], v1[1]); w.w = pk2c(v1[2], v1[3]);
                    *(u32x4*)(rowp + bj * 128) = w; } }
    }
};
struct EpiWout {
    static constexpr bool PERM = true, P16 = false;
    const float* x; const float* mod; bf16* x1;
    __device__ __forceinline__ void operator()(const f32x4 (&acc)[2][2][4][2], const g8::Unit& u, int wr, int wc, int fr, int fq) const {
        const int row0 = u.r0 + wr * 64 + fr, col0 = u.pn * 256 + wc * 32 + 8 * fq; const int b = u.r0 / SEQ;
        const float* gt = mod + (size_t)b * 6 * DM + 2 * DM;
        f32x4 gv[2][2];
#pragma unroll
        for (int bj = 0; bj < 2; ++bj)
#pragma unroll
            for (int n = 0; n < 2; ++n) gv[bj][n] = *(const f32x4*)(gt + col0 + bj * 128 + n * 4);
#pragma unroll
        for (int ai = 0; ai < 2; ++ai)
#pragma unroll
            for (int m = 0; m < 4; ++m) { const size_t off = (size_t)(row0 + ai * 128 + m * 16) * DM + col0;
#pragma unroll
                for (int bj = 0; bj < 2; ++bj) { const f32x4 v0 = *(const f32x4*)(x + off + bj * 128) + gv[bj][0] * acc[ai][bj][m][0], v1 = *(const f32x4*)(x + off + bj * 128 + 4) + gv[bj][1] * acc[ai][bj][m][1];
                    u32x4 w; w.x = pk2(v0[0], v0[1]); w.y = pk2(v0[2], v0[3]); w.z = pk2(v1[0], v1[1]); w.w = pk2(v1[2], v1[3]);
                    *(u32x4*)(x1 + off + bj * 128) = w; }
                asm volatile("" ::: "memory"); }
    }
};
struct EpiSwiglu {
    static constexpr bool PERM = true, P16 = false;
    unsigned char* act;
    __device__ __forceinline__ void operator()(const f32x4 (&acc)[2][2][4][2], const g8::Unit& u, int wr, int wc, int fr, int fq) const {
        const int row0 = u.r0 + wr * 64 + fr, col0 = u.pn * 128 + wc * 32 + 8 * fq;
#pragma unroll
        for (int ai = 0; ai < 2; ++ai)
#pragma unroll
            for (int m = 0; m < 4; ++m) { float o[8];
#pragma unroll
                for (int n = 0; n < 2; ++n)
#pragma unroll
                    for (int j = 0; j < 4; ++j) { const float g = acc[ai][0][m][n][j] * (1.0f / (SC_H8 * SC_WEI)), up = acc[ai][1][m][n][j] * (SC_ACT / (SC_H8 * SC_WEI)); o[4 * n + j] = g * __builtin_amdgcn_rcpf(1.0f + __expf(-g)) * up; }
                u32x2 w; w.x = pk4_fp8(o[0], o[1], o[2], o[3]); w.y = pk4_fp8(o[4], o[5], o[6], o[7]);
                *(u32x2*)(act + (size_t)(row0 + ai * 128 + m * 16) * EH + col0) = w; }
    }
};
struct EpiDown {
    static constexpr bool PERM = true, P16 = true;
    unsigned char* y;
    __device__ __forceinline__ void operator()(const f32x4 (&acc)[2][2][4][2], const g8::Unit& u, int wr, int wc, int fr, int fq) const {
        const int row0 = u.r0 + wr * 64 + fr, col0 = u.pn * 256 + wc * 64 + 16 * fq; constexpr float sc = SC_Y / (SC_ACT * SC_WEO); static_assert(sc == 1.0f, "scales chosen so that y needs no multiply");
#pragma unroll
        for (int ai = 0; ai < 2; ++ai)
#pragma unroll
            for (int m = 0; m < 4; ++m) { u32x4 w;
                { const f32x4 v0 = acc[ai][0][m][0], v1 = acc[ai][0][m][1], v2 = acc[ai][1][m][0], v3 = acc[ai][1][m][1];
                  w.x = pk4_fp8(v0[0], v0[1], v0[2], v0[3]); w.y = pk4_fp8(v1[0], v1[1], v1[2], v1[3]); w.z = pk4_fp8(v2[0], v2[1], v2[2], v2[3]); w.w = pk4_fp8(v3[0], v3[1], v3[2], v3[3]); }
                *(u32x4*)(y + (size_t)(row0 + ai * 128 + m * 16) * DM + col0) = w; }
    }
};

struct MoeTables { LAS int* row0; LAS int* te; LAS int* pend; LAS int* tp; };
__device__ __forceinline__ MoeTables moe_tables(Ctx& F) { MoeTables M; M.row0 = (LAS int*)(F.lds + TT_OFF); M.te = M.row0 + MAXTILES; M.pend = M.te + MAXTILES; M.tp = M.pend + 80; return M; }
__device__ __forceinline__ int moe_build_tables(Ctx& F) {
    MoeTables M = moe_tables(F);
    const unsigned* cnt = (const unsigned*)(F.ws + WS_CTL) + CW_CNT;
    __syncthreads();
    if (F.tid < NE) M.row0[F.tid] = (int)ld_agent(cnt + 32 * F.tid);
    __syncthreads();
    if (F.tid == 0) { int tiles = 0;
        for (int e = 0; e < NE; ++e) { const int c = M.row0[e]; M.tp[e] = tiles; M.pend[e] = tiles * 256 + c; tiles += (c + 255) >> 8; }
        M.tp[NE] = NR_ROUTED / 256; M.pend[NE] = NR; M.tp[NE + 1] = NR_ROUTED / 256 + T / 256; M.tp[NE + 2] = tiles; }
    __syncthreads();
    const int rt = M.tp[NE + 2];
    for (int tau = F.tid; tau < rt; tau += NWAVES * 64) { int e = 0; while (e + 1 < NE && M.tp[e + 1] <= tau) ++e; M.te[tau] = e; M.row0[tau] = tau * 256; }
    for (int s = F.tid; s < T / 256; s += NWAVES * 64) { M.te[rt + s] = NE; M.row0[rt + s] = NR_ROUTED + s * 256; }
    __syncthreads();
    return rt + T / 256;
}
template <int PHASE>
struct MoeOrder {
    MoeTables M; const char* A; const char* W; const int* row_tok; int U, CH, x, j;
    static constexpr int NPN = (PHASE == 1) ? 4 : 8;
    __device__ void init(Ctx& F, int ntiles) { M = moe_tables(F); U = ntiles * NPN; CH = (U + 7) / 8; x = F.vcu / (F.G / 8); j = F.vcu % (F.G / 8);
        A = (const char*)(F.ws + (PHASE == 1 ? WS_H8 : WS_ACT)); W = (const char*)(F.ws + (PHASE == 1 ? WS_WEI : WS_WEO)); row_tok = (const int*)(F.ws + WS_TOKOF); }
    __device__ __forceinline__ bool next(int i, g8::Unit& u) const {
        const int q = i * 32 + j; const int L = x * CH + q; if (q >= CH || L >= U) return false;
        int R[2], C[2]; g8::stage_rc((int)threadIdx.x * 16, R[0], C[0]); g8::stage_rc((int)threadIdx.x * 16 + 8192, R[1], C[1]);
        const int tile = L / NPN, pn = L % NPN;
        const int e = __builtin_amdgcn_readfirstlane(M.te[tile]), r0 = __builtin_amdgcn_readfirstlane(M.row0[tile]), rend = __builtin_amdgcn_readfirstlane(M.pend[e]);
        u.r0 = r0; u.pn = pn; u.e = e; u.rend = rend; u.A = A;
        if (PHASE == 1) {
            u.B = W + ((size_t)e * 1024 + (size_t)pn * 256) * DM;
#pragma unroll
            for (int k = 0; k < 2; ++k) { const int ra = r0 + R[k], rb = ra + 128; int ta, tb;
                if (e == NE) { ta = ra - NR_ROUTED; tb = rb - NR_ROUTED; }
                else { const int ps_ = __builtin_amdgcn_readfirstlane(M.tp[e]) * 256; const int* tk = row_tok + (size_t)e * T - ps_; ta = (ra < rend) ? ld_agent_i(tk + ra) : T; tb = (rb < rend) ? ld_agent_i(tk + rb) : T; }
                u.vA0[k] = (unsigned)(ta * DM + C[k] * 2); u.vA1[k] = (unsigned)(tb * DM + C[k] * 2); }
        } else {
            u.B = W + ((size_t)e * DM + (size_t)pn * 256) * EH;
#pragma unroll
            for (int k = 0; k < 2; ++k) { u.vA0[k] = (unsigned)((r0 + R[k]) * EH + C[k] * 2); u.vA1[k] = (unsigned)((r0 + R[k] + 128) * EH + C[k] * 2); }
        }
        asm volatile("" : "+v"(u.vA0[0]), "+v"(u.vA0[1]), "+v"(u.vA1[0]), "+v"(u.vA1[1]));
        return true;
    }
};

constexpr int LP = 136;
__device__ __forceinline__ void ret_item(Ctx& F, int item) {
    const int tid = F.tid, lane = F.lane, w = F.wave, fr = lane & 15, fq = lane >> 4;
    const int b = item >> 5, h = (item >> 2) & 7, eb = item & 3;
    LAS bf16* qL = (LAS bf16*)(F.lds); LAS bf16* kL = qL + 128 * LP; LAS bf16* kTL = kL + 128 * LP; LAS bf16* vTL = kTL + 128 * LP; LAS bf16* STL = vTL + 32 * LP;
    const bf16* proj = (const bf16*)(F.ws + WS_PROJ); const f32x2* rope = (const f32x2*)(F.ws + WS_ROPE); float* reto = (float*)(F.ws + WS_RETO);
    const float lg = log1pf(-exp2f(-5.0f - (float)h)), lg2 = lg * 1.4426950408889634f, dec = __expf(lg * 128.0f);
    f32x4 st[2] = {(f32x4){0.f, 0.f, 0.f, 0.f}, (f32x4){0.f, 0.f, 0.f, 0.f}};
    __syncthreads();
    for (int i = tid; i < 32 * LP; i += NWAVES * 64) STL[i] = 0;
    const int r = tid >> 2, qd = tid & 3, j0 = 16 * qd;
    const float kdec = __builtin_amdgcn_exp2f(lg2 * (float)(127 - r));
    u32x4 q1[2], q2[2], k1[2], k2[2], vv; f32x2 cs[16];
#define RET_LOAD(nn) do { const bf16* p_ = proj + (size_t)(b * SEQ + (nn) * 128 + r) * NIN + h * 128; const f32x2* c_ = rope + (size_t)(b * SEQ + (nn) * 128 + r) * 64 + j0; \
        q1[0] = *(const u32x4*)(p_ + j0); q1[1] = *(const u32x4*)(p_ + j0 + 8); q2[0] = *(const u32x4*)(p_ + 64 + j0); q2[1] = *(const u32x4*)(p_ + 64 + j0 + 8); \
        k1[0] = *(const u32x4*)(p_ + RW + j0); k1[1] = *(const u32x4*)(p_ + RW + j0 + 8); k2[0] = *(const u32x4*)(p_ + RW + 64 + j0); k2[1] = *(const u32x4*)(p_ + RW + 64 + j0 + 8); \
        vv = *(const u32x4*)(p_ + 2 * RW + eb * 32 + qd * 8); \
        _Pragma("unroll") for (int jj_ = 0; jj_ < 16; ++jj_) cs[jj_] = c_[jj_]; } while (0)
    RET_LOAD(0);
#pragma unroll 1
    for (int n = 0; n < 16; ++n) {
        const int t0 = b * SEQ + n * 128;
        __syncthreads();
        {
#pragma unroll
            for (int hh = 0; hh < 2; ++hh) { unsigned oq1[4], oq2[4], ok1[4], ok2[4];
#pragma unroll
                for (int c = 0; c < 4; ++c) { float a[2], bq[2], ka[2], kb[2];
#pragma unroll
                    for (int z = 0; z < 2; ++z) { const int jj = hh * 8 + c * 2 + z; const f32x2 sc = cs[jj];
                        const float x1 = z ? bfhi(q1[hh][c]) : bflo(q1[hh][c]), x2 = z ? bfhi(q2[hh][c]) : bflo(q2[hh][c]);
                        const float y1 = z ? bfhi(k1[hh][c]) : bflo(k1[hh][c]), y2 = z ? bfhi(k2[hh][c]) : bflo(k2[hh][c]);
                        a[z] = (x1 * sc.x - x2 * sc.y) * 0.08838834764831845f; bq[z] = (x2 * sc.x + x1 * sc.y) * 0.08838834764831845f;
                        ka[z] = y1 * sc.x - y2 * sc.y; kb[z] = y2 * sc.x + y1 * sc.y;
                        kTL[(j0 + jj) * LP + r] = f2bf(ka[z] * kdec); kTL[(64 + j0 + jj) * LP + r] = f2bf(kb[z] * kdec); }
                    oq1[c] = pk2(a[0], a[1]); oq2[c] = pk2(bq[0], bq[1]); ok1[c] = pk2(ka[0], ka[1]); ok2[c] = pk2(kb[0], kb[1]); }
                *(LAS u32x4*)(qL + r * LP + j0 + hh * 8) = (u32x4){oq1[0], oq1[1], oq1[2], oq1[3]}; *(LAS u32x4*)(qL + r * LP + 64 + j0 + hh * 8) = (u32x4){oq2[0], oq2[1], oq2[2], oq2[3]};
                *(LAS u32x4*)(kL + r * LP + j0 + hh * 8) = (u32x4){ok1[0], ok1[1], ok1[2], ok1[3]}; *(LAS u32x4*)(kL + r * LP + 64 + j0 + hh * 8) = (u32x4){ok2[0], ok2[1], ok2[2], ok2[3]}; }
#pragma unroll
            for (int c = 0; c < 4; ++c) { vTL[(qd * 8 + 2 * c) * LP + r] = (bf16)(vv[c] & 0xffffu); vTL[(qd * 8 + 2 * c + 1) * LP + r] = (bf16)(vv[c] >> 16); }
        }
        if (n + 1 < 16) RET_LOAD(n + 1);
        __syncthreads();
        f32x4 sacc[8];
#pragma unroll
        for (int mt = 0; mt < 8; ++mt) sacc[mt] = (f32x4){0.f, 0.f, 0.f, 0.f};
#pragma unroll
        for (int ks = 0; ks < 4; ++ks) { const bf16x8 bq = *(const LAS bf16x8*)(qL + (16 * w + fr) * LP + 32 * ks + 8 * fq);
#pragma unroll
            for (int mt = 0; mt < 8; ++mt) { const bf16x8 ak = *(const LAS bf16x8*)(kL + (16 * mt + fr) * LP + 32 * ks + 8 * fq); sacc[mt] = __builtin_amdgcn_mfma_f32_16x16x32_bf16(ak, bq, sacc[mt], 0, 0, 0); } }
        const int c = 16 * w + fr;
        bf16x8 pb[4];
#pragma unroll
        for (int sk = 0; sk < 4; ++sk) { unsigned pw[4];
#pragma unroll
            for (int hlf = 0; hlf < 2; ++hlf) { const int mt = 2 * sk + hlf; float pv[4];
#pragma unroll
                for (int rr = 0; rr < 4; ++rr) { const int m = 16 * mt + 4 * fq + rr; pv[rr] = (c >= m) ? sacc[mt][rr] * __builtin_amdgcn_exp2f(lg2 * (float)(c - m)) : 0.f; }
                pw[2 * hlf] = pk2(pv[0], pv[1]); pw[2 * hlf + 1] = pk2(pv[2], pv[3]); }
            pb[sk] = __builtin_bit_cast(bf16x8, (u32x4){pw[0], pw[1], pw[2], pw[3]}); }
        f32x4 oi[2], oc[2];
#pragma unroll
        for (int et = 0; et < 2; ++et) { oi[et] = (f32x4){0.f, 0.f, 0.f, 0.f}; oc[et] = (f32x4){0.f, 0.f, 0.f, 0.f}; }
#pragma unroll
        for (int ks = 0; ks < 4; ++ks) { const bf16x8 bq = *(const LAS bf16x8*)(qL + (16 * w + fr) * LP + 32 * ks + 8 * fq);
#pragma unroll
            for (int et = 0; et < 2; ++et) { const u32x2 v0 = *(const LAS u32x2*)(vTL + (16 * et + fr) * LP + 32 * ks + 4 * fq), v1 = *(const LAS u32x2*)(vTL + (16 * et + fr) * LP + 32 * ks + 16 + 4 * fq);
                const bf16x8 av = __builtin_bit_cast(bf16x8, (u32x4){v0.x, v0.y, v1.x, v1.y}); const bf16x8 as = *(const LAS bf16x8*)(STL + (16 * et + fr) * LP + 32 * ks + 8 * fq);
                oi[et] = __builtin_amdgcn_mfma_f32_16x16x32_bf16(av, pb[ks], oi[et], 0, 0, 0); oc[et] = __builtin_amdgcn_mfma_f32_16x16x32_bf16(as, bq, oc[et], 0, 0, 0); } }
        { const float qd = __builtin_amdgcn_exp2f(lg2 * (float)(c + 1));
#pragma unroll
          for (int et = 0; et < 2; ++et) *(f32x4*)(reto + (size_t)(t0 + c) * RW + h * 128 + eb * 32 + 16 * et + 4 * fq) = oi[et] + oc[et] * qd; }
        __syncthreads();
#pragma unroll
        for (int et = 0; et < 2; ++et) st[et] = st[et] * dec;
#pragma unroll
        for (int ks = 0; ks < 4; ++ks) { const bf16x8 bk = *(const LAS bf16x8*)(kTL + (16 * w + fr) * LP + 32 * ks + 8 * fq);
#pragma unroll
            for (int et = 0; et < 2; ++et) { const bf16x8 av = *(const LAS bf16x8*)(vTL + (16 * et + fr) * LP + 32 * ks + 8 * fq); st[et] = __builtin_amdgcn_mfma_f32_16x16x32_bf16(av, bk, st[et], 0, 0, 0); } }
#pragma unroll
        for (int et = 0; et < 2; ++et)
#pragma unroll
            for (int rr = 0; rr < 4; ++rr) STL[(16 * et + 4 * fq + rr) * LP + 16 * w + fr] = f2bf(st[et][rr]);
    }
#undef RET_LOAD
    __syncthreads();
}

struct LruIn { bf16x8 bA[4], bX[4]; unsigned xr[19]; f32x2 w0, w1, w2, w3, bc; float bav, bxv, lamv; };
__device__ __forceinline__ void lru_issue(Ctx& F, int item, LruIn& L) {
    const int lane = F.lane, w = F.wave, fr = lane & 15, fq = lane >> 4;
    const int b = item >> 7, n = (item >> 3) & 15, g = item & 7; const int ch = g * 128 + 2 * lane;
    const bf16* Wa = (const bf16*)(F.ws + WS_WA) + (size_t)g * 128 * 128 + (size_t)(16 * w + fr) * 128 + 8 * fq; const bf16* Wx = (const bf16*)(F.ws + WS_WX) + (size_t)g * 128 * 128 + (size_t)(16 * w + fr) * 128 + 8 * fq;
#pragma unroll
    for (int ks = 0; ks < 4; ++ks) { L.bA[ks] = *(const bf16x8*)(Wa + 32 * ks); L.bX[ks] = *(const bf16x8*)(Wx + 32 * ks); }
    const float* wconv = (const float*)F.in[7];
    L.w0 = *(const f32x2*)(wconv + ch); L.w1 = *(const f32x2*)(wconv + LW + ch); L.w2 = *(const f32x2*)(wconv + 2 * LW + ch); L.w3 = *(const f32x2*)(wconv + 3 * LW + ch); L.bc = *(const f32x2*)((const float*)F.in[8] + ch);
    const int cj = g * 128 + 16 * w + fr; L.bav = ((const float*)F.in[10])[cj]; L.bxv = ((const float*)F.in[12])[cj]; L.lamv = ((const float*)F.in[13])[cj];
    const int s0 = n * 128 + 16 * w; const bf16* p = (const bf16*)(F.ws + WS_PROJ) + (size_t)(b * SEQ) * NIN + 4 * RW + ch;
#pragma unroll
    for (int i = 0; i < 19; ++i) { const int sp = s0 - 3 + i; L.xr[i] = (sp >= 0) ? *(const unsigned*)(p + (size_t)sp * NIN) : 0u; }
}
__device__ __forceinline__ void lru_body(Ctx& F, int item, const LruIn& L) {
    const int lane = F.lane, w = F.wave, fr = lane & 15, fq = lane >> 4;
    const int b = item >> 7, n = (item >> 3) & 15, g = item & 7;
    LAS bf16* xcL = (LAS bf16*)(F.lds); LAS float* aL = (LAS float*)(F.lds + 34816); LAS bf16* mL = (LAS bf16*)(F.lds + 34816 + 65536); LAS float* segA = (LAS float*)(F.lds + 34816 + 65536 + 32768); LAS float* segB = segA + 1024;
    const int cp = lane, sg = w, ch = g * 128 + 2 * cp;
    float xc[16][2];
#pragma unroll
    for (int i = 0; i < 16; ++i) {
        xc[i][0] = L.bc.x + L.w0.x * bflo(L.xr[i]) + L.w1.x * bflo(L.xr[i + 1]) + L.w2.x * bflo(L.xr[i + 2]) + L.w3.x * bflo(L.xr[i + 3]);
        xc[i][1] = L.bc.y + L.w0.y * bfhi(L.xr[i]) + L.w1.y * bfhi(L.xr[i + 1]) + L.w2.y * bfhi(L.xr[i + 2]) + L.w3.y * bfhi(L.xr[i + 3]);
        *(LAS unsigned*)(xcL + (16 * sg + i) * LP + 2 * cp) = pk2(xc[i][0], xc[i][1]); }
    __syncthreads();
    {
        const int j = 16 * w + fr; const float bav = L.bav, bxv = L.bxv, sp8 = -8.0f * log1pf(__expf(-L.lamv));
#pragma unroll 2
        for (int tt = 0; tt < 8; ++tt) { f32x4 ra = (f32x4){0.f, 0.f, 0.f, 0.f}, rx = (f32x4){0.f, 0.f, 0.f, 0.f};
#pragma unroll
            for (int ks = 0; ks < 4; ++ks) { const bf16x8 a = *(const LAS bf16x8*)(xcL + (16 * tt + fr) * LP + 32 * ks + 8 * fq);
                ra = __builtin_amdgcn_mfma_f32_16x16x32_bf16(a, L.bA[ks], ra, 0, 0, 0); rx = __builtin_amdgcn_mfma_f32_16x16x32_bf16(a, L.bX[ks], rx, 0, 0, 0); }
#pragma unroll
            for (int rr = 0; rr < 4; ++rr) { const int t = 16 * tt + 4 * fq + rr;
                const float rgt = __builtin_amdgcn_rcpf(1.0f + __expf(-(ra[rr] + bav))), igt = __builtin_amdgcn_rcpf(1.0f + __expf(-(rx[rr] + bxv)));
                const float av = __expf(sp8 * rgt); const float mu = __builtin_amdgcn_sqrtf(fmaxf(1.0f - av * av, 0.f)) * igt;
                aL[t * 128 + j] = av; mL[t * 128 + j] = f2bf(mu); } }
    }
    __syncthreads();
    {
        float h0 = 0.f, h1 = 0.f, P0 = 1.f, P1 = 1.f;
#pragma unroll
        for (int i = 0; i < 16; ++i) { const int t = 16 * sg + i; const f32x2 av = *(const LAS f32x2*)(aL + t * 128 + 2 * cp); const unsigned mw = *(const LAS unsigned*)(mL + t * 128 + 2 * cp);
            h0 = av.x * h0 + bflo(mw) * xc[i][0]; h1 = av.y * h1 + bfhi(mw) * xc[i][1]; P0 *= av.x; P1 *= av.y; }
        *(LAS f32x2*)(segA + sg * 128 + 2 * cp) = (f32x2){P0, P1}; *(LAS f32x2*)(segB + sg * 128 + 2 * cp) = (f32x2){h0, h1};
    }
    __syncthreads();
    {
        float c0 = 0.f, c1 = 0.f, Q0 = 1.f, Q1 = 1.f;
        for (int s = 0; s < sg; ++s) { const f32x2 A = *(const LAS f32x2*)(segA + s * 128 + 2 * cp), Bv = *(const LAS f32x2*)(segB + s * 128 + 2 * cp); c0 = A.x * c0 + Bv.x; c1 = A.y * c1 + Bv.y; Q0 *= A.x; Q1 *= A.y; }
        bf16* hl = (bf16*)(F.ws + WS_HLOC) + (size_t)(b * SEQ + n * 128 + 16 * sg) * LW + ch; bf16* pl = (bf16*)(F.ws + WS_PLOC) + (size_t)(b * SEQ + n * 128 + 16 * sg) * LW + ch;
        float h0 = c0, h1 = c1, P0 = Q0, P1 = Q1;
#pragma unroll
        for (int i = 0; i < 16; ++i) { const int t = 16 * sg + i; const f32x2 av = *(const LAS f32x2*)(aL + t * 128 + 2 * cp); const unsigned mw = *(const LAS unsigned*)(mL + t * 128 + 2 * cp);
            h0 = av.x * h0 + bflo(mw) * xc[i][0]; h1 = av.y * h1 + bfhi(mw) * xc[i][1]; P0 *= av.x; P1 *= av.y;
            *(unsigned*)(hl + (size_t)i * LW) = pk2(h0, h1); *(unsigned*)(pl + (size_t)i * LW) = pk2(P0, P1); }
        if (sg == 7) { *(f32x2*)((float*)(F.ws + WS_AGGA) + (size_t)(b * 16 + n) * LW + ch) = (f32x2){P0, P1}; *(f32x2*)((float*)(F.ws + WS_AGGB) + (size_t)(b * 16 + n) * LW + ch) = (f32x2){h0, h1}; }
    }
    __syncthreads();
}

__device__ __forceinline__ void p4_item(Ctx& F, int item) {
    const int tid = F.tid, lane = F.lane, w = F.wave;
    const int b = item >> 5, n = (item & 31) >> 1;
    LAS float* carry = (LAS float*)F.lds;
    const float* aggA = (const float*)(F.ws + WS_AGGA); const float* aggB = (const float*)(F.ws + WS_AGGB);
    __syncthreads();
#pragma unroll
    for (int q = 0; q < 2; ++q) { const int ch = tid + 512 * q; float cin = 0.f;
        for (int jn = 0; jn < n; ++jn) cin = aggA[(size_t)(b * 16 + jn) * LW + ch] * cin + aggB[(size_t)(b * 16 + jn) * LW + ch];
        carry[ch] = cin; }
    __syncthreads();
    const bf16* proj = (const bf16*)(F.ws + WS_PROJ); const float* reto = (const float*)(F.ws + WS_RETO); const bf16* hl = (const bf16*)(F.ws + WS_HLOC); const bf16* pl = (const bf16*)(F.ws + WS_PLOC);
    bf16* cat = (bf16*)(F.ws + WS_CAT); const int c0 = 16 * lane;
    float beta_r[16], beta_l[16], cr[16];
#pragma unroll
    for (int q = 0; q < 4; ++q) { const f32x4 a = *(const f32x4*)((const float*)F.in[14] + c0 + 4 * q), bq = *(const f32x4*)((const float*)F.in[15] + c0 + 4 * q); const f32x4 cq = *(const LAS f32x4*)(carry + c0 + 4 * q);
        beta_r[4 * q] = a.x; beta_r[4 * q + 1] = a.y; beta_r[4 * q + 2] = a.z; beta_r[4 * q + 3] = a.w; beta_l[4 * q] = bq.x; beta_l[4 * q + 1] = bq.y; beta_l[4 * q + 2] = bq.z; beta_l[4 * q + 3] = bq.w;
        cr[4 * q] = cq.x; cr[4 * q + 1] = cq.y; cr[4 * q + 2] = cq.z; cr[4 * q + 3] = cq.w; }
#pragma unroll 2
    for (int rr = 0; rr < 8; ++rr) {
        const int t = item * 64 + 8 * w + rr;
        {
            float o[16];
#pragma unroll
            for (int q = 0; q < 4; ++q) { const f32x4 v = *(const f32x4*)(reto + (size_t)t * RW + c0 + 4 * q); o[4 * q] = v.x; o[4 * q + 1] = v.y; o[4 * q + 2] = v.z; o[4 * q + 3] = v.w; }
            float s = 0.f;
#pragma unroll
            for (int q = 0; q < 16; ++q) s += o[q];
            s += __shfl_xor(s, 1); s += __shfl_xor(s, 2); s += __shfl_xor(s, 4);
            const float mu = s * (1.0f / 128.0f); float vq = 0.f;
#pragma unroll
            for (int q = 0; q < 16; ++q) { o[q] -= mu; vq += o[q] * o[q]; }
            vq += __shfl_xor(vq, 1); vq += __shfl_xor(vq, 2); vq += __shfl_xor(vq, 4);
            const float rs = rsqrtf(vq * (1.0f / 128.0f) + EPS);
            const u32x4 g0 = *(const u32x4*)(proj + (size_t)t * NIN + 3 * RW + c0), g1 = *(const u32x4*)(proj + (size_t)t * NIN + 3 * RW + c0 + 8);
            float ss = 0.f;
#pragma unroll
            for (int q = 0; q < 8; ++q) { const unsigned gw_ = (q < 4) ? g0[q & 3] : g1[q & 3]; const float ga = bflo(gw_), gb = bfhi(gw_);
                o[2 * q] = siluf_(ga) * (o[2 * q] * rs); o[2 * q + 1] = siluf_(gb) * (o[2 * q + 1] * rs); ss += o[2 * q] * o[2 * q] + o[2 * q + 1] * o[2 * q + 1]; }
            const float rstd = rsqrtf(wave_sum(ss) * (1.0f / RW) + EPS);
            u32x4 w0, w1;
#pragma unroll
            for (int q = 0; q < 4; ++q) { w0[q] = pk2(o[2 * q] * rstd * beta_r[2 * q], o[2 * q + 1] * rstd * beta_r[2 * q + 1]); w1[q] = pk2(o[8 + 2 * q] * rstd * beta_r[8 + 2 * q], o[9 + 2 * q] * rstd * beta_r[9 + 2 * q]); }
            *(u32x4*)(cat + (size_t)t * DM + c0) = w0; *(u32x4*)(cat + (size_t)t * DM + c0 + 8) = w1;
        }
        {
            const u32x4 h0 = *(const u32x4*)(hl + (size_t)t * LW + c0), h1 = *(const u32x4*)(hl + (size_t)t * LW + c0 + 8), p0 = *(const u32x4*)(pl + (size_t)t * LW + c0), p1 = *(const u32x4*)(pl + (size_t)t * LW + c0 + 8);
            const u32x4 y0 = *(const u32x4*)(proj + (size_t)t * NIN + 5 * RW + c0), y1 = *(const u32x4*)(proj + (size_t)t * NIN + 5 * RW + c0 + 8);
            float o[16]; float ss = 0.f;
#pragma unroll
            for (int q = 0; q < 8; ++q) { const unsigned hw = (q < 4) ? h0[q & 3] : h1[q & 3], pw = (q < 4) ? p0[q & 3] : p1[q & 3], yw = (q < 4) ? y0[q & 3] : y1[q & 3];
                const float ha = bflo(hw) + bflo(pw) * cr[2 * q], hb = bfhi(hw) + bfhi(pw) * cr[2 * q + 1];
                o[2 * q] = ha * gelu_tanh_(bflo(yw)); o[2 * q + 1] = hb * gelu_tanh_(bfhi(yw)); ss += o[2 * q] * o[2 * q] + o[2 * q + 1] * o[2 * q + 1]; }
            const float rstd = rsqrtf(wave_sum(ss) * (1.0f / LW) + EPS);
            u32x4 w0, w1;
#pragma unroll
            for (int q = 0; q < 4; ++q) { w0[q] = pk2(o[2 * q] * rstd * beta_l[2 * q], o[2 * q + 1] * rstd * beta_l[2 * q + 1]); w1[q] = pk2(o[8 + 2 * q] * rstd * beta_l[8 + 2 * q], o[9 + 2 * q] * rstd * beta_l[9 + 2 * q]); }
            *(u32x4*)(cat + (size_t)t * DM + RW + c0) = w0; *(u32x4*)(cat + (size_t)t * DM + RW + c0 + 8) = w1;
        }
    }
    __syncthreads();
}

constexpr int HAP = 2056;
template <bool DRY> __device__ __forceinline__ void p6_item(Ctx& F, int item) {
    const int tid = F.tid, lane = F.lane, w = F.wave, fr = lane & 15, fq = lane >> 4;
    const int t0 = item * 64, b = t0 / SEQ;
    LAS bf16* hA = (LAS bf16*)F.lds;
    LAS float* lgt = (LAS float*)(F.lds + 16 * HAP * 2);
    LAS unsigned char* selE = (LAS unsigned char*)(F.lds + 16 * HAP * 2 + 8 * 16 * 65 * 4); LAS unsigned char* selL = selE + 512; LAS unsigned* wcnt = (LAS unsigned*)(selL + 512); LAS unsigned* gb = wcnt + 512;
    const bf16* x1 = (const bf16*)(F.ws + WS_X1); const float* mod = (const float*)(F.ws + WS_MOD) + (size_t)b * 6 * DM; bf16* h2 = (bf16*)(F.ws + WS_H); unsigned char* h8 = F.ws + WS_H8;
    const bf16* Wr = (const bf16*)(F.ws + WS_WR);
    int* eidx = (int*)(F.ws + WS_EIDX); float* wsel = (float*)(F.ws + WS_WSEL); int* slot = (int*)(F.ws + (DRY ? WS_DEST : WS_SLOT)); unsigned* cnt = (unsigned*)(F.ws + WS_CTL) + CW_CNT + (DRY ? 4096 : 0);
    f32x4 gg[4][2];
#pragma unroll
    for (int j = 0; j < 4; ++j)
#pragma unroll
        for (int h = 0; h < 2; ++h) { const int c = 8 * lane + 512 * j + 4 * h; gg[j][h] = *(const f32x4*)((const float*)F.in[17] + c) * (*(const f32x4*)(mod + 4 * DM + c) + 1.0f); }
    const float brl = ((const float*)F.in[19])[lane]; const int g = lane >> 3;
    unsigned lc = 0u;
    bf16x8 bw[2][4];
#pragma unroll
    for (int ks = 0; ks < 2; ++ks)
#pragma unroll
        for (int et = 0; et < 4; ++et) bw[ks][et] = *(const bf16x8*)(Wr + (size_t)(16 * et + fr) * DM + 256 * w + 32 * ks + 8 * fq);
    u32x4 xq[2][4];
#pragma unroll
    for (int i = 0; i < 2; ++i)
#pragma unroll
        for (int j = 0; j < 4; ++j) xq[i][j] = *(const u32x4*)(x1 + (size_t)(t0 + 2 * w + i) * DM + 8 * lane + 512 * j);
    __syncthreads();
#pragma unroll 1
    for (int ps = 0; ps < 4; ++ps) {
#pragma unroll
        for (int i = 0; i < 2; ++i) { const int rl = 2 * w + i, t = t0 + 16 * ps + rl;
            f32x4 v[4][2]; float ss = 0.f;
#pragma unroll
            for (int j = 0; j < 4; ++j) { const u32x4 xw = xq[i][j]; v[j][0] = (f32x4){bflo(xw.x), bfhi(xw.x), bflo(xw.y), bfhi(xw.y)}; v[j][1] = (f32x4){bflo(xw.z), bfhi(xw.z), bflo(xw.w), bfhi(xw.w)};
#pragma unroll
                for (int h = 0; h < 2; ++h) ss += (v[j][h].x * v[j][h].x + v[j][h].y * v[j][h].y) + (v[j][h].z * v[j][h].z + v[j][h].w * v[j][h].w); }
            const float rstd = rsqrtf(wave_sum(ss) * (1.0f / DM) + EPS);
#pragma unroll
            for (int j = 0; j < 4; ++j) { const f32x4 o0 = v[j][0] * rstd * gg[j][0] + *(const f32x4*)(mod + 3 * DM + 8 * lane + 512 * j), o1 = v[j][1] * rstd * gg[j][1] + *(const f32x4*)(mod + 3 * DM + 8 * lane + 512 * j + 4);
                u32x4 wv; wv.x = pk2(o0.x, o0.y); wv.y = pk2(o0.z, o0.w); wv.z = pk2(o1.x, o1.y); wv.w = pk2(o1.z, o1.w);
                *(LAS u32x4*)(hA + rl * HAP + 8 * lane + 512 * j) = wv;
                u32x2 w8; w8.x = pk4_fp8(o0.x * SC_H8, o0.y * SC_H8, o0.z * SC_H8, o0.w * SC_H8); w8.y = pk4_fp8(o1.x * SC_H8, o1.y * SC_H8, o1.z * SC_H8, o1.w * SC_H8);
                *(u32x2*)(h8 + (size_t)t * DM + 8 * lane + 512 * j) = w8; }
            __builtin_amdgcn_sched_barrier(0); }
        __syncthreads();
        {
            f32x4 acc[4];
#pragma unroll
            for (int et = 0; et < 4; ++et) acc[et] = (f32x4){0.f, 0.f, 0.f, 0.f};
            bf16x8 bw2[6][4];
#pragma unroll
            for (int ks = 0; ks < 6; ++ks)
#pragma unroll
                for (int et = 0; et < 4; ++et) bw2[ks][et] = *(const bf16x8*)(Wr + (size_t)(16 * et + fr) * DM + 256 * w + 64 + 32 * ks + 8 * fq);
#pragma unroll
            for (int ks = 0; ks < 2; ++ks) { const bf16x8 a = *(const LAS bf16x8*)(hA + fr * HAP + 256 * w + 32 * ks + 8 * fq);
#pragma unroll
                for (int et = 0; et < 4; ++et) acc[et] = __builtin_amdgcn_mfma_f32_16x16x32_bf16(a, bw[ks][et], acc[et], 0, 0, 0); }
#pragma unroll
            for (int ks = 0; ks < 6; ++ks) { const bf16x8 a = *(const LAS bf16x8*)(hA + fr * HAP + 256 * w + 64 + 32 * ks + 8 * fq);
#pragma unroll
                for (int et = 0; et < 4; ++et) acc[et] = __builtin_amdgcn_mfma_f32_16x16x32_bf16(a, bw2[ks][et], acc[et], 0, 0, 0); }
#pragma unroll
            for (int et = 0; et < 4; ++et)
#pragma unroll
                for (int rr = 0; rr < 4; ++rr) lgt[(w * 16 + 4 * fq + rr) * 65 + 16 * et + fr] = acc[et][rr];
        }
        __syncthreads();
        if (ps + 1 < 4) {
#pragma unroll
            for (int i = 0; i < 2; ++i)
#pragma unroll
                for (int j = 0; j < 4; ++j) xq[i][j] = *(const u32x4*)(x1 + (size_t)(t0 + 16 * (ps + 1) + 2 * w + i) * DM + 8 * lane + 512 * j); }
#pragma unroll 1
        for (int i = 0; i < 2; ++i) {
            const int tl = 2 * w + i, tt = 16 * ps + tl; float z = 0.f;
#pragma unroll
            for (int w2 = 0; w2 < 8; ++w2) z += lgt[(w2 * 16 + tl) * 65 + lane];
            const float s = sigmoidf_(z); const float bsc = s + brl;
            float m1 = bsc; m1 = fmaxf(m1, __shfl_xor(m1, 1)); m1 = fmaxf(m1, __shfl_xor(m1, 2)); m1 = fmaxf(m1, __shfl_xor(m1, 4));
            const unsigned long long eq = __ballot(bsc == m1); const unsigned gm = (unsigned)(eq >> (8 * g)) & 0xffu;
            const bool first = (lane & 7) == (__builtin_ctz(gm | 0x100u) & 7);
            float m2 = first ? -3.0e38f : bsc; m2 = fmaxf(m2, __shfl_xor(m2, 1)); m2 = fmaxf(m2, __shfl_xor(m2, 2)); m2 = fmaxf(m2, __shfl_xor(m2, 4));
            const float gs = m1 + m2;
            int rank_g = 0;
#pragma unroll
            for (int g2 = 0; g2 < 8; ++g2) { const float o = __int_as_float(__builtin_amdgcn_readlane(__float_as_int(gs), 8 * g2)); rank_g += (o > gs || (o == gs && g2 < g)) ? 1 : 0; }
            const bool selg = rank_g < 4;
            const float key = selg ? bsc : -3.0e38f;
            int rank = 0;
#pragma unroll
            for (int e2 = 0; e2 < 64; ++e2) { const float o = __int_as_float(__builtin_amdgcn_readlane(__float_as_int(key), e2)); rank += (o > key || (o == key && e2 < lane)) ? 1 : 0; }
            const bool chosen = selg && rank < 8;
            const float wsum = wave_sum(chosen ? s : 0.f);
            if (chosen) { const int t = t0 + tt; eidx[t * 8 + rank] = lane; wsel[t * 8 + rank] = s * (2.5f / wsum); selE[tt * 8 + rank] = (unsigned char)lane; selL[tt * 8 + rank] = (unsigned char)lc; }
            lc += chosen ? 1u : 0u;
        }
        __syncthreads();
    }
    wcnt[w * 64 + lane] = lc;
    __syncthreads();
    if (w == 0) { unsigned tot = 0u;
#pragma unroll
        for (int w2 = 0; w2 < 8; ++w2) tot += wcnt[w2 * 64 + lane];
        gb[lane] = tot ? __hip_atomic_fetch_add(cnt + 32 * lane, tot, __ATOMIC_RELAXED, __HIP_MEMORY_SCOPE_AGENT) : 0u; }
    __syncthreads();
    { const int tok = tid >> 3, k = tid & 7, e = selE[tok * 8 + k], wt = (tok & 15) >> 1; unsigned off = gb[e] + selL[tok * 8 + k];
        for (int w2 = 0; w2 < wt; ++w2) off += wcnt[w2 * 64 + e];
        slot[(t0 + tok) * 8 + k] = (int)off; if (!DRY) ((int*)(F.ws + WS_TOKOF))[(size_t)e * T + off] = t0 + tok; }
    __syncthreads();
}

__device__ __forceinline__ void p10_final(Ctx& F, bool have_tables) {
    const int gw = F.vcu * NWAVES + F.wave, NGW = F.G * NWAVES, lane = F.lane;
    const bf16* x1 = (const bf16*)(F.ws + WS_X1); const unsigned char* y = F.ws + WS_Y; const int* eidx = (const int*)(F.ws + WS_EIDX); const int* slot = (const int*)(F.ws + WS_SLOT); const float* wsel = (const float*)(F.ws + WS_WSEL); const float* gf = (const float*)F.in[24];
    LAS int* ps = (LAS int*)F.lds; const unsigned* cnt = (const unsigned*)(F.ws + WS_CTL) + CW_CNT;
    __syncthreads();
    if (have_tables) { if (F.tid < NE) ps[F.tid] = moe_tables(F).tp[F.tid] * 256; }
    else { if (F.tid < NE) ps[64 + F.tid] = (((int)ld_agent(cnt + 32 * F.tid) + 255) >> 8) << 8;
        __syncthreads();
        if (F.tid < NE) { int acc = 0; for (int e = 0; e < F.tid; ++e) acc += ps[64 + e]; ps[F.tid] = acc; } }
    __syncthreads();
    for (int t = gw; t < T; t += NGW) { const int b = t / SEQ; const float* gt2 = (const float*)(F.ws + WS_MOD) + (size_t)b * 6 * DM + 5 * DM;
        int rows[9]; float wk[9];
#pragma unroll
        for (int k = 0; k < 8; ++k) { rows[k] = ps[ld_agent_i(eidx + t * 8 + k)] + ld_agent_i(slot + t * 8 + k); wk[k] = wsel[t * 8 + k] * (1.0f / SC_Y); }
        rows[8] = NR_ROUTED + t; wk[8] = 1.0f / SC_Y;
        float ss = 0.f; f32x4 v[4][2];
#pragma unroll
        for (int j = 0; j < 4; ++j) { const int c = 8 * lane + 512 * j; float s[8];
#pragma unroll
            for (int q = 0; q < 8; ++q) s[q] = 0.f;
#pragma unroll
            for (int k = 0; k < 9; ++k) { const u32x2 yv = *(const u32x2*)(y + (size_t)rows[k] * DM + c);
#pragma unroll
                for (int q = 0; q < 2; ++q) { const f32x2 lo = __builtin_amdgcn_cvt_pk_f32_fp8((int)yv[q], false), hi = __builtin_amdgcn_cvt_pk_f32_fp8((int)yv[q], true);
                    s[4 * q] += wk[k] * lo.x; s[4 * q + 1] += wk[k] * lo.y; s[4 * q + 2] += wk[k] * hi.x; s[4 * q + 3] += wk[k] * hi.y; } }
            const u32x4 xw = *(const u32x4*)(x1 + (size_t)t * DM + c);
#pragma unroll
            for (int hh = 0; hh < 2; ++hh) { const f32x4 xv = hh ? (f32x4){bflo(xw.z), bfhi(xw.z), bflo(xw.w), bfhi(xw.w)} : (f32x4){bflo(xw.x), bfhi(xw.x), bflo(xw.y), bfhi(xw.y)}, gv = *(const f32x4*)(gt2 + c + 4 * hh);
                v[j][hh] = xv + gv * (f32x4){s[4 * hh], s[4 * hh + 1], s[4 * hh + 2], s[4 * hh + 3]};
                ss += (v[j][hh].x * v[j][hh].x + v[j][hh].y * v[j][hh].y) + (v[j][hh].z * v[j][hh].z + v[j][hh].w * v[j][hh].w); } }
        const float rstd = rsqrtf(wave_sum(ss) * (1.0f / DM) + EPS);
#pragma unroll
        for (int j = 0; j < 4; ++j)
#pragma unroll
            for (int hh = 0; hh < 2; ++hh) { const int c = 8 * lane + 512 * j + 4 * hh; *(f32x4*)(F.out + (size_t)t * DM + c) = v[j][hh] * rstd * *(const f32x4*)(gf + c); }
    }
}

__global__ void __launch_bounds__(NWAVES * 64, 2) fwd_kernel(Args args) {
    extern __shared__ __attribute__((aligned(16))) unsigned char lds_raw[];
    Ctx F;
    F.lds = (LAS unsigned char*)lds_raw; F.ws = args.ws; F.in = args.in; F.out = args.out;
    F.tid = threadIdx.x; F.lane = F.tid & 63; F.wave = __builtin_amdgcn_readfirstlane(F.tid >> 6);
    F.G = gridDim.x; { const int bx = blockIdx.x; F.vcu = (F.G % 8 == 0) ? (bx % 8) * (F.G / 8) + bx / 8 : bx; }
    if (F.tid < 16) ((LAS unsigned*)(F.lds + MISC_OFF))[F.tid] = 0u;
    __syncthreads();
    unsigned* ctl = (unsigned*)(F.ws + WS_CTL);
#if N_LAUNCHES == 1
    XcdBarrier bar = xcd_barrier_post(ctl + CW_BAR, (volatile LAS unsigned*)(F.lds + MISC_OFF));
#define GRID_BAR() xcd_barrier(bar)
#else
#define GRID_BAR() do { } while (0)
#endif
    const int lo = args.ph_lo, hi = args.ph_hi;
#define IN(k) (lo <= (k) && (k) < hi)
#define BOTH(k) (IN(k) && IN((k) + 1))
    const int NIT = F.G;

#define REP(k) _Pragma("unroll") for (int rep_ = 0; rep_ < ((PROBE_PHASE == (k)) ? 2 : 1); ++rep_)
    if (IN(0)) { p0_adaln(F); p0_prologue(F); if (BOTH(0)) p0_wait_mod(F); }
    if (IN(1)) { REP(1) { p1_norm(F); } if (BOTH(1)) GRID_BAR(); if (PROBE_PHASE == 100) { GRID_BAR(); GRID_BAR(); GRID_BAR(); GRID_BAR(); } }
    if (IN(2)) {
        if (F.vcu & 1) p2_convert_experts(F);
        REP(2) {
        g8::DenseOrder S; S.init(F.ws + WS_H, F.ws + WS_WIN, T, NIN, DM * 2, F.G, (int)blockIdx.x);
        EpiProj E{(bf16*)(F.ws + WS_PROJ)};
        g8::gemm_phase<EpiProj, g8::DenseOrder>(F.lds, DM * 2, S, E);
        }
        if (!(F.vcu & 1)) p2_convert_experts(F);
        if (BOTH(2)) GRID_BAR();
    }
    if (IN(3)) {
        for (int it = F.vcu; it < NB * 8 * 4 * ((PROBE_PHASE == 31) ? 2 : 1); it += NIT) ret_item(F, it & 255);
        {
            LruIn La, Lb; int it = F.vcu; const int NL = NB * 16 * 8;
            __syncthreads();
            if (it < NL) lru_issue(F, it, La);
            while (it < NL) {
                if (it + NIT < NL) lru_issue(F, it + NIT, Lb);
                lru_body(F, it, La); it += NIT;
                if (it >= NL) break;
                if (it + NIT < NL) lru_issue(F, it + NIT, La);
                lru_body(F, it, Lb); it += NIT;
            }
        }
        if (BOTH(3)) GRID_BAR();
    }
    if (IN(4)) { REP(4) { for (int it = F.vcu; it < T / 64; it += NIT) p4_item(F, it); } if (BOTH(4)) GRID_BAR(); }
    if (IN(5)) {
        REP(5) {
        g8::DenseOrder S; S.init(F.ws + WS_CAT, F.ws + WS_WOUT, T, DM, DM * 2, F.G, (int)blockIdx.x);
        EpiWout E{(const float*)F.in[0], (const float*)(F.ws + WS_MOD), (bf16*)(F.ws + WS_X1)};
        g8::gemm_phase<EpiWout, g8::DenseOrder>(F.lds, DM * 2, S, E);
        }
        if (BOTH(5)) GRID_BAR();
    }
    if (IN(6)) { for (int it = F.vcu; it < T / 64; it += NIT) p6_item<false>(F, it); if (PROBE_PHASE == 6) { for (int it = F.vcu; it < T / 64; it += NIT) p6_item<true>(F, it); } if (BOTH(6)) GRID_BAR(); }
    int ntiles = 0;
    if (IN(8)) {
        REP(8) {
        ntiles = moe_build_tables(F);
        MoeOrder<1> S; S.init(F, ntiles);
        EpiSwiglu E{F.ws + WS_ACT};
        g8::gemm_phase<EpiSwiglu, MoeOrder<1>, true>(F.lds, DM, S, E);
        }
        if (BOTH(8)) GRID_BAR();
    }
    if (IN(9)) {
        REP(9) {
        if (!IN(8)) ntiles = moe_build_tables(F);
        MoeOrder<2> S; S.init(F, ntiles);
        EpiDown E{F.ws + WS_Y};
        g8::gemm_phase<EpiDown, MoeOrder<2>, true>(F.lds, EH, S, E);
        }
        if (BOTH(9)) GRID_BAR();
    }
    if (IN(10)) { REP(10) { p10_final(F, IN(8)); } }
#undef REP
#undef IN
#undef BOTH
}

extern "C" void kernel_launch(void* const* d_in, const int* in_sizes, int n_in, void* d_out, int out_size, void* d_ws, size_t ws_size, hipStream_t stream) {
    static int grid = 0;
    if (grid == 0) {
        if (n_in != 25 || out_size != T * DM || ws_size < WS_END) { fprintf(stderr, "kernel_launch: unexpected problem (n_in %d, out %d, ws %zu)\n", n_in, out_size, ws_size); grid = -1; return; }
        int dev = 0, cus = 0, per_cu = 0;
        if (hipGetDevice(&dev) != hipSuccess || hipDeviceGetAttribute(&cus, hipDeviceAttributeMultiprocessorCount, dev) != hipSuccess) { grid = -1; return; }
        if (hipFuncSetAttribute((const void*)fwd_kernel, hipFuncAttributeMaxDynamicSharedMemorySize, LDS_BYTES) != hipSuccess) { fprintf(stderr, "kernel_launch: hipFuncSetAttribute failed\n"); grid = -1; return; }
        if (hipOccupancyMaxActiveBlocksPerMultiprocessor(&per_cu, (const void*)fwd_kernel, NWAVES * 64, LDS_BYTES) != hipSuccess || per_cu < 1) { fprintf(stderr, "kernel_launch: occupancy query says %d\n", per_cu); }
        (void)hipGetLastError();
        grid = cus;
    }
    if (grid < 0) return;
    (void)hipMemsetAsync((char*)d_ws + WS_CTL, 0, CTL_ZERO_BYTES, stream);
    Args a{};
    for (int i = 0; i < 25; ++i) a.in[i] = d_in[i];
    a.out = (float*)d_out; a.ws = (unsigned char*)d_ws;
#if N_LAUNCHES == 1
    a.ph_lo = 0; a.ph_hi = 11;
    hipLaunchKernelGGL(fwd_kernel, dim3(grid), dim3(NWAVES * 64), LDS_BYTES, stream, a);
#else
    for (int p = 0; p < 11; ++p) { a.ph_lo = p; a.ph_hi = p + 1; hipLaunchKernelGGL(fwd_kernel, dim3(grid), dim3(NWAVES * 64), LDS_BYTES, stream, a); }
#endif
}
```

```cpp
#include <hip/hip_runtime.h>
#include <cstdio>
#include <cstdint>

#ifndef PROBE_PHASE
#define PROBE_PHASE -1
#endif
#ifndef N_LAUNCHES
#define N_LAUNCHES 1
#endif

#define LAS __attribute__((address_space(3)))
typedef unsigned short bf16;
typedef short bf16x8 __attribute__((ext_vector_type(8)));
typedef float f32x4 __attribute__((ext_vector_type(4)));
typedef float f32x2 __attribute__((ext_vector_type(2)));
typedef unsigned u32x4 __attribute__((ext_vector_type(4)));
typedef unsigned u32x2 __attribute__((ext_vector_type(2)));
typedef int i32x4 __attribute__((ext_vector_type(4)));
typedef _Float16 h16x2 __attribute__((ext_vector_type(2)));
typedef int i32x8 __attribute__((ext_vector_type(8)));

constexpr int NB = 8, SEQ = 2048, DM = 2048, T = NB * SEQ;
constexpr int NIN = 6144, RW = 1024, LW = 1024, NE = 64, EH = 512, TOPK = 8;
constexpr int NR_ROUTED = T * TOPK + NE * 256;
constexpr int NR = NR_ROUTED + T;
constexpr int NWAVES = 8;
constexpr float EPS = 1e-6f;
constexpr float SC_H8 = 16.0f, SC_WEI = 64.0f, SC_ACT = 8.0f, SC_WEO = 4.0f, SC_Y = 32.0f;

constexpr size_t MiB = 1u << 20;
constexpr size_t WS_CTL = 0, CTL_ZERO_BYTES = 2 * MiB;
constexpr size_t WS_MOD = 1 * MiB;
constexpr size_t WS_ROPE = 2 * MiB;
constexpr size_t WS_WIN = 10 * MiB;
constexpr size_t WS_WOUT = 34 * MiB;
constexpr size_t WS_WR = 42 * MiB;
constexpr size_t WS_WA = WS_WR + 256 * 1024;
constexpr size_t WS_WX = WS_WA + 256 * 1024;
constexpr size_t WS_WEI = 44 * MiB;
constexpr size_t WS_H8 = 176 * MiB;
constexpr size_t WS_WEO = 304 * MiB;
constexpr size_t WS_H = 434 * MiB;
constexpr size_t WS_X1 = 500 * MiB;
constexpr size_t WS_EIDX = 628 * MiB;
constexpr size_t WS_WSEL = WS_EIDX + 512 * 1024;
constexpr size_t WS_SLOT = WS_WSEL + 512 * 1024;
constexpr size_t WS_DEST = WS_SLOT + 512 * 1024;
constexpr size_t WS_RTOK = WS_DEST + 512 * 1024;
constexpr size_t WS_RW = WS_RTOK + 640 * 1024;
constexpr size_t WS_AGGA = 632 * MiB;
constexpr size_t WS_AGGB = WS_AGGA + 512 * 1024;
constexpr size_t WS_ACT = 634 * MiB;
constexpr size_t WS_PROJ = 794 * MiB;
constexpr size_t WS_RETO = 986 * MiB;
constexpr size_t WS_HLOC = 1050 * MiB;
constexpr size_t WS_PLOC = 1082 * MiB;
constexpr size_t WS_CAT = 1114 * MiB;
constexpr size_t WS_Y = 794 * MiB;
constexpr size_t WS_TOKOF = 1434 * MiB;
constexpr size_t WS_END = 1438 * MiB;
constexpr int CW_BAR = 4096;
constexpr int CW_CNT = 8192;
constexpr int CW_MODCNT = 16384;

constexpr int RING_BYTES = 131072;
constexpr int LDS_BYTES = 147456;
constexpr int TT_OFF = 137216;
constexpr int MISC_OFF = LDS_BYTES - 256;
static_assert(TT_OFF + (2 * 704 + 80 + 68) * 4 <= MISC_OFF, "LDS map");
constexpr int MAXTILES = 704;

__device__ __forceinline__ unsigned pk2(float lo, float hi) { unsigned r; asm volatile("v_cvt_pk_bf16_f32 %0, %1, %2" : "=v"(r) : "v"(lo), "v"(hi)); return r; }
typedef __bf16 bf16x2_t __attribute__((ext_vector_type(2)));
__device__ __forceinline__ unsigned pk2c(float lo, float hi) { const bf16x2_t r = __builtin_convertvector((f32x2){lo, hi}, bf16x2_t); return __builtin_bit_cast(unsigned, r); }
__device__ __forceinline__ bf16 f2bf(float f) { return __builtin_bit_cast(bf16, (__bf16)f); }
__device__ __forceinline__ float bf2f(bf16 b) { return __uint_as_float(((unsigned)b) << 16); }
__device__ __forceinline__ float bflo(unsigned w) { return __uint_as_float(w << 16); }
__device__ __forceinline__ float bfhi(unsigned w) { return __uint_as_float(w & 0xffff0000u); }
__device__ __forceinline__ float wave_sum(float v) {
#pragma unroll
    for (int o = 1; o < 64; o <<= 1) v += __shfl_xor(v, o);
    return v;
}
__device__ __forceinline__ float sigmoidf_(float x) { return __builtin_amdgcn_rcpf(1.0f + __expf(-x)); }
__device__ __forceinline__ float siluf_(float x) { return x * __builtin_amdgcn_rcpf(1.0f + __expf(-x)); }
__device__ __forceinline__ float gelu_tanh_(float x) { const float u = 0.7978845608028654f * (x + 0.044715f * x * x * x); const float e = __expf(2.0f * u); const float th = 1.0f - 2.0f * __builtin_amdgcn_rcpf(e + 1.0f); return 0.5f * x * (1.0f + th); }
__device__ __forceinline__ unsigned ld_agent(const unsigned* p) { return __hip_atomic_load(p, __ATOMIC_RELAXED, __HIP_MEMORY_SCOPE_AGENT); }
__device__ __forceinline__ int ld_agent_i(const int* p) { return (int)__hip_atomic_load((const unsigned*)p, __ATOMIC_RELAXED, __HIP_MEMORY_SCOPE_AGENT); }
__device__ __forceinline__ float clamp448(float x) { return __builtin_amdgcn_fmed3f(x, -448.0f, 448.0f); }
__device__ __forceinline__ unsigned pk4_fp8(float a, float b, float c, float d) { int w = 0; w = __builtin_amdgcn_cvt_pk_fp8_f32(clamp448(a), clamp448(b), w, false); w = __builtin_amdgcn_cvt_pk_fp8_f32(clamp448(c), clamp448(d), w, true); return (unsigned)w; }
#define LDS_WAIT() asm volatile("s_waitcnt lgkmcnt(0)" ::: "memory")
#define VM_WAIT() asm volatile("s_waitcnt vmcnt(0)" ::: "memory")

#define XB_TMO      128
#define XB_XCNT(j)  (256  + 64 * (j))
#define XB_XSUB(j)  (1280 + 64 * (j))
#define XB_XGEN(j)  (2304 + 64 * (j))
#define XB_TOP      3328
#define XB_TOPGEN   3392
#define XCD_BAR_WORDS 3456
#define XB_SPIN_CAP (1u << 18)
__device__ __forceinline__ unsigned xb_ld(unsigned* p)              { return __hip_atomic_load(p, __ATOMIC_RELAXED, __HIP_MEMORY_SCOPE_AGENT); }
__device__ __forceinline__ unsigned xb_add(unsigned* p, unsigned v) { return __hip_atomic_fetch_add(p, v, __ATOMIC_RELAXED, __HIP_MEMORY_SCOPE_AGENT); }
__device__ __forceinline__ unsigned xb_xcc_id() { return (unsigned)__builtin_amdgcn_s_getreg((3 << 11) | 20) & 0xFu; }
#define XB_SPIN(cond, bar) do { unsigned _sp = 0; while (cond) { __builtin_amdgcn_s_sleep(1); \
    if ((++_sp & 255u) == 0u) { if (xb_ld(&(bar)[XB_TMO])) break; if (_sp > XB_SPIN_CAP) { atomicAdd(&(bar)[XB_TMO], 1u); break; } } } } while (0)
struct XcdBarrier { unsigned* bar; unsigned x; volatile LAS unsigned* st; };
__device__ __forceinline__ XcdBarrier xcd_barrier_post(unsigned* bar, volatile LAS unsigned* st) {
    XcdBarrier b; b.bar = bar; b.x = xb_xcc_id(); b.st = st;
    if (threadIdx.x == 0) (void)xb_add(&bar[XB_XCNT(b.x)], 1u);
    return b;
}
__device__ __forceinline__ void xcd_barrier_complete(unsigned* bar, unsigned x, unsigned& nloc, unsigned& nx) {
    const unsigned G = gridDim.x * gridDim.y * gridDim.z;
    unsigned sum, cnt, mine, sp = 0u;
    for (;;) {
        sum = 0u; cnt = 0u; mine = 0u;
#pragma unroll
        for (unsigned j = 0; j < 16; ++j) { const unsigned c = xb_ld(&bar[XB_XCNT(j)]); sum += c; cnt += (c > 0u) ? 1u : 0u; mine = (j == x) ? c : mine; }
        if (sum == G) break;
        __builtin_amdgcn_s_sleep(1);
        if ((++sp & 255u) == 0u) { if (xb_ld(&bar[XB_TMO])) break; if (sp > XB_SPIN_CAP) { atomicAdd(&bar[XB_TMO], 1u); break; } }
    }
    nloc = mine > 0u ? mine : 1u; nx = cnt > 0u ? cnt : 1u;
}
__device__ __forceinline__ void xcd_barrier(const XcdBarrier& b) {
    asm volatile("s_waitcnt vmcnt(0)" ::: "memory");
    __syncthreads();
    if (threadIdx.x == 0) {
        unsigned* bar = b.bar;
        __builtin_amdgcn_s_waitcnt(0);
        unsigned nloc = b.st[0], nx = b.st[1];
        if (nloc == 0u) { xcd_barrier_complete(bar, b.x, nloc, nx); b.st[0] = nloc; b.st[1] = nx; }
        const unsigned old = xb_add(&bar[XB_XSUB(b.x)], 1u);
        const unsigned gen = old / nloc;
        if (old + 1u == (gen + 1u) * nloc) {
            __builtin_amdgcn_fence(__ATOMIC_RELEASE, "agent");
            asm volatile("s_waitcnt vmcnt(0)" ::: "memory");
            const unsigned og = xb_add(&bar[XB_TOP], 1u);
            const unsigned tg = og / nx;
            if (og + 1u == (tg + 1u) * nx) xb_add(&bar[XB_TOPGEN], 1u);
            else XB_SPIN(xb_ld(&bar[XB_TOPGEN]) == tg, bar);
            __builtin_amdgcn_fence(__ATOMIC_ACQUIRE, "agent");
            xb_add(&bar[XB_XGEN(b.x)], 1u);
            asm volatile("s_waitcnt vmcnt(0)" ::: "memory");
        } else {
            XB_SPIN(xb_ld(&bar[XB_XGEN(b.x)]) == gen, bar);
            __builtin_amdgcn_fence(__ATOMIC_ACQUIRE, "agent");
            asm volatile("s_waitcnt vmcnt(0)" ::: "memory");
        }
    }
    __syncthreads();
}

namespace g8 {
constexpr int BM = 256, BK = 64, HALF = 128, HTB = HALF * BK * 2, NXCD = 8, WGM = 8;
__device__ __forceinline__ int lds_byte(int r, int c) { const int st = (r >> 4) * 2 + (c >> 5), rr = r & 15, cc = c & 31, ob = rr * 64 + cc * 2; return st * 1024 + (ob ^ (((ob >> 9) & 1) << 5)); }
__device__ __forceinline__ void stage_rc(int b, int& R, int& C) { const int st = b / 1024, sb = b % 1024, swz = sb ^ (((sb >> 9) & 1) << 5); R = (st >> 1) * 16 + swz / 64; C = (st & 1) * 32 + (swz % 64) / 2; }
__device__ __forceinline__ int perm32(int rho) { const int n = rho >> 4, i = rho & 15; return 8 * (i >> 2) + 4 * n + (i & 3); }

struct Unit { const char* A; const char* B; unsigned vA0[2], vA1[2]; int r0, pn, e, rend; };

template <class Epi, class Sched, bool F8 = false>
__device__ __forceinline__ void gemm_phase(LAS unsigned char* lds, const int pitch, const Sched& S, const Epi& E) {
    const int tid = threadIdx.x, wid = __builtin_amdgcn_readfirstlane(tid >> 6), lane = tid & 63, wr = wid >> 2, wc = wid & 3, fr = lane & 15, fq = lane >> 4;
    const int nt = pitch / 128;
    unsigned voffB[2], voffB1[2];
#pragma unroll
    for (int i = 0; i < 2; ++i) { int R, C; stage_rc(tid * 16 + i * 8192, R, C); const int p = perm32(R & 31);
        if constexpr (Epi::P16) { const int base = 64 * (R >> 5) + 16 * (p >> 3) + (p & 7); voffB[i] = (unsigned)(base * pitch + C * 2); voffB1[i] = (unsigned)((base + 8) * pitch + C * 2); }
        else { const int Rb = Epi::PERM ? ((R & ~31) + p) : R; voffB[i] = (unsigned)(Rb * pitch + C * 2); voffB1[i] = voffB[i] + (unsigned)(HALF * pitch); } }
    const size_t kstep = 128;
    const size_t hstepB = (size_t)HALF * pitch;
    const unsigned ldsw = (unsigned)wid * 1024u;
    const int aoff = lds_byte(wr * 64 + fr, fq * 8), boff = lds_byte(wc * 32 + fr, fq * 8);
#define G8_SA(b, h) (((b) * 2 + (h)) * HTB)
#define G8_SB(b, h) ((4 + (b) * 2 + (h)) * HTB)
#define G8_STAGE(bufoff, gbase, voff) do { _Pragma("unroll") for (int _i = 0; _i < 2; ++_i) \
        __builtin_amdgcn_global_load_lds((const unsigned*)((const char*)(gbase) + (voff)[_i]), (LAS unsigned*)(lds + (bufoff) + ldsw + _i * 8192), 16, 0, 0); } while (0)
#define G8_LDA(dst, b, h) do { _Pragma("unroll") for (int m = 0; m < 4; ++m) _Pragma("unroll") for (int k = 0; k < 2; ++k) dst[m][k] = *(const LAS bf16x8*)(lds + G8_SA(b, h) + aoff + m * 2048 + k * 1024); } while (0)
#define G8_LDB(dst, b, h) do { _Pragma("unroll") for (int n = 0; n < 2; ++n) _Pragma("unroll") for (int k = 0; k < 2; ++k) dst[n][k] = *(const LAS bf16x8*)(lds + G8_SB(b, h) + boff + n * 2048 + k * 1024); } while (0)
#define G8_CAT(x) __builtin_shufflevector(__builtin_bit_cast(i32x4, x[0]), __builtin_bit_cast(i32x4, x[1]), 0, 1, 2, 3, 4, 5, 6, 7)
#define G8_MMA(ai, bj, At, Bt) do { __builtin_amdgcn_s_setprio(1); _Pragma("unroll") for (int m = 0; m < 4; ++m) _Pragma("unroll") for (int n = 0; n < 2; ++n) { \
        if constexpr (F8) acc[ai][bj][m][n] = __builtin_amdgcn_mfma_scale_f32_16x16x128_f8f6f4(G8_CAT(Bt[n]), G8_CAT(At[m]), acc[ai][bj][m][n], 0, 0, 0, 0x7f7f7f7f, 0, 0x7f7f7f7f); \
        else { _Pragma("unroll") for (int k = 0; k < 2; ++k) acc[ai][bj][m][n] = __builtin_amdgcn_mfma_f32_16x16x32_bf16(Bt[n][k], At[m][k], acc[ai][bj][m][n], 0, 0, 0); } } \
        __builtin_amdgcn_s_setprio(0); } while (0)
#define G8_WAIT_V(n) asm volatile("s_waitcnt vmcnt(" #n ")" ::: "memory")
#define G8_WAIT_L(n) asm volatile("s_waitcnt lgkmcnt(" #n ")" ::: "memory")
#define G8_BAR __builtin_amdgcn_s_barrier()
#define G8_SCHED __builtin_amdgcn_sched_barrier(0)
    Unit cur, nxt; int ui = 0;
    if (!S.next(0, cur)) return;
    f32x4 acc[2][2][4][2];
#pragma unroll
    for (int a = 0; a < 2; ++a)
#pragma unroll
        for (int b = 0; b < 2; ++b)
#pragma unroll
            for (int m = 0; m < 4; ++m)
#pragma unroll
                for (int n = 0; n < 2; ++n) acc[a][b][m][n] = (f32x4){0.f, 0.f, 0.f, 0.f};
    bf16x8 At[4][2], B0[2][2], B1[2][2];
    const char* cA = cur.A; const char* cB = cur.B;
    G8_STAGE(G8_SB(0, 0), cB, voffB); G8_STAGE(G8_SB(0, 1), cB, voffB1); G8_STAGE(G8_SA(0, 0), cA, cur.vA0); G8_STAGE(G8_SA(0, 1), cA, cur.vA1);
    if (wr == 1) G8_BAR;
    G8_WAIT_V(2); G8_BAR;
    G8_STAGE(G8_SB(1, 0), cB + kstep, voffB); G8_STAGE(G8_SA(1, 0), cA + kstep, cur.vA0); G8_STAGE(G8_SB(1, 1), cB + kstep, voffB1);
    G8_WAIT_V(6); G8_BAR;
    for (;;) {
        const bool has_next = S.next(ui + 1, nxt);
        if (!has_next) nxt = cur;
        const char* nA = nxt.A; const char* nB = nxt.B;
#pragma unroll 1
        for (int t = 0; t < nt; t += 2) {
            const bool last = (t == nt - 2);
            const char* a1 = cA + (size_t)(t + 1) * kstep;
            const char* a2 = last ? nA : cA + (size_t)(t + 2) * kstep; const char* b2 = last ? nB : cB + (size_t)(t + 2) * kstep;
            const char* a3 = a2 + kstep; const char* b3 = b2 + kstep;
            G8_LDB(B0, 0, 0); G8_LDB(B1, 0, 1); G8_SCHED; G8_LDA(At, 0, 0); G8_STAGE(G8_SA(1, 1), a1, cur.vA1);
            if (last) { cur.vA0[0] = nxt.vA0[0]; cur.vA0[1] = nxt.vA0[1]; cur.vA1[0] = nxt.vA1[0]; cur.vA1[1] = nxt.vA1[1]; }
            G8_WAIT_V(8); G8_WAIT_L(0); G8_BAR; G8_MMA(0, 0, At, B0); G8_MMA(0, 1, At, B1); G8_BAR; G8_SCHED;
            G8_LDA(At, 0, 1); G8_STAGE(G8_SB(0, 0), b2, voffB); G8_STAGE(G8_SB(0, 1), b2, voffB1); G8_STAGE(G8_SA(0, 0), a2, cur.vA0);
            G8_WAIT_V(8); G8_WAIT_L(0); G8_BAR; G8_MMA(1, 0, At, B0); G8_MMA(1, 1, At, B1); G8_BAR; G8_SCHED;
            G8_LDB(B0, 1, 0); G8_LDB(B1, 1, 1); G8_SCHED; G8_LDA(At, 1, 0); G8_STAGE(G8_SA(0, 1), a2, cur.vA1);
            G8_WAIT_V(8); G8_WAIT_L(0); G8_BAR; G8_MMA(0, 0, At, B0); G8_MMA(0, 1, At, B1); G8_BAR; G8_SCHED;
            G8_LDA(At, 1, 1); G8_STAGE(G8_SB(1, 0), b3, voffB); G8_STAGE(G8_SB(1, 1), b3, voffB1); G8_STAGE(G8_SA(1, 0), a3, cur.vA0);
            G8_WAIT_V(8); G8_WAIT_L(0); G8_BAR; G8_MMA(1, 0, At, B0); G8_MMA(1, 1, At, B1); G8_BAR; G8_SCHED;
        }
        if (wr == 0) G8_BAR;
        E(acc, cur, wr, wc, fr, fq);
        if (!has_next) break;
#pragma unroll
        for (int a = 0; a < 2; ++a)
#pragma unroll
            for (int b = 0; b < 2; ++b)
#pragma unroll
                for (int m = 0; m < 4; ++m)
#pragma unroll
                    for (int n = 0; n < 2; ++n) acc[a][b][m][n] = (f32x4){0.f, 0.f, 0.f, 0.f};
        cur = nxt; cA = nA; cB = nB; ++ui;
        if (wr == 1) G8_BAR;
    }
    G8_WAIT_V(0);
    G8_BAR;
#undef G8_SA
#undef G8_SB
#undef G8_STAGE
#undef G8_LDA
#undef G8_CAT
#undef G8_LDB
#undef G8_MMA
#undef G8_WAIT_V
#undef G8_WAIT_L
#undef G8_BAR
#undef G8_SCHED
}

struct DenseOrder {
    const char* A; const char* Bt; int pitch; int nM, nN, nwg, G, c;
    __device__ void init(const void* A_, const void* Bt_, int M, int N, int pitch_, int G_, int c_) { A = (const char*)A_; Bt = (const char*)Bt_; pitch = pitch_; nM = M / BM; nN = N / BM; nwg = nM * nN; G = G_; c = c_; }
    __device__ __forceinline__ bool next(int i, Unit& u) const {
        const long L = (long)i * G + c; if (L >= nwg) return false;
        int R[2], C[2]; stage_rc((int)threadIdx.x * 16, R[0], C[0]); stage_rc((int)threadIdx.x * 16 + 8192, R[1], C[1]);
        int wgid = (int)L; { const int q = nwg / NXCD, r = nwg % NXCD, xcd = wgid % NXCD, off = wgid / NXCD; wgid = (xcd < r ? xcd * (q + 1) : r * (q + 1) + (xcd - r) * q) + off; }
        const int nig = WGM * nN, gid = wgid / nig, fm = gid * WGM, gsz = (nM - fm) < WGM ? (nM - fm) : WGM;
        const int pm = fm + ((wgid % nig) % gsz), pn = (wgid % nig) / gsz;
        u.A = A + (size_t)pm * BM * pitch; u.B = Bt + (size_t)pn * BM * pitch;
#pragma unroll
        for (int j = 0; j < 2; ++j) { u.vA0[j] = (unsigned)(R[j] * pitch + C[j] * 2); u.vA1[j] = (unsigned)((R[j] + HALF) * pitch + C[j] * 2); }
        u.r0 = pm * BM; u.pn = pn; u.e = 0; u.rend = 0; return true;
    }
};
}

struct Args { const void* in[25]; float* out; unsigned char* ws; int ph_lo, ph_hi; };
struct Ctx {
    LAS unsigned char* lds; unsigned char* ws; const void* const* in; float* out;
    int tid, lane, wave, vcu, G;
};

__device__ __forceinline__ void p0_adaln(Ctx& F) {
    LAS float* sc = (LAS float*)F.lds;
    LAS float* red = (LAS float*)(F.lds + 65536);
    const float* cvec = (const float*)F.in[1]; const float* wada = (const float*)F.in[3]; const float* bada = (const float*)F.in[4]; float* mod = (float*)(F.ws + WS_MOD);
    __syncthreads();
    for (int i = F.tid; i < NB * DM; i += NWAVES * 64) sc[i] = siluf_(cvec[i]);
    __syncthreads();
    for (int cb = F.vcu; cb < 6 * DM / 48; cb += F.G) {
        const int n0 = cb * 48, l = F.lane < 48 ? F.lane : 47, k0 = F.wave * 256;
        float acc[8];
#pragma unroll
        for (int b = 0; b < 8; ++b) acc[b] = 0.f;
        const float* col = wada + (size_t)k0 * (6 * DM) + n0 + l;
#pragma unroll 1
        for (int kk = 0; kk < 256; kk += 32) { float wv[32];
#pragma unroll
            for (int u = 0; u < 32; ++u) wv[u] = col[(size_t)(kk + u) * (6 * DM)];
#pragma unroll
            for (int u = 0; u < 32; ++u)
#pragma unroll
                for (int b = 0; b < 8; ++b) acc[b] += sc[b * DM + k0 + kk + u] * wv[u]; }
        if (F.lane < 48) {
#pragma unroll
            for (int b = 0; b < 8; ++b) red[(F.wave * 8 + b) * 48 + F.lane] = acc[b]; }
        __syncthreads();
        if (F.tid < 384) { const int b = F.tid / 48, cc = F.tid % 48; float s = bada[n0 + cc];
#pragma unroll
            for (int w = 0; w < 8; ++w) s += red[(w * 8 + b) * 48 + cc];
            __hip_atomic_store(mod + (size_t)b * 6 * DM + n0 + cc, s, __ATOMIC_RELAXED, __HIP_MEMORY_SCOPE_AGENT); }
        VM_WAIT();
        __syncthreads();
    }
    if (F.tid == 0) __hip_atomic_fetch_add((unsigned*)(F.ws + WS_CTL) + CW_MODCNT, 1u, __ATOMIC_RELAXED, __HIP_MEMORY_SCOPE_AGENT);
}
__device__ __forceinline__ void p0_wait_mod(Ctx& F) {
    if (F.tid == 0) { unsigned* ctl = (unsigned*)(F.ws + WS_CTL); unsigned sp = 0u;
        while (ld_agent(ctl + CW_MODCNT) < (unsigned)F.G) { __builtin_amdgcn_s_sleep(2); if (++sp > (1u << 20)) { atomicAdd(ctl + CW_BAR + XB_TMO, 1u); break; } }
        __builtin_amdgcn_fence(__ATOMIC_ACQUIRE, "agent");
        asm volatile("s_waitcnt vmcnt(0)" ::: "memory"); }
    __syncthreads();
}
template <bool F8>
__device__ __forceinline__ void p0_transpose_item(const float* W, int K, int N, void* WT, int out_row0, int k0, int n0, float scale, LAS float* scr, int lane) {
    f32x4 v[16];
#pragma unroll
    for (int i = 0; i < 16; ++i) v[i] = *(const f32x4*)(W + (size_t)(k0 + 4 * i + (lane >> 4)) * N + n0 + 4 * (lane & 15));
#pragma unroll
    for (int i = 0; i < 16; ++i) { LAS float* d = scr + (4 * i + (lane >> 4)) * 65 + 4 * (lane & 15); d[0] = v[i].x; d[1] = v[i].y; d[2] = v[i].z; d[3] = v[i].w; }
    LDS_WAIT(); asm volatile("" ::: "memory");
    if (!F8) {
        const int c = lane & 7;
#pragma unroll
        for (int j = 0; j < 8; ++j) { const int n = (lane >> 3) + 8 * j; const LAS float* s = scr + (8 * c) * 65 + n;
            u32x4 o; o.x = pk2(s[0 * 65], s[1 * 65]); o.y = pk2(s[2 * 65], s[3 * 65]); o.z = pk2(s[4 * 65], s[5 * 65]); o.w = pk2(s[6 * 65], s[7 * 65]);
            *(u32x4*)((bf16*)WT + (size_t)(out_row0 + n) * K + k0 + 8 * c) = o; }
    } else {
        const int c = lane & 3;
#pragma unroll
        for (int j = 0; j < 4; ++j) { const int n = (lane >> 2) + 16 * j; const LAS float* s = scr + (16 * c) * 65 + n; int o[4];
#pragma unroll
            for (int q = 0; q < 4; ++q) { int wv = 0; wv = __builtin_amdgcn_cvt_pk_fp8_f32(s[(4 * q) * 65] * scale, s[(4 * q + 1) * 65] * scale, wv, false); wv = __builtin_amdgcn_cvt_pk_fp8_f32(s[(4 * q + 2) * 65] * scale, s[(4 * q + 3) * 65] * scale, wv, true); o[q] = wv; }
            *(u32x4*)((unsigned char*)WT + (size_t)(out_row0 + n) * K + k0 + 16 * c) = (u32x4){(unsigned)o[0], (unsigned)o[1], (unsigned)o[2], (unsigned)o[3]}; }
    }
    LDS_WAIT(); asm volatile("" ::: "memory");
}
struct CvItem { const float* src; unsigned char* dst; int N, K; float scale; };
__device__ __forceinline__ CvItem cv_decode(const void* const* in, unsigned char* ws, int r) {
    constexpr int I_EI = 32 * 16, I_EO = 8 * 32; CvItem c;
    if (r < 65 * I_EI) { const int e = r / I_EI, q = r % I_EI, kb = q / 16, nb = q % 16, n0 = 64 * nb, j = n0 & 511, up = n0 >> 9;
        const float* W = (e < 64) ? (const float*)in[20] + (size_t)e * DM * 1024 : (const float*)in[22];
        c.src = W + (size_t)(64 * kb) * 1024 + n0; c.N = 1024; c.K = DM; c.scale = SC_WEI;
        c.dst = ws + WS_WEI + (size_t)e * 1024 * DM + (size_t)((j >> 7) * 256 + up * 128 + (j & 127)) * DM + 64 * kb; }
    else { r -= 65 * I_EI; const int e = r / I_EO, q = r % I_EO, kb = q / 32, nb = q % 32;
        const float* W = (e < 64) ? (const float*)in[21] + (size_t)e * EH * DM : (const float*)in[23];
        c.src = W + (size_t)(64 * kb) * DM + 64 * nb; c.N = DM; c.K = EH; c.scale = SC_WEO;
        c.dst = ws + WS_WEO + (size_t)e * DM * EH + (size_t)(64 * nb) * EH + 64 * kb; }
    return c;
}
__device__ __forceinline__ void p2_convert_experts(Ctx& F) {
    const int gw = F.vcu * NWAVES + F.wave, NGW = F.G * NWAVES, lane = F.lane, li = lane & 15, lg = lane >> 4;
    constexpr int NCV = 65 * (32 * 16 + 8 * 32);
    int it = gw; CvItem cur; f32x4 v[16];
    const int krow = 16 * (li >> 2) + (li & 3);
#define CV_LOAD(c) do { _Pragma("unroll") for (int nh = 0; nh < 2; ++nh) _Pragma("unroll") for (int q = 0; q < 4; ++q) { const float* p_ = (c).src + (size_t)(krow + 4 * q) * (c).N + 32 * nh + 8 * lg; \
        v[(nh * 4 + q) * 2] = *(const f32x4*)p_; v[(nh * 4 + q) * 2 + 1] = *(const f32x4*)(p_ + 4); } } while (0)
    if (it < NCV) { cur = cv_decode(F.in, F.ws, it); CV_LOAD(cur); }
    while (it < NCV) {
        bf16x8 a[2][4];
#pragma unroll
        for (int nh = 0; nh < 2; ++nh)
#pragma unroll
            for (int q = 0; q < 4; ++q) { const f32x4 lo = v[(nh * 4 + q) * 2], hi = v[(nh * 4 + q) * 2 + 1];
                const u32x4 pk = (u32x4){pk2c(lo.x, lo.y), pk2c(lo.z, lo.w), pk2c(hi.x, hi.y), pk2c(hi.z, hi.w)}; a[nh][q] = __builtin_bit_cast(bf16x8, pk); }
        const CvItem me = cur; const int nit = it + NGW;
        if (nit < NCV) { cur = cv_decode(F.in, F.ws, nit); CV_LOAD(cur); }
        const unsigned sbits = (unsigned)f2bf(me.scale);
#pragma unroll
        for (int h = 0; h < 2; ++h) {
            u32x4 sel = (u32x4){0u, 0u, 0u, 0u}; { const int d = 16 * h + li - 8 * lg; if (d >= 0 && d < 8) { const unsigned wv = (d & 1) ? (sbits << 16) : sbits; if ((d >> 1) == 0) sel.x = wv; else if ((d >> 1) == 1) sel.y = wv; else if ((d >> 1) == 2) sel.z = wv; else sel.w = wv; } }
            const bf16x8 bs = __builtin_bit_cast(bf16x8, sel);
#pragma unroll
            for (int nh = 0; nh < 2; ++nh) { unsigned o[4];
#pragma unroll
                for (int q = 0; q < 4; ++q) { const f32x4 d = __builtin_amdgcn_mfma_f32_16x16x32_bf16(a[nh][q], bs, (f32x4){0.f, 0.f, 0.f, 0.f}, 0, 0, 0); o[q] = pk4_fp8(d[0], d[1], d[2], d[3]); }
                *(u32x4*)(me.dst + (size_t)(32 * nh + 16 * h + li) * me.K + 16 * lg) = (u32x4){o[0], o[1], o[2], o[3]}; }
        }
        it = nit;
    }
#undef CV_LOAD
}
__device__ __forceinline__ void p0_prologue(Ctx& F) {
    LAS float* scr = (LAS float*)(F.lds + F.wave * 16640);
    const int gw = F.vcu * NWAVES + F.wave, NGW = F.G * NWAVES, lane = F.lane;
    unsigned char* ws = F.ws;
    constexpr int I_IN = 32 * 96, I_OUT = 32 * 32, I_R = 32 * 1, I_G = 2 * 2;
    constexpr int NTR = I_IN + I_OUT + I_R + 16 * I_G;
    for (int it = gw; it < NTR; it += NGW) {
        int r = it;
        if (r < I_IN) { const int kb = r / 96, nb = r % 96; p0_transpose_item<false>((const float*)F.in[6], DM, NIN, ws + WS_WIN, 64 * nb, 64 * kb, 64 * nb, 1.f, scr, lane); continue; } r -= I_IN;
        if (r < I_OUT) { const int kb = r / 32, nb = r % 32; p0_transpose_item<false>((const float*)F.in[16], DM, DM, ws + WS_WOUT, 64 * nb, 64 * kb, 64 * nb, 1.f, scr, lane); continue; } r -= I_OUT;
        if (r < I_R) { const int kb = r; p0_transpose_item<false>((const float*)F.in[18], DM, NE, ws + WS_WR, 0, 64 * kb, 0, 1.f, scr, lane); continue; } r -= I_R;
        { const int m = r / I_G, q = r % I_G, kb = q / 2, nb = q % 2, g = m & 7;
          const float* W = ((m < 8) ? (const float*)F.in[9] : (const float*)F.in[11]) + (size_t)g * 128 * 128;
          p0_transpose_item<false>(W, 128, 128, (bf16*)(ws + (m < 8 ? WS_WA : WS_WX)) + (size_t)g * 128 * 128, 64 * nb, 64 * kb, 64 * nb, 1.f, scr, lane); }
    }
    {
        const int* pos = (const int*)F.in[2]; unsigned* rt = (unsigned*)(ws + WS_ROPE);
        for (int it = gw; it < T * 64 / 512; it += NGW) {
#pragma unroll 1
            for (int q = 0; q < 8; ++q) { const int idx = it * 512 + q * 64 + lane, t = idx >> 6, i = idx & 63;
                const double inv = exp(-9.210340371976184 * (double)i / 64.0); const double ang = (double)pos[t] * inv; double sn, cs; sincos(ang, &sn, &cs);
                rt[idx] = pk2c((float)cs, (float)sn); }
        }
    }
    if (gw == 0) { u32x4* z = (u32x4*)((bf16*)(ws + WS_H) + (size_t)T * DM); for (int i = lane; i < DM * 2 / 16; i += 64) z[i] = (u32x4){0u, 0u, 0u, 0u};
        u32x4* z8 = (u32x4*)(ws + WS_H8 + (size_t)T * DM); for (int i = lane; i < DM / 16; i += 64) z8[i] = (u32x4){0u, 0u, 0u, 0u}; }
}

template <bool W8, bool INBF>
__device__ __forceinline__ void norm_mod_row(const void* xrow_, const float* g, const float* sc, const float* sh, bf16* orow, unsigned char* orow8, int lane) {
    f32x4 v[4][2]; float ss = 0.f;
#pragma unroll
    for (int j = 0; j < 4; ++j) {
        if constexpr (INBF) { const u32x4 w = *(const u32x4*)((const bf16*)xrow_ + 8 * lane + 512 * j); v[j][0] = (f32x4){bflo(w.x), bfhi(w.x), bflo(w.y), bfhi(w.y)}; v[j][1] = (f32x4){bflo(w.z), bfhi(w.z), bflo(w.w), bfhi(w.w)}; }
        else { v[j][0] = *(const f32x4*)((const float*)xrow_ + 8 * lane + 512 * j); v[j][1] = *(const f32x4*)((const float*)xrow_ + 8 * lane + 512 * j + 4); }
#pragma unroll
        for (int h = 0; h < 2; ++h) ss += (v[j][h].x * v[j][h].x + v[j][h].y * v[j][h].y) + (v[j][h].z * v[j][h].z + v[j][h].w * v[j][h].w); }
    const float rstd = rsqrtf(wave_sum(ss) * (1.0f / DM) + EPS);
#pragma unroll
    for (int j = 0; j < 4; ++j) { f32x4 o[2];
#pragma unroll
        for (int h = 0; h < 2; ++h) { const int c = 8 * lane + 512 * j + 4 * h; const f32x4 gg = *(const f32x4*)(g + c), s1 = *(const f32x4*)(sc + c), s0 = *(const f32x4*)(sh + c);
            o[h] = (v[j][h] * rstd * gg) * (s1 + 1.0f) + s0; }
        u32x4 w; w.x = pk2(o[0].x, o[0].y); w.y = pk2(o[0].z, o[0].w); w.z = pk2(o[1].x, o[1].y); w.w = pk2(o[1].z, o[1].w);
        *(u32x4*)(orow + 8 * lane + 512 * j) = w;
        if constexpr (W8) { u32x2 w8; w8.x = pk4_fp8(o[0].x * SC_H8, o[0].y * SC_H8, o[0].z * SC_H8, o[0].w * SC_H8); w8.y = pk4_fp8(o[1].x * SC_H8, o[1].y * SC_H8, o[1].z * SC_H8, o[1].w * SC_H8); *(u32x2*)(orow8 + 8 * lane + 512 * j) = w8; } }
}
__device__ __forceinline__ void p1_norm(Ctx& F) {
    const int gw = F.vcu * NWAVES + F.wave, NGW = F.G * NWAVES;
    const float* x = (const float*)F.in[0]; const float* g = (const float*)F.in[5]; const float* mod = (const float*)(F.ws + WS_MOD); bf16* h = (bf16*)(F.ws + WS_H);
    for (int m = gw; m < T; m += NGW) { const int b = m / SEQ; norm_mod_row<false, false>(x + (size_t)m * DM, g, mod + (size_t)b * 6 * DM + DM, mod + (size_t)b * 6 * DM, h + (size_t)m * DM, nullptr, F.lane); }
}

struct EpiProj {
    static constexpr bool PERM = true, P16 = false;
    bf16* O;
    __device__ __forceinline__ void operator()(const f32x4 (&acc)[2][2][4][2], const g8::Unit& u, int wr, int wc, int fr, int fq) const {
        const int row0 = u.r0 + wr * 64 + fr, col0 = u.pn * 256 + wc * 32 + 8 * fq;
#pragma unroll
        for (int ai = 0; ai < 2; ++ai)
#pragma unroll
            for (int m = 0; m < 4; ++m) { bf16* rowp = O + (size_t)(row0 + ai * 128 + m * 16) * NIN + col0;
#pragma unroll
                for (int bj = 0; bj < 2; ++bj) { const f32x4 v0 = acc[ai][bj][m][0], v1 = acc[ai][bj][m][1];
                    u32x4 w; w.x = pk2c(v0[0], v0[1]); w.y = pk2c(v0[2], v0[3]); w.z = pk2c(v1[0], v1[1]); w.w = pk2c(v1[2], v1[3]);
                    *(u32x4*)(rowp + bj * 128) = w; } }
    }
};
struct EpiWout {
    static constexpr bool PERM = true, P16 = false;
    const float* x; const float* mod; bf16* x1;
    __device__ __forceinline__ void operator()(const f32x4 (&acc)[2][2][4][2], const g8::Unit& u, int wr, int wc, int fr, int fq) const {
        const int row0 = u.r0 + wr * 64 + fr, col0 = u.pn * 256 + wc * 32 + 8 * fq; const int b = u.r0 / SEQ;
        const float* gt = mod + (size_t)b * 6 * DM + 2 * DM;
        f32x4 gv[2][2];
#pragma unroll
        for (int bj = 0; bj < 2; ++bj)
#pragma unroll
            for (int n = 0; n < 2; ++n) gv[bj][n] = *(const f32x4*)(gt + col0 + bj * 128 + n * 4);
#pragma unroll
        for (int ai = 0; ai < 2; ++ai)
#pragma unroll
            for (int m = 0; m < 4; ++m) { const size_t off = (size_t)(row0 + ai * 128 + m * 16) * DM + col0;
#pragma unroll
                for (int bj = 0; bj < 2; ++bj) { const f32x4 v0 = *(const f32x4*)(x + off + bj * 128) + gv[bj][0] * acc[ai][bj][m][0], v1 = *(const f32x4*)(x + off + bj * 128 + 4) + gv[bj][1] * acc[ai][bj][m][1];
                    u32x4 w; w.x = pk2(v0[0], v0[1]); w.y = pk2(v0[2], v0[3]); w.z = pk2(v1[0], v1[1]); w.w = pk2(v1[2], v1[3]);
                    *(u32x4*)(x1 + off + bj * 128) = w; }
                asm volatile("" ::: "memory"); }
    }
};
struct EpiSwiglu {
    static constexpr bool PERM = true, P16 = false;
    unsigned char* act;
    __device__ __forceinline__ void operator()(const f32x4 (&acc)[2][2][4][2], const g8::Unit& u, int wr, int wc, int fr, int fq) const {
        const int row0 = u.r0 + wr * 64 + fr, col0 = u.pn * 128 + wc * 32 + 8 * fq;
#pragma unroll
        for (int ai = 0; ai < 2; ++ai)
#pragma unroll
            for (int m = 0; m < 4; ++m) { float o[8];
#pragma unroll
                for (int n = 0; n < 2; ++n)
#pragma unroll
                    for (int j = 0; j < 4; ++j) { const float g = acc[ai][0][m][n][j] * (1.0f / (SC_H8 * SC_WEI)), up = acc[ai][1][m][n][j] * (SC_ACT / (SC_H8 * SC_WEI)); o[4 * n + j] = g * __builtin_amdgcn_rcpf(1.0f + __expf(-g)) * up; }
                u32x2 w; w.x = pk4_fp8(o[0], o[1], o[2], o[3]); w.y = pk4_fp8(o[4], o[5], o[6], o[7]);
                *(u32x2*)(act + (size_t)(row0 + ai * 128 + m * 16) * EH + col0) = w; }
    }
};
struct EpiDown {
    static constexpr bool PERM = true, P16 = true;
    unsigned char* y;
    __device__ __forceinline__ void operator()(const f32x4 (&acc)[2][2][4][2], const g8::Unit& u, int wr, int wc, int fr, int fq) const {
        const int row0 = u.r0 + wr * 64 + fr, col0 = u.pn * 256 + wc * 64 + 16 * fq; constexpr float sc = SC_Y / (SC_ACT * SC_WEO); static_assert(sc == 1.0f, "scales chosen so that y needs no multiply");
#pragma unroll
        for (int ai = 0; ai < 2; ++ai)
#pragma unroll
            for (int m = 0; m < 4; ++m) { u32x4 w;
                { const f32x4 v0 = acc[ai][0][m][0], v1 = acc[ai][0][m][1], v2 = acc[ai][1][m][0], v3 = acc[ai][1][m][1];
                  w.x = pk4_fp8(v0[0], v0[1], v0[2], v0[3]); w.y = pk4_fp8(v1[0], v1[1], v1[2], v1[3]); w.z = pk4_fp8(v2[0], v2[1], v2[2], v2[3]); w.w = pk4_fp8(v3[0], v3[1], v3[2], v3[3]); }
                *(u32x4*)(y + (size_t)(row0 + ai * 128 + m * 16) * DM + col0) = w; }
    }
};

struct MoeTables { LAS int* row0; LAS int* te; LAS int* pend; LAS int* tp; };
__device__ __forceinline__ MoeTables moe_tables(Ctx& F) { MoeTables M; M.row0 = (LAS int*)(F.lds + TT_OFF); M.te = M.row0 + MAXTILES; M.pend = M.te + MAXTILES; M.tp = M.pend + 80; return M; }
__device__ __forceinline__ int moe_build_tables(Ctx& F) {
    MoeTables M = moe_tables(F);
    const unsigned* cnt = (const unsigned*)(F.ws + WS_CTL) + CW_CNT;
    __syncthreads();
    if (F.tid < NE) M.row0[F.tid] = (int)ld_agent(cnt + 32 * F.tid);
    __syncthreads();
    if (F.tid == 0) { int tiles = 0;
        for (int e = 0; e < NE; ++e) { const int c = M.row0[e]; M.tp[e] = tiles; M.pend[e] = tiles * 256 + c; tiles += (c + 255) >> 8; }
        M.tp[NE] = NR_ROUTED / 256; M.pend[NE] = NR; M.tp[NE + 1] = NR_ROUTED / 256 + T / 256; M.tp[NE + 2] = tiles; }
    __syncthreads();
    const int rt = M.tp[NE + 2];
    for (int tau = F.tid; tau < rt; tau += NWAVES * 64) { int e = 0; while (e + 1 < NE && M.tp[e + 1] <= tau) ++e; M.te[tau] = e; M.row0[tau] = tau * 256; }
    for (int s = F.tid; s < T / 256; s += NWAVES * 64) { M.te[rt + s] = NE; M.row0[rt + s] = NR_ROUTED + s * 256; }
    __syncthreads();
    return rt + T / 256;
}
template <int PHASE>
struct MoeOrder {
    MoeTables M; const char* A; const char* W; const int* row_tok; int U, CH, x, j;
    static constexpr int NPN = (PHASE == 1) ? 4 : 8;
    __device__ void init(Ctx& F, int ntiles) { M = moe_tables(F); U = ntiles * NPN; CH = (U + 7) / 8; x = F.vcu / (F.G / 8); j = F.vcu % (F.G / 8);
        A = (const char*)(F.ws + (PHASE == 1 ? WS_H8 : WS_ACT)); W = (const char*)(F.ws + (PHASE == 1 ? WS_WEI : WS_WEO)); row_tok = (const int*)(F.ws + WS_TOKOF); }
    __device__ __forceinline__ bool next(int i, g8::Unit& u) const {
        const int q = i * 32 + j; const int L = x * CH + q; if (q >= CH || L >= U) return false;
        int R[2], C[2]; g8::stage_rc((int)threadIdx.x * 16, R[0], C[0]); g8::stage_rc((int)threadIdx.x * 16 + 8192, R[1], C[1]);
        const int tile = L / NPN, pn = L % NPN;
        const int e = __builtin_amdgcn_readfirstlane(M.te[tile]), r0 = __builtin_amdgcn_readfirstlane(M.row0[tile]), rend = __builtin_amdgcn_readfirstlane(M.pend[e]);
        u.r0 = r0; u.pn = pn; u.e = e; u.rend = rend; u.A = A;
        if (PHASE == 1) {
            u.B = W + ((size_t)e * 1024 + (size_t)pn * 256) * DM;
#pragma unroll
            for (int k = 0; k < 2; ++k) { const int ra = r0 + R[k], rb = ra + 128; int ta, tb;
                if (e == NE) { ta = ra - NR_ROUTED; tb = rb - NR_ROUTED; }
                else { const int ps_ = __builtin_amdgcn_readfirstlane(M.tp[e]) * 256; const int* tk = row_tok + (size_t)e * T - ps_; ta = (ra < rend) ? ld_agent_i(tk + ra) : T; tb = (rb < rend) ? ld_agent_i(tk + rb) : T; }
                u.vA0[k] = (unsigned)(ta * DM + C[k] * 2); u.vA1[k] = (unsigned)(tb * DM + C[k] * 2); }
        } else {
            u.B = W + ((size_t)e * DM + (size_t)pn * 256) * EH;
#pragma unroll
            for (int k = 0; k < 2; ++k) { u.vA0[k] = (unsigned)((r0 + R[k]) * EH + C[k] * 2); u.vA1[k] = (unsigned)((r0 + R[k] + 128) * EH + C[k] * 2); }
        }
        asm volatile("" : "+v"(u.vA0[0]), "+v"(u.vA0[1]), "+v"(u.vA1[0]), "+v"(u.vA1[1]));
        return true;
    }
};

constexpr int LP = 136;
__device__ __forceinline__ void ret_item(Ctx& F, int item) {
    const int tid = F.tid, lane = F.lane, w = F.wave, fr = lane & 15, fq = lane >> 4;
    const int b = item >> 5, h = (item >> 2) & 7, eb = item & 3;
    LAS bf16* qL = (LAS bf16*)(F.lds); LAS bf16* kL = qL + 128 * LP; LAS bf16* kTL = kL + 128 * LP; LAS bf16* vTL = kTL + 128 * LP; LAS bf16* STL = vTL + 32 * LP;
    const bf16* proj = (const bf16*)(F.ws + WS_PROJ); const unsigned* rope = (const unsigned*)(F.ws + WS_ROPE); float* reto = (float*)(F.ws + WS_RETO);
    const float lg = log1pf(-exp2f(-5.0f - (float)h)), lg2 = lg * 1.4426950408889634f, dec = __expf(lg * 128.0f);
    f32x4 st[2] = {(f32x4){0.f, 0.f, 0.f, 0.f}, (f32x4){0.f, 0.f, 0.f, 0.f}};
    __syncthreads();
    for (int i = tid; i < 32 * LP; i += NWAVES * 64) STL[i] = 0;
    const int r = tid >> 2, qd = tid & 3, j0 = 16 * qd;
    const float kdec = __builtin_amdgcn_exp2f(lg2 * (float)(127 - r));
    u32x4 q1[2], q2[2], k1[2], k2[2], vv, cs4[4];
#define RET_LOAD(nn) do { const bf16* p_ = proj + (size_t)(b * SEQ + (nn) * 128 + r) * NIN + h * 128; const unsigned* c_ = rope + (size_t)(b * SEQ + (nn) * 128 + r) * 64 + j0; \
        q1[0] = *(const u32x4*)(p_ + j0); q1[1] = *(const u32x4*)(p_ + j0 + 8); q2[0] = *(const u32x4*)(p_ + 64 + j0); q2[1] = *(const u32x4*)(p_ + 64 + j0 + 8); \
        k1[0] = *(const u32x4*)(p_ + RW + j0); k1[1] = *(const u32x4*)(p_ + RW + j0 + 8); k2[0] = *(const u32x4*)(p_ + RW + 64 + j0); k2[1] = *(const u32x4*)(p_ + RW + 64 + j0 + 8); \
        vv = *(const u32x4*)(p_ + 2 * RW + eb * 32 + qd * 8); \
        _Pragma("unroll") for (int jj_ = 0; jj_ < 4; ++jj_) cs4[jj_] = *(const u32x4*)(c_ + 4 * jj_); } while (0)
    RET_LOAD(0);
#pragma unroll 1
    for (int n = 0; n < 16; ++n) {
        const int t0 = b * SEQ + n * 128;
        __syncthreads();
        {
            float rc[16], rs[16];
#pragma unroll
            for (int i4 = 0; i4 < 4; ++i4) { const u32x4 cw = cs4[i4];
#pragma unroll
                for (int e4 = 0; e4 < 4; ++e4) { rc[4 * i4 + e4] = bflo(cw[e4]); rs[4 * i4 + e4] = bfhi(cw[e4]); } }
#pragma unroll
            for (int hh = 0; hh < 2; ++hh) { unsigned oq1[4], oq2[4], ok1[4], ok2[4];
#pragma unroll
                for (int c = 0; c < 4; ++c) { float a[2], bq[2], ka[2], kb[2];
#pragma unroll
                    for (int z = 0; z < 2; ++z) { const int jj = hh * 8 + c * 2 + z; const f32x2 sc = (f32x2){rc[jj], rs[jj]};
                        const float x1 = z ? bfhi(q1[hh][c]) : bflo(q1[hh][c]), x2 = z ? bfhi(q2[hh][c]) : bflo(q2[hh][c]);
                        const float y1 = z ? bfhi(k1[hh][c]) : bflo(k1[hh][c]), y2 = z ? bfhi(k2[hh][c]) : bflo(k2[hh][c]);
                        a[z] = (x1 * sc.x - x2 * sc.y) * 0.08838834764831845f; bq[z] = (x2 * sc.x + x1 * sc.y) * 0.08838834764831845f;
                        ka[z] = y1 * sc.x - y2 * sc.y; kb[z] = y2 * sc.x + y1 * sc.y;
                        kTL[(j0 + jj) * LP + r] = f2bf(ka[z] * kdec); kTL[(64 + j0 + jj) * LP + r] = f2bf(kb[z] * kdec); }
                    oq1[c] = pk2(a[0], a[1]); oq2[c] = pk2(bq[0], bq[1]); ok1[c] = pk2(ka[0], ka[1]); ok2[c] = pk2(kb[0], kb[1]); }
                *(LAS u32x4*)(qL + r * LP + j0 + hh * 8) = (u32x4){oq1[0], oq1[1], oq1[2], oq1[3]}; *(LAS u32x4*)(qL + r * LP + 64 + j0 + hh * 8) = (u32x4){oq2[0], oq2[1], oq2[2], oq2[3]};
                *(LAS u32x4*)(kL + r * LP + j0 + hh * 8) = (u32x4){ok1[0], ok1[1], ok1[2], ok1[3]}; *(LAS u32x4*)(kL + r * LP + 64 + j0 + hh * 8) = (u32x4){ok2[0], ok2[1], ok2[2], ok2[3]}; }
#pragma unroll
            for (int c = 0; c < 4; ++c) { vTL[(qd * 8 + 2 * c) * LP + r] = (bf16)(vv[c] & 0xffffu); vTL[(qd * 8 + 2 * c + 1) * LP + r] = (bf16)(vv[c] >> 16); }
        }
        if (n + 1 < 16) RET_LOAD(n + 1);
        __syncthreads();
        f32x4 sacc[8];
#pragma unroll
        for (int mt = 0; mt < 8; ++mt) sacc[mt] = (f32x4){0.f, 0.f, 0.f, 0.f};
#pragma unroll
        for (int ks = 0; ks < 4; ++ks) { const bf16x8 bq = *(const LAS bf16x8*)(qL + (16 * w + fr) * LP + 32 * ks + 8 * fq);
#pragma unroll
            for (int mt = 0; mt < 8; ++mt) { const bf16x8 ak = *(const LAS bf16x8*)(kL + (16 * mt + fr) * LP + 32 * ks + 8 * fq); sacc[mt] = __builtin_amdgcn_mfma_f32_16x16x32_bf16(ak, bq, sacc[mt], 0, 0, 0); } }
        const int c = 16 * w + fr;
        bf16x8 pb[4];
#pragma unroll
        for (int sk = 0; sk < 4; ++sk) { unsigned pw[4];
#pragma unroll
            for (int hlf = 0; hlf < 2; ++hlf) { const int mt = 2 * sk + hlf; float pv[4];
#pragma unroll
                for (int rr = 0; rr < 4; ++rr) { const int m = 16 * mt + 4 * fq + rr; pv[rr] = (c >= m) ? sacc[mt][rr] * __builtin_amdgcn_exp2f(lg2 * (float)(c - m)) : 0.f; }
                pw[2 * hlf] = pk2(pv[0], pv[1]); pw[2 * hlf + 1] = pk2(pv[2], pv[3]); }
            pb[sk] = __builtin_bit_cast(bf16x8, (u32x4){pw[0], pw[1], pw[2], pw[3]}); }
        f32x4 oi[2], oc[2];
#pragma unroll
        for (int et = 0; et < 2; ++et) { oi[et] = (f32x4){0.f, 0.f, 0.f, 0.f}; oc[et] = (f32x4){0.f, 0.f, 0.f, 0.f}; }
#pragma unroll
        for (int ks = 0; ks < 4; ++ks) { const bf16x8 bq = *(const LAS bf16x8*)(qL + (16 * w + fr) * LP + 32 * ks + 8 * fq);
#pragma unroll
            for (int et = 0; et < 2; ++et) { const u32x2 v0 = *(const LAS u32x2*)(vTL + (16 * et + fr) * LP + 32 * ks + 4 * fq), v1 = *(const LAS u32x2*)(vTL + (16 * et + fr) * LP + 32 * ks + 16 + 4 * fq);
                const bf16x8 av = __builtin_bit_cast(bf16x8, (u32x4){v0.x, v0.y, v1.x, v1.y}); const bf16x8 as = *(const LAS bf16x8*)(STL + (16 * et + fr) * LP + 32 * ks + 8 * fq);
                oi[et] = __builtin_amdgcn_mfma_f32_16x16x32_bf16(av, pb[ks], oi[et], 0, 0, 0); oc[et] = __builtin_amdgcn_mfma_f32_16x16x32_bf16(as, bq, oc[et], 0, 0, 0); } }
        { const float qd = __builtin_amdgcn_exp2f(lg2 * (float)(c + 1));
#pragma unroll
          for (int et = 0; et < 2; ++et) *(f32x4*)(reto + (size_t)(t0 + c) * RW + h * 128 + eb * 32 + 16 * et + 4 * fq) = oi[et] + oc[et] * qd; }
        __syncthreads();
#pragma unroll
        for (int et = 0; et < 2; ++et) st[et] = st[et] * dec;
#pragma unroll
        for (int ks = 0; ks < 4; ++ks) { const bf16x8 bk = *(const LAS bf16x8*)(kTL + (16 * w + fr) * LP + 32 * ks + 8 * fq);
#pragma unroll
            for (int et = 0; et < 2; ++et) { const bf16x8 av = *(const LAS bf16x8*)(vTL + (16 * et + fr) * LP + 32 * ks + 8 * fq); st[et] = __builtin_amdgcn_mfma_f32_16x16x32_bf16(av, bk, st[et], 0, 0, 0); } }
#pragma unroll
        for (int et = 0; et < 2; ++et)
#pragma unroll
            for (int rr = 0; rr < 4; ++rr) STL[(16 * et + 4 * fq + rr) * LP + 16 * w + fr] = f2bf(st[et][rr]);
    }
#undef RET_LOAD
    __syncthreads();
}

struct LruIn { bf16x8 bA[4], bX[4]; unsigned xr[19]; f32x2 w0, w1, w2, w3, bc; float bav, bxv, lamv; };
__device__ __forceinline__ void lru_issue(Ctx& F, int item, LruIn& L) {
    const int lane = F.lane, w = F.wave, fr = lane & 15, fq = lane >> 4;
    const int b = item >> 7, n = (item >> 3) & 15, g = item & 7; const int ch = g * 128 + 2 * lane;
    const bf16* Wa = (const bf16*)(F.ws + WS_WA) + (size_t)g * 128 * 128 + (size_t)(16 * w + fr) * 128 + 8 * fq; const bf16* Wx = (const bf16*)(F.ws + WS_WX) + (size_t)g * 128 * 128 + (size_t)(16 * w + fr) * 128 + 8 * fq;
#pragma unroll
    for (int ks = 0; ks < 4; ++ks) { L.bA[ks] = *(const bf16x8*)(Wa + 32 * ks); L.bX[ks] = *(const bf16x8*)(Wx + 32 * ks); }
    const float* wconv = (const float*)F.in[7];
    L.w0 = *(const f32x2*)(wconv + ch); L.w1 = *(const f32x2*)(wconv + LW + ch); L.w2 = *(const f32x2*)(wconv + 2 * LW + ch); L.w3 = *(const f32x2*)(wconv + 3 * LW + ch); L.bc = *(const f32x2*)((const float*)F.in[8] + ch);
    const int cj = g * 128 + 16 * w + fr; L.bav = ((const float*)F.in[10])[cj]; L.bxv = ((const float*)F.in[12])[cj]; L.lamv = ((const float*)F.in[13])[cj];
    const int s0 = n * 128 + 16 * w; const bf16* p = (const bf16*)(F.ws + WS_PROJ) + (size_t)(b * SEQ) * NIN + 4 * RW + ch;
#pragma unroll
    for (int i = 0; i < 19; ++i) { const int sp = s0 - 3 + i; L.xr[i] = (sp >= 0) ? *(const unsigned*)(p + (size_t)sp * NIN) : 0u; }
}
__device__ __forceinline__ void lru_body(Ctx& F, int item, const LruIn& L) {
    const int lane = F.lane, w = F.wave, fr = lane & 15, fq = lane >> 4;
    const int b = item >> 7, n = (item >> 3) & 15, g = item & 7;
    LAS bf16* xcL = (LAS bf16*)(F.lds); LAS float* aL = (LAS float*)(F.lds + 34816); LAS bf16* mL = (LAS bf16*)(F.lds + 34816 + 65536); LAS float* segA = (LAS float*)(F.lds + 34816 + 65536 + 32768); LAS float* segB = segA + 1024;
    const int cp = lane, sg = w, ch = g * 128 + 2 * cp;
    float xc[16][2];
#pragma unroll
    for (int i = 0; i < 16; ++i) {
        xc[i][0] = L.bc.x + L.w0.x * bflo(L.xr[i]) + L.w1.x * bflo(L.xr[i + 1]) + L.w2.x * bflo(L.xr[i + 2]) + L.w3.x * bflo(L.xr[i + 3]);
        xc[i][1] = L.bc.y + L.w0.y * bfhi(L.xr[i]) + L.w1.y * bfhi(L.xr[i + 1]) + L.w2.y * bfhi(L.xr[i + 2]) + L.w3.y * bfhi(L.xr[i + 3]);
        *(LAS unsigned*)(xcL + (16 * sg + i) * LP + 2 * cp) = pk2(xc[i][0], xc[i][1]); }
    __syncthreads();
    {
        const int j = 16 * w + fr; const float bav = L.bav, bxv = L.bxv, sp8 = -8.0f * log1pf(__expf(-L.lamv));
#pragma unroll 2
        for (int tt = 0; tt < 8; ++tt) { f32x4 ra = (f32x4){0.f, 0.f, 0.f, 0.f}, rx = (f32x4){0.f, 0.f, 0.f, 0.f};
#pragma unroll
            for (int ks = 0; ks < 4; ++ks) { const bf16x8 a = *(const LAS bf16x8*)(xcL + (16 * tt + fr) * LP + 32 * ks + 8 * fq);
                ra = __builtin_amdgcn_mfma_f32_16x16x32_bf16(a, L.bA[ks], ra, 0, 0, 0); rx = __builtin_amdgcn_mfma_f32_16x16x32_bf16(a, L.bX[ks], rx, 0, 0, 0); }
#pragma unroll
            for (int rr = 0; rr < 4; ++rr) { const int t = 16 * tt + 4 * fq + rr;
                const float rgt = __builtin_amdgcn_rcpf(1.0f + __expf(-(ra[rr] + bav))), igt = __builtin_amdgcn_rcpf(1.0f + __expf(-(rx[rr] + bxv)));
                const float av = __expf(sp8 * rgt); const float mu = __builtin_amdgcn_sqrtf(fmaxf(1.0f - av * av, 0.f)) * igt;
                aL[t * 128 + j] = av; mL[t * 128 + j] = f2bf(mu); } }
    }
    __syncthreads();
    {
        float h0 = 0.f, h1 = 0.f, P0 = 1.f, P1 = 1.f;
#pragma unroll
        for (int i = 0; i < 16; ++i) { const int t = 16 * sg + i; const f32x2 av = *(const LAS f32x2*)(aL + t * 128 + 2 * cp); const unsigned mw = *(const LAS unsigned*)(mL + t * 128 + 2 * cp);
            h0 = av.x * h0 + bflo(mw) * xc[i][0]; h1 = av.y * h1 + bfhi(mw) * xc[i][1]; P0 *= av.x; P1 *= av.y; }
        *(LAS f32x2*)(segA + sg * 128 + 2 * cp) = (f32x2){P0, P1}; *(LAS f32x2*)(segB + sg * 128 + 2 * cp) = (f32x2){h0, h1};
    }
    __syncthreads();
    {
        float c0 = 0.f, c1 = 0.f, Q0 = 1.f, Q1 = 1.f;
        for (int s = 0; s < sg; ++s) { const f32x2 A = *(const LAS f32x2*)(segA + s * 128 + 2 * cp), Bv = *(const LAS f32x2*)(segB + s * 128 + 2 * cp); c0 = A.x * c0 + Bv.x; c1 = A.y * c1 + Bv.y; Q0 *= A.x; Q1 *= A.y; }
        bf16* hl = (bf16*)(F.ws + WS_HLOC) + (size_t)(b * SEQ + n * 128 + 16 * sg) * LW + ch; bf16* pl = (bf16*)(F.ws + WS_PLOC) + (size_t)(b * SEQ + n * 128 + 16 * sg) * LW + ch;
        float h0 = c0, h1 = c1, P0 = Q0, P1 = Q1;
#pragma unroll
        for (int i = 0; i < 16; ++i) { const int t = 16 * sg + i; const f32x2 av = *(const LAS f32x2*)(aL + t * 128 + 2 * cp); const unsigned mw = *(const LAS unsigned*)(mL + t * 128 + 2 * cp);
            h0 = av.x * h0 + bflo(mw) * xc[i][0]; h1 = av.y * h1 + bfhi(mw) * xc[i][1]; P0 *= av.x; P1 *= av.y;
            *(unsigned*)(hl + (size_t)i * LW) = pk2(h0, h1); *(unsigned*)(pl + (size_t)i * LW) = pk2(P0, P1); }
        if (sg == 7) { *(f32x2*)((float*)(F.ws + WS_AGGA) + (size_t)(b * 16 + n) * LW + ch) = (f32x2){P0, P1}; *(f32x2*)((float*)(F.ws + WS_AGGB) + (size_t)(b * 16 + n) * LW + ch) = (f32x2){h0, h1}; }
    }
    __syncthreads();
}

__device__ __forceinline__ void p4_item(Ctx& F, int item) {
    const int tid = F.tid, lane = F.lane, w = F.wave;
    const int b = item >> 5, n = (item & 31) >> 1;
    LAS float* carry = (LAS float*)F.lds;
    const float* aggA = (const float*)(F.ws + WS_AGGA); const float* aggB = (const float*)(F.ws + WS_AGGB);
    __syncthreads();
#pragma unroll
    for (int q = 0; q < 2; ++q) { const int ch = tid + 512 * q; float cin = 0.f;
        for (int jn = 0; jn < n; ++jn) cin = aggA[(size_t)(b * 16 + jn) * LW + ch] * cin + aggB[(size_t)(b * 16 + jn) * LW + ch];
        carry[ch] = cin; }
    __syncthreads();
    const bf16* proj = (const bf16*)(F.ws + WS_PROJ); const float* reto = (const float*)(F.ws + WS_RETO); const bf16* hl = (const bf16*)(F.ws + WS_HLOC); const bf16* pl = (const bf16*)(F.ws + WS_PLOC);
    bf16* cat = (bf16*)(F.ws + WS_CAT); const int c0 = 16 * lane;
    float beta_r[16], beta_l[16], cr[16];
#pragma unroll
    for (int q = 0; q < 4; ++q) { const f32x4 a = *(const f32x4*)((const float*)F.in[14] + c0 + 4 * q), bq = *(const f32x4*)((const float*)F.in[15] + c0 + 4 * q); const f32x4 cq = *(const LAS f32x4*)(carry + c0 + 4 * q);
        beta_r[4 * q] = a.x; beta_r[4 * q + 1] = a.y; beta_r[4 * q + 2] = a.z; beta_r[4 * q + 3] = a.w; beta_l[4 * q] = bq.x; beta_l[4 * q + 1] = bq.y; beta_l[4 * q + 2] = bq.z; beta_l[4 * q + 3] = bq.w;
        cr[4 * q] = cq.x; cr[4 * q + 1] = cq.y; cr[4 * q + 2] = cq.z; cr[4 * q + 3] = cq.w; }
#pragma unroll 2
    for (int rr = 0; rr < 8; ++rr) {
        const int t = item * 64 + 8 * w + rr;
        {
            float o[16];
#pragma unroll
            for (int q = 0; q < 4; ++q) { const f32x4 v = *(const f32x4*)(reto + (size_t)t * RW + c0 + 4 * q); o[4 * q] = v.x; o[4 * q + 1] = v.y; o[4 * q + 2] = v.z; o[4 * q + 3] = v.w; }
            float s = 0.f;
#pragma unroll
            for (int q = 0; q < 16; ++q) s += o[q];
            s += __shfl_xor(s, 1); s += __shfl_xor(s, 2); s += __shfl_xor(s, 4);
            const float mu = s * (1.0f / 128.0f); float vq = 0.f;
#pragma unroll
            for (int q = 0; q < 16; ++q) { o[q] -= mu; vq += o[q] * o[q]; }
            vq += __shfl_xor(vq, 1); vq += __shfl_xor(vq, 2); vq += __shfl_xor(vq, 4);
            const float rs = rsqrtf(vq * (1.0f / 128.0f) + EPS);
            const u32x4 g0 = *(const u32x4*)(proj + (size_t)t * NIN + 3 * RW + c0), g1 = *(const u32x4*)(proj + (size_t)t * NIN + 3 * RW + c0 + 8);
            float ss = 0.f;
#pragma unroll
            for (int q = 0; q < 8; ++q) { const unsigned gw_ = (q < 4) ? g0[q & 3] : g1[q & 3]; const float ga = bflo(gw_), gb = bfhi(gw_);
                o[2 * q] = siluf_(ga) * (o[2 * q] * rs); o[2 * q + 1] = siluf_(gb) * (o[2 * q + 1] * rs); ss += o[2 * q] * o[2 * q] + o[2 * q + 1] * o[2 * q + 1]; }
            const float rstd = rsqrtf(wave_sum(ss) * (1.0f / RW) + EPS);
            u32x4 w0, w1;
#pragma unroll
            for (int q = 0; q < 4; ++q) { w0[q] = pk2(o[2 * q] * rstd * beta_r[2 * q], o[2 * q + 1] * rstd * beta_r[2 * q + 1]); w1[q] = pk2(o[8 + 2 * q] * rstd * beta_r[8 + 2 * q], o[9 + 2 * q] * rstd * beta_r[9 + 2 * q]); }
            *(u32x4*)(cat + (size_t)t * DM + c0) = w0; *(u32x4*)(cat + (size_t)t * DM + c0 + 8) = w1;
        }
        {
            const u32x4 h0 = *(const u32x4*)(hl + (size_t)t * LW + c0), h1 = *(const u32x4*)(hl + (size_t)t * LW + c0 + 8), p0 = *(const u32x4*)(pl + (size_t)t * LW + c0), p1 = *(const u32x4*)(pl + (size_t)t * LW + c0 + 8);
            const u32x4 y0 = *(const u32x4*)(proj + (size_t)t * NIN + 5 * RW + c0), y1 = *(const u32x4*)(proj + (size_t)t * NIN + 5 * RW + c0 + 8);
            float o[16]; float ss = 0.f;
#pragma unroll
            for (int q = 0; q < 8; ++q) { const unsigned hw = (q < 4) ? h0[q & 3] : h1[q & 3], pw = (q < 4) ? p0[q & 3] : p1[q & 3], yw = (q < 4) ? y0[q & 3] : y1[q & 3];
                const float ha = bflo(hw) + bflo(pw) * cr[2 * q], hb = bfhi(hw) + bfhi(pw) * cr[2 * q + 1];
                o[2 * q] = ha * gelu_tanh_(bflo(yw)); o[2 * q + 1] = hb * gelu_tanh_(bfhi(yw)); ss += o[2 * q] * o[2 * q] + o[2 * q + 1] * o[2 * q + 1]; }
            const float rstd = rsqrtf(wave_sum(ss) * (1.0f / LW) + EPS);
            u32x4 w0, w1;
#pragma unroll
            for (int q = 0; q < 4; ++q) { w0[q] = pk2(o[2 * q] * rstd * beta_l[2 * q], o[2 * q + 1] * rstd * beta_l[2 * q + 1]); w1[q] = pk2(o[8 + 2 * q] * rstd * beta_l[8 + 2 * q], o[9 + 2 * q] * rstd * beta_l[9 + 2 * q]); }
            *(u32x4*)(cat + (size_t)t * DM + RW + c0) = w0; *(u32x4*)(cat + (size_t)t * DM + RW + c0 + 8) = w1;
        }
    }
    __syncthreads();
}

constexpr int HAP = 2056;
template <bool DRY> __device__ __forceinline__ void p6_item(Ctx& F, int item) {
    const int tid = F.tid, lane = F.lane, w = F.wave, fr = lane & 15, fq = lane >> 4;
    const int t0 = item * 64, b = t0 / SEQ;
    LAS bf16* hA = (LAS bf16*)F.lds;
    LAS float* lgt = (LAS float*)(F.lds + 16 * HAP * 2);
    LAS unsigned char* selE = (LAS unsigned char*)(F.lds + 16 * HAP * 2 + 8 * 16 * 65 * 4); LAS unsigned char* selL = selE + 512; LAS unsigned* wcnt = (LAS unsigned*)(selL + 512); LAS unsigned* gb = wcnt + 512;
    const bf16* x1 = (const bf16*)(F.ws + WS_X1); const float* mod = (const float*)(F.ws + WS_MOD) + (size_t)b * 6 * DM; bf16* h2 = (bf16*)(F.ws + WS_H); unsigned char* h8 = F.ws + WS_H8;
    const bf16* Wr = (const bf16*)(F.ws + WS_WR);
    int* eidx = (int*)(F.ws + WS_EIDX); float* wsel = (float*)(F.ws + WS_WSEL); int* slot = (int*)(F.ws + (DRY ? WS_DEST : WS_SLOT)); unsigned* cnt = (unsigned*)(F.ws + WS_CTL) + CW_CNT + (DRY ? 4096 : 0);
    f32x4 gg[4][2];
#pragma unroll
    for (int j = 0; j < 4; ++j)
#pragma unroll
        for (int h = 0; h < 2; ++h) { const int c = 8 * lane + 512 * j + 4 * h; gg[j][h] = *(const f32x4*)((const float*)F.in[17] + c) * (*(const f32x4*)(mod + 4 * DM + c) + 1.0f); }
    const float brl = ((const float*)F.in[19])[lane]; const int g = lane >> 3;
    unsigned lc = 0u;
    bf16x8 bw[2][4];
#pragma unroll
    for (int ks = 0; ks < 2; ++ks)
#pragma unroll
        for (int et = 0; et < 4; ++et) bw[ks][et] = *(const bf16x8*)(Wr + (size_t)(16 * et + fr) * DM + 256 * w + 32 * ks + 8 * fq);
    u32x4 xq[2][4];
#pragma unroll
    for (int i = 0; i < 2; ++i)
#pragma unroll
        for (int j = 0; j < 4; ++j) xq[i][j] = *(const u32x4*)(x1 + (size_t)(t0 + 2 * w + i) * DM + 8 * lane + 512 * j);
    __syncthreads();
#pragma unroll 1
    for (int ps = 0; ps < 4; ++ps) {
#pragma unroll
        for (int i = 0; i < 2; ++i) { const int rl = 2 * w + i, t = t0 + 16 * ps + rl;
            f32x4 v[4][2]; float ss = 0.f;
#pragma unroll
            for (int j = 0; j < 4; ++j) { const u32x4 xw = xq[i][j]; v[j][0] = (f32x4){bflo(xw.x), bfhi(xw.x), bflo(xw.y), bfhi(xw.y)}; v[j][1] = (f32x4){bflo(xw.z), bfhi(xw.z), bflo(xw.w), bfhi(xw.w)};
#pragma unroll
                for (int h = 0; h < 2; ++h) ss += (v[j][h].x * v[j][h].x + v[j][h].y * v[j][h].y) + (v[j][h].z * v[j][h].z + v[j][h].w * v[j][h].w); }
            const float rstd = rsqrtf(wave_sum(ss) * (1.0f / DM) + EPS);
#pragma unroll
            for (int j = 0; j < 4; ++j) { const f32x4 o0 = v[j][0] * rstd * gg[j][0] + *(const f32x4*)(mod + 3 * DM + 8 * lane + 512 * j), o1 = v[j][1] * rstd * gg[j][1] + *(const f32x4*)(mod + 3 * DM + 8 * lane + 512 * j + 4);
                u32x4 wv; wv.x = pk2(o0.x, o0.y); wv.y = pk2(o0.z, o0.w); wv.z = pk2(o1.x, o1.y); wv.w = pk2(o1.z, o1.w);
                *(LAS u32x4*)(hA + rl * HAP + 8 * lane + 512 * j) = wv;
                u32x2 w8; w8.x = pk4_fp8(o0.x * SC_H8, o0.y * SC_H8, o0.z * SC_H8, o0.w * SC_H8); w8.y = pk4_fp8(o1.x * SC_H8, o1.y * SC_H8, o1.z * SC_H8, o1.w * SC_H8);
                *(u32x2*)(h8 + (size_t)t * DM + 8 * lane + 512 * j) = w8; }
            __builtin_amdgcn_sched_barrier(0); }
        __syncthreads();
        {
            f32x4 acc[4];
#pragma unroll
            for (int et = 0; et < 4; ++et) acc[et] = (f32x4){0.f, 0.f, 0.f, 0.f};
            bf16x8 bw2[6][4];
#pragma unroll
            for (int ks = 0; ks < 6; ++ks)
#pragma unroll
                for (int et = 0; et < 4; ++et) bw2[ks][et] = *(const bf16x8*)(Wr + (size_t)(16 * et + fr) * DM + 256 * w + 64 + 32 * ks + 8 * fq);
#pragma unroll
            for (int ks = 0; ks < 2; ++ks) { const bf16x8 a = *(const LAS bf16x8*)(hA + fr * HAP + 256 * w + 32 * ks + 8 * fq);
#pragma unroll
                for (int et = 0; et < 4; ++et) acc[et] = __builtin_amdgcn_mfma_f32_16x16x32_bf16(a, bw[ks][et], acc[et], 0, 0, 0); }
#pragma unroll
            for (int ks = 0; ks < 6; ++ks) { const bf16x8 a = *(const LAS bf16x8*)(hA + fr * HAP + 256 * w + 64 + 32 * ks + 8 * fq);
#pragma unroll
                for (int et = 0; et < 4; ++et) acc[et] = __builtin_amdgcn_mfma_f32_16x16x32_bf16(a, bw2[ks][et], acc[et], 0, 0, 0); }
#pragma unroll
            for (int et = 0; et < 4; ++et)
#pragma unroll
                for (int rr = 0; rr < 4; ++rr) lgt[(w * 16 + 4 * fq + rr) * 65 + 16 * et + fr] = acc[et][rr];
        }
        __syncthreads();
        if (ps + 1 < 4) {
#pragma unroll
            for (int i = 0; i < 2; ++i)
#pragma unroll
                for (int j = 0; j < 4; ++j) xq[i][j] = *(const u32x4*)(x1 + (size_t)(t0 + 16 * (ps + 1) + 2 * w + i) * DM + 8 * lane + 512 * j); }
#pragma unroll 1
        for (int i = 0; i < 2; ++i) {
            const int tl = 2 * w + i, tt = 16 * ps + tl; float z = 0.f;
#pragma unroll
            for (int w2 = 0; w2 < 8; ++w2) z += lgt[(w2 * 16 + tl) * 65 + lane];
            const float s = sigmoidf_(z); const float bsc = s + brl;
            float m1 = bsc; m1 = fmaxf(m1, __shfl_xor(m1, 1)); m1 = fmaxf(m1, __shfl_xor(m1, 2)); m1 = fmaxf(m1, __shfl_xor(m1, 4));
            const unsigned long long eq = __ballot(bsc == m1); const unsigned gm = (unsigned)(eq >> (8 * g)) & 0xffu;
            const bool first = (lane & 7) == (__builtin_ctz(gm | 0x100u) & 7);
            float m2 = first ? -3.0e38f : bsc; m2 = fmaxf(m2, __shfl_xor(m2, 1)); m2 = fmaxf(m2, __shfl_xor(m2, 2)); m2 = fmaxf(m2, __shfl_xor(m2, 4));
            const float gs = m1 + m2;
            int rank_g = 0;
#pragma unroll
            for (int g2 = 0; g2 < 8; ++g2) { const float o = __int_as_float(__builtin_amdgcn_readlane(__float_as_int(gs), 8 * g2)); rank_g += (o > gs || (o == gs && g2 < g)) ? 1 : 0; }
            const bool selg = rank_g < 4;
            const float key = selg ? bsc : -3.0e38f;
            int rank = 0;
#pragma unroll
            for (int e2 = 0; e2 < 64; ++e2) { const float o = __int_as_float(__builtin_amdgcn_readlane(__float_as_int(key), e2)); rank += (o > key || (o == key && e2 < lane)) ? 1 : 0; }
            const bool chosen = selg && rank < 8;
            const float wsum = wave_sum(chosen ? s : 0.f);
            if (chosen) { const int t = t0 + tt; eidx[t * 8 + rank] = lane; wsel[t * 8 + rank] = s * (2.5f / wsum); selE[tt * 8 + rank] = (unsigned char)lane; selL[tt * 8 + rank] = (unsigned char)lc; }
            lc += chosen ? 1u : 0u;
        }
        __syncthreads();
    }
    wcnt[w * 64 + lane] = lc;
    __syncthreads();
    if (w == 0) { unsigned tot = 0u;
#pragma unroll
        for (int w2 = 0; w2 < 8; ++w2) tot += wcnt[w2 * 64 + lane];
        gb[lane] = tot ? __hip_atomic_fetch_add(cnt + 32 * lane, tot, __ATOMIC_RELAXED, __HIP_MEMORY_SCOPE_AGENT) : 0u; }
    __syncthreads();
    { const int tok = tid >> 3, k = tid & 7, e = selE[tok * 8 + k], wt = (tok & 15) >> 1; unsigned off = gb[e] + selL[tok * 8 + k];
        for (int w2 = 0; w2 < wt; ++w2) off += wcnt[w2 * 64 + e];
        slot[(t0 + tok) * 8 + k] = (int)off; if (!DRY) ((int*)(F.ws + WS_TOKOF))[(size_t)e * T + off] = t0 + tok; }
    __syncthreads();
}

__device__ __forceinline__ void p10_final(Ctx& F, bool have_tables) {
    const int gw = F.vcu * NWAVES + F.wave, NGW = F.G * NWAVES, lane = F.lane;
    const bf16* x1 = (const bf16*)(F.ws + WS_X1); const unsigned char* y = F.ws + WS_Y; const int* eidx = (const int*)(F.ws + WS_EIDX); const int* slot = (const int*)(F.ws + WS_SLOT); const float* wsel = (const float*)(F.ws + WS_WSEL); const float* gf = (const float*)F.in[24];
    LAS int* ps = (LAS int*)F.lds; const unsigned* cnt = (const unsigned*)(F.ws + WS_CTL) + CW_CNT;
    __syncthreads();
    if (have_tables) { if (F.tid < NE) ps[F.tid] = moe_tables(F).tp[F.tid] * 256; }
    else { if (F.tid < NE) ps[64 + F.tid] = (((int)ld_agent(cnt + 32 * F.tid) + 255) >> 8) << 8;
        __syncthreads();
        if (F.tid < NE) { int acc = 0; for (int e = 0; e < F.tid; ++e) acc += ps[64 + e]; ps[F.tid] = acc; } }
    __syncthreads();
    for (int t = gw; t < T; t += NGW) { const int b = t / SEQ; const float* gt2 = (const float*)(F.ws + WS_MOD) + (size_t)b * 6 * DM + 5 * DM;
        int rows[9]; float wk[9];
#pragma unroll
        for (int k = 0; k < 8; ++k) { rows[k] = ps[ld_agent_i(eidx + t * 8 + k)] + ld_agent_i(slot + t * 8 + k); wk[k] = wsel[t * 8 + k] * (1.0f / SC_Y); }
        rows[8] = NR_ROUTED + t; wk[8] = 1.0f / SC_Y;
        float ss = 0.f; f32x4 v[4][2];
#pragma unroll
        for (int j = 0; j < 4; ++j) { const int c = 8 * lane + 512 * j; float s[8];
#pragma unroll
            for (int q = 0; q < 8; ++q) s[q] = 0.f;
#pragma unroll
            for (int k = 0; k < 9; ++k) { const u32x2 yv = *(const u32x2*)(y + (size_t)rows[k] * DM + c);
#pragma unroll
                for (int q = 0; q < 2; ++q) { const f32x2 lo = __builtin_amdgcn_cvt_pk_f32_fp8((int)yv[q], false), hi = __builtin_amdgcn_cvt_pk_f32_fp8((int)yv[q], true);
                    s[4 * q] += wk[k] * lo.x; s[4 * q + 1] += wk[k] * lo.y; s[4 * q + 2] += wk[k] * hi.x; s[4 * q + 3] += wk[k] * hi.y; } }
            const u32x4 xw = *(const u32x4*)(x1 + (size_t)t * DM + c);
#pragma unroll
            for (int hh = 0; hh < 2; ++hh) { const f32x4 xv = hh ? (f32x4){bflo(xw.z), bfhi(xw.z), bflo(xw.w), bfhi(xw.w)} : (f32x4){bflo(xw.x), bfhi(xw.x), bflo(xw.y), bfhi(xw.y)}, gv = *(const f32x4*)(gt2 + c + 4 * hh);
                v[j][hh] = xv + gv * (f32x4){s[4 * hh], s[4 * hh + 1], s[4 * hh + 2], s[4 * hh + 3]};
                ss += (v[j][hh].x * v[j][hh].x + v[j][hh].y * v[j][hh].y) + (v[j][hh].z * v[j][hh].z + v[j][hh].w * v[j][hh].w); } }
        const float rstd = rsqrtf(wave_sum(ss) * (1.0f / DM) + EPS);
#pragma unroll
        for (int j = 0; j < 4; ++j)
#pragma unroll
            for (int hh = 0; hh < 2; ++hh) { const int c = 8 * lane + 512 * j + 4 * hh; *(f32x4*)(F.out + (size_t)t * DM + c) = v[j][hh] * rstd * *(const f32x4*)(gf + c); }
    }
}

__global__ void __launch_bounds__(NWAVES * 64, 2) fwd_kernel(Args args) {
    extern __shared__ __attribute__((aligned(16))) unsigned char lds_raw[];
    Ctx F;
    F.lds = (LAS unsigned char*)lds_raw; F.ws = args.ws; F.in = args.in; F.out = args.out;
    F.tid = threadIdx.x; F.lane = F.tid & 63; F.wave = __builtin_amdgcn_readfirstlane(F.tid >> 6);
    F.G = gridDim.x; { const int bx = blockIdx.x; F.vcu = (F.G % 8 == 0) ? (bx % 8) * (F.G / 8) + bx / 8 : bx; }
    if (F.tid < 16) ((LAS unsigned*)(F.lds + MISC_OFF))[F.tid] = 0u;
    __syncthreads();
    unsigned* ctl = (unsigned*)(F.ws + WS_CTL);
#if N_LAUNCHES == 1
    XcdBarrier bar = xcd_barrier_post(ctl + CW_BAR, (volatile LAS unsigned*)(F.lds + MISC_OFF));
#define GRID_BAR() xcd_barrier(bar)
#else
#define GRID_BAR() do { } while (0)
#endif
    const int lo = args.ph_lo, hi = args.ph_hi;
#define IN(k) (lo <= (k) && (k) < hi)
#define BOTH(k) (IN(k) && IN((k) + 1))
    const int NIT = F.G;

#define REP(k) _Pragma("unroll") for (int rep_ = 0; rep_ < ((PROBE_PHASE == (k)) ? 2 : 1); ++rep_)
    if (IN(0)) { p0_adaln(F); p0_prologue(F); if (BOTH(0)) p0_wait_mod(F); }
    if (IN(1)) { REP(1) { p1_norm(F); } if (BOTH(1)) GRID_BAR(); if (PROBE_PHASE == 100) { GRID_BAR(); GRID_BAR(); GRID_BAR(); GRID_BAR(); } }
    if (IN(2)) {
        if (F.vcu & 1) p2_convert_experts(F);
        REP(2) {
        g8::DenseOrder S; S.init(F.ws + WS_H, F.ws + WS_WIN, T, NIN, DM * 2, F.G, (int)blockIdx.x);
        EpiProj E{(bf16*)(F.ws + WS_PROJ)};
        g8::gemm_phase<EpiProj, g8::DenseOrder>(F.lds, DM * 2, S, E);
        }
        if (!(F.vcu & 1)) p2_convert_experts(F);
        if (BOTH(2)) GRID_BAR();
    }
    if (IN(3)) {
        for (int it = F.vcu; it < NB * 8 * 4 * ((PROBE_PHASE == 31) ? 2 : 1); it += NIT) ret_item(F, it & 255);
        {
            LruIn La, Lb; int it = F.vcu; const int NL = NB * 16 * 8;
            __syncthreads();
            if (it < NL) lru_issue(F, it, La);
            while (it < NL) {
                if (it + NIT < NL) lru_issue(F, it + NIT, Lb);
                lru_body(F, it, La); it += NIT;
                if (it >= NL) break;
                if (it + NIT < NL) lru_issue(F, it + NIT, La);
                lru_body(F, it, Lb); it += NIT;
            }
        }
        if (BOTH(3)) GRID_BAR();
    }
    if (IN(4)) { REP(4) { for (int it = F.vcu; it < T / 64; it += NIT) p4_item(F, it); } if (BOTH(4)) GRID_BAR(); }
    if (IN(5)) {
        REP(5) {
        g8::DenseOrder S; S.init(F.ws + WS_CAT, F.ws + WS_WOUT, T, DM, DM * 2, F.G, (int)blockIdx.x);
        EpiWout E{(const float*)F.in[0], (const float*)(F.ws + WS_MOD), (bf16*)(F.ws + WS_X1)};
        g8::gemm_phase<EpiWout, g8::DenseOrder>(F.lds, DM * 2, S, E);
        }
        if (BOTH(5)) GRID_BAR();
    }
    if (IN(6)) { for (int it = F.vcu; it < T / 64; it += NIT) p6_item<false>(F, it); if (PROBE_PHASE == 6) { for (int it = F.vcu; it < T / 64; it += NIT) p6_item<true>(F, it); } if (BOTH(6)) GRID_BAR(); }
    int ntiles = 0;
    if (IN(8)) {
        REP(8) {
        ntiles = moe_build_tables(F);
        MoeOrder<1> S; S.init(F, ntiles);
        EpiSwiglu E{F.ws + WS_ACT};
        g8::gemm_phase<EpiSwiglu, MoeOrder<1>, true>(F.lds, DM, S, E);
        }
        if (BOTH(8)) GRID_BAR();
    }
    if (IN(9)) {
        REP(9) {
        if (!IN(8)) ntiles = moe_build_tables(F);
        MoeOrder<2> S; S.init(F, ntiles);
        EpiDown E{F.ws + WS_Y};
        g8::gemm_phase<EpiDown, MoeOrder<2>, true>(F.lds, EH, S, E);
        }
        if (BOTH(9)) GRID_BAR();
    }
    if (IN(10)) { REP(10) { p10_final(F, IN(8)); } }
#undef REP
#undef IN
#undef BOTH
}

extern "C" void kernel_launch(void* const* d_in, const int* in_sizes, int n_in, void* d_out, int out_size, void* d_ws, size_t ws_size, hipStream_t stream) {
    static int grid = 0;
    if (grid == 0) {
        if (n_in != 25 || out_size != T * DM || ws_size < WS_END) { fprintf(stderr, "kernel_launch: unexpected problem (n_in %d, out %d, ws %zu)\n", n_in, out_size, ws_size); grid = -1; return; }
        int dev = 0, cus = 0, per_cu = 0;
        if (hipGetDevice(&dev) != hipSuccess || hipDeviceGetAttribute(&cus, hipDeviceAttributeMultiprocessorCount, dev) != hipSuccess) { grid = -1; return; }
        if (hipFuncSetAttribute((const void*)fwd_kernel, hipFuncAttributeMaxDynamicSharedMemorySize, LDS_BYTES) != hipSuccess) { fprintf(stderr, "kernel_launch: hipFuncSetAttribute failed\n"); grid = -1; return; }
        if (hipOccupancyMaxActiveBlocksPerMultiprocessor(&per_cu, (const void*)fwd_kernel, NWAVES * 64, LDS_BYTES) != hipSuccess || per_cu < 1) { fprintf(stderr, "kernel_launch: occupancy query says %d\n", per_cu); }
        (void)hipGetLastError();
        grid = cus;
    }
    if (grid < 0) return;
    (void)hipMemsetAsync((char*)d_ws + WS_CTL, 0, CTL_ZERO_BYTES, stream);
    Args a{};
    for (int i = 0; i < 25; ++i) a.in[i] = d_in[i];
    a.out = (float*)d_out; a.ws = (unsigned char*)d_ws;
#if N_LAUNCHES == 1
    a.ph_lo = 0; a.ph_hi = 11;
    hipLaunchKernelGGL(fwd_kernel, dim3(grid), dim3(NWAVES * 64), LDS_BYTES, stream, a);
#else
    for (int p = 0; p < 11; ++p) { a.ph_lo = p; a.ph_hi = p + 1; hipLaunchKernelGGL(fwd_kernel, dim3(grid), dim3(NWAVES * 64), LDS_BYTES, stream, a); }
#endif
}
```

```cpp
#include <hip/hip_runtime.h>
#include <cstdio>
#include <cstdint>

#ifndef PROBE_PHASE
#define PROBE_PHASE -1
#endif
#ifndef N_LAUNCHES
#define N_LAUNCHES 1
#endif

#define LAS __attribute__((address_space(3)))
typedef unsigned short bf16;
typedef short bf16x8 __attribute__((ext_vector_type(8)));
typedef float f32x4 __attribute__((ext_vector_type(4)));
typedef float f32x2 __attribute__((ext_vector_type(2)));
typedef unsigned u32x4 __attribute__((ext_vector_type(4)));
typedef unsigned u32x2 __attribute__((ext_vector_type(2)));
typedef int i32x4 __attribute__((ext_vector_type(4)));
typedef int i32x8 __attribute__((ext_vector_type(8)));

constexpr int NB = 8, SEQ = 2048, DM = 2048, T = NB * SEQ;
constexpr int NIN = 6144, RW = 1024, LW = 1024, NE = 64, EH = 512, TOPK = 8;
constexpr int NR_ROUTED = T * TOPK + NE * 256;
constexpr int NR = NR_ROUTED + T;
constexpr int NWAVES = 8;
constexpr float EPS = 1e-6f;
constexpr float SC_H8 = 16.0f, SC_WEI = 64.0f, SC_ACT = 8.0f, SC_WEO = 4.0f, SC_Y = 32.0f;

constexpr size_t MiB = 1u << 20;
constexpr size_t WS_CTL = 0, CTL_ZERO_BYTES = 2 * MiB;
constexpr size_t WS_MOD = 1 * MiB;
constexpr size_t WS_ROPE = 2 * MiB;
constexpr size_t WS_WIN = 10 * MiB;
constexpr size_t WS_WOUT = 34 * MiB;
constexpr size_t WS_WR = 42 * MiB;
constexpr size_t WS_WA = WS_WR + 256 * 1024;
constexpr size_t WS_WX = WS_WA + 256 * 1024;
constexpr size_t WS_WEI = 44 * MiB;
constexpr size_t WS_H8 = 176 * MiB;
constexpr size_t WS_WEO = 304 * MiB;
constexpr size_t WS_H = 434 * MiB;
constexpr size_t WS_X1 = 500 * MiB;
constexpr size_t WS_EIDX = 628 * MiB;
constexpr size_t WS_WSEL = WS_EIDX + 512 * 1024;
constexpr size_t WS_SLOT = WS_WSEL + 512 * 1024;
constexpr size_t WS_DEST = WS_SLOT + 512 * 1024;
constexpr size_t WS_RTOK = WS_DEST + 512 * 1024;
constexpr size_t WS_RW = WS_RTOK + 640 * 1024;
constexpr size_t WS_AGGA = 632 * MiB;
constexpr size_t WS_AGGB = WS_AGGA + 512 * 1024;
constexpr size_t WS_ACT = 634 * MiB;
constexpr size_t WS_PROJ = 794 * MiB;
constexpr size_t WS_RETO = 986 * MiB;
constexpr size_t WS_HLOC = 1050 * MiB;
constexpr size_t WS_PLOC = 1082 * MiB;
constexpr size_t WS_CAT = 1114 * MiB;
constexpr size_t WS_Y = 794 * MiB;
constexpr size_t WS_TOKOF = 1434 * MiB;
constexpr size_t WS_END = 1438 * MiB;
constexpr int CW_BAR = 4096;
constexpr int CW_CNT = 8192;
constexpr int CW_MODCNT = 16384;

constexpr int RING_BYTES = 131072;
constexpr int LDS_BYTES = 147456;
constexpr int TT_OFF = 137216;
constexpr int MISC_OFF = LDS_BYTES - 256;
static_assert(TT_OFF + (2 * 704 + 80 + 68) * 4 <= MISC_OFF, "LDS map");
constexpr int MAXTILES = 704;

__device__ __forceinline__ unsigned pk2(float lo, float hi) { unsigned r; asm volatile("v_cvt_pk_bf16_f32 %0, %1, %2" : "=v"(r) : "v"(lo), "v"(hi)); return r; }
typedef __bf16 bf16x2_t __attribute__((ext_vector_type(2)));
__device__ __forceinline__ unsigned pk2c(float lo, float hi) { const bf16x2_t r = __builtin_convertvector((f32x2){lo, hi}, bf16x2_t); return __builtin_bit_cast(unsigned, r); }
__device__ __forceinline__ bf16 f2bf(float f) { return __builtin_bit_cast(bf16, (__bf16)f); }
__device__ __forceinline__ float bf2f(bf16 b) { return __uint_as_float(((unsigned)b) << 16); }
__device__ __forceinline__ float bflo(unsigned w) { return __uint_as_float(w << 16); }
__device__ __forceinline__ float bfhi(unsigned w) { return __uint_as_float(w & 0xffff0000u); }
__device__ __forceinline__ float wave_sum(float v) {
#pragma unroll
    for (int o = 1; o < 64; o <<= 1) v += __shfl_xor(v, o);
    return v;
}
__device__ __forceinline__ float sigmoidf_(float x) { return __builtin_amdgcn_rcpf(1.0f + __expf(-x)); }
__device__ __forceinline__ float siluf_(float x) { return x * __builtin_amdgcn_rcpf(1.0f + __expf(-x)); }
__device__ __forceinline__ float gelu_tanh_(float x) { const float u = 0.7978845608028654f * (x + 0.044715f * x * x * x); const float e = __expf(2.0f * u); const float th = 1.0f - 2.0f * __builtin_amdgcn_rcpf(e + 1.0f); return 0.5f * x * (1.0f + th); }
__device__ __forceinline__ unsigned ld_agent(const unsigned* p) { return __hip_atomic_load(p, __ATOMIC_RELAXED, __HIP_MEMORY_SCOPE_AGENT); }
__device__ __forceinline__ int ld_agent_i(const int* p) { return (int)__hip_atomic_load((const unsigned*)p, __ATOMIC_RELAXED, __HIP_MEMORY_SCOPE_AGENT); }
__device__ __forceinline__ float clamp448(float x) { return __builtin_amdgcn_fmed3f(x, -448.0f, 448.0f); }
__device__ __forceinline__ unsigned pk4_fp8(float a, float b, float c, float d) { int w = 0; w = __builtin_amdgcn_cvt_pk_fp8_f32(clamp448(a), clamp448(b), w, false); w = __builtin_amdgcn_cvt_pk_fp8_f32(clamp448(c), clamp448(d), w, true); return (unsigned)w; }
#define LDS_WAIT() asm volatile("s_waitcnt lgkmcnt(0)" ::: "memory")
#define VM_WAIT() asm volatile("s_waitcnt vmcnt(0)" ::: "memory")

#define XB_TMO      128
#define XB_XCNT(j)  (256  + 64 * (j))
#define XB_XSUB(j)  (1280 + 64 * (j))
#define XB_XGEN(j)  (2304 + 64 * (j))
#define XB_TOP      3328
#define XB_TOPGEN   3392
#define XCD_BAR_WORDS 3456
#define XB_SPIN_CAP (1u << 18)
__device__ __forceinline__ unsigned xb_ld(unsigned* p)              { return __hip_atomic_load(p, __ATOMIC_RELAXED, __HIP_MEMORY_SCOPE_AGENT); }
__device__ __forceinline__ unsigned xb_add(unsigned* p, unsigned v) { return __hip_atomic_fetch_add(p, v, __ATOMIC_RELAXED, __HIP_MEMORY_SCOPE_AGENT); }
__device__ __forceinline__ unsigned xb_xcc_id() { return (unsigned)__builtin_amdgcn_s_getreg((3 << 11) | 20) & 0xFu; }
#define XB_SPIN(cond, bar) do { unsigned _sp = 0; while (cond) { __builtin_amdgcn_s_sleep(1); \
    if ((++_sp & 255u) == 0u) { if (xb_ld(&(bar)[XB_TMO])) break; if (_sp > XB_SPIN_CAP) { atomicAdd(&(bar)[XB_TMO], 1u); break; } } } } while (0)
struct XcdBarrier { unsigned* bar; unsigned x; volatile LAS unsigned* st; };
__device__ __forceinline__ XcdBarrier xcd_barrier_post(unsigned* bar, volatile LAS unsigned* st) {
    XcdBarrier b; b.bar = bar; b.x = xb_xcc_id(); b.st = st;
    if (threadIdx.x == 0) (void)xb_add(&bar[XB_XCNT(b.x)], 1u);
    return b;
}
__device__ __forceinline__ void xcd_barrier_complete(unsigned* bar, unsigned x, unsigned& nloc, unsigned& nx) {
    const unsigned G = gridDim.x * gridDim.y * gridDim.z;
    unsigned sum, cnt, mine, sp = 0u;
    for (;;) {
        sum = 0u; cnt = 0u; mine = 0u;
#pragma unroll
        for (unsigned j = 0; j < 16; ++j) { const unsigned c = xb_ld(&bar[XB_XCNT(j)]); sum += c; cnt += (c > 0u) ? 1u : 0u; mine = (j == x) ? c : mine; }
        if (sum == G) break;
        __builtin_amdgcn_s_sleep(1);
        if ((++sp & 255u) == 0u) { if (xb_ld(&bar[XB_TMO])) break; if (sp > XB_SPIN_CAP) { atomicAdd(&bar[XB_TMO], 1u); break; } }
    }
    nloc = mine > 0u ? mine : 1u; nx = cnt > 0u ? cnt : 1u;
}
__device__ __forceinline__ void xcd_barrier(const XcdBarrier& b) {
    asm volatile("s_waitcnt vmcnt(0)" ::: "memory");
    __syncthreads();
    if (threadIdx.x == 0) {
        unsigned* bar = b.bar;
        __builtin_amdgcn_s_waitcnt(0);
        unsigned nloc = b.st[0], nx = b.st[1];
        if (nloc == 0u) { xcd_barrier_complete(bar, b.x, nloc, nx); b.st[0] = nloc; b.st[1] = nx; }
        const unsigned old = xb_add(&bar[XB_XSUB(b.x)], 1u);
        const unsigned gen = old / nloc;
        if (old + 1u == (gen + 1u) * nloc) {
            __builtin_amdgcn_fence(__ATOMIC_RELEASE, "agent");
            asm volatile("s_waitcnt vmcnt(0)" ::: "memory");
            const unsigned og = xb_add(&bar[XB_TOP], 1u);
            const unsigned tg = og / nx;
            if (og + 1u == (tg + 1u) * nx) xb_add(&bar[XB_TOPGEN], 1u);
            else XB_SPIN(xb_ld(&bar[XB_TOPGEN]) == tg, bar);
            __builtin_amdgcn_fence(__ATOMIC_ACQUIRE, "agent");
            xb_add(&bar[XB_XGEN(b.x)], 1u);
            asm volatile("s_waitcnt vmcnt(0)" ::: "memory");
        } else {
            XB_SPIN(xb_ld(&bar[XB_XGEN(b.x)]) == gen, bar);
            __builtin_amdgcn_fence(__ATOMIC_ACQUIRE, "agent");
            asm volatile("s_waitcnt vmcnt(0)" ::: "memory");
        }
    }
    __syncthreads();
}

namespace g8 {
constexpr int BM = 256, BK = 64, HALF = 128, HTB = HALF * BK * 2, NXCD = 8, WGM = 8;
__device__ __forceinline__ int lds_byte(int r, int c) { const int st = (r >> 4) * 2 + (c >> 5), rr = r & 15, cc = c & 31, ob = rr * 64 + cc * 2; return st * 1024 + (ob ^ (((ob >> 9) & 1) << 5)); }
__device__ __forceinline__ void stage_rc(int b, int& R, int& C) { const int st = b / 1024, sb = b % 1024, swz = sb ^ (((sb >> 9) & 1) << 5); R = (st >> 1) * 16 + swz / 64; C = (st & 1) * 32 + (swz % 64) / 2; }
__device__ __forceinline__ int perm32(int rho) { const int n = rho >> 4, i = rho & 15; return 8 * (i >> 2) + 4 * n + (i & 3); }

struct Unit { const char* A; const char* B; unsigned vA0[2], vA1[2]; int r0, pn, e, rend; };

template <class Epi, class Sched, bool F8 = false>
__device__ __forceinline__ void gemm_phase(LAS unsigned char* lds, const int pitch, const Sched& S, const Epi& E) {
    const int tid = threadIdx.x, wid = __builtin_amdgcn_readfirstlane(tid >> 6), lane = tid & 63, wr = wid >> 2, wc = wid & 3, fr = lane & 15, fq = lane >> 4;
    const int nt = pitch / 128;
    unsigned voffB[2], voffB1[2];
#pragma unroll
    for (int i = 0; i < 2; ++i) { int R, C; stage_rc(tid * 16 + i * 8192, R, C); const int p = perm32(R & 31);
        if constexpr (Epi::P16) { const int base = 64 * (R >> 5) + 16 * (p >> 3) + (p & 7); voffB[i] = (unsigned)(base * pitch + C * 2); voffB1[i] = (unsigned)((base + 8) * pitch + C * 2); }
        else { const int Rb = Epi::PERM ? ((R & ~31) + p) : R; voffB[i] = (unsigned)(Rb * pitch + C * 2); voffB1[i] = voffB[i] + (unsigned)(HALF * pitch); } }
    const size_t kstep = 128;
    const size_t hstepB = (size_t)HALF * pitch;
    const unsigned ldsw = (unsigned)wid * 1024u;
    const int aoff = lds_byte(wr * 64 + fr, fq * 8), boff = lds_byte(wc * 32 + fr, fq * 8);
#define G8_SA(b, h) (((b) * 2 + (h)) * HTB)
#define G8_SB(b, h) ((4 + (b) * 2 + (h)) * HTB)
#define G8_STAGE(bufoff, gbase, voff) do { _Pragma("unroll") for (int _i = 0; _i < 2; ++_i) \
        __builtin_amdgcn_global_load_lds((const unsigned*)((const char*)(gbase) + (voff)[_i]), (LAS unsigned*)(lds + (bufoff) + ldsw + _i * 8192), 16, 0, 0); } while (0)
#define G8_LDA(dst, b, h) do { _Pragma("unroll") for (int m = 0; m < 4; ++m) _Pragma("unroll") for (int k = 0; k < 2; ++k) dst[m][k] = *(const LAS bf16x8*)(lds + G8_SA(b, h) + aoff + m * 2048 + k * 1024); } while (0)
#define G8_LDB(dst, b, h) do { _Pragma("unroll") for (int n = 0; n < 2; ++n) _Pragma("unroll") for (int k = 0; k < 2; ++k) dst[n][k] = *(const LAS bf16x8*)(lds + G8_SB(b, h) + boff + n * 2048 + k * 1024); } while (0)
#define G8_CAT(x) __builtin_shufflevector(__builtin_bit_cast(i32x4, x[0]), __builtin_bit_cast(i32x4, x[1]), 0, 1, 2, 3, 4, 5, 6, 7)
#define G8_MMA(ai, bj, At, Bt) do { __builtin_amdgcn_s_setprio(1); _Pragma("unroll") for (int m = 0; m < 4; ++m) _Pragma("unroll") for (int n = 0; n < 2; ++n) { \
        if constexpr (F8) acc[ai][bj][m][n] = __builtin_amdgcn_mfma_scale_f32_16x16x128_f8f6f4(G8_CAT(Bt[n]), G8_CAT(At[m]), acc[ai][bj][m][n], 0, 0, 0, 0x7f7f7f7f, 0, 0x7f7f7f7f); \
        else { _Pragma("unroll") for (int k = 0; k < 2; ++k) acc[ai][bj][m][n] = __builtin_amdgcn_mfma_f32_16x16x32_bf16(Bt[n][k], At[m][k], acc[ai][bj][m][n], 0, 0, 0); } } \
        __builtin_amdgcn_s_setprio(0); } while (0)
#define G8_WAIT_V(n) asm volatile("s_waitcnt vmcnt(" #n ")" ::: "memory")
#define G8_WAIT_L(n) asm volatile("s_waitcnt lgkmcnt(" #n ")" ::: "memory")
#define G8_BAR __builtin_amdgcn_s_barrier()
#define G8_SCHED __builtin_amdgcn_sched_barrier(0)
    Unit cur, nxt; int ui = 0;
    if (!S.next(0, cur)) return;
    f32x4 acc[2][2][4][2];
#pragma unroll
    for (int a = 0; a < 2; ++a)
#pragma unroll
        for (int b = 0; b < 2; ++b)
#pragma unroll
            for (int m = 0; m < 4; ++m)
#pragma unroll
                for (int n = 0; n < 2; ++n) acc[a][b][m][n] = (f32x4){0.f, 0.f, 0.f, 0.f};
    bf16x8 At[4][2], B0[2][2], B1[2][2];
    const char* cA = cur.A; const char* cB = cur.B;
    G8_STAGE(G8_SB(0, 0), cB, voffB); G8_STAGE(G8_SB(0, 1), cB, voffB1); G8_STAGE(G8_SA(0, 0), cA, cur.vA0); G8_STAGE(G8_SA(0, 1), cA, cur.vA1);
    if (wr == 1) G8_BAR;
    G8_WAIT_V(2); G8_BAR;
    G8_STAGE(G8_SB(1, 0), cB + kstep, voffB); G8_STAGE(G8_SA(1, 0), cA + kstep, cur.vA0); G8_STAGE(G8_SB(1, 1), cB + kstep, voffB1);
    G8_WAIT_V(6); G8_BAR;
    for (;;) {
        const bool has_next = S.next(ui + 1, nxt);
        if (!has_next) nxt = cur;
        const char* nA = nxt.A; const char* nB = nxt.B;
#pragma unroll 1
        for (int t = 0; t < nt; t += 2) {
            const bool last = (t == nt - 2);
            const char* a1 = cA + (size_t)(t + 1) * kstep;
            const char* a2 = last ? nA : cA + (size_t)(t + 2) * kstep; const char* b2 = last ? nB : cB + (size_t)(t + 2) * kstep;
            const char* a3 = a2 + kstep; const char* b3 = b2 + kstep;
            G8_LDB(B0, 0, 0); G8_LDB(B1, 0, 1); G8_SCHED; G8_LDA(At, 0, 0); G8_STAGE(G8_SA(1, 1), a1, cur.vA1);
            if (last) { cur.vA0[0] = nxt.vA0[0]; cur.vA0[1] = nxt.vA0[1]; cur.vA1[0] = nxt.vA1[0]; cur.vA1[1] = nxt.vA1[1]; }
            G8_WAIT_V(8); G8_WAIT_L(0); G8_BAR; G8_MMA(0, 0, At, B0); G8_MMA(0, 1, At, B1); G8_BAR; G8_SCHED;
            G8_LDA(At, 0, 1); G8_STAGE(G8_SB(0, 0), b2, voffB); G8_STAGE(G8_SB(0, 1), b2, voffB1); G8_STAGE(G8_SA(0, 0), a2, cur.vA0);
            G8_WAIT_V(8); G8_WAIT_L(0); G8_BAR; G8_MMA(1, 0, At, B0); G8_MMA(1, 1, At, B1); G8_BAR; G8_SCHED;
            G8_LDB(B0, 1, 0); G8_LDB(B1, 1, 1); G8_SCHED; G8_LDA(At, 1, 0); G8_STAGE(G8_SA(0, 1), a2, cur.vA1);
            G8_WAIT_V(8); G8_WAIT_L(0); G8_BAR; G8_MMA(0, 0, At, B0); G8_MMA(0, 1, At, B1); G8_BAR; G8_SCHED;
            G8_LDA(At, 1, 1); G8_STAGE(G8_SB(1, 0), b3, voffB); G8_STAGE(G8_SB(1, 1), b3, voffB1); G8_STAGE(G8_SA(1, 0), a3, cur.vA0);
            G8_WAIT_V(8); G8_WAIT_L(0); G8_BAR; G8_MMA(1, 0, At, B0); G8_MMA(1, 1, At, B1); G8_BAR; G8_SCHED;
        }
        if (wr == 0) G8_BAR;
        E(acc, cur, wr, wc, fr, fq);
        if (!has_next) break;
#pragma unroll
        for (int a = 0; a < 2; ++a)
#pragma unroll
            for (int b = 0; b < 2; ++b)
#pragma unroll
                for (int m = 0; m < 4; ++m)
#pragma unroll
                    for (int n = 0; n < 2; ++n) acc[a][b][m][n] = (f32x4){0.f, 0.f, 0.f, 0.f};
        cur = nxt; cA = nA; cB = nB; ++ui;
        if (wr == 1) G8_BAR;
    }
    G8_WAIT_V(0);
    G8_BAR;
#undef G8_SA
#undef G8_SB
#undef G8_STAGE
#undef G8_LDA
#undef G8_CAT
#undef G8_LDB
#undef G8_MMA
#undef G8_WAIT_V
#undef G8_WAIT_L
#undef G8_BAR
#undef G8_SCHED
}

struct DenseOrder {
    const char* A; const char* Bt; int pitch; int nM, nN, nwg, G, c;
    __device__ void init(const void* A_, const void* Bt_, int M, int N, int pitch_, int G_, int c_) { A = (const char*)A_; Bt = (const char*)Bt_; pitch = pitch_; nM = M / BM; nN = N / BM; nwg = nM * nN; G = G_; c = c_; }
    __device__ __forceinline__ bool next(int i, Unit& u) const {
        const long L = (long)i * G + c; if (L >= nwg) return false;
        int R[2], C[2]; stage_rc((int)threadIdx.x * 16, R[0], C[0]); stage_rc((int)threadIdx.x * 16 + 8192, R[1], C[1]);
        int wgid = (int)L; { const int q = nwg / NXCD, r = nwg % NXCD, xcd = wgid % NXCD, off = wgid / NXCD; wgid = (xcd < r ? xcd * (q + 1) : r * (q + 1) + (xcd - r) * q) + off; }
        const int nig = WGM * nN, gid = wgid / nig, fm = gid * WGM, gsz = (nM - fm) < WGM ? (nM - fm) : WGM;
        const int pm = fm + ((wgid % nig) % gsz), pn = (wgid % nig) / gsz;
        u.A = A + (size_t)pm * BM * pitch; u.B = Bt + (size_t)pn * BM * pitch;
#pragma unroll
        for (int j = 0; j < 2; ++j) { u.vA0[j] = (unsigned)(R[j] * pitch + C[j] * 2); u.vA1[j] = (unsigned)((R[j] + HALF) * pitch + C[j] * 2); }
        u.r0 = pm * BM; u.pn = pn; u.e = 0; u.rend = 0; return true;
    }
};
}

struct Args { const void* in[25]; float* out; unsigned char* ws; int ph_lo, ph_hi; };
struct Ctx {
    LAS unsigned char* lds; unsigned char* ws; const void* const* in; float* out;
    int tid, lane, wave, vcu, G;
};

__device__ __forceinline__ void p0_adaln(Ctx& F) {
    LAS float* sc = (LAS float*)F.lds;
    LAS float* red = (LAS float*)(F.lds + 65536);
    const float* cvec = (const float*)F.in[1]; const float* wada = (const float*)F.in[3]; const float* bada = (const float*)F.in[4]; float* mod = (float*)(F.ws + WS_MOD);
    __syncthreads();
    for (int i = F.tid; i < NB * DM; i += NWAVES * 64) sc[i] = siluf_(cvec[i]);
    __syncthreads();
    for (int cb = F.vcu; cb < 6 * DM / 48; cb += F.G) {
        const int n0 = cb * 48, l = F.lane < 48 ? F.lane : 47, k0 = F.wave * 256;
        float acc[8];
#pragma unroll
        for (int b = 0; b < 8; ++b) acc[b] = 0.f;
        const float* col = wada + (size_t)k0 * (6 * DM) + n0 + l;
#pragma unroll 1
        for (int kk = 0; kk < 256; kk += 32) { float wv[32];
#pragma unroll
            for (int u = 0; u < 32; ++u) wv[u] = col[(size_t)(kk + u) * (6 * DM)];
#pragma unroll
            for (int u = 0; u < 32; ++u)
#pragma unroll
                for (int b = 0; b < 8; ++b) acc[b] += sc[b * DM + k0 + kk + u] * wv[u]; }
        if (F.lane < 48) {
#pragma unroll
            for (int b = 0; b < 8; ++b) red[(F.wave * 8 + b) * 48 + F.lane] = acc[b]; }
        __syncthreads();
        if (F.tid < 384) { const int b = F.tid / 48, cc = F.tid % 48; float s = bada[n0 + cc];
#pragma unroll
            for (int w = 0; w < 8; ++w) s += red[(w * 8 + b) * 48 + cc];
            __hip_atomic_store(mod + (size_t)b * 6 * DM + n0 + cc, s, __ATOMIC_RELAXED, __HIP_MEMORY_SCOPE_AGENT); }
        VM_WAIT();
        __syncthreads();
    }
    if (F.tid == 0) __hip_atomic_fetch_add((unsigned*)(F.ws + WS_CTL) + CW_MODCNT, 1u, __ATOMIC_RELAXED, __HIP_MEMORY_SCOPE_AGENT);
}
__device__ __forceinline__ void p0_wait_mod(Ctx& F) {
    if (F.tid == 0) { unsigned* ctl = (unsigned*)(F.ws + WS_CTL); unsigned sp = 0u;
        while (ld_agent(ctl + CW_MODCNT) < (unsigned)F.G) { __builtin_amdgcn_s_sleep(2); if (++sp > (1u << 20)) { atomicAdd(ctl + CW_BAR + XB_TMO, 1u); break; } }
        __builtin_amdgcn_fence(__ATOMIC_ACQUIRE, "agent");
        asm volatile("s_waitcnt vmcnt(0)" ::: "memory"); }
    __syncthreads();
}
template <bool F8>
__device__ __forceinline__ void p0_transpose_item(const float* W, int K, int N, void* WT, int out_row0, int k0, int n0, float scale, LAS float* scr, int lane) {
    f32x4 v[16];
#pragma unroll
    for (int i = 0; i < 16; ++i) v[i] = *(const f32x4*)(W + (size_t)(k0 + 4 * i + (lane >> 4)) * N + n0 + 4 * (lane & 15));
#pragma unroll
    for (int i = 0; i < 16; ++i) { LAS float* d = scr + (4 * i + (lane >> 4)) * 65 + 4 * (lane & 15); d[0] = v[i].x; d[1] = v[i].y; d[2] = v[i].z; d[3] = v[i].w; }
    LDS_WAIT(); asm volatile("" ::: "memory");
    if (!F8) {
        const int c = lane & 7;
#pragma unroll
        for (int j = 0; j < 8; ++j) { const int n = (lane >> 3) + 8 * j; const LAS float* s = scr + (8 * c) * 65 + n;
            u32x4 o; o.x = pk2(s[0 * 65], s[1 * 65]); o.y = pk2(s[2 * 65], s[3 * 65]); o.z = pk2(s[4 * 65], s[5 * 65]); o.w = pk2(s[6 * 65], s[7 * 65]);
            *(u32x4*)((bf16*)WT + (size_t)(out_row0 + n) * K + k0 + 8 * c) = o; }
    } else {
        const int c = lane & 3;
#pragma unroll
        for (int j = 0; j < 4; ++j) { const int n = (lane >> 2) + 16 * j; const LAS float* s = scr + (16 * c) * 65 + n; int o[4];
#pragma unroll
            for (int q = 0; q < 4; ++q) { int wv = 0; wv = __builtin_amdgcn_cvt_pk_fp8_f32(s[(4 * q) * 65] * scale, s[(4 * q + 1) * 65] * scale, wv, false); wv = __builtin_amdgcn_cvt_pk_fp8_f32(s[(4 * q + 2) * 65] * scale, s[(4 * q + 3) * 65] * scale, wv, true); o[q] = wv; }
            *(u32x4*)((unsigned char*)WT + (size_t)(out_row0 + n) * K + k0 + 16 * c) = (u32x4){(unsigned)o[0], (unsigned)o[1], (unsigned)o[2], (unsigned)o[3]}; }
    }
    LDS_WAIT(); asm volatile("" ::: "memory");
}
struct CvItem { const float* src; unsigned char* dst; int N, K; float scale; };
__device__ __forceinline__ CvItem cv_decode(const void* const* in, unsigned char* ws, int r) {
    constexpr int I_EI = 32 * 16, I_EO = 8 * 32; CvItem c;
    if (r < 65 * I_EI) { const int e = r / I_EI, q = r % I_EI, kb = q / 16, nb = q % 16, n0 = 64 * nb, j = n0 & 511, up = n0 >> 9;
        const float* W = (e < 64) ? (const float*)in[20] + (size_t)e * DM * 1024 : (const float*)in[22];
        c.src = W + (size_t)(64 * kb) * 1024 + n0; c.N = 1024; c.K = DM; c.scale = SC_WEI;
        c.dst = ws + WS_WEI + (size_t)e * 1024 * DM + (size_t)((j >> 7) * 256 + up * 128 + (j & 127)) * DM + 64 * kb; }
    else { r -= 65 * I_EI; const int e = r / I_EO, q = r % I_EO, kb = q / 32, nb = q % 32;
        const float* W = (e < 64) ? (const float*)in[21] + (size_t)e * EH * DM : (const float*)in[23];
        c.src = W + (size_t)(64 * kb) * DM + 64 * nb; c.N = DM; c.K = EH; c.scale = SC_WEO;
        c.dst = ws + WS_WEO + (size_t)e * DM * EH + (size_t)(64 * nb) * EH + 64 * kb; }
    return c;
}
__device__ __forceinline__ void p2_convert_experts(Ctx& F) {
    const int gw = F.vcu * NWAVES + F.wave, NGW = F.G * NWAVES, lane = F.lane, li = lane & 15, lg = lane >> 4;
    constexpr int NCV = 65 * (32 * 16 + 8 * 32);
    int it = gw; CvItem cur; f32x4 v[16];
    const int krow = 16 * (li >> 2) + (li & 3);
#define CV_LOAD(c) do { _Pragma("unroll") for (int nh = 0; nh < 2; ++nh) _Pragma("unroll") for (int q = 0; q < 4; ++q) { const float* p_ = (c).src + (size_t)(krow + 4 * q) * (c).N + 32 * nh + 8 * lg; \
        v[(nh * 4 + q) * 2] = *(const f32x4*)p_; v[(nh * 4 + q) * 2 + 1] = *(const f32x4*)(p_ + 4); } } while (0)
    if (it < NCV) { cur = cv_decode(F.in, F.ws, it); CV_LOAD(cur); }
    while (it < NCV) {
        bf16x8 a[2][4];
#pragma unroll
        for (int nh = 0; nh < 2; ++nh)
#pragma unroll
            for (int q = 0; q < 4; ++q) { const f32x4 lo = v[(nh * 4 + q) * 2], hi = v[(nh * 4 + q) * 2 + 1];
                const u32x4 pk = (u32x4){pk2c(lo.x, lo.y), pk2c(lo.z, lo.w), pk2c(hi.x, hi.y), pk2c(hi.z, hi.w)}; a[nh][q] = __builtin_bit_cast(bf16x8, pk); }
        const CvItem me = cur; const int nit = it + NGW;
        if (nit < NCV) { cur = cv_decode(F.in, F.ws, nit); CV_LOAD(cur); }
        const unsigned sbits = (unsigned)f2bf(me.scale);
#pragma unroll
        for (int h = 0; h < 2; ++h) {
            u32x4 sel = (u32x4){0u, 0u, 0u, 0u}; { const int d = 16 * h + li - 8 * lg; if (d >= 0 && d < 8) { const unsigned wv = (d & 1) ? (sbits << 16) : sbits; if ((d >> 1) == 0) sel.x = wv; else if ((d >> 1) == 1) sel.y = wv; else if ((d >> 1) == 2) sel.z = wv; else sel.w = wv; } }
            const bf16x8 bs = __builtin_bit_cast(bf16x8, sel);
#pragma unroll
            for (int nh = 0; nh < 2; ++nh) { unsigned o[4];
#pragma unroll
                for (int q = 0; q < 4; ++q) { const f32x4 d = __builtin_amdgcn_mfma_f32_16x16x32_bf16(a[nh][q], bs, (f32x4){0.f, 0.f, 0.f, 0.f}, 0, 0, 0); o[q] = pk4_fp8(d[0], d[1], d[2], d[3]); }
                *(u32x4*)(me.dst + (size_t)(32 * nh + 16 * h + li) * me.K + 16 * lg) = (u32x4){o[0], o[1], o[2], o[3]}; }
        }
        it = nit;
    }
#undef CV_LOAD
}
__device__ __forceinline__ void p0_prologue(Ctx& F) {
    LAS float* scr = (LAS float*)(F.lds + F.wave * 16640);
    const int gw = F.vcu * NWAVES + F.wave, NGW = F.G * NWAVES, lane = F.lane;
    unsigned char* ws = F.ws;
    constexpr int I_IN = 32 * 96, I_OUT = 32 * 32, I_R = 32 * 1, I_G = 2 * 2;
    constexpr int NTR = I_IN + I_OUT + I_R + 16 * I_G;
    for (int it = gw; it < NTR; it += NGW) {
        int r = it;
        if (r < I_IN) { const int kb = r / 96, nb = r % 96; p0_transpose_item<false>((const float*)F.in[6], DM, NIN, ws + WS_WIN, 64 * nb, 64 * kb, 64 * nb, 1.f, scr, lane); continue; } r -= I_IN;
        if (r < I_OUT) { const int kb = r / 32, nb = r % 32; p0_transpose_item<false>((const float*)F.in[16], DM, DM, ws + WS_WOUT, 64 * nb, 64 * kb, 64 * nb, 1.f, scr, lane); continue; } r -= I_OUT;
        if (r < I_R) { const int kb = r; p0_transpose_item<false>((const float*)F.in[18], DM, NE, ws + WS_WR, 0, 64 * kb, 0, 1.f, scr, lane); continue; } r -= I_R;
        { const int m = r / I_G, q = r % I_G, kb = q / 2, nb = q % 2, g = m & 7;
          const float* W = ((m < 8) ? (const float*)F.in[9] : (const float*)F.in[11]) + (size_t)g * 128 * 128;
          p0_transpose_item<false>(W, 128, 128, (bf16*)(ws + (m < 8 ? WS_WA : WS_WX)) + (size_t)g * 128 * 128, 64 * nb, 64 * kb, 64 * nb, 1.f, scr, lane); }
    }
    {
        const int* pos = (const int*)F.in[2]; unsigned* rt = (unsigned*)(ws + WS_ROPE);
        for (int it = gw; it < T * 64 / 512; it += NGW) {
#pragma unroll 1
            for (int q = 0; q < 8; ++q) { const int idx = it * 512 + q * 64 + lane, t = idx >> 6, i = idx & 63;
                const double inv = exp(-9.210340371976184 * (double)i / 64.0); const double ang = (double)pos[t] * inv; double sn, cs; sincos(ang, &sn, &cs);
                rt[idx] = pk2c((float)cs, (float)sn); }
        }
    }
    if (gw == 0) { u32x4* z = (u32x4*)((bf16*)(ws + WS_H) + (size_t)T * DM); for (int i = lane; i < DM * 2 / 16; i += 64) z[i] = (u32x4){0u, 0u, 0u, 0u};
        u32x4* z8 = (u32x4*)(ws + WS_H8 + (size_t)T * DM); for (int i = lane; i < DM / 16; i += 64) z8[i] = (u32x4){0u, 0u, 0u, 0u}; }
}

template <bool W8, bool INBF>
__device__ __forceinline__ void norm_mod_row(const void* xrow_, const float* g, const float* sc, const float* sh, bf16* orow, unsigned char* orow8, int lane) {
    f32x4 v[4][2]; float ss = 0.f;
#pragma unroll
    for (int j = 0; j < 4; ++j) {
        if constexpr (INBF) { const u32x4 w = *(const u32x4*)((const bf16*)xrow_ + 8 * lane + 512 * j); v[j][0] = (f32x4){bflo(w.x), bfhi(w.x), bflo(w.y), bfhi(w.y)}; v[j][1] = (f32x4){bflo(w.z), bfhi(w.z), bflo(w.w), bfhi(w.w)}; }
        else { v[j][0] = *(const f32x4*)((const float*)xrow_ + 8 * lane + 512 * j); v[j][1] = *(const f32x4*)((const float*)xrow_ + 8 * lane + 512 * j + 4); }
#pragma unroll
        for (int h = 0; h < 2; ++h) ss += (v[j][h].x * v[j][h].x + v[j][h].y * v[j][h].y) + (v[j][h].z * v[j][h].z + v[j][h].w * v[j][h].w); }
    const float rstd = rsqrtf(wave_sum(ss) * (1.0f / DM) + EPS);
#pragma unroll
    for (int j = 0; j < 4; ++j) { f32x4 o[2];
#pragma unroll
        for (int h = 0; h < 2; ++h) { const int c = 8 * lane + 512 * j + 4 * h; const f32x4 gg = *(const f32x4*)(g + c), s1 = *(const f32x4*)(sc + c), s0 = *(const f32x4*)(sh + c);
            o[h] = (v[j][h] * rstd * gg) * (s1 + 1.0f) + s0; }
        u32x4 w; w.x = pk2(o[0].x, o[0].y); w.y = pk2(o[0].z, o[0].w); w.z = pk2(o[1].x, o[1].y); w.w = pk2(o[1].z, o[1].w);
        *(u32x4*)(orow + 8 * lane + 512 * j) = w;
        if constexpr (W8) { u32x2 w8; w8.x = pk4_fp8(o[0].x * SC_H8, o[0].y * SC_H8, o[0].z * SC_H8, o[0].w * SC_H8); w8.y = pk4_fp8(o[1].x * SC_H8, o[1].y * SC_H8, o[1].z * SC_H8, o[1].w * SC_H8); *(u32x2*)(orow8 + 8 * lane + 512 * j) = w8; } }
}
__device__ __forceinline__ void p1_norm(Ctx& F) {
    const int gw = F.vcu * NWAVES + F.wave, NGW = F.G * NWAVES;
    const float* x = (const float*)F.in[0]; const float* g = (const float*)F.in[5]; const float* mod = (const float*)(F.ws + WS_MOD); bf16* h = (bf16*)(F.ws + WS_H);
    for (int m = gw; m < T; m += NGW) { const int b = m / SEQ; norm_mod_row<false, false>(x + (size_t)m * DM, g, mod + (size_t)b * 6 * DM + DM, mod + (size_t)b * 6 * DM, h + (size_t)m * DM, nullptr, F.lane); }
}

struct EpiProj {
    static constexpr bool PERM = true, P16 = false;
    bf16* O;
    __device__ __forceinline__ void operator()(const f32x4 (&acc)[2][2][4][2], const g8::Unit& u, int wr, int wc, int fr, int fq) const {
        const int row0 = u.r0 + wr * 64 + fr, col0 = u.pn * 256 + wc * 32 + 8 * fq;
#pragma unroll
        for (int ai = 0; ai < 2; ++ai)
#pragma unroll
            for (int m = 0; m < 4; ++m) { bf16* rowp = O + (size_t)(row0 + ai * 128 + m * 16) * NIN + col0;
#pragma unroll
                for (int bj = 0; bj < 2; ++bj) { const f32x4 v0 = acc[ai][bj][m][0], v1 = acc[ai][bj][m][1];
                    u32x4 w; w.x = pk2c(v0[0], v0[1]); w.y = pk2c(v0[2], v0[3]); w.z = pk2c(v1[0], v1[1]); w.w = pk2c(v1[2], v1[3]);
                    *(u32x4*)(rowp + bj * 128) = w; } }
    }
};
struct EpiWout {
    static constexpr bool PERM = true, P16 = false;
    const float* x; const float* mod; bf16* x1;
    __device__ __forceinline__ void operator()(const f32x4 (&acc)[2][2][4][2], const g8::Unit& u, int wr, int wc, int fr, int fq) const {
        const int row0 = u.r0 + wr * 64 + fr, col0 = u.pn * 256 + wc * 32 + 8 * fq; const int b = u.r0 / SEQ;
        const float* gt = mod + (size_t)b * 6 * DM + 2 * DM;
        f32x4 gv[2][2];
#pragma unroll
        for (int bj = 0; bj < 2; ++bj)
#pragma unroll
            for (int n = 0; n < 2; ++n) gv[bj][n] = *(const f32x4*)(gt + col0 + bj * 128 + n * 4);
#pragma unroll
        for (int ai = 0; ai < 2; ++ai)
#pragma unroll
            for (int m = 0; m < 4; ++m) { const size_t off = (size_t)(row0 + ai * 128 + m * 16) * DM + col0;
#pragma unroll
                for (int bj = 0; bj < 2; ++bj) { const f32x4 v0 = *(const f32x4*)(x + off + bj * 128) + gv[bj][0] * acc[ai][bj][m][0], v1 = *(const f32x4*)(x + off + bj * 128 + 4) + gv[bj][1] * acc[ai][bj][m][1];
                    u32x4 w; w.x = pk2(v0[0], v0[1]); w.y = pk2(v0[2], v0[3]); w.z = pk2(v1[0], v1[1]); w.w = pk2(v1[2], v1[3]);
                    *(u32x4*)(x1 + off + bj * 128) = w; }
                asm volatile("" ::: "memory"); }
    }
};
struct EpiSwiglu {
    static constexpr bool PERM = true, P16 = false;
    unsigned char* act;
    __device__ __forceinline__ void operator()(const f32x4 (&acc)[2][2][4][2], const g8::Unit& u, int wr, int wc, int fr, int fq) const {
        const int row0 = u.r0 + wr * 64 + fr, col0 = u.pn * 128 + wc * 32 + 8 * fq;
#pragma unroll
        for (int ai = 0; ai < 2; ++ai)
#pragma unroll
            for (int m = 0; m < 4; ++m) { float o[8];
#pragma unroll
                for (int n = 0; n < 2; ++n)
#pragma unroll
                    for (int j = 0; j < 4; ++j) { const float g = acc[ai][0][m][n][j] * (1.0f / (SC_H8 * SC_WEI)), up = acc[ai][1][m][n][j] * (SC_ACT / (SC_H8 * SC_WEI)); o[4 * n + j] = g * __builtin_amdgcn_rcpf(1.0f + __expf(-g)) * up; }
                u32x2 w; w.x = pk4_fp8(o[0], o[1], o[2], o[3]); w.y = pk4_fp8(o[4], o[5], o[6], o[7]);
                *(u32x2*)(act + (size_t)(row0 + ai * 128 + m * 16) * EH + col0) = w; }
    }
};
struct EpiDown {
    static constexpr bool PERM = true, P16 = true;
    unsigned char* y;
    __device__ __forceinline__ void operator()(const f32x4 (&acc)[2][2][4][2], const g8::Unit& u, int wr, int wc, int fr, int fq) const {
        const int row0 = u.r0 + wr * 64 + fr, col0 = u.pn * 256 + wc * 64 + 16 * fq; constexpr float sc = SC_Y / (SC_ACT * SC_WEO); static_assert(sc == 1.0f, "scales chosen so that y needs no multiply");
#pragma unroll
        for (int ai = 0; ai < 2; ++ai)
#pragma unroll
            for (int m = 0; m < 4; ++m) { u32x4 w;
                { const f32x4 v0 = acc[ai][0][m][0], v1 = acc[ai][0][m][1], v2 = acc[ai][1][m][0], v3 = acc[ai][1][m][1];
                  w.x = pk4_fp8(v0[0], v0[1], v0[2], v0[3]); w.y = pk4_fp8(v1[0], v1[1], v1[2], v1[3]); w.z = pk4_fp8(v2[0], v2[1], v2[2], v2[3]); w.w = pk4_fp8(v3[0], v3[1], v3[2], v3[3]); }
                *(u32x4*)(y + (size_t)(row0 + ai * 128 + m * 16) * DM + col0) = w; }
    }
};

struct MoeTables { LAS int* row0; LAS int* te; LAS int* pend; LAS int* tp; };
__device__ __forceinline__ MoeTables moe_tables(Ctx& F) { MoeTables M; M.row0 = (LAS int*)(F.lds + TT_OFF); M.te = M.row0 + MAXTILES; M.pend = M.te + MAXTILES; M.tp = M.pend + 80; return M; }
__device__ __forceinline__ int moe_build_tables(Ctx& F) {
    MoeTables M = moe_tables(F);
    const unsigned* cnt = (const unsigned*)(F.ws + WS_CTL) + CW_CNT;
    __syncthreads();
    if (F.tid < NE) M.row0[F.tid] = (int)ld_agent(cnt + 32 * F.tid);
    __syncthreads();
    if (F.tid == 0) { int tiles = 0;
        for (int e = 0; e < NE; ++e) { const int c = M.row0[e]; M.tp[e] = tiles; M.pend[e] = tiles * 256 + c; tiles += (c + 255) >> 8; }
        M.tp[NE] = NR_ROUTED / 256; M.pend[NE] = NR; M.tp[NE + 1] = NR_ROUTED / 256 + T / 256; M.tp[NE + 2] = tiles; }
    __syncthreads();
    const int rt = M.tp[NE + 2];
    for (int tau = F.tid; tau < rt; tau += NWAVES * 64) { int e = 0; while (e + 1 < NE && M.tp[e + 1] <= tau) ++e; M.te[tau] = e; M.row0[tau] = tau * 256; }
    for (int s = F.tid; s < T / 256; s += NWAVES * 64) { M.te[rt + s] = NE; M.row0[rt + s] = NR_ROUTED + s * 256; }
    __syncthreads();
    return rt + T / 256;
}
template <int PHASE>
struct MoeOrder {
    MoeTables M; const char* A; const char* W; const int* row_tok; int U, CH, x, j;
    static constexpr int NPN = (PHASE == 1) ? 4 : 8;
    __device__ void init(Ctx& F, int ntiles) { M = moe_tables(F); U = ntiles * NPN; CH = (U + 7) / 8; x = F.vcu / (F.G / 8); j = F.vcu % (F.G / 8);
        A = (const char*)(F.ws + (PHASE == 1 ? WS_H8 : WS_ACT)); W = (const char*)(F.ws + (PHASE == 1 ? WS_WEI : WS_WEO)); row_tok = (const int*)(F.ws + WS_TOKOF); }
    __device__ __forceinline__ bool next(int i, g8::Unit& u) const {
        const int q = i * 32 + j; const int L = x * CH + q; if (q >= CH || L >= U) return false;
        int R[2], C[2]; g8::stage_rc((int)threadIdx.x * 16, R[0], C[0]); g8::stage_rc((int)threadIdx.x * 16 + 8192, R[1], C[1]);
        const int tile = L / NPN, pn = L % NPN;
        const int e = __builtin_amdgcn_readfirstlane(M.te[tile]), r0 = __builtin_amdgcn_readfirstlane(M.row0[tile]), rend = __builtin_amdgcn_readfirstlane(M.pend[e]);
        u.r0 = r0; u.pn = pn; u.e = e; u.rend = rend; u.A = A;
        if (PHASE == 1) {
            u.B = W + ((size_t)e * 1024 + (size_t)pn * 256) * DM;
#pragma unroll
            for (int k = 0; k < 2; ++k) { const int ra = r0 + R[k], rb = ra + 128; int ta, tb;
                if (e == NE) { ta = ra - NR_ROUTED; tb = rb - NR_ROUTED; }
                else { const int ps_ = __builtin_amdgcn_readfirstlane(M.tp[e]) * 256; const int* tk = row_tok + (size_t)e * T - ps_; ta = (ra < rend) ? ld_agent_i(tk + ra) : T; tb = (rb < rend) ? ld_agent_i(tk + rb) : T; }
                u.vA0[k] = (unsigned)(ta * DM + C[k] * 2); u.vA1[k] = (unsigned)(tb * DM + C[k] * 2); }
        } else {
            u.B = W + ((size_t)e * DM + (size_t)pn * 256) * EH;
#pragma unroll
            for (int k = 0; k < 2; ++k) { u.vA0[k] = (unsigned)((r0 + R[k]) * EH + C[k] * 2); u.vA1[k] = (unsigned)((r0 + R[k] + 128) * EH + C[k] * 2); }
        }
        asm volatile("" : "+v"(u.vA0[0]), "+v"(u.vA0[1]), "+v"(u.vA1[0]), "+v"(u.vA1[1]));
        return true;
    }
};

__device__ __forceinline__ bf16x8 tr_pair(unsigned a0, unsigned a1) { u32x2 r0, r1; asm volatile("ds_read_b64_tr_b16 %0, %2\n\tds_read_b64_tr_b16 %1, %3\n\ts_waitcnt lgkmcnt(0)" : "=&v"(r0), "=&v"(r1) : "v"(a0), "v"(a1) : "memory"); return __builtin_bit_cast(bf16x8, (u32x4){r0.x, r0.y, r1.x, r1.y}); }
__device__ __forceinline__ void tr_quad(bf16x8 (&o)[4], unsigned a0, unsigned a1, unsigned a2, unsigned a3, unsigned d1) {
    u32x2 r0, r1, r2, r3, r4, r5, r6, r7; const unsigned b0 = a0 + d1, b1 = a1 + d1, b2 = a2 + d1, b3 = a3 + d1;
    asm volatile("ds_read_b64_tr_b16 %0, %8\n\tds_read_b64_tr_b16 %1, %9\n\tds_read_b64_tr_b16 %2, %10\n\tds_read_b64_tr_b16 %3, %11\n\tds_read_b64_tr_b16 %4, %12\n\tds_read_b64_tr_b16 %5, %13\n\tds_read_b64_tr_b16 %6, %14\n\tds_read_b64_tr_b16 %7, %15\n\ts_waitcnt lgkmcnt(0)"
        : "=&v"(r0), "=&v"(r1), "=&v"(r2), "=&v"(r3), "=&v"(r4), "=&v"(r5), "=&v"(r6), "=&v"(r7) : "v"(a0), "v"(b0), "v"(a1), "v"(b1), "v"(a2), "v"(b2), "v"(a3), "v"(b3) : "memory");
    o[0] = __builtin_bit_cast(bf16x8, (u32x4){r0.x, r0.y, r1.x, r1.y}); o[1] = __builtin_bit_cast(bf16x8, (u32x4){r2.x, r2.y, r3.x, r3.y});
    o[2] = __builtin_bit_cast(bf16x8, (u32x4){r4.x, r4.y, r5.x, r5.y}); o[3] = __builtin_bit_cast(bf16x8, (u32x4){r6.x, r6.y, r7.x, r7.y}); }
constexpr int LP = 136;
__device__ __forceinline__ void ret_item(Ctx& F, int item) {
    const int tid = F.tid, lane = F.lane, w = F.wave, fr = lane & 15, fq = lane >> 4;
    const int b = item >> 5, h = (item >> 2) & 7, eb = item & 3;
    constexpr int VP = 40;
    LAS bf16* qL = (LAS bf16*)(F.lds); LAS bf16* kL = qL + 128 * LP; LAS bf16* vL = kL + 128 * LP; LAS bf16* vdL = vL + 128 * VP; LAS bf16* STL = vdL + 128 * VP;
    const unsigned trq = (unsigned)((lane & 15) >> 2), trp = (unsigned)(lane & 3);
    const unsigned kLb = (unsigned)(size_t)kL + trq * (LP * 2) + 8u * trp + (unsigned)(16 * w) * 2u, vLb = (unsigned)(size_t)vL + trq * (VP * 2) + 8u * trp, vdLb = (unsigned)(size_t)vdL + trq * (VP * 2) + 8u * trp;
    const bf16* proj = (const bf16*)(F.ws + WS_PROJ); const unsigned* rope = (const unsigned*)(F.ws + WS_ROPE); float* reto = (float*)(F.ws + WS_RETO);
    const float lg = log1pf(-exp2f(-5.0f - (float)h)), lg2 = lg * 1.4426950408889634f, dec = __expf(lg * 128.0f);
    f32x4 st[2] = {(f32x4){0.f, 0.f, 0.f, 0.f}, (f32x4){0.f, 0.f, 0.f, 0.f}};
    __syncthreads();
    for (int i = tid; i < 32 * LP; i += NWAVES * 64) STL[i] = 0;
    const int r = tid >> 2, qd = tid & 3, j0 = 16 * qd;
    const float kdec = __builtin_amdgcn_exp2f(lg2 * (float)(127 - r));
    u32x4 q1[2], q2[2], k1[2], k2[2], vv, cs4[4];
#define RET_LOAD(nn) do { const bf16* p_ = proj + (size_t)(b * SEQ + (nn) * 128 + r) * NIN + h * 128; const unsigned* c_ = rope + (size_t)(b * SEQ + (nn) * 128 + r) * 64 + j0; \
        q1[0] = *(const u32x4*)(p_ + j0); q1[1] = *(const u32x4*)(p_ + j0 + 8); q2[0] = *(const u32x4*)(p_ + 64 + j0); q2[1] = *(const u32x4*)(p_ + 64 + j0 + 8); \
        k1[0] = *(const u32x4*)(p_ + RW + j0); k1[1] = *(const u32x4*)(p_ + RW + j0 + 8); k2[0] = *(const u32x4*)(p_ + RW + 64 + j0); k2[1] = *(const u32x4*)(p_ + RW + 64 + j0 + 8); \
        vv = *(const u32x4*)(p_ + 2 * RW + eb * 32 + qd * 8); \
        _Pragma("unroll") for (int jj_ = 0; jj_ < 4; ++jj_) cs4[jj_] = *(const u32x4*)(c_ + 4 * jj_); } while (0)
    RET_LOAD(0);
#pragma unroll 1
    for (int n = 0; n < 16; ++n) {
        const int t0 = b * SEQ + n * 128;
        __syncthreads();
        {
#pragma unroll
            for (int hh = 0; hh < 2; ++hh) { unsigned oq1[4], oq2[4], ok1[4], ok2[4];
#pragma unroll
                for (int c = 0; c < 4; ++c) { float a[2], bq[2], ka[2], kb[2];
#pragma unroll
                    for (int z = 0; z < 2; ++z) { const int jj = hh * 8 + c * 2 + z; const unsigned cw_ = cs4[jj >> 2][jj & 3]; const f32x2 sc = (f32x2){bflo(cw_), bfhi(cw_)};
                        const float x1 = z ? bfhi(q1[hh][c]) : bflo(q1[hh][c]), x2 = z ? bfhi(q2[hh][c]) : bflo(q2[hh][c]);
                        const float y1 = z ? bfhi(k1[hh][c]) : bflo(k1[hh][c]), y2 = z ? bfhi(k2[hh][c]) : bflo(k2[hh][c]);
                        a[z] = (x1 * sc.x - x2 * sc.y) * 0.08838834764831845f; bq[z] = (x2 * sc.x + x1 * sc.y) * 0.08838834764831845f;
                        ka[z] = y1 * sc.x - y2 * sc.y; kb[z] = y2 * sc.x + y1 * sc.y;
                    }
                    oq1[c] = pk2(a[0], a[1]); oq2[c] = pk2(bq[0], bq[1]); ok1[c] = pk2(ka[0], ka[1]); ok2[c] = pk2(kb[0], kb[1]); }
                *(LAS u32x4*)(qL + r * LP + j0 + hh * 8) = (u32x4){oq1[0], oq1[1], oq1[2], oq1[3]}; *(LAS u32x4*)(qL + r * LP + 64 + j0 + hh * 8) = (u32x4){oq2[0], oq2[1], oq2[2], oq2[3]};
                *(LAS u32x4*)(kL + r * LP + j0 + hh * 8) = (u32x4){ok1[0], ok1[1], ok1[2], ok1[3]}; *(LAS u32x4*)(kL + r * LP + 64 + j0 + hh * 8) = (u32x4){ok2[0], ok2[1], ok2[2], ok2[3]}; }
            unsigned vd[4];
#pragma unroll
            for (int c = 0; c < 4; ++c) vd[c] = pk2(bflo(vv[c]) * kdec, bfhi(vv[c]) * kdec);
            *(LAS u32x4*)(vL + r * VP + 8 * qd) = vv; *(LAS u32x4*)(vdL + r * VP + 8 * qd) = (u32x4){vd[0], vd[1], vd[2], vd[3]};
        }
        if (n + 1 < 16) RET_LOAD(n + 1);
        __syncthreads();
        f32x4 sacc[8];
#pragma unroll
        for (int mt = 0; mt < 8; ++mt) sacc[mt] = (f32x4){0.f, 0.f, 0.f, 0.f};
#pragma unroll
        for (int ks = 0; ks < 4; ++ks) { const bf16x8 bq = *(const LAS bf16x8*)(qL + (16 * w + fr) * LP + 32 * ks + 8 * fq);
#pragma unroll
            for (int mt = 0; mt < 8; ++mt) { const bf16x8 ak = *(const LAS bf16x8*)(kL + (16 * mt + fr) * LP + 32 * ks + 8 * fq); sacc[mt] = __builtin_amdgcn_mfma_f32_16x16x32_bf16(ak, bq, sacc[mt], 0, 0, 0); } }
        const int c = 16 * w + fr;
        bf16x8 pb[4];
#pragma unroll
        for (int sk = 0; sk < 4; ++sk) { unsigned pw[4];
#pragma unroll
            for (int hlf = 0; hlf < 2; ++hlf) { const int mt = 2 * sk + hlf; float pv[4];
#pragma unroll
                for (int rr = 0; rr < 4; ++rr) { const int m = 16 * mt + 4 * fq + rr; pv[rr] = (c >= m) ? sacc[mt][rr] * __builtin_amdgcn_exp2f(lg2 * (float)(c - m)) : 0.f; }
                pw[2 * hlf] = pk2(pv[0], pv[1]); pw[2 * hlf + 1] = pk2(pv[2], pv[3]); }
            pb[sk] = __builtin_bit_cast(bf16x8, (u32x4){pw[0], pw[1], pw[2], pw[3]}); }
        f32x4 oi[2], oc[2];
#pragma unroll
        for (int et = 0; et < 2; ++et) { oi[et] = (f32x4){0.f, 0.f, 0.f, 0.f}; oc[et] = (f32x4){0.f, 0.f, 0.f, 0.f}; }
#pragma unroll
        for (int et = 0; et < 2; ++et) { bf16x8 avq[4]; const unsigned a0 = vLb + (unsigned)((4 * fq) * (VP * 2) + 32 * et); tr_quad(avq, a0, a0 + 32 * (VP * 2), a0 + 64 * (VP * 2), a0 + 96 * (VP * 2), 16 * (VP * 2));
#pragma unroll
            for (int ks = 0; ks < 4; ++ks) oi[et] = __builtin_amdgcn_mfma_f32_16x16x32_bf16(avq[ks], pb[ks], oi[et], 0, 0, 0); }
#pragma unroll
        for (int ks = 0; ks < 4; ++ks) { const bf16x8 bq = *(const LAS bf16x8*)(qL + (16 * w + fr) * LP + 32 * ks + 8 * fq);
#pragma unroll
            for (int et = 0; et < 2; ++et) { const bf16x8 as = *(const LAS bf16x8*)(STL + (16 * et + fr) * LP + 32 * ks + 8 * fq); oc[et] = __builtin_amdgcn_mfma_f32_16x16x32_bf16(as, bq, oc[et], 0, 0, 0); } }
        { const float qd = __builtin_amdgcn_exp2f(lg2 * (float)(c + 1));
#pragma unroll
          for (int et = 0; et < 2; ++et) *(f32x4*)(reto + (size_t)(t0 + c) * RW + h * 128 + eb * 32 + 16 * et + 4 * fq) = oi[et] + oc[et] * qd; }
        __syncthreads();
#pragma unroll
        for (int et = 0; et < 2; ++et) st[et] = st[et] * dec;
        { bf16x8 bkq[4], vq0[4], vq1[4];
          { const unsigned k0 = kLb + (unsigned)((8 * fq) * (LP * 2)); tr_quad(bkq, k0, k0 + 32 * (LP * 2), k0 + 64 * (LP * 2), k0 + 96 * (LP * 2), 4 * (LP * 2)); }
          { const unsigned v0 = vdLb + (unsigned)((8 * fq) * (VP * 2)); tr_quad(vq0, v0, v0 + 32 * (VP * 2), v0 + 64 * (VP * 2), v0 + 96 * (VP * 2), 4 * (VP * 2)); tr_quad(vq1, v0 + 32, v0 + 32 + 32 * (VP * 2), v0 + 32 + 64 * (VP * 2), v0 + 32 + 96 * (VP * 2), 4 * (VP * 2)); }
#pragma unroll
          for (int ks = 0; ks < 4; ++ks) { st[0] = __builtin_amdgcn_mfma_f32_16x16x32_bf16(vq0[ks], bkq[ks], st[0], 0, 0, 0); st[1] = __builtin_amdgcn_mfma_f32_16x16x32_bf16(vq1[ks], bkq[ks], st[1], 0, 0, 0); } }
#pragma unroll
        for (int et = 0; et < 2; ++et)
#pragma unroll
            for (int rr = 0; rr < 4; ++rr) STL[(16 * et + 4 * fq + rr) * LP + 16 * w + fr] = f2bf(st[et][rr]);
    }
#undef RET_LOAD
    __syncthreads();
}

struct LruIn { bf16x8 bA[4], bX[4]; unsigned xr[19]; f32x2 w0, w1, w2, w3, bc; float bav, bxv, lamv; };
__device__ __forceinline__ void lru_issue(Ctx& F, int item, LruIn& L) {
    const int lane = F.lane, w = F.wave, fr = lane & 15, fq = lane >> 4;
    const int b = item >> 7, n = (item >> 3) & 15, g = item & 7; const int ch = g * 128 + 2 * lane;
    const bf16* Wa = (const bf16*)(F.ws + WS_WA) + (size_t)g * 128 * 128 + (size_t)(16 * w + fr) * 128 + 8 * fq; const bf16* Wx = (const bf16*)(F.ws + WS_WX) + (size_t)g * 128 * 128 + (size_t)(16 * w + fr) * 128 + 8 * fq;
#pragma unroll
    for (int ks = 0; ks < 4; ++ks) { L.bA[ks] = *(const bf16x8*)(Wa + 32 * ks); L.bX[ks] = *(const bf16x8*)(Wx + 32 * ks); }
    const float* wconv = (const float*)F.in[7];
    L.w0 = *(const f32x2*)(wconv + ch); L.w1 = *(const f32x2*)(wconv + LW + ch); L.w2 = *(const f32x2*)(wconv + 2 * LW + ch); L.w3 = *(const f32x2*)(wconv + 3 * LW + ch); L.bc = *(const f32x2*)((const float*)F.in[8] + ch);
    const int cj = g * 128 + 16 * w + fr; L.bav = ((const float*)F.in[10])[cj]; L.bxv = ((const float*)F.in[12])[cj]; L.lamv = ((const float*)F.in[13])[cj];
    const int s0 = n * 128 + 16 * w; const bf16* p = (const bf16*)(F.ws + WS_PROJ) + (size_t)(b * SEQ) * NIN + 4 * RW + ch;
#pragma unroll
    for (int i = 0; i < 19; ++i) { const int sp = s0 - 3 + i; L.xr[i] = (sp >= 0) ? *(const unsigned*)(p + (size_t)sp * NIN) : 0u; }
}
__device__ __forceinline__ void lru_body(Ctx& F, int item, const LruIn& L) {
    const int lane = F.lane, w = F.wave, fr = lane & 15, fq = lane >> 4;
    const int b = item >> 7, n = (item >> 3) & 15, g = item & 7;
    LAS bf16* xcL = (LAS bf16*)(F.lds); LAS float* aL = (LAS float*)(F.lds + 34816); LAS bf16* mL = (LAS bf16*)(F.lds + 34816 + 65536); LAS float* segA = (LAS float*)(F.lds + 34816 + 65536 + 32768); LAS float* segB = segA + 1024;
    const int cp = lane, sg = w, ch = g * 128 + 2 * cp;
    float xc[16][2];
#pragma unroll
    for (int i = 0; i < 16; ++i) {
        xc[i][0] = L.bc.x + L.w0.x * bflo(L.xr[i]) + L.w1.x * bflo(L.xr[i + 1]) + L.w2.x * bflo(L.xr[i + 2]) + L.w3.x * bflo(L.xr[i + 3]);
        xc[i][1] = L.bc.y + L.w0.y * bfhi(L.xr[i]) + L.w1.y * bfhi(L.xr[i + 1]) + L.w2.y * bfhi(L.xr[i + 2]) + L.w3.y * bfhi(L.xr[i + 3]);
        *(LAS unsigned*)(xcL + (16 * sg + i) * LP + 2 * cp) = pk2(xc[i][0], xc[i][1]); }
    __syncthreads();
    {
        const int j = 16 * w + fr; const float bav = L.bav, bxv = L.bxv, sp8 = -8.0f * log1pf(__expf(-L.lamv));
#pragma unroll 2
        for (int tt = 0; tt < 8; ++tt) { f32x4 ra = (f32x4){0.f, 0.f, 0.f, 0.f}, rx = (f32x4){0.f, 0.f, 0.f, 0.f};
#pragma unroll
            for (int ks = 0; ks < 4; ++ks) { const bf16x8 a = *(const LAS bf16x8*)(xcL + (16 * tt + fr) * LP + 32 * ks + 8 * fq);
                ra = __builtin_amdgcn_mfma_f32_16x16x32_bf16(a, L.bA[ks], ra, 0, 0, 0); rx = __builtin_amdgcn_mfma_f32_16x16x32_bf16(a, L.bX[ks], rx, 0, 0, 0); }
#pragma unroll
            for (int rr = 0; rr < 4; ++rr) { const int t = 16 * tt + 4 * fq + rr;
                const float rgt = __builtin_amdgcn_rcpf(1.0f + __expf(-(ra[rr] + bav))), igt = __builtin_amdgcn_rcpf(1.0f + __expf(-(rx[rr] + bxv)));
                const float av = __expf(sp8 * rgt); const float mu = __builtin_amdgcn_sqrtf(fmaxf(1.0f - av * av, 0.f)) * igt;
                aL[t * 128 + j] = av; mL[t * 128 + j] = f2bf(mu); } }
    }
    __syncthreads();
    {
        float h0 = 0.f, h1 = 0.f, P0 = 1.f, P1 = 1.f;
#pragma unroll
        for (int i = 0; i < 16; ++i) { const int t = 16 * sg + i; const f32x2 av = *(const LAS f32x2*)(aL + t * 128 + 2 * cp); const unsigned mw = *(const LAS unsigned*)(mL + t * 128 + 2 * cp);
            h0 = av.x * h0 + bflo(mw) * xc[i][0]; h1 = av.y * h1 + bfhi(mw) * xc[i][1]; P0 *= av.x; P1 *= av.y; }
        *(LAS f32x2*)(segA + sg * 128 + 2 * cp) = (f32x2){P0, P1}; *(LAS f32x2*)(segB + sg * 128 + 2 * cp) = (f32x2){h0, h1};
    }
    __syncthreads();
    {
        float c0 = 0.f, c1 = 0.f, Q0 = 1.f, Q1 = 1.f;
        for (int s = 0; s < sg; ++s) { const f32x2 A = *(const LAS f32x2*)(segA + s * 128 + 2 * cp), Bv = *(const LAS f32x2*)(segB + s * 128 + 2 * cp); c0 = A.x * c0 + Bv.x; c1 = A.y * c1 + Bv.y; Q0 *= A.x; Q1 *= A.y; }
        bf16* hl = (bf16*)(F.ws + WS_HLOC) + (size_t)(b * SEQ + n * 128 + 16 * sg) * LW + ch; bf16* pl = (bf16*)(F.ws + WS_PLOC) + (size_t)(b * SEQ + n * 128 + 16 * sg) * LW + ch;
        float h0 = c0, h1 = c1, P0 = Q0, P1 = Q1;
#pragma unroll
        for (int i = 0; i < 16; ++i) { const int t = 16 * sg + i; const f32x2 av = *(const LAS f32x2*)(aL + t * 128 + 2 * cp); const unsigned mw = *(const LAS unsigned*)(mL + t * 128 + 2 * cp);
            h0 = av.x * h0 + bflo(mw) * xc[i][0]; h1 = av.y * h1 + bfhi(mw) * xc[i][1]; P0 *= av.x; P1 *= av.y;
            *(unsigned*)(hl + (size_t)i * LW) = pk2(h0, h1); *(unsigned*)(pl + (size_t)i * LW) = pk2(P0, P1); }
        if (sg == 7) { *(f32x2*)((float*)(F.ws + WS_AGGA) + (size_t)(b * 16 + n) * LW + ch) = (f32x2){P0, P1}; *(f32x2*)((float*)(F.ws + WS_AGGB) + (size_t)(b * 16 + n) * LW + ch) = (f32x2){h0, h1}; }
    }
    __syncthreads();
}

__device__ __forceinline__ void p4_item(Ctx& F, int item) {
    const int tid = F.tid, lane = F.lane, w = F.wave;
    const int b = item >> 5, n = (item & 31) >> 1;
    LAS float* carry = (LAS float*)F.lds;
    const float* aggA = (const float*)(F.ws + WS_AGGA); const float* aggB = (const float*)(F.ws + WS_AGGB);
    __syncthreads();
#pragma unroll
    for (int q = 0; q < 2; ++q) { const int ch = tid + 512 * q; float cin = 0.f;
        for (int jn = 0; jn < n; ++jn) cin = aggA[(size_t)(b * 16 + jn) * LW + ch] * cin + aggB[(size_t)(b * 16 + jn) * LW + ch];
        carry[ch] = cin; }
    __syncthreads();
    const bf16* proj = (const bf16*)(F.ws + WS_PROJ); const float* reto = (const float*)(F.ws + WS_RETO); const bf16* hl = (const bf16*)(F.ws + WS_HLOC); const bf16* pl = (const bf16*)(F.ws + WS_PLOC);
    bf16* cat = (bf16*)(F.ws + WS_CAT); const int c0 = 16 * lane;
    float beta_r[16], beta_l[16], cr[16];
#pragma unroll
    for (int q = 0; q < 4; ++q) { const f32x4 a = *(const f32x4*)((const float*)F.in[14] + c0 + 4 * q), bq = *(const f32x4*)((const float*)F.in[15] + c0 + 4 * q); const f32x4 cq = *(const LAS f32x4*)(carry + c0 + 4 * q);
        beta_r[4 * q] = a.x; beta_r[4 * q + 1] = a.y; beta_r[4 * q + 2] = a.z; beta_r[4 * q + 3] = a.w; beta_l[4 * q] = bq.x; beta_l[4 * q + 1] = bq.y; beta_l[4 * q + 2] = bq.z; beta_l[4 * q + 3] = bq.w;
        cr[4 * q] = cq.x; cr[4 * q + 1] = cq.y; cr[4 * q + 2] = cq.z; cr[4 * q + 3] = cq.w; }
#pragma unroll 2
    for (int rr = 0; rr < 8; ++rr) {
        const int t = item * 64 + 8 * w + rr;
        {
            float o[16];
#pragma unroll
            for (int q = 0; q < 4; ++q) { const f32x4 v = *(const f32x4*)(reto + (size_t)t * RW + c0 + 4 * q); o[4 * q] = v.x; o[4 * q + 1] = v.y; o[4 * q + 2] = v.z; o[4 * q + 3] = v.w; }
            float s = 0.f;
#pragma unroll
            for (int q = 0; q < 16; ++q) s += o[q];
            s += __shfl_xor(s, 1); s += __shfl_xor(s, 2); s += __shfl_xor(s, 4);
            const float mu = s * (1.0f / 128.0f); float vq = 0.f;
#pragma unroll
            for (int q = 0; q < 16; ++q) { o[q] -= mu; vq += o[q] * o[q]; }
            vq += __shfl_xor(vq, 1); vq += __shfl_xor(vq, 2); vq += __shfl_xor(vq, 4);
            const float rs = rsqrtf(vq * (1.0f / 128.0f) + EPS);
            const u32x4 g0 = *(const u32x4*)(proj + (size_t)t * NIN + 3 * RW + c0), g1 = *(const u32x4*)(proj + (size_t)t * NIN + 3 * RW + c0 + 8);
            float ss = 0.f;
#pragma unroll
            for (int q = 0; q < 8; ++q) { const unsigned gw_ = (q < 4) ? g0[q & 3] : g1[q & 3]; const float ga = bflo(gw_), gb = bfhi(gw_);
                o[2 * q] = siluf_(ga) * (o[2 * q] * rs); o[2 * q + 1] = siluf_(gb) * (o[2 * q + 1] * rs); ss += o[2 * q] * o[2 * q] + o[2 * q + 1] * o[2 * q + 1]; }
            const float rstd = rsqrtf(wave_sum(ss) * (1.0f / RW) + EPS);
            u32x4 w0, w1;
#pragma unroll
            for (int q = 0; q < 4; ++q) { w0[q] = pk2(o[2 * q] * rstd * beta_r[2 * q], o[2 * q + 1] * rstd * beta_r[2 * q + 1]); w1[q] = pk2(o[8 + 2 * q] * rstd * beta_r[8 + 2 * q], o[9 + 2 * q] * rstd * beta_r[9 + 2 * q]); }
            *(u32x4*)(cat + (size_t)t * DM + c0) = w0; *(u32x4*)(cat + (size_t)t * DM + c0 + 8) = w1;
        }
        {
            const u32x4 h0 = *(const u32x4*)(hl + (size_t)t * LW + c0), h1 = *(const u32x4*)(hl + (size_t)t * LW + c0 + 8), p0 = *(const u32x4*)(pl + (size_t)t * LW + c0), p1 = *(const u32x4*)(pl + (size_t)t * LW + c0 + 8);
            const u32x4 y0 = *(const u32x4*)(proj + (size_t)t * NIN + 5 * RW + c0), y1 = *(const u32x4*)(proj + (size_t)t * NIN + 5 * RW + c0 + 8);
            float o[16]; float ss = 0.f;
#pragma unroll
            for (int q = 0; q < 8; ++q) { const unsigned hw = (q < 4) ? h0[q & 3] : h1[q & 3], pw = (q < 4) ? p0[q & 3] : p1[q & 3], yw = (q < 4) ? y0[q & 3] : y1[q & 3];
                const float ha = bflo(hw) + bflo(pw) * cr[2 * q], hb = bfhi(hw) + bfhi(pw) * cr[2 * q + 1];
                o[2 * q] = ha * gelu_tanh_(bflo(yw)); o[2 * q + 1] = hb * gelu_tanh_(bfhi(yw)); ss += o[2 * q] * o[2 * q] + o[2 * q + 1] * o[2 * q + 1]; }
            const float rstd = rsqrtf(wave_sum(ss) * (1.0f / LW) + EPS);
            u32x4 w0, w1;
#pragma unroll
            for (int q = 0; q < 4; ++q) { w0[q] = pk2(o[2 * q] * rstd * beta_l[2 * q], o[2 * q + 1] * rstd * beta_l[2 * q + 1]); w1[q] = pk2(o[8 + 2 * q] * rstd * beta_l[8 + 2 * q], o[9 + 2 * q] * rstd * beta_l[9 + 2 * q]); }
            *(u32x4*)(cat + (size_t)t * DM + RW + c0) = w0; *(u32x4*)(cat + (size_t)t * DM + RW + c0 + 8) = w1;
        }
    }
    __syncthreads();
}

constexpr int HAP = 2056;
template <bool DRY> __device__ __forceinline__ void p6_item(Ctx& F, int item) {
    const int tid = F.tid, lane = F.lane, w = F.wave, fr = lane & 15, fq = lane >> 4;
    const int t0 = item * 64, b = t0 / SEQ;
    LAS bf16* hA = (LAS bf16*)F.lds;
    LAS float* lgt = (LAS float*)(F.lds + 16 * HAP * 2);
    LAS unsigned char* selE = (LAS unsigned char*)(F.lds + 16 * HAP * 2 + 8 * 16 * 65 * 4); LAS unsigned char* selL = selE + 512; LAS unsigned* wcnt = (LAS unsigned*)(selL + 512); LAS unsigned* gb = wcnt + 512;
    const bf16* x1 = (const bf16*)(F.ws + WS_X1); const float* mod = (const float*)(F.ws + WS_MOD) + (size_t)b * 6 * DM; bf16* h2 = (bf16*)(F.ws + WS_H); unsigned char* h8 = F.ws + WS_H8;
    const bf16* Wr = (const bf16*)(F.ws + WS_WR);
    int* eidx = (int*)(F.ws + WS_EIDX); float* wsel = (float*)(F.ws + WS_WSEL); int* slot = (int*)(F.ws + (DRY ? WS_DEST : WS_SLOT)); unsigned* cnt = (unsigned*)(F.ws + WS_CTL) + CW_CNT + (DRY ? 4096 : 0);
    f32x4 gg[4][2];
#pragma unroll
    for (int j = 0; j < 4; ++j)
#pragma unroll
        for (int h = 0; h < 2; ++h) { const int c = 8 * lane + 512 * j + 4 * h; gg[j][h] = *(const f32x4*)((const float*)F.in[17] + c) * (*(const f32x4*)(mod + 4 * DM + c) + 1.0f); }
    const float brl = ((const float*)F.in[19])[lane]; const int g = lane >> 3;
    unsigned lc = 0u;
    bf16x8 bw[2][4];
#pragma unroll
    for (int ks = 0; ks < 2; ++ks)
#pragma unroll
        for (int et = 0; et < 4; ++et) bw[ks][et] = *(const bf16x8*)(Wr + (size_t)(16 * et + fr) * DM + 256 * w + 32 * ks + 8 * fq);
    u32x4 xq[2][4];
#pragma unroll
    for (int i = 0; i < 2; ++i)
#pragma unroll
        for (int j = 0; j < 4; ++j) xq[i][j] = *(const u32x4*)(x1 + (size_t)(t0 + 2 * w + i) * DM + 8 * lane + 512 * j);
    __syncthreads();
#pragma unroll 1
    for (int ps = 0; ps < 4; ++ps) {
#pragma unroll
        for (int i = 0; i < 2; ++i) { const int rl = 2 * w + i, t = t0 + 16 * ps + rl;
            f32x4 v[4][2]; float ss = 0.f;
#pragma unroll
            for (int j = 0; j < 4; ++j) { const u32x4 xw = xq[i][j]; v[j][0] = (f32x4){bflo(xw.x), bfhi(xw.x), bflo(xw.y), bfhi(xw.y)}; v[j][1] = (f32x4){bflo(xw.z), bfhi(xw.z), bflo(xw.w), bfhi(xw.w)};
#pragma unroll
                for (int h = 0; h < 2; ++h) ss += (v[j][h].x * v[j][h].x + v[j][h].y * v[j][h].y) + (v[j][h].z * v[j][h].z + v[j][h].w * v[j][h].w); }
            const float rstd = rsqrtf(wave_sum(ss) * (1.0f / DM) + EPS);
#pragma unroll
            for (int j = 0; j < 4; ++j) { const f32x4 o0 = v[j][0] * rstd * gg[j][0] + *(const f32x4*)(mod + 3 * DM + 8 * lane + 512 * j), o1 = v[j][1] * rstd * gg[j][1] + *(const f32x4*)(mod + 3 * DM + 8 * lane + 512 * j + 4);
                u32x4 wv; wv.x = pk2(o0.x, o0.y); wv.y = pk2(o0.z, o0.w); wv.z = pk2(o1.x, o1.y); wv.w = pk2(o1.z, o1.w);
                *(LAS u32x4*)(hA + rl * HAP + 8 * lane + 512 * j) = wv;
                u32x2 w8; w8.x = pk4_fp8(o0.x * SC_H8, o0.y * SC_H8, o0.z * SC_H8, o0.w * SC_H8); w8.y = pk4_fp8(o1.x * SC_H8, o1.y * SC_H8, o1.z * SC_H8, o1.w * SC_H8);
                *(u32x2*)(h8 + (size_t)t * DM + 8 * lane + 512 * j) = w8; }
            __builtin_amdgcn_sched_barrier(0); }
        __syncthreads();
        {
            f32x4 acc[4];
#pragma unroll
            for (int et = 0; et < 4; ++et) acc[et] = (f32x4){0.f, 0.f, 0.f, 0.f};
            bf16x8 bw2[6][4];
#pragma unroll
            for (int ks = 0; ks < 6; ++ks)
#pragma unroll
                for (int et = 0; et < 4; ++et) bw2[ks][et] = *(const bf16x8*)(Wr + (size_t)(16 * et + fr) * DM + 256 * w + 64 + 32 * ks + 8 * fq);
#pragma unroll
            for (int ks = 0; ks < 2; ++ks) { const bf16x8 a = *(const LAS bf16x8*)(hA + fr * HAP + 256 * w + 32 * ks + 8 * fq);
#pragma unroll
                for (int et = 0; et < 4; ++et) acc[et] = __builtin_amdgcn_mfma_f32_16x16x32_bf16(a, bw[ks][et], acc[et], 0, 0, 0); }
#pragma unroll
            for (int ks = 0; ks < 6; ++ks) { const bf16x8 a = *(const LAS bf16x8*)(hA + fr * HAP + 256 * w + 64 + 32 * ks + 8 * fq);
#pragma unroll
                for (int et = 0; et < 4; ++et) acc[et] = __builtin_amdgcn_mfma_f32_16x16x32_bf16(a, bw2[ks][et], acc[et], 0, 0, 0); }
#pragma unroll
            for (int et = 0; et < 4; ++et)
#pragma unroll
                for (int rr = 0; rr < 4; ++rr) lgt[(w * 16 + 4 * fq + rr) * 65 + 16 * et + fr] = acc[et][rr];
        }
        __syncthreads();
        if (ps + 1 < 4) {
#pragma unroll
            for (int i = 0; i < 2; ++i)
#pragma unroll
                for (int j = 0; j < 4; ++j) xq[i][j] = *(const u32x4*)(x1 + (size_t)(t0 + 16 * (ps + 1) + 2 * w + i) * DM + 8 * lane + 512 * j); }
#pragma unroll 1
        for (int i = 0; i < 2; ++i) {
            const int tl = 2 * w + i, tt = 16 * ps + tl; float z = 0.f;
#pragma unroll
            for (int w2 = 0; w2 < 8; ++w2) z += lgt[(w2 * 16 + tl) * 65 + lane];
            const float s = sigmoidf_(z); const float bsc = s + brl;
            float m1 = bsc; m1 = fmaxf(m1, __shfl_xor(m1, 1)); m1 = fmaxf(m1, __shfl_xor(m1, 2)); m1 = fmaxf(m1, __shfl_xor(m1, 4));
            const unsigned long long eq = __ballot(bsc == m1); const unsigned gm = (unsigned)(eq >> (8 * g)) & 0xffu;
            const bool first = (lane & 7) == (__builtin_ctz(gm | 0x100u) & 7);
            float m2 = first ? -3.0e38f : bsc; m2 = fmaxf(m2, __shfl_xor(m2, 1)); m2 = fmaxf(m2, __shfl_xor(m2, 2)); m2 = fmaxf(m2, __shfl_xor(m2, 4));
            const float gs = m1 + m2;
            int rank_g = 0;
#pragma unroll
            for (int g2 = 0; g2 < 8; ++g2) { const float o = __int_as_float(__builtin_amdgcn_readlane(__float_as_int(gs), 8 * g2)); rank_g += (o > gs || (o == gs && g2 < g)) ? 1 : 0; }
            const bool selg = rank_g < 4;
            const float key = selg ? bsc : -3.0e38f;
            int rank = 0;
#pragma unroll
            for (int e2 = 0; e2 < 64; ++e2) { const float o = __int_as_float(__builtin_amdgcn_readlane(__float_as_int(key), e2)); rank += (o > key || (o == key && e2 < lane)) ? 1 : 0; }
            const bool chosen = selg && rank < 8;
            const float wsum = wave_sum(chosen ? s : 0.f);
            if (chosen) { const int t = t0 + tt; eidx[t * 8 + rank] = lane; wsel[t * 8 + rank] = s * (2.5f / wsum); selE[tt * 8 + rank] = (unsigned char)lane; selL[tt * 8 + rank] = (unsigned char)lc; }
            lc += chosen ? 1u : 0u;
        }
        __syncthreads();
    }
    wcnt[w * 64 + lane] = lc;
    __syncthreads();
    if (w == 0) { unsigned tot = 0u;
#pragma unroll
        for (int w2 = 0; w2 < 8; ++w2) tot += wcnt[w2 * 64 + lane];
        gb[lane] = tot ? __hip_atomic_fetch_add(cnt + 32 * lane, tot, __ATOMIC_RELAXED, __HIP_MEMORY_SCOPE_AGENT) : 0u; }
    __syncthreads();
    { const int tok = tid >> 3, k = tid & 7, e = selE[tok * 8 + k], wt = (tok & 15) >> 1; unsigned off = gb[e] + selL[tok * 8 + k];
        for (int w2 = 0; w2 < wt; ++w2) off += wcnt[w2 * 64 + e];
        slot[(t0 + tok) * 8 + k] = (int)off; if (!DRY) ((int*)(F.ws + WS_TOKOF))[(size_t)e * T + off] = t0 + tok; }
    __syncthreads();
}

__device__ __forceinline__ void p10_final(Ctx& F, bool have_tables) {
    const int gw = F.vcu * NWAVES + F.wave, NGW = F.G * NWAVES, lane = F.lane;
    const bf16* x1 = (const bf16*)(F.ws + WS_X1); const unsigned char* y = F.ws + WS_Y; const int* eidx = (const int*)(F.ws + WS_EIDX); const int* slot = (const int*)(F.ws + WS_SLOT); const float* wsel = (const float*)(F.ws + WS_WSEL); const float* gf = (const float*)F.in[24];
    LAS int* ps = (LAS int*)F.lds; const unsigned* cnt = (const unsigned*)(F.ws + WS_CTL) + CW_CNT;
    __syncthreads();
    if (have_tables) { if (F.tid < NE) ps[F.tid] = moe_tables(F).tp[F.tid] * 256; }
    else { if (F.tid < NE) ps[64 + F.tid] = (((int)ld_agent(cnt + 32 * F.tid) + 255) >> 8) << 8;
        __syncthreads();
        if (F.tid < NE) { int acc = 0; for (int e = 0; e < F.tid; ++e) acc += ps[64 + e]; ps[F.tid] = acc; } }
    __syncthreads();
    for (int t = gw; t < T; t += NGW) { const int b = t / SEQ; const float* gt2 = (const float*)(F.ws + WS_MOD) + (size_t)b * 6 * DM + 5 * DM;
        int rows[9]; float wk[9];
#pragma unroll
        for (int k = 0; k < 8; ++k) { rows[k] = ps[ld_agent_i(eidx + t * 8 + k)] + ld_agent_i(slot + t * 8 + k); wk[k] = wsel[t * 8 + k] * (1.0f / SC_Y); }
        rows[8] = NR_ROUTED + t; wk[8] = 1.0f / SC_Y;
        float ss = 0.f; f32x4 v[4][2];
#pragma unroll
        for (int j = 0; j < 4; ++j) { const int c = 8 * lane + 512 * j; float s[8];
#pragma unroll
            for (int q = 0; q < 8; ++q) s[q] = 0.f;
#pragma unroll
            for (int k = 0; k < 9; ++k) { const u32x2 yv = *(const u32x2*)(y + (size_t)rows[k] * DM + c);
#pragma unroll
                for (int q = 0; q < 2; ++q) { const f32x2 lo = __builtin_amdgcn_cvt_pk_f32_fp8((int)yv[q], false), hi = __builtin_amdgcn_cvt_pk_f32_fp8((int)yv[q], true);
                    s[4 * q] += wk[k] * lo.x; s[4 * q + 1] += wk[k] * lo.y; s[4 * q + 2] += wk[k] * hi.x; s[4 * q + 3] += wk[k] * hi.y; } }
            const u32x4 xw = *(const u32x4*)(x1 + (size_t)t * DM + c);
#pragma unroll
            for (int hh = 0; hh < 2; ++hh) { const f32x4 xv = hh ? (f32x4){bflo(xw.z), bfhi(xw.z), bflo(xw.w), bfhi(xw.w)} : (f32x4){bflo(xw.x), bfhi(xw.x), bflo(xw.y), bfhi(xw.y)}, gv = *(const f32x4*)(gt2 + c + 4 * hh);
                v[j][hh] = xv + gv * (f32x4){s[4 * hh], s[4 * hh + 1], s[4 * hh + 2], s[4 * hh + 3]};
                ss += (v[j][hh].x * v[j][hh].x + v[j][hh].y * v[j][hh].y) + (v[j][hh].z * v[j][hh].z + v[j][hh].w * v[j][hh].w); } }
        const float rstd = rsqrtf(wave_sum(ss) * (1.0f / DM) + EPS);
#pragma unroll
        for (int j = 0; j < 4; ++j)
#pragma unroll
            for (int hh = 0; hh < 2; ++hh) { const int c = 8 * lane + 512 * j + 4 * hh; *(f32x4*)(F.out + (size_t)t * DM + c) = v[j][hh] * rstd * *(const f32x4*)(gf + c); }
    }
}

__global__ void __launch_bounds__(NWAVES * 64, 2) fwd_kernel(Args args) {
    extern __shared__ __attribute__((aligned(16))) unsigned char lds_raw[];
    Ctx F;
    F.lds = (LAS unsigned char*)lds_raw; F.ws = args.ws; F.in = args.in; F.out = args.out;
    F.tid = threadIdx.x; F.lane = F.tid & 63; F.wave = __builtin_amdgcn_readfirstlane(F.tid >> 6);
    F.G = gridDim.x; { const int bx = blockIdx.x; F.vcu = (F.G % 8 == 0) ? (bx % 8) * (F.G / 8) + bx / 8 : bx; }
    if (F.tid < 16) ((LAS unsigned*)(F.lds + MISC_OFF))[F.tid] = 0u;
    __syncthreads();
    unsigned* ctl = (unsigned*)(F.ws + WS_CTL);
#if N_LAUNCHES == 1
    XcdBarrier bar = xcd_barrier_post(ctl + CW_BAR, (volatile LAS unsigned*)(F.lds + MISC_OFF));
#define GRID_BAR() xcd_barrier(bar)
#else
#define GRID_BAR() do { } while (0)
#endif
    const int lo = args.ph_lo, hi = args.ph_hi;
#define IN(k) (lo <= (k) && (k) < hi)
#define BOTH(k) (IN(k) && IN((k) + 1))
    const int NIT = F.G;

#define REP(k) _Pragma("unroll") for (int rep_ = 0; rep_ < ((PROBE_PHASE == (k)) ? 2 : 1); ++rep_)
    if (IN(0)) { p0_adaln(F); p0_prologue(F); if (BOTH(0)) p0_wait_mod(F); }
    if (IN(1)) { REP(1) { p1_norm(F); } if (BOTH(1)) GRID_BAR(); if (PROBE_PHASE == 100) { GRID_BAR(); GRID_BAR(); GRID_BAR(); GRID_BAR(); } }
    if (IN(2)) {
        if (F.vcu & 1) p2_convert_experts(F);
        REP(2) {
        g8::DenseOrder S; S.init(F.ws + WS_H, F.ws + WS_WIN, T, NIN, DM * 2, F.G, (int)blockIdx.x);
        EpiProj E{(bf16*)(F.ws + WS_PROJ)};
        g8::gemm_phase<EpiProj, g8::DenseOrder>(F.lds, DM * 2, S, E);
        }
        if (!(F.vcu & 1)) p2_convert_experts(F);
        if (BOTH(2)) GRID_BAR();
    }
    if (IN(3)) {
        for (int it = F.vcu; it < NB * 8 * 4 * ((PROBE_PHASE == 31) ? 2 : 1); it += NIT) ret_item(F, it & 255);
        {
            LruIn La, Lb; int it = F.vcu; const int NL = NB * 16 * 8;
            __syncthreads();
            if (it < NL) lru_issue(F, it, La);
            while (it < NL) {
                if (it + NIT < NL) lru_issue(F, it + NIT, Lb);
                lru_body(F, it, La); it += NIT;
                if (it >= NL) break;
                if (it + NIT < NL) lru_issue(F, it + NIT, La);
                lru_body(F, it, Lb); it += NIT;
            }
        }
        if (BOTH(3)) GRID_BAR();
    }
    if (IN(4)) { REP(4) { for (int it = F.vcu; it < T / 64; it += NIT) p4_item(F, it); } if (BOTH(4)) GRID_BAR(); }
    if (IN(5)) {
        REP(5) {
        g8::DenseOrder S; S.init(F.ws + WS_CAT, F.ws + WS_WOUT, T, DM, DM * 2, F.G, (int)blockIdx.x);
        EpiWout E{(const float*)F.in[0], (const float*)(F.ws + WS_MOD), (bf16*)(F.ws + WS_X1)};
        g8::gemm_phase<EpiWout, g8::DenseOrder>(F.lds, DM * 2, S, E);
        }
        if (BOTH(5)) GRID_BAR();
    }
    if (IN(6)) { for (int it = F.vcu; it < T / 64; it += NIT) p6_item<false>(F, it); if (PROBE_PHASE == 6) { for (int it = F.vcu; it < T / 64; it += NIT) p6_item<true>(F, it); } if (BOTH(6)) GRID_BAR(); }
    int ntiles = 0;
    if (IN(8)) {
        REP(8) {
        ntiles = moe_build_tables(F);
        MoeOrder<1> S; S.init(F, ntiles);
        EpiSwiglu E{F.ws + WS_ACT};
        g8::gemm_phase<EpiSwiglu, MoeOrder<1>, true>(F.lds, DM, S, E);
        }
        if (BOTH(8)) GRID_BAR();
    }
    if (IN(9)) {
        REP(9) {
        if (!IN(8)) ntiles = moe_build_tables(F);
        MoeOrder<2> S; S.init(F, ntiles);
        EpiDown E{F.ws + WS_Y};
        g8::gemm_phase<EpiDown, MoeOrder<2>, true>(F.lds, EH, S, E);
        }
        if (BOTH(9)) GRID_BAR();
    }
    if (IN(10)) { REP(10) { p10_final(F, IN(8)); } }
#undef REP
#undef IN
#undef BOTH
}

extern "C" void kernel_launch(void* const* d_in, const int* in_sizes, int n_in, void* d_out, int out_size, void* d_ws, size_t ws_size, hipStream_t stream) {
    static int grid = 0;
    if (grid == 0) {
        if (n_in != 25 || out_size != T * DM || ws_size < WS_END) { fprintf(stderr, "kernel_launch: unexpected problem (n_in %d, out %d, ws %zu)\n", n_in, out_size, ws_size); grid = -1; return; }
        int dev = 0, cus = 0, per_cu = 0;
        if (hipGetDevice(&dev) != hipSuccess || hipDeviceGetAttribute(&cus, hipDeviceAttributeMultiprocessorCount, dev) != hipSuccess) { grid = -1; return; }
        if (hipFuncSetAttribute((const void*)fwd_kernel, hipFuncAttributeMaxDynamicSharedMemorySize, LDS_BYTES) != hipSuccess) { fprintf(stderr, "kernel_launch: hipFuncSetAttribute failed\n"); grid = -1; return; }
        if (hipOccupancyMaxActiveBlocksPerMultiprocessor(&per_cu, (const void*)fwd_kernel, NWAVES * 64, LDS_BYTES) != hipSuccess || per_cu < 1) { fprintf(stderr, "kernel_launch: occupancy query says %d\n", per_cu); }
        (void)hipGetLastError();
        grid = cus;
    }
    if (grid < 0) return;
    (void)hipMemsetAsync((char*)d_ws + WS_CTL, 0, CTL_ZERO_BYTES, stream);
    Args a{};
    for (int i = 0; i < 25; ++i) a.in[i] = d_in[i];
    a.out = (float*)d_out; a.ws = (unsigned char*)d_ws;
#if N_LAUNCHES == 1
    a.ph_lo = 0; a.ph_hi = 11;
    hipLaunchKernelGGL(fwd_kernel, dim3(grid), dim3(NWAVES * 64), LDS_BYTES, stream, a);
#else
    for (int p = 0; p < 11; ++p) { a.ph_lo = p; a.ph_hi = p + 1; hipLaunchKernelGGL(fwd_kernel, dim3(grid), dim3(NWAVES * 64), LDS_BYTES, stream, a); }
#endif
}
```

```cpp
#include <hip/hip_runtime.h>
#include <cstdio>
#include <cstdint>

#ifndef PROBE_PHASE
#define PROBE_PHASE -1
#endif
#ifndef N_LAUNCHES
#define N_LAUNCHES 1
#endif

#define LAS __attribute__((address_space(3)))
typedef unsigned short bf16;
typedef short bf16x8 __attribute__((ext_vector_type(8)));
typedef float f32x4 __attribute__((ext_vector_type(4)));
typedef float f32x2 __attribute__((ext_vector_type(2)));
typedef unsigned u32x4 __attribute__((ext_vector_type(4)));
typedef unsigned u32x2 __attribute__((ext_vector_type(2)));
typedef int i32x4 __attribute__((ext_vector_type(4)));
typedef int i32x8 __attribute__((ext_vector_type(8)));

constexpr int NB = 8, SEQ = 2048, DM = 2048, T = NB * SEQ;
constexpr int NIN = 6144, RW = 1024, LW = 1024, NE = 64, EH = 512, TOPK = 8;
constexpr int NR_ROUTED = T * TOPK + NE * 256;
constexpr int NR = NR_ROUTED + T;
constexpr int NWAVES = 8;
constexpr float EPS = 1e-6f;
constexpr float SC_H8 = 16.0f, SC_WEI = 64.0f, SC_ACT = 8.0f, SC_WEO = 4.0f, SC_Y = 32.0f;

constexpr size_t MiB = 1u << 20;
constexpr size_t WS_CTL = 0, CTL_ZERO_BYTES = 2 * MiB;
constexpr size_t WS_MOD = 1 * MiB;
constexpr size_t WS_ROPE = 2 * MiB;
constexpr size_t WS_WIN = 10 * MiB;
constexpr size_t WS_WOUT = 34 * MiB;
constexpr size_t WS_WR = 42 * MiB;
constexpr size_t WS_WA = WS_WR + 256 * 1024;
constexpr size_t WS_WX = WS_WA + 256 * 1024;
constexpr size_t WS_WEI = 44 * MiB;
constexpr size_t WS_H8 = 176 * MiB;
constexpr size_t WS_WEO = 304 * MiB;
constexpr size_t WS_H = 434 * MiB;
constexpr size_t WS_X1 = 500 * MiB;
constexpr size_t WS_EIDX = 628 * MiB;
constexpr size_t WS_WSEL = WS_EIDX + 512 * 1024;
constexpr size_t WS_SLOT = WS_WSEL + 512 * 1024;
constexpr size_t WS_DEST = WS_SLOT + 512 * 1024;
constexpr size_t WS_RTOK = WS_DEST + 512 * 1024;
constexpr size_t WS_RW = WS_RTOK + 640 * 1024;
constexpr size_t WS_AGGA = 632 * MiB;
constexpr size_t WS_AGGB = WS_AGGA + 512 * 1024;
constexpr size_t WS_ACT = 634 * MiB;
constexpr size_t WS_PROJ = 794 * MiB;
constexpr size_t WS_RETO = 986 * MiB;
constexpr size_t WS_HLOC = 1050 * MiB;
constexpr size_t WS_PLOC = 1082 * MiB;
constexpr size_t WS_CAT = 1114 * MiB;
constexpr size_t WS_Y = 794 * MiB;
constexpr size_t WS_TOKOF = 1434 * MiB;
constexpr size_t WS_END = 1438 * MiB;
constexpr int CW_BAR = 4096;
constexpr int CW_CNT = 8192;
constexpr int CW_MODCNT = 16384;

constexpr int RING_BYTES = 131072;
constexpr int LDS_BYTES = 163840;
constexpr int TOKL_OFF = 147456, TOKL_UNITS = 12;
constexpr int TT_OFF = 137216;
constexpr int MISC_OFF = LDS_BYTES - 256;
static_assert(TT_OFF + (2 * 704 + 80 + 68) * 4 <= TOKL_OFF && TOKL_OFF + TOKL_UNITS * 1024 <= MISC_OFF, "LDS map");
constexpr int MAXTILES = 704;

__device__ __forceinline__ unsigned pk2(float lo, float hi) { unsigned r; asm volatile("v_cvt_pk_bf16_f32 %0, %1, %2" : "=v"(r) : "v"(lo), "v"(hi)); return r; }
typedef __bf16 bf16x2_t __attribute__((ext_vector_type(2)));
__device__ __forceinline__ unsigned pk2c(float lo, float hi) { const bf16x2_t r = __builtin_convertvector((f32x2){lo, hi}, bf16x2_t); return __builtin_bit_cast(unsigned, r); }
__device__ __forceinline__ bf16 f2bf(float f) { return __builtin_bit_cast(bf16, (__bf16)f); }
__device__ __forceinline__ float bf2f(bf16 b) { return __uint_as_float(((unsigned)b) << 16); }
__device__ __forceinline__ float bflo(unsigned w) { return __uint_as_float(w << 16); }
__device__ __forceinline__ float bfhi(unsigned w) { return __uint_as_float(w & 0xffff0000u); }
__device__ __forceinline__ float wave_sum(float v) {
#pragma unroll
    for (int o = 1; o < 64; o <<= 1) v += __shfl_xor(v, o);
    return v;
}
__device__ __forceinline__ float sigmoidf_(float x) { return __builtin_amdgcn_rcpf(1.0f + __expf(-x)); }
__device__ __forceinline__ float siluf_(float x) { return x * __builtin_amdgcn_rcpf(1.0f + __expf(-x)); }
__device__ __forceinline__ float gelu_tanh_(float x) { const float u = 0.7978845608028654f * (x + 0.044715f * x * x * x); const float e = __expf(2.0f * u); const float th = 1.0f - 2.0f * __builtin_amdgcn_rcpf(e + 1.0f); return 0.5f * x * (1.0f + th); }
__device__ __forceinline__ unsigned ld_agent(const unsigned* p) { return __hip_atomic_load(p, __ATOMIC_RELAXED, __HIP_MEMORY_SCOPE_AGENT); }
__device__ __forceinline__ int ld_agent_i(const int* p) { return (int)__hip_atomic_load((const unsigned*)p, __ATOMIC_RELAXED, __HIP_MEMORY_SCOPE_AGENT); }
__device__ __forceinline__ float clamp448(float x) { return __builtin_amdgcn_fmed3f(x, -448.0f, 448.0f); }
__device__ __forceinline__ unsigned pk4_fp8(float a, float b, float c, float d) { int w = 0; w = __builtin_amdgcn_cvt_pk_fp8_f32(clamp448(a), clamp448(b), w, false); w = __builtin_amdgcn_cvt_pk_fp8_f32(clamp448(c), clamp448(d), w, true); return (unsigned)w; }
#define LDS_WAIT() asm volatile("s_waitcnt lgkmcnt(0)" ::: "memory")
#define VM_WAIT() asm volatile("s_waitcnt vmcnt(0)" ::: "memory")

#define XB_TMO      128
#define XB_XCNT(j)  (256  + 64 * (j))
#define XB_XSUB(j)  (1280 + 64 * (j))
#define XB_XGEN(j)  (2304 + 64 * (j))
#define XB_TOP      3328
#define XB_TOPGEN   3392
#define XCD_BAR_WORDS 3456
#define XB_SPIN_CAP (1u << 18)
__device__ __forceinline__ unsigned xb_ld(unsigned* p)              { return __hip_atomic_load(p, __ATOMIC_RELAXED, __HIP_MEMORY_SCOPE_AGENT); }
__device__ __forceinline__ unsigned xb_add(unsigned* p, unsigned v) { return __hip_atomic_fetch_add(p, v, __ATOMIC_RELAXED, __HIP_MEMORY_SCOPE_AGENT); }
__device__ __forceinline__ unsigned xb_xcc_id() { return (unsigned)__builtin_amdgcn_s_getreg((3 << 11) | 20) & 0xFu; }
#define XB_SPIN(cond, bar) do { unsigned _sp = 0; while (cond) { __builtin_amdgcn_s_sleep(1); \
    if ((++_sp & 255u) == 0u) { if (xb_ld(&(bar)[XB_TMO])) break; if (_sp > XB_SPIN_CAP) { atomicAdd(&(bar)[XB_TMO], 1u); break; } } } } while (0)
struct XcdBarrier { unsigned* bar; unsigned x; volatile LAS unsigned* st; };
__device__ __forceinline__ XcdBarrier xcd_barrier_post(unsigned* bar, volatile LAS unsigned* st) {
    XcdBarrier b; b.bar = bar; b.x = xb_xcc_id(); b.st = st;
    if (threadIdx.x == 0) (void)xb_add(&bar[XB_XCNT(b.x)], 1u);
    return b;
}
__device__ __forceinline__ void xcd_barrier_complete(unsigned* bar, unsigned x, unsigned& nloc, unsigned& nx) {
    const unsigned G = gridDim.x * gridDim.y * gridDim.z;
    unsigned sum, cnt, mine, sp = 0u;
    for (;;) {
        sum = 0u; cnt = 0u; mine = 0u;
#pragma unroll
        for (unsigned j = 0; j < 16; ++j) { const unsigned c = xb_ld(&bar[XB_XCNT(j)]); sum += c; cnt += (c > 0u) ? 1u : 0u; mine = (j == x) ? c : mine; }
        if (sum == G) break;
        __builtin_amdgcn_s_sleep(1);
        if ((++sp & 255u) == 0u) { if (xb_ld(&bar[XB_TMO])) break; if (sp > XB_SPIN_CAP) { atomicAdd(&bar[XB_TMO], 1u); break; } }
    }
    nloc = mine > 0u ? mine : 1u; nx = cnt > 0u ? cnt : 1u;
}
__device__ __forceinline__ void xcd_barrier(const XcdBarrier& b) {
    asm volatile("s_waitcnt vmcnt(0)" ::: "memory");
    __syncthreads();
    if (threadIdx.x == 0) {
        unsigned* bar = b.bar;
        __builtin_amdgcn_s_waitcnt(0);
        unsigned nloc = b.st[0], nx = b.st[1];
        if (nloc == 0u) { xcd_barrier_complete(bar, b.x, nloc, nx); b.st[0] = nloc; b.st[1] = nx; }
        const unsigned old = xb_add(&bar[XB_XSUB(b.x)], 1u);
        const unsigned gen = old / nloc;
        if (old + 1u == (gen + 1u) * nloc) {
            __builtin_amdgcn_fence(__ATOMIC_RELEASE, "agent");
            asm volatile("s_waitcnt vmcnt(0)" ::: "memory");
            const unsigned og = xb_add(&bar[XB_TOP], 1u);
            const unsigned tg = og / nx;
            if (og + 1u == (tg + 1u) * nx) xb_add(&bar[XB_TOPGEN], 1u);
            else XB_SPIN(xb_ld(&bar[XB_TOPGEN]) == tg, bar);
            __builtin_amdgcn_fence(__ATOMIC_ACQUIRE, "agent");
            xb_add(&bar[XB_XGEN(b.x)], 1u);
            asm volatile("s_waitcnt vmcnt(0)" ::: "memory");
        } else {
            XB_SPIN(xb_ld(&bar[XB_XGEN(b.x)]) == gen, bar);
            __builtin_amdgcn_fence(__ATOMIC_ACQUIRE, "agent");
            asm volatile("s_waitcnt vmcnt(0)" ::: "memory");
        }
    }
    __syncthreads();
}

namespace g8 {
constexpr int BM = 256, BK = 64, HALF = 128, HTB = HALF * BK * 2, NXCD = 8, WGM = 8;
__device__ __forceinline__ int lds_byte(int r, int c) { const int st = (r >> 4) * 2 + (c >> 5), rr = r & 15, cc = c & 31, ob = rr * 64 + cc * 2; return st * 1024 + (ob ^ (((ob >> 9) & 1) << 5)); }
__device__ __forceinline__ void stage_rc(int b, int& R, int& C) { const int st = b / 1024, sb = b % 1024, swz = sb ^ (((sb >> 9) & 1) << 5); R = (st >> 1) * 16 + swz / 64; C = (st & 1) * 32 + (swz % 64) / 2; }
__device__ __forceinline__ int perm32(int rho) { const int n = rho >> 4, i = rho & 15; return 8 * (i >> 2) + 4 * n + (i & 3); }

struct Unit { const char* A; const char* B; unsigned vA0[2], vA1[2]; int r0, pn, e, rend; };

template <class Epi, class Sched, bool F8 = false>
__device__ __forceinline__ void gemm_phase(LAS unsigned char* lds, const int pitch, const Sched& S, const Epi& E) {
    const int tid = threadIdx.x, wid = __builtin_amdgcn_readfirstlane(tid >> 6), lane = tid & 63, wr = wid >> 2, wc = wid & 3, fr = lane & 15, fq = lane >> 4;
    const int nt = pitch / 128;
    unsigned voffB[2], voffB1[2];
#pragma unroll
    for (int i = 0; i < 2; ++i) { int R, C; stage_rc(tid * 16 + i * 8192, R, C); const int p = perm32(R & 31);
        if constexpr (Epi::P16) { const int base = 64 * (R >> 5) + 16 * (p >> 3) + (p & 7); voffB[i] = (unsigned)(base * pitch + C * 2); voffB1[i] = (unsigned)((base + 8) * pitch + C * 2); }
        else { const int Rb = Epi::PERM ? ((R & ~31) + p) : R; voffB[i] = (unsigned)(Rb * pitch + C * 2); voffB1[i] = voffB[i] + (unsigned)(HALF * pitch); } }
    const size_t kstep = 128;
    const size_t hstepB = (size_t)HALF * pitch;
    const unsigned ldsw = (unsigned)wid * 1024u;
    const int aoff = lds_byte(wr * 64 + fr, fq * 8), boff = lds_byte(wc * 32 + fr, fq * 8);
#define G8_SA(b, h) (((b) * 2 + (h)) * HTB)
#define G8_SB(b, h) ((4 + (b) * 2 + (h)) * HTB)
#define G8_STAGE(bufoff, gbase, voff) do { _Pragma("unroll") for (int _i = 0; _i < 2; ++_i) \
        __builtin_amdgcn_global_load_lds((const unsigned*)((const char*)(gbase) + (voff)[_i]), (LAS unsigned*)(lds + (bufoff) + ldsw + _i * 8192), 16, 0, 0); } while (0)
#define G8_LDA(dst, b, h) do { _Pragma("unroll") for (int m = 0; m < 4; ++m) _Pragma("unroll") for (int k = 0; k < 2; ++k) dst[m][k] = *(const LAS bf16x8*)(lds + G8_SA(b, h) + aoff + m * 2048 + k * 1024); } while (0)
#define G8_LDB(dst, b, h) do { _Pragma("unroll") for (int n = 0; n < 2; ++n) _Pragma("unroll") for (int k = 0; k < 2; ++k) dst[n][k] = *(const LAS bf16x8*)(lds + G8_SB(b, h) + boff + n * 2048 + k * 1024); } while (0)
#define G8_CAT(x) __builtin_shufflevector(__builtin_bit_cast(i32x4, x[0]), __builtin_bit_cast(i32x4, x[1]), 0, 1, 2, 3, 4, 5, 6, 7)
#define G8_MMA(ai, bj, At, Bt) do { __builtin_amdgcn_s_setprio(1); _Pragma("unroll") for (int m = 0; m < 4; ++m) _Pragma("unroll") for (int n = 0; n < 2; ++n) { \
        if constexpr (F8) acc[ai][bj][m][n] = __builtin_amdgcn_mfma_scale_f32_16x16x128_f8f6f4(G8_CAT(Bt[n]), G8_CAT(At[m]), acc[ai][bj][m][n], 0, 0, 0, 0x7f7f7f7f, 0, 0x7f7f7f7f); \
        else { _Pragma("unroll") for (int k = 0; k < 2; ++k) acc[ai][bj][m][n] = __builtin_amdgcn_mfma_f32_16x16x32_bf16(Bt[n][k], At[m][k], acc[ai][bj][m][n], 0, 0, 0); } } \
        __builtin_amdgcn_s_setprio(0); } while (0)
#define G8_WAIT_V(n) asm volatile("s_waitcnt vmcnt(" #n ")" ::: "memory")
#define G8_WAIT_L(n) asm volatile("s_waitcnt lgkmcnt(" #n ")" ::: "memory")
#define G8_BAR __builtin_amdgcn_s_barrier()
#define G8_SCHED __builtin_amdgcn_sched_barrier(0)
    Unit cur, nxt; int ui = 0;
    if (!S.next(0, cur)) return;
    f32x4 acc[2][2][4][2];
#pragma unroll
    for (int a = 0; a < 2; ++a)
#pragma unroll
        for (int b = 0; b < 2; ++b)
#pragma unroll
            for (int m = 0; m < 4; ++m)
#pragma unroll
                for (int n = 0; n < 2; ++n) acc[a][b][m][n] = (f32x4){0.f, 0.f, 0.f, 0.f};
    bf16x8 At[4][2], B0[2][2], B1[2][2];
    const char* cA = cur.A; const char* cB = cur.B;
    G8_STAGE(G8_SB(0, 0), cB, voffB); G8_STAGE(G8_SB(0, 1), cB, voffB1); G8_STAGE(G8_SA(0, 0), cA, cur.vA0); G8_STAGE(G8_SA(0, 1), cA, cur.vA1);
    if (wr == 1) G8_BAR;
    G8_WAIT_V(2); G8_BAR;
    G8_STAGE(G8_SB(1, 0), cB + kstep, voffB); G8_STAGE(G8_SA(1, 0), cA + kstep, cur.vA0); G8_STAGE(G8_SB(1, 1), cB + kstep, voffB1);
    G8_WAIT_V(6); G8_BAR;
    for (;;) {
        const bool has_next = S.next(ui + 1, nxt);
        if (!has_next) nxt = cur;
        const char* nA = nxt.A; const char* nB = nxt.B;
#pragma unroll 1
        for (int t = 0; t < nt; t += 2) {
            const bool last = (t == nt - 2);
            const char* a1 = cA + (size_t)(t + 1) * kstep;
            const char* a2 = last ? nA : cA + (size_t)(t + 2) * kstep; const char* b2 = last ? nB : cB + (size_t)(t + 2) * kstep;
            const char* a3 = a2 + kstep; const char* b3 = b2 + kstep;
            G8_LDB(B0, 0, 0); G8_LDB(B1, 0, 1); G8_SCHED; G8_LDA(At, 0, 0); G8_STAGE(G8_SA(1, 1), a1, cur.vA1);
            if (last) { cur.vA0[0] = nxt.vA0[0]; cur.vA0[1] = nxt.vA0[1]; cur.vA1[0] = nxt.vA1[0]; cur.vA1[1] = nxt.vA1[1]; }
            G8_WAIT_V(8); G8_WAIT_L(0); G8_BAR; G8_MMA(0, 0, At, B0); G8_MMA(0, 1, At, B1); G8_BAR; G8_SCHED;
            G8_LDA(At, 0, 1); G8_STAGE(G8_SB(0, 0), b2, voffB); G8_STAGE(G8_SB(0, 1), b2, voffB1); G8_STAGE(G8_SA(0, 0), a2, cur.vA0);
            G8_WAIT_V(8); G8_WAIT_L(0); G8_BAR; G8_MMA(1, 0, At, B0); G8_MMA(1, 1, At, B1); G8_BAR; G8_SCHED;
            G8_LDB(B0, 1, 0); G8_LDB(B1, 1, 1); G8_SCHED; G8_LDA(At, 1, 0); G8_STAGE(G8_SA(0, 1), a2, cur.vA1);
            G8_WAIT_V(8); G8_WAIT_L(0); G8_BAR; G8_MMA(0, 0, At, B0); G8_MMA(0, 1, At, B1); G8_BAR; G8_SCHED;
            G8_LDA(At, 1, 1); G8_STAGE(G8_SB(1, 0), b3, voffB); G8_STAGE(G8_SB(1, 1), b3, voffB1); G8_STAGE(G8_SA(1, 0), a3, cur.vA0);
            G8_WAIT_V(8); G8_WAIT_L(0); G8_BAR; G8_MMA(1, 0, At, B0); G8_MMA(1, 1, At, B1); G8_BAR; G8_SCHED;
        }
        if (wr == 0) G8_BAR;
        E(acc, cur, wr, wc, fr, fq);
        if (!has_next) break;
#pragma unroll
        for (int a = 0; a < 2; ++a)
#pragma unroll
            for (int b = 0; b < 2; ++b)
#pragma unroll
                for (int m = 0; m < 4; ++m)
#pragma unroll
                    for (int n = 0; n < 2; ++n) acc[a][b][m][n] = (f32x4){0.f, 0.f, 0.f, 0.f};
        cur = nxt; cA = nA; cB = nB; ++ui;
        if (wr == 1) G8_BAR;
    }
    G8_WAIT_V(0);
    G8_BAR;
#undef G8_SA
#undef G8_SB
#undef G8_STAGE
#undef G8_LDA
#undef G8_CAT
#undef G8_LDB
#undef G8_MMA
#undef G8_WAIT_V
#undef G8_WAIT_L
#undef G8_BAR
#undef G8_SCHED
}

struct DenseOrder {
    const char* A; const char* Bt; int pitch; int nM, nN, nwg, G, c;
    __device__ void init(const void* A_, const void* Bt_, int M, int N, int pitch_, int G_, int c_) { A = (const char*)A_; Bt = (const char*)Bt_; pitch = pitch_; nM = M / BM; nN = N / BM; nwg = nM * nN; G = G_; c = c_; }
    __device__ __forceinline__ bool next(int i, Unit& u) const {
        const long L = (long)i * G + c; if (L >= nwg) return false;
        int R[2], C[2]; stage_rc((int)threadIdx.x * 16, R[0], C[0]); stage_rc((int)threadIdx.x * 16 + 8192, R[1], C[1]);
        int wgid = (int)L; { const int q = nwg / NXCD, r = nwg % NXCD, xcd = wgid % NXCD, off = wgid / NXCD; wgid = (xcd < r ? xcd * (q + 1) : r * (q + 1) + (xcd - r) * q) + off; }
        const int nig = WGM * nN, gid = wgid / nig, fm = gid * WGM, gsz = (nM - fm) < WGM ? (nM - fm) : WGM;
        const int pm = fm + ((wgid % nig) % gsz), pn = (wgid % nig) / gsz;
        u.A = A + (size_t)pm * BM * pitch; u.B = Bt + (size_t)pn * BM * pitch;
#pragma unroll
        for (int j = 0; j < 2; ++j) { u.vA0[j] = (unsigned)(R[j] * pitch + C[j] * 2); u.vA1[j] = (unsigned)((R[j] + HALF) * pitch + C[j] * 2); }
        u.r0 = pm * BM; u.pn = pn; u.e = 0; u.rend = 0; return true;
    }
};
}

struct Args { const void* in[25]; float* out; unsigned char* ws; int ph_lo, ph_hi; };
struct Ctx {
    LAS unsigned char* lds; unsigned char* ws; const void* const* in; float* out;
    int tid, lane, wave, vcu, G;
};

__device__ __forceinline__ void p0_adaln(Ctx& F) {
    LAS float* sc = (LAS float*)F.lds;
    LAS float* red = (LAS float*)(F.lds + 65536);
    const float* cvec = (const float*)F.in[1]; const float* wada = (const float*)F.in[3]; const float* bada = (const float*)F.in[4]; float* mod = (float*)(F.ws + WS_MOD);
    __syncthreads();
    for (int i = F.tid; i < NB * DM; i += NWAVES * 64) sc[i] = siluf_(cvec[i]);
    __syncthreads();
    for (int cb = F.vcu; cb < 6 * DM / 48; cb += F.G) {
        const int n0 = cb * 48, l = F.lane < 48 ? F.lane : 47, k0 = F.wave * 256;
        float acc[8];
#pragma unroll
        for (int b = 0; b < 8; ++b) acc[b] = 0.f;
        const float* col = wada + (size_t)k0 * (6 * DM) + n0 + l;
#pragma unroll 1
        for (int kk = 0; kk < 256; kk += 32) { float wv[32];
#pragma unroll
            for (int u = 0; u < 32; ++u) wv[u] = col[(size_t)(kk + u) * (6 * DM)];
#pragma unroll
            for (int u = 0; u < 32; ++u)
#pragma unroll
                for (int b = 0; b < 8; ++b) acc[b] += sc[b * DM + k0 + kk + u] * wv[u]; }
        if (F.lane < 48) {
#pragma unroll
            for (int b = 0; b < 8; ++b) red[(F.wave * 8 + b) * 48 + F.lane] = acc[b]; }
        __syncthreads();
        if (F.tid < 384) { const int b = F.tid / 48, cc = F.tid % 48; float s = bada[n0 + cc];
#pragma unroll
            for (int w = 0; w < 8; ++w) s += red[(w * 8 + b) * 48 + cc];
            __hip_atomic_store(mod + (size_t)b * 6 * DM + n0 + cc, s, __ATOMIC_RELAXED, __HIP_MEMORY_SCOPE_AGENT); }
        VM_WAIT();
        __syncthreads();
    }
    if (F.tid == 0) __hip_atomic_fetch_add((unsigned*)(F.ws + WS_CTL) + CW_MODCNT, 1u, __ATOMIC_RELAXED, __HIP_MEMORY_SCOPE_AGENT);
}
__device__ __forceinline__ void p0_wait_mod(Ctx& F) {
    if (F.tid == 0) { unsigned* ctl = (unsigned*)(F.ws + WS_CTL); unsigned sp = 0u;
        while (ld_agent(ctl + CW_MODCNT) < (unsigned)F.G) { __builtin_amdgcn_s_sleep(2); if (++sp > (1u << 20)) { atomicAdd(ctl + CW_BAR + XB_TMO, 1u); break; } }
        __builtin_amdgcn_fence(__ATOMIC_ACQUIRE, "agent");
        asm volatile("s_waitcnt vmcnt(0)" ::: "memory"); }
    __syncthreads();
}
template <bool F8>
__device__ __forceinline__ void p0_transpose_item(const float* W, int K, int N, void* WT, int out_row0, int k0, int n0, float scale, LAS float* scr, int lane) {
    f32x4 v[16];
#pragma unroll
    for (int i = 0; i < 16; ++i) v[i] = *(const f32x4*)(W + (size_t)(k0 + 4 * i + (lane >> 4)) * N + n0 + 4 * (lane & 15));
#pragma unroll
    for (int i = 0; i < 16; ++i) { LAS float* d = scr + (4 * i + (lane >> 4)) * 65 + 4 * (lane & 15); d[0] = v[i].x; d[1] = v[i].y; d[2] = v[i].z; d[3] = v[i].w; }
    LDS_WAIT(); asm volatile("" ::: "memory");
    if (!F8) {
        const int c = lane & 7;
#pragma unroll
        for (int j = 0; j < 8; ++j) { const int n = (lane >> 3) + 8 * j; const LAS float* s = scr + (8 * c) * 65 + n;
            u32x4 o; o.x = pk2(s[0 * 65], s[1 * 65]); o.y = pk2(s[2 * 65], s[3 * 65]); o.z = pk2(s[4 * 65], s[5 * 65]); o.w = pk2(s[6 * 65], s[7 * 65]);
            *(u32x4*)((bf16*)WT + (size_t)(out_row0 + n) * K + k0 + 8 * c) = o; }
    } else {
        const int c = lane & 3;
#pragma unroll
        for (int j = 0; j < 4; ++j) { const int n = (lane >> 2) + 16 * j; const LAS float* s = scr + (16 * c) * 65 + n; int o[4];
#pragma unroll
            for (int q = 0; q < 4; ++q) { int wv = 0; wv = __builtin_amdgcn_cvt_pk_fp8_f32(s[(4 * q) * 65] * scale, s[(4 * q + 1) * 65] * scale, wv, false); wv = __builtin_amdgcn_cvt_pk_fp8_f32(s[(4 * q + 2) * 65] * scale, s[(4 * q + 3) * 65] * scale, wv, true); o[q] = wv; }
            *(u32x4*)((unsigned char*)WT + (size_t)(out_row0 + n) * K + k0 + 16 * c) = (u32x4){(unsigned)o[0], (unsigned)o[1], (unsigned)o[2], (unsigned)o[3]}; }
    }
    LDS_WAIT(); asm volatile("" ::: "memory");
}
struct CvItem { const float* src; unsigned char* dst; int N, K; float scale; };
__device__ __forceinline__ CvItem cv_decode(const void* const* in, unsigned char* ws, int r) {
    constexpr int I_EI = 32 * 16, I_EO = 8 * 32; CvItem c;
    if (r < 65 * I_EI) { const int e = r / I_EI, q = r % I_EI, kb = q / 16, nb = q % 16, n0 = 64 * nb, j = n0 & 511, up = n0 >> 9;
        const float* W = (e < 64) ? (const float*)in[20] + (size_t)e * DM * 1024 : (const float*)in[22];
        c.src = W + (size_t)(64 * kb) * 1024 + n0; c.N = 1024; c.K = DM; c.scale = SC_WEI;
        c.dst = ws + WS_WEI + (size_t)e * 1024 * DM + (size_t)((j >> 7) * 256 + up * 128 + (j & 127)) * DM + 64 * kb; }
    else { r -= 65 * I_EI; const int e = r / I_EO, q = r % I_EO, kb = q / 32, nb = q % 32;
        const float* W = (e < 64) ? (const float*)in[21] + (size_t)e * EH * DM : (const float*)in[23];
        c.src = W + (size_t)(64 * kb) * DM + 64 * nb; c.N = DM; c.K = EH; c.scale = SC_WEO;
        c.dst = ws + WS_WEO + (size_t)e * DM * EH + (size_t)(64 * nb) * EH + 64 * kb; }
    return c;
}
__device__ __forceinline__ void p2_convert_experts(Ctx& F) {
    const int gw = F.vcu * NWAVES + F.wave, NGW = F.G * NWAVES, lane = F.lane, li = lane & 15, lg = lane >> 4;
    constexpr int NCV = 65 * (32 * 16 + 8 * 32);
    int it = gw; CvItem cur; f32x4 v[16];
    const int krow = 16 * (li >> 2) + (li & 3);
#define CV_LOAD(c) do { _Pragma("unroll") for (int nh = 0; nh < 2; ++nh) _Pragma("unroll") for (int q = 0; q < 4; ++q) { const float* p_ = (c).src + (size_t)(krow + 4 * q) * (c).N + 32 * nh + 8 * lg; \
        v[(nh * 4 + q) * 2] = *(const f32x4*)p_; v[(nh * 4 + q) * 2 + 1] = *(const f32x4*)(p_ + 4); } } while (0)
    if (it < NCV) { cur = cv_decode(F.in, F.ws, it); CV_LOAD(cur); }
    while (it < NCV) {
        bf16x8 a[2][4];
#pragma unroll
        for (int nh = 0; nh < 2; ++nh)
#pragma unroll
            for (int q = 0; q < 4; ++q) { const f32x4 lo = v[(nh * 4 + q) * 2], hi = v[(nh * 4 + q) * 2 + 1];
                const u32x4 pk = (u32x4){pk2c(lo.x, lo.y), pk2c(lo.z, lo.w), pk2c(hi.x, hi.y), pk2c(hi.z, hi.w)}; a[nh][q] = __builtin_bit_cast(bf16x8, pk); }
        const CvItem me = cur; const int nit = it + NGW;
        if (nit < NCV) { cur = cv_decode(F.in, F.ws, nit); CV_LOAD(cur); }
        const unsigned sbits = (unsigned)f2bf(me.scale);
#pragma unroll
        for (int h = 0; h < 2; ++h) {
            u32x4 sel = (u32x4){0u, 0u, 0u, 0u}; { const int d = 16 * h + li - 8 * lg; if (d >= 0 && d < 8) { const unsigned wv = (d & 1) ? (sbits << 16) : sbits; if ((d >> 1) == 0) sel.x = wv; else if ((d >> 1) == 1) sel.y = wv; else if ((d >> 1) == 2) sel.z = wv; else sel.w = wv; } }
            const bf16x8 bs = __builtin_bit_cast(bf16x8, sel);
#pragma unroll
            for (int nh = 0; nh < 2; ++nh) { unsigned o[4];
#pragma unroll
                for (int q = 0; q < 4; ++q) { const f32x4 d = __builtin_amdgcn_mfma_f32_16x16x32_bf16(a[nh][q], bs, (f32x4){0.f, 0.f, 0.f, 0.f}, 0, 0, 0); o[q] = pk4_fp8(d[0], d[1], d[2], d[3]); }
                *(u32x4*)(me.dst + (size_t)(32 * nh + 16 * h + li) * me.K + 16 * lg) = (u32x4){o[0], o[1], o[2], o[3]}; }
        }
        it = nit;
    }
#undef CV_LOAD
}
__device__ __forceinline__ void p0_prologue(Ctx& F) {
    LAS float* scr = (LAS float*)(F.lds + F.wave * 16640);
    const int gw = F.vcu * NWAVES + F.wave, NGW = F.G * NWAVES, lane = F.lane;
    unsigned char* ws = F.ws;
    constexpr int I_IN = 32 * 96, I_OUT = 32 * 32, I_R = 32 * 1, I_G = 2 * 2;
    constexpr int NTR = I_IN + I_OUT + I_R + 16 * I_G;
    for (int it = gw; it < NTR; it += NGW) {
        int r = it;
        if (r < I_IN) { const int kb = r / 96, nb = r % 96; p0_transpose_item<false>((const float*)F.in[6], DM, NIN, ws + WS_WIN, 64 * nb, 64 * kb, 64 * nb, 1.f, scr, lane); continue; } r -= I_IN;
        if (r < I_OUT) { const int kb = r / 32, nb = r % 32; p0_transpose_item<false>((const float*)F.in[16], DM, DM, ws + WS_WOUT, 64 * nb, 64 * kb, 64 * nb, 1.f, scr, lane); continue; } r -= I_OUT;
        if (r < I_R) { const int kb = r; p0_transpose_item<false>((const float*)F.in[18], DM, NE, ws + WS_WR, 0, 64 * kb, 0, 1.f, scr, lane); continue; } r -= I_R;
        { const int m = r / I_G, q = r % I_G, kb = q / 2, nb = q % 2, g = m & 7;
          const float* W = ((m < 8) ? (const float*)F.in[9] : (const float*)F.in[11]) + (size_t)g * 128 * 128;
          p0_transpose_item<false>(W, 128, 128, (bf16*)(ws + (m < 8 ? WS_WA : WS_WX)) + (size_t)g * 128 * 128, 64 * nb, 64 * kb, 64 * nb, 1.f, scr, lane); }
    }
    {
        const int* pos = (const int*)F.in[2]; unsigned* rt = (unsigned*)(ws + WS_ROPE);
        for (int it = gw; it < T * 64 / 512; it += NGW) {
#pragma unroll 1
            for (int q = 0; q < 8; ++q) { const int idx = it * 512 + q * 64 + lane, t = idx >> 6, i = idx & 63;
                const double inv = exp(-9.210340371976184 * (double)i / 64.0); const double ang = (double)pos[t] * inv; double sn, cs; sincos(ang, &sn, &cs);
                rt[idx] = pk2c((float)cs, (float)sn); }
        }
    }
    if (gw == 0) { u32x4* z = (u32x4*)((bf16*)(ws + WS_H) + (size_t)T * DM); for (int i = lane; i < DM * 2 / 16; i += 64) z[i] = (u32x4){0u, 0u, 0u, 0u};
        u32x4* z8 = (u32x4*)(ws + WS_H8 + (size_t)T * DM); for (int i = lane; i < DM / 16; i += 64) z8[i] = (u32x4){0u, 0u, 0u, 0u}; }
}

template <bool W8, bool INBF>
__device__ __forceinline__ void norm_mod_row(const void* xrow_, const float* g, const float* sc, const float* sh, bf16* orow, unsigned char* orow8, int lane) {
    f32x4 v[4][2]; float ss = 0.f;
#pragma unroll
    for (int j = 0; j < 4; ++j) {
        if constexpr (INBF) { const u32x4 w = *(const u32x4*)((const bf16*)xrow_ + 8 * lane + 512 * j); v[j][0] = (f32x4){bflo(w.x), bfhi(w.x), bflo(w.y), bfhi(w.y)}; v[j][1] = (f32x4){bflo(w.z), bfhi(w.z), bflo(w.w), bfhi(w.w)}; }
        else { v[j][0] = *(const f32x4*)((const float*)xrow_ + 8 * lane + 512 * j); v[j][1] = *(const f32x4*)((const float*)xrow_ + 8 * lane + 512 * j + 4); }
#pragma unroll
        for (int h = 0; h < 2; ++h) ss += (v[j][h].x * v[j][h].x + v[j][h].y * v[j][h].y) + (v[j][h].z * v[j][h].z + v[j][h].w * v[j][h].w); }
    const float rstd = rsqrtf(wave_sum(ss) * (1.0f / DM) + EPS);
#pragma unroll
    for (int j = 0; j < 4; ++j) { f32x4 o[2];
#pragma unroll
        for (int h = 0; h < 2; ++h) { const int c = 8 * lane + 512 * j + 4 * h; const f32x4 gg = *(const f32x4*)(g + c), s1 = *(const f32x4*)(sc + c), s0 = *(const f32x4*)(sh + c);
            o[h] = (v[j][h] * rstd * gg) * (s1 + 1.0f) + s0; }
        u32x4 w; w.x = pk2(o[0].x, o[0].y); w.y = pk2(o[0].z, o[0].w); w.z = pk2(o[1].x, o[1].y); w.w = pk2(o[1].z, o[1].w);
        *(u32x4*)(orow + 8 * lane + 512 * j) = w;
        if constexpr (W8) { u32x2 w8; w8.x = pk4_fp8(o[0].x * SC_H8, o[0].y * SC_H8, o[0].z * SC_H8, o[0].w * SC_H8); w8.y = pk4_fp8(o[1].x * SC_H8, o[1].y * SC_H8, o[1].z * SC_H8, o[1].w * SC_H8); *(u32x2*)(orow8 + 8 * lane + 512 * j) = w8; } }
}
__device__ __forceinline__ void p1_norm(Ctx& F) {
    const int gw = F.vcu * NWAVES + F.wave, NGW = F.G * NWAVES;
    const float* x = (const float*)F.in[0]; const float* g = (const float*)F.in[5]; const float* mod = (const float*)(F.ws + WS_MOD); bf16* h = (bf16*)(F.ws + WS_H);
    for (int m = gw; m < T; m += NGW) { const int b = m / SEQ; norm_mod_row<false, false>(x + (size_t)m * DM, g, mod + (size_t)b * 6 * DM + DM, mod + (size_t)b * 6 * DM, h + (size_t)m * DM, nullptr, F.lane); }
}

struct EpiProj {
    static constexpr bool PERM = true, P16 = false;
    bf16* O;
    __device__ __forceinline__ void operator()(const f32x4 (&acc)[2][2][4][2], const g8::Unit& u, int wr, int wc, int fr, int fq) const {
        const int row0 = u.r0 + wr * 64 + fr, col0 = u.pn * 256 + wc * 32 + 8 * fq;
#pragma unroll
        for (int ai = 0; ai < 2; ++ai)
#pragma unroll
            for (int m = 0; m < 4; ++m) { bf16* rowp = O + (size_t)(row0 + ai * 128 + m * 16) * NIN + col0;
#pragma unroll
                for (int bj = 0; bj < 2; ++bj) { const f32x4 v0 = acc[ai][bj][m][0], v1 = acc[ai][bj][m][1];
                    u32x4 w; w.x = pk2c(v0[0], v0[1]); w.y = pk2c(v0[2], v0[3]); w.z = pk2c(v1[0], v1[1]); w.w = pk2c(v1[2], v1[3]);
                    *(u32x4*)(rowp + bj * 128) = w; } }
    }
};
struct EpiWout {
    static constexpr bool PERM = true, P16 = false;
    const float* x; const float* mod; bf16* x1;
    __device__ __forceinline__ void operator()(const f32x4 (&acc)[2][2][4][2], const g8::Unit& u, int wr, int wc, int fr, int fq) const {
        const int row0 = u.r0 + wr * 64 + fr, col0 = u.pn * 256 + wc * 32 + 8 * fq; const int b = u.r0 / SEQ;
        const float* gt = mod + (size_t)b * 6 * DM + 2 * DM;
        f32x4 gv[2][2];
#pragma unroll
        for (int bj = 0; bj < 2; ++bj)
#pragma unroll
            for (int n = 0; n < 2; ++n) gv[bj][n] = *(const f32x4*)(gt + col0 + bj * 128 + n * 4);
#pragma unroll
        for (int ai = 0; ai < 2; ++ai)
#pragma unroll
            for (int m = 0; m < 4; ++m) { const size_t off = (size_t)(row0 + ai * 128 + m * 16) * DM + col0;
#pragma unroll
                for (int bj = 0; bj < 2; ++bj) { const f32x4 v0 = *(const f32x4*)(x + off + bj * 128) + gv[bj][0] * acc[ai][bj][m][0], v1 = *(const f32x4*)(x + off + bj * 128 + 4) + gv[bj][1] * acc[ai][bj][m][1];
                    u32x4 w; w.x = pk2(v0[0], v0[1]); w.y = pk2(v0[2], v0[3]); w.z = pk2(v1[0], v1[1]); w.w = pk2(v1[2], v1[3]);
                    *(u32x4*)(x1 + off + bj * 128) = w; }
                asm volatile("" ::: "memory"); }
    }
};
struct EpiSwiglu {
    static constexpr bool PERM = true, P16 = false;
    unsigned char* act;
    __device__ __forceinline__ void operator()(const f32x4 (&acc)[2][2][4][2], const g8::Unit& u, int wr, int wc, int fr, int fq) const {
        const int row0 = u.r0 + wr * 64 + fr, col0 = u.pn * 128 + wc * 32 + 8 * fq;
#pragma unroll
        for (int ai = 0; ai < 2; ++ai)
#pragma unroll
            for (int m = 0; m < 4; ++m) { float o[8];
#pragma unroll
                for (int n = 0; n < 2; ++n)
#pragma unroll
                    for (int j = 0; j < 4; ++j) { const float g = acc[ai][0][m][n][j] * (1.0f / (SC_H8 * SC_WEI)), up = acc[ai][1][m][n][j] * (SC_ACT / (SC_H8 * SC_WEI)); o[4 * n + j] = g * __builtin_amdgcn_rcpf(1.0f + __expf(-g)) * up; }
                u32x2 w; w.x = pk4_fp8(o[0], o[1], o[2], o[3]); w.y = pk4_fp8(o[4], o[5], o[6], o[7]);
                *(u32x2*)(act + (size_t)(row0 + ai * 128 + m * 16) * EH + col0) = w; }
    }
};
struct EpiDown {
    static constexpr bool PERM = true, P16 = true;
    unsigned char* y;
    __device__ __forceinline__ void operator()(const f32x4 (&acc)[2][2][4][2], const g8::Unit& u, int wr, int wc, int fr, int fq) const {
        const int row0 = u.r0 + wr * 64 + fr, col0 = u.pn * 256 + wc * 64 + 16 * fq; constexpr float sc = SC_Y / (SC_ACT * SC_WEO); static_assert(sc == 1.0f, "scales chosen so that y needs no multiply");
#pragma unroll
        for (int ai = 0; ai < 2; ++ai)
#pragma unroll
            for (int m = 0; m < 4; ++m) { u32x4 w;
                { const f32x4 v0 = acc[ai][0][m][0], v1 = acc[ai][0][m][1], v2 = acc[ai][1][m][0], v3 = acc[ai][1][m][1];
                  w.x = pk4_fp8(v0[0], v0[1], v0[2], v0[3]); w.y = pk4_fp8(v1[0], v1[1], v1[2], v1[3]); w.z = pk4_fp8(v2[0], v2[1], v2[2], v2[3]); w.w = pk4_fp8(v3[0], v3[1], v3[2], v3[3]); }
                *(u32x4*)(y + (size_t)(row0 + ai * 128 + m * 16) * DM + col0) = w; }
    }
};

struct MoeTables { LAS int* row0; LAS int* te; LAS int* pend; LAS int* tp; };
__device__ __forceinline__ MoeTables moe_tables(Ctx& F) { MoeTables M; M.row0 = (LAS int*)(F.lds + TT_OFF); M.te = M.row0 + MAXTILES; M.pend = M.te + MAXTILES; M.tp = M.pend + 80; return M; }
__device__ __forceinline__ int moe_build_tables(Ctx& F) {
    MoeTables M = moe_tables(F);
    const unsigned* cnt = (const unsigned*)(F.ws + WS_CTL) + CW_CNT;
    __syncthreads();
    if (F.tid < NE) M.row0[F.tid] = (int)ld_agent(cnt + 32 * F.tid);
    __syncthreads();
    if (F.tid == 0) { int tiles = 0;
        for (int e = 0; e < NE; ++e) { const int c = M.row0[e]; M.tp[e] = tiles; M.pend[e] = tiles * 256 + c; tiles += (c + 255) >> 8; }
        M.tp[NE] = NR_ROUTED / 256; M.pend[NE] = NR; M.tp[NE + 1] = NR_ROUTED / 256 + T / 256; M.tp[NE + 2] = tiles; }
    __syncthreads();
    const int rt = M.tp[NE + 2];
    for (int tau = F.tid; tau < rt; tau += NWAVES * 64) { int e = 0; while (e + 1 < NE && M.tp[e + 1] <= tau) ++e; M.te[tau] = e; M.row0[tau] = tau * 256; }
    for (int s = F.tid; s < T / 256; s += NWAVES * 64) { M.te[rt + s] = NE; M.row0[rt + s] = NR_ROUTED + s * 256; }
    __syncthreads();
    return rt + T / 256;
}
template <int PHASE>
struct MoeOrder {
    MoeTables M; const char* A; const char* W; const int* row_tok; LAS unsigned char* lds_tok; int U, CH, x, j;
    static constexpr int NPN = (PHASE == 1) ? 4 : 8;
    __device__ void init(Ctx& F, int ntiles) { M = moe_tables(F); U = ntiles * NPN; CH = (U + 7) / 8; x = F.vcu / (F.G / 8); j = F.vcu % (F.G / 8);
        A = (const char*)(F.ws + (PHASE == 1 ? WS_H8 : WS_ACT)); W = (const char*)(F.ws + (PHASE == 1 ? WS_WEI : WS_WEO)); row_tok = (const int*)(F.ws + WS_TOKOF); lds_tok = F.lds + TOKL_OFF; }
    __device__ __forceinline__ void fill_tokens(Ctx& F) const {
        for (int i = 0; i < TOKL_UNITS; ++i) { const int q = i * 32 + j; const int L = x * CH + q; if (q >= CH || L >= U) break;
            const int tile = L / NPN; const int e = M.te[tile], r0 = M.row0[tile], rend = M.pend[e];
            if (F.tid < 256) { const int ra = r0 + F.tid; int tk;
                if (e == NE) tk = ra - NR_ROUTED; else tk = (ra < rend) ? ld_agent_i(row_tok + (size_t)e * T + (ra - M.tp[e] * 256)) : T;
                ((LAS int*)lds_tok)[i * 256 + F.tid] = tk; } }
        __syncthreads();
    }
    __device__ __forceinline__ bool next(int i, g8::Unit& u) const {
        const int q = i * 32 + j; const int L = x * CH + q; if (q >= CH || L >= U) return false;
        int R[2], C[2]; g8::stage_rc((int)threadIdx.x * 16, R[0], C[0]); g8::stage_rc((int)threadIdx.x * 16 + 8192, R[1], C[1]);
        const int tile = L / NPN, pn = L % NPN;
        const int e = __builtin_amdgcn_readfirstlane(M.te[tile]), r0 = __builtin_amdgcn_readfirstlane(M.row0[tile]), rend = __builtin_amdgcn_readfirstlane(M.pend[e]);
        u.r0 = r0; u.pn = pn; u.e = e; u.rend = rend; u.A = A;
        if (PHASE == 1) {
            u.B = W + ((size_t)e * 1024 + (size_t)pn * 256) * DM;
#pragma unroll
            for (int k = 0; k < 2; ++k) { const int ra = r0 + R[k], rb = ra + 128; int ta, tb;
                if (e == NE) { ta = ra - NR_ROUTED; tb = rb - NR_ROUTED; }
                else { const LAS int* tl = (const LAS int*)(lds_tok) + (i % TOKL_UNITS) * 256; ta = tl[R[k]]; tb = tl[R[k] + 128]; }
                u.vA0[k] = (unsigned)(ta * DM + C[k] * 2); u.vA1[k] = (unsigned)(tb * DM + C[k] * 2); }
        } else {
            u.B = W + ((size_t)e * DM + (size_t)pn * 256) * EH;
#pragma unroll
            for (int k = 0; k < 2; ++k) { u.vA0[k] = (unsigned)((r0 + R[k]) * EH + C[k] * 2); u.vA1[k] = (unsigned)((r0 + R[k] + 128) * EH + C[k] * 2); }
        }
        asm volatile("" : "+v"(u.vA0[0]), "+v"(u.vA0[1]), "+v"(u.vA1[0]), "+v"(u.vA1[1]));
        return true;
    }
};

__device__ __forceinline__ bf16x8 tr_pair(unsigned a0, unsigned a1) { u32x2 r0, r1; asm volatile("ds_read_b64_tr_b16 %0, %2\n\tds_read_b64_tr_b16 %1, %3\n\ts_waitcnt lgkmcnt(0)" : "=&v"(r0), "=&v"(r1) : "v"(a0), "v"(a1) : "memory"); return __builtin_bit_cast(bf16x8, (u32x4){r0.x, r0.y, r1.x, r1.y}); }
__device__ __forceinline__ void tr_quad(bf16x8 (&o)[4], unsigned a0, unsigned a1, unsigned a2, unsigned a3, unsigned d1) {
    u32x2 r0, r1, r2, r3, r4, r5, r6, r7; const unsigned b0 = a0 + d1, b1 = a1 + d1, b2 = a2 + d1, b3 = a3 + d1;
    asm volatile("ds_read_b64_tr_b16 %0, %8\n\tds_read_b64_tr_b16 %1, %9\n\tds_read_b64_tr_b16 %2, %10\n\tds_read_b64_tr_b16 %3, %11\n\tds_read_b64_tr_b16 %4, %12\n\tds_read_b64_tr_b16 %5, %13\n\tds_read_b64_tr_b16 %6, %14\n\tds_read_b64_tr_b16 %7, %15\n\ts_waitcnt lgkmcnt(0)"
        : "=&v"(r0), "=&v"(r1), "=&v"(r2), "=&v"(r3), "=&v"(r4), "=&v"(r5), "=&v"(r6), "=&v"(r7) : "v"(a0), "v"(b0), "v"(a1), "v"(b1), "v"(a2), "v"(b2), "v"(a3), "v"(b3) : "memory");
    o[0] = __builtin_bit_cast(bf16x8, (u32x4){r0.x, r0.y, r1.x, r1.y}); o[1] = __builtin_bit_cast(bf16x8, (u32x4){r2.x, r2.y, r3.x, r3.y});
    o[2] = __builtin_bit_cast(bf16x8, (u32x4){r4.x, r4.y, r5.x, r5.y}); o[3] = __builtin_bit_cast(bf16x8, (u32x4){r6.x, r6.y, r7.x, r7.y}); }
constexpr int LP = 136;
__device__ __forceinline__ void ret_item(Ctx& F, int item) {
    const int tid = F.tid, lane = F.lane, w = F.wave, fr = lane & 15, fq = lane >> 4;
    const int b = item >> 5, h = (item >> 2) & 7, eb = item & 3;
    constexpr int VP = 40;
    LAS bf16* qL = (LAS bf16*)(F.lds); LAS bf16* kL = qL + 128 * LP; LAS bf16* vL = kL + 128 * LP; LAS bf16* vdL = vL + 128 * VP; LAS bf16* STL = vdL + 128 * VP;
    const unsigned trq = (unsigned)((lane & 15) >> 2), trp = (unsigned)(lane & 3);
    const unsigned kLb = (unsigned)(size_t)kL + trq * (LP * 2) + 8u * trp + (unsigned)(16 * w) * 2u, vLb = (unsigned)(size_t)vL + trq * (VP * 2) + 8u * trp, vdLb = (unsigned)(size_t)vdL + trq * (VP * 2) + 8u * trp;
    const bf16* proj = (const bf16*)(F.ws + WS_PROJ); const unsigned* rope = (const unsigned*)(F.ws + WS_ROPE); float* reto = (float*)(F.ws + WS_RETO);
    const float lg = log1pf(-exp2f(-5.0f - (float)h)), lg2 = lg * 1.4426950408889634f, dec = __expf(lg * 128.0f);
    f32x4 st[2] = {(f32x4){0.f, 0.f, 0.f, 0.f}, (f32x4){0.f, 0.f, 0.f, 0.f}};
    __syncthreads();
    for (int i = tid; i < 32 * LP; i += NWAVES * 64) STL[i] = 0;
    const int r = tid >> 2, qd = tid & 3, j0 = 16 * qd;
    const float kdec = __builtin_amdgcn_exp2f(lg2 * (float)(127 - r));
    u32x4 q1[2], q2[2], k1[2], k2[2], vv, cs4[4];
#define RET_LOAD(nn) do { const bf16* p_ = proj + (size_t)(b * SEQ + (nn) * 128 + r) * NIN + h * 128; const unsigned* c_ = rope + (size_t)(b * SEQ + (nn) * 128 + r) * 64 + j0; \
        q1[0] = *(const u32x4*)(p_ + j0); q1[1] = *(const u32x4*)(p_ + j0 + 8); q2[0] = *(const u32x4*)(p_ + 64 + j0); q2[1] = *(const u32x4*)(p_ + 64 + j0 + 8); \
        k1[0] = *(const u32x4*)(p_ + RW + j0); k1[1] = *(const u32x4*)(p_ + RW + j0 + 8); k2[0] = *(const u32x4*)(p_ + RW + 64 + j0); k2[1] = *(const u32x4*)(p_ + RW + 64 + j0 + 8); \
        vv = *(const u32x4*)(p_ + 2 * RW + eb * 32 + qd * 8); \
        _Pragma("unroll") for (int jj_ = 0; jj_ < 4; ++jj_) cs4[jj_] = *(const u32x4*)(c_ + 4 * jj_); } while (0)
    RET_LOAD(0);
#pragma unroll 1
    for (int n = 0; n < 16; ++n) {
        const int t0 = b * SEQ + n * 128;
        __syncthreads();
        {
#pragma unroll
            for (int hh = 0; hh < 2; ++hh) { unsigned oq1[4], oq2[4], ok1[4], ok2[4];
#pragma unroll
                for (int c = 0; c < 4; ++c) { float a[2], bq[2], ka[2], kb[2];
#pragma unroll
                    for (int z = 0; z < 2; ++z) { const int jj = hh * 8 + c * 2 + z; const unsigned cw_ = cs4[jj >> 2][jj & 3]; const f32x2 sc = (f32x2){bflo(cw_), bfhi(cw_)};
                        const float x1 = z ? bfhi(q1[hh][c]) : bflo(q1[hh][c]), x2 = z ? bfhi(q2[hh][c]) : bflo(q2[hh][c]);
                        const float y1 = z ? bfhi(k1[hh][c]) : bflo(k1[hh][c]), y2 = z ? bfhi(k2[hh][c]) : bflo(k2[hh][c]);
                        a[z] = (x1 * sc.x - x2 * sc.y) * 0.08838834764831845f; bq[z] = (x2 * sc.x + x1 * sc.y) * 0.08838834764831845f;
                        ka[z] = y1 * sc.x - y2 * sc.y; kb[z] = y2 * sc.x + y1 * sc.y;
                    }
                    oq1[c] = pk2(a[0], a[1]); oq2[c] = pk2(bq[0], bq[1]); ok1[c] = pk2(ka[0], ka[1]); ok2[c] = pk2(kb[0], kb[1]); }
                *(LAS u32x4*)(qL + r * LP + j0 + hh * 8) = (u32x4){oq1[0], oq1[1], oq1[2], oq1[3]}; *(LAS u32x4*)(qL + r * LP + 64 + j0 + hh * 8) = (u32x4){oq2[0], oq2[1], oq2[2], oq2[3]};
                *(LAS u32x4*)(kL + r * LP + j0 + hh * 8) = (u32x4){ok1[0], ok1[1], ok1[2], ok1[3]}; *(LAS u32x4*)(kL + r * LP + 64 + j0 + hh * 8) = (u32x4){ok2[0], ok2[1], ok2[2], ok2[3]}; }
            unsigned vd[4];
#pragma unroll
            for (int c = 0; c < 4; ++c) vd[c] = pk2(bflo(vv[c]) * kdec, bfhi(vv[c]) * kdec);
            *(LAS u32x4*)(vL + r * VP + 8 * qd) = vv; *(LAS u32x4*)(vdL + r * VP + 8 * qd) = (u32x4){vd[0], vd[1], vd[2], vd[3]};
        }
        if (n + 1 < 16) RET_LOAD(n + 1);
        __syncthreads();
        f32x4 sacc[8];
#pragma unroll
        for (int mt = 0; mt < 8; ++mt) sacc[mt] = (f32x4){0.f, 0.f, 0.f, 0.f};
#pragma unroll
        for (int ks = 0; ks < 4; ++ks) { const bf16x8 bq = *(const LAS bf16x8*)(qL + (16 * w + fr) * LP + 32 * ks + 8 * fq);
#pragma unroll
            for (int mt = 0; mt < 8; ++mt) { const bf16x8 ak = *(const LAS bf16x8*)(kL + (16 * mt + fr) * LP + 32 * ks + 8 * fq); sacc[mt] = __builtin_amdgcn_mfma_f32_16x16x32_bf16(ak, bq, sacc[mt], 0, 0, 0); } }
        const int c = 16 * w + fr;
        bf16x8 pb[4];
#pragma unroll
        for (int sk = 0; sk < 4; ++sk) { unsigned pw[4];
#pragma unroll
            for (int hlf = 0; hlf < 2; ++hlf) { const int mt = 2 * sk + hlf; float pv[4];
#pragma unroll
                for (int rr = 0; rr < 4; ++rr) { const int m = 16 * mt + 4 * fq + rr; pv[rr] = (c >= m) ? sacc[mt][rr] * __builtin_amdgcn_exp2f(lg2 * (float)(c - m)) : 0.f; }
                pw[2 * hlf] = pk2(pv[0], pv[1]); pw[2 * hlf + 1] = pk2(pv[2], pv[3]); }
            pb[sk] = __builtin_bit_cast(bf16x8, (u32x4){pw[0], pw[1], pw[2], pw[3]}); }
        f32x4 oi[2], oc[2];
#pragma unroll
        for (int et = 0; et < 2; ++et) { oi[et] = (f32x4){0.f, 0.f, 0.f, 0.f}; oc[et] = (f32x4){0.f, 0.f, 0.f, 0.f}; }
#pragma unroll
        for (int et = 0; et < 2; ++et) { bf16x8 avq[4]; const unsigned a0 = vLb + (unsigned)((4 * fq) * (VP * 2) + 32 * et); tr_quad(avq, a0, a0 + 32 * (VP * 2), a0 + 64 * (VP * 2), a0 + 96 * (VP * 2), 16 * (VP * 2));
#pragma unroll
            for (int ks = 0; ks < 4; ++ks) oi[et] = __builtin_amdgcn_mfma_f32_16x16x32_bf16(avq[ks], pb[ks], oi[et], 0, 0, 0); }
#pragma unroll
        for (int ks = 0; ks < 4; ++ks) { const bf16x8 bq = *(const LAS bf16x8*)(qL + (16 * w + fr) * LP + 32 * ks + 8 * fq);
#pragma unroll
            for (int et = 0; et < 2; ++et) { const bf16x8 as = *(const LAS bf16x8*)(STL + (16 * et + fr) * LP + 32 * ks + 8 * fq); oc[et] = __builtin_amdgcn_mfma_f32_16x16x32_bf16(as, bq, oc[et], 0, 0, 0); } }
        { const float qd = __builtin_amdgcn_exp2f(lg2 * (float)(c + 1));
#pragma unroll
          for (int et = 0; et < 2; ++et) *(f32x4*)(reto + (size_t)(t0 + c) * RW + h * 128 + eb * 32 + 16 * et + 4 * fq) = oi[et] + oc[et] * qd; }
        __syncthreads();
#pragma unroll
        for (int et = 0; et < 2; ++et) st[et] = st[et] * dec;
        { bf16x8 bkq[4], vq0[4], vq1[4];
          { const unsigned k0 = kLb + (unsigned)((8 * fq) * (LP * 2)); tr_quad(bkq, k0, k0 + 32 * (LP * 2), k0 + 64 * (LP * 2), k0 + 96 * (LP * 2), 4 * (LP * 2)); }
          { const unsigned v0 = vdLb + (unsigned)((8 * fq) * (VP * 2)); tr_quad(vq0, v0, v0 + 32 * (VP * 2), v0 + 64 * (VP * 2), v0 + 96 * (VP * 2), 4 * (VP * 2)); tr_quad(vq1, v0 + 32, v0 + 32 + 32 * (VP * 2), v0 + 32 + 64 * (VP * 2), v0 + 32 + 96 * (VP * 2), 4 * (VP * 2)); }
#pragma unroll
          for (int ks = 0; ks < 4; ++ks) { st[0] = __builtin_amdgcn_mfma_f32_16x16x32_bf16(vq0[ks], bkq[ks], st[0], 0, 0, 0); st[1] = __builtin_amdgcn_mfma_f32_16x16x32_bf16(vq1[ks], bkq[ks], st[1], 0, 0, 0); } }
#pragma unroll
        for (int et = 0; et < 2; ++et)
#pragma unroll
            for (int rr = 0; rr < 4; ++rr) STL[(16 * et + 4 * fq + rr) * LP + 16 * w + fr] = f2bf(st[et][rr]);
    }
#undef RET_LOAD
    __syncthreads();
}

struct LruIn { bf16x8 bA[4], bX[4]; unsigned xr[19]; f32x2 w0, w1, w2, w3, bc; float bav, bxv, lamv; };
__device__ __forceinline__ void lru_issue(Ctx& F, int item, LruIn& L) {
    const int lane = F.lane, w = F.wave, fr = lane & 15, fq = lane >> 4;
    const int b = item >> 7, n = (item >> 3) & 15, g = item & 7; const int ch = g * 128 + 2 * lane;
    const bf16* Wa = (const bf16*)(F.ws + WS_WA) + (size_t)g * 128 * 128 + (size_t)(16 * w + fr) * 128 + 8 * fq; const bf16* Wx = (const bf16*)(F.ws + WS_WX) + (size_t)g * 128 * 128 + (size_t)(16 * w + fr) * 128 + 8 * fq;
#pragma unroll
    for (int ks = 0; ks < 4; ++ks) { L.bA[ks] = *(const bf16x8*)(Wa + 32 * ks); L.bX[ks] = *(const bf16x8*)(Wx + 32 * ks); }
    const float* wconv = (const float*)F.in[7];
    L.w0 = *(const f32x2*)(wconv + ch); L.w1 = *(const f32x2*)(wconv + LW + ch); L.w2 = *(const f32x2*)(wconv + 2 * LW + ch); L.w3 = *(const f32x2*)(wconv + 3 * LW + ch); L.bc = *(const f32x2*)((const float*)F.in[8] + ch);
    const int cj = g * 128 + 16 * w + fr; L.bav = ((const float*)F.in[10])[cj]; L.bxv = ((const float*)F.in[12])[cj]; L.lamv = ((const float*)F.in[13])[cj];
    const int s0 = n * 128 + 16 * w; const bf16* p = (const bf16*)(F.ws + WS_PROJ) + (size_t)(b * SEQ) * NIN + 4 * RW + ch;
#pragma unroll
    for (int i = 0; i < 19; ++i) { const int sp = s0 - 3 + i; L.xr[i] = (sp >= 0) ? *(const unsigned*)(p + (size_t)sp * NIN) : 0u; }
}
__device__ __forceinline__ void lru_body(Ctx& F, int item, const LruIn& L) {
    const int lane = F.lane, w = F.wave, fr = lane & 15, fq = lane >> 4;
    const int b = item >> 7, n = (item >> 3) & 15, g = item & 7;
    LAS bf16* xcL = (LAS bf16*)(F.lds); LAS float* aL = (LAS float*)(F.lds + 34816); LAS bf16* mL = (LAS bf16*)(F.lds + 34816 + 65536); LAS float* segA = (LAS float*)(F.lds + 34816 + 65536 + 32768); LAS float* segB = segA + 1024;
    const int cp = lane, sg = w, ch = g * 128 + 2 * cp;
    float xc[16][2];
#pragma unroll
    for (int i = 0; i < 16; ++i) {
        xc[i][0] = L.bc.x + L.w0.x * bflo(L.xr[i]) + L.w1.x * bflo(L.xr[i + 1]) + L.w2.x * bflo(L.xr[i + 2]) + L.w3.x * bflo(L.xr[i + 3]);
        xc[i][1] = L.bc.y + L.w0.y * bfhi(L.xr[i]) + L.w1.y * bfhi(L.xr[i + 1]) + L.w2.y * bfhi(L.xr[i + 2]) + L.w3.y * bfhi(L.xr[i + 3]);
        *(LAS unsigned*)(xcL + (16 * sg + i) * LP + 2 * cp) = pk2(xc[i][0], xc[i][1]); }
    __syncthreads();
    {
        const int j = 16 * w + fr; const float bav = L.bav, bxv = L.bxv, sp8 = -8.0f * log1pf(__expf(-L.lamv));
#pragma unroll 2
        for (int tt = 0; tt < 8; ++tt) { f32x4 ra = (f32x4){0.f, 0.f, 0.f, 0.f}, rx = (f32x4){0.f, 0.f, 0.f, 0.f};
#pragma unroll
            for (int ks = 0; ks < 4; ++ks) { const bf16x8 a = *(const LAS bf16x8*)(xcL + (16 * tt + fr) * LP + 32 * ks + 8 * fq);
                ra = __builtin_amdgcn_mfma_f32_16x16x32_bf16(a, L.bA[ks], ra, 0, 0, 0); rx = __builtin_amdgcn_mfma_f32_16x16x32_bf16(a, L.bX[ks], rx, 0, 0, 0); }
#pragma unroll
            for (int rr = 0; rr < 4; ++rr) { const int t = 16 * tt + 4 * fq + rr;
                const float rgt = __builtin_amdgcn_rcpf(1.0f + __expf(-(ra[rr] + bav))), igt = __builtin_amdgcn_rcpf(1.0f + __expf(-(rx[rr] + bxv)));
                const float av = __expf(sp8 * rgt); const float mu = __builtin_amdgcn_sqrtf(fmaxf(1.0f - av * av, 0.f)) * igt;
                aL[t * 128 + j] = av; mL[t * 128 + j] = f2bf(mu); } }
    }
    __syncthreads();
    {
        float h0 = 0.f, h1 = 0.f, P0 = 1.f, P1 = 1.f;
#pragma unroll
        for (int i = 0; i < 16; ++i) { const int t = 16 * sg + i; const f32x2 av = *(const LAS f32x2*)(aL + t * 128 + 2 * cp); const unsigned mw = *(const LAS unsigned*)(mL + t * 128 + 2 * cp);
            h0 = av.x * h0 + bflo(mw) * xc[i][0]; h1 = av.y * h1 + bfhi(mw) * xc[i][1]; P0 *= av.x; P1 *= av.y; }
        *(LAS f32x2*)(segA + sg * 128 + 2 * cp) = (f32x2){P0, P1}; *(LAS f32x2*)(segB + sg * 128 + 2 * cp) = (f32x2){h0, h1};
    }
    __syncthreads();
    {
        float c0 = 0.f, c1 = 0.f, Q0 = 1.f, Q1 = 1.f;
        for (int s = 0; s < sg; ++s) { const f32x2 A = *(const LAS f32x2*)(segA + s * 128 + 2 * cp), Bv = *(const LAS f32x2*)(segB + s * 128 + 2 * cp); c0 = A.x * c0 + Bv.x; c1 = A.y * c1 + Bv.y; Q0 *= A.x; Q1 *= A.y; }
        bf16* hl = (bf16*)(F.ws + WS_HLOC) + (size_t)(b * SEQ + n * 128 + 16 * sg) * LW + ch; bf16* pl = (bf16*)(F.ws + WS_PLOC) + (size_t)(b * SEQ + n * 128 + 16 * sg) * LW + ch;
        float h0 = c0, h1 = c1, P0 = Q0, P1 = Q1;
#pragma unroll
        for (int i = 0; i < 16; ++i) { const int t = 16 * sg + i; const f32x2 av = *(const LAS f32x2*)(aL + t * 128 + 2 * cp); const unsigned mw = *(const LAS unsigned*)(mL + t * 128 + 2 * cp);
            h0 = av.x * h0 + bflo(mw) * xc[i][0]; h1 = av.y * h1 + bfhi(mw) * xc[i][1]; P0 *= av.x; P1 *= av.y;
            *(unsigned*)(hl + (size_t)i * LW) = pk2(h0, h1); *(unsigned*)(pl + (size_t)i * LW) = pk2(P0, P1); }
        if (sg == 7) { *(f32x2*)((float*)(F.ws + WS_AGGA) + (size_t)(b * 16 + n) * LW + ch) = (f32x2){P0, P1}; *(f32x2*)((float*)(F.ws + WS_AGGB) + (size_t)(b * 16 + n) * LW + ch) = (f32x2){h0, h1}; }
    }
    __syncthreads();
}

__device__ __forceinline__ void p4_item(Ctx& F, int item) {
    const int tid = F.tid, lane = F.lane, w = F.wave;
    const int b = item >> 5, n = (item & 31) >> 1;
    LAS float* carry = (LAS float*)F.lds;
    const float* aggA = (const float*)(F.ws + WS_AGGA); const float* aggB = (const float*)(F.ws + WS_AGGB);
    __syncthreads();
#pragma unroll
    for (int q = 0; q < 2; ++q) { const int ch = tid + 512 * q; float cin = 0.f;
        for (int jn = 0; jn < n; ++jn) cin = aggA[(size_t)(b * 16 + jn) * LW + ch] * cin + aggB[(size_t)(b * 16 + jn) * LW + ch];
        carry[ch] = cin; }
    __syncthreads();
    const bf16* proj = (const bf16*)(F.ws + WS_PROJ); const float* reto = (const float*)(F.ws + WS_RETO); const bf16* hl = (const bf16*)(F.ws + WS_HLOC); const bf16* pl = (const bf16*)(F.ws + WS_PLOC);
    bf16* cat = (bf16*)(F.ws + WS_CAT); const int c0 = 16 * lane;
    float beta_r[16], beta_l[16], cr[16];
#pragma unroll
    for (int q = 0; q < 4; ++q) { const f32x4 a = *(const f32x4*)((const float*)F.in[14] + c0 + 4 * q), bq = *(const f32x4*)((const float*)F.in[15] + c0 + 4 * q); const f32x4 cq = *(const LAS f32x4*)(carry + c0 + 4 * q);
        beta_r[4 * q] = a.x; beta_r[4 * q + 1] = a.y; beta_r[4 * q + 2] = a.z; beta_r[4 * q + 3] = a.w; beta_l[4 * q] = bq.x; beta_l[4 * q + 1] = bq.y; beta_l[4 * q + 2] = bq.z; beta_l[4 * q + 3] = bq.w;
        cr[4 * q] = cq.x; cr[4 * q + 1] = cq.y; cr[4 * q + 2] = cq.z; cr[4 * q + 3] = cq.w; }
#pragma unroll 2
    for (int rr = 0; rr < 8; ++rr) {
        const int t = item * 64 + 8 * w + rr;
        {
            float o[16];
#pragma unroll
            for (int q = 0; q < 4; ++q) { const f32x4 v = *(const f32x4*)(reto + (size_t)t * RW + c0 + 4 * q); o[4 * q] = v.x; o[4 * q + 1] = v.y; o[4 * q + 2] = v.z; o[4 * q + 3] = v.w; }
            float s = 0.f;
#pragma unroll
            for (int q = 0; q < 16; ++q) s += o[q];
            s += __shfl_xor(s, 1); s += __shfl_xor(s, 2); s += __shfl_xor(s, 4);
            const float mu = s * (1.0f / 128.0f); float vq = 0.f;
#pragma unroll
            for (int q = 0; q < 16; ++q) { o[q] -= mu; vq += o[q] * o[q]; }
            vq += __shfl_xor(vq, 1); vq += __shfl_xor(vq, 2); vq += __shfl_xor(vq, 4);
            const float rs = rsqrtf(vq * (1.0f / 128.0f) + EPS);
            const u32x4 g0 = *(const u32x4*)(proj + (size_t)t * NIN + 3 * RW + c0), g1 = *(const u32x4*)(proj + (size_t)t * NIN + 3 * RW + c0 + 8);
            float ss = 0.f;
#pragma unroll
            for (int q = 0; q < 8; ++q) { const unsigned gw_ = (q < 4) ? g0[q & 3] : g1[q & 3]; const float ga = bflo(gw_), gb = bfhi(gw_);
                o[2 * q] = siluf_(ga) * (o[2 * q] * rs); o[2 * q + 1] = siluf_(gb) * (o[2 * q + 1] * rs); ss += o[2 * q] * o[2 * q] + o[2 * q + 1] * o[2 * q + 1]; }
            const float rstd = rsqrtf(wave_sum(ss) * (1.0f / RW) + EPS);
            u32x4 w0, w1;
#pragma unroll
            for (int q = 0; q < 4; ++q) { w0[q] = pk2(o[2 * q] * rstd * beta_r[2 * q], o[2 * q + 1] * rstd * beta_r[2 * q + 1]); w1[q] = pk2(o[8 + 2 * q] * rstd * beta_r[8 + 2 * q], o[9 + 2 * q] * rstd * beta_r[9 + 2 * q]); }
            *(u32x4*)(cat + (size_t)t * DM + c0) = w0; *(u32x4*)(cat + (size_t)t * DM + c0 + 8) = w1;
        }
        {
            const u32x4 h0 = *(const u32x4*)(hl + (size_t)t * LW + c0), h1 = *(const u32x4*)(hl + (size_t)t * LW + c0 + 8), p0 = *(const u32x4*)(pl + (size_t)t * LW + c0), p1 = *(const u32x4*)(pl + (size_t)t * LW + c0 + 8);
            const u32x4 y0 = *(const u32x4*)(proj + (size_t)t * NIN + 5 * RW + c0), y1 = *(const u32x4*)(proj + (size_t)t * NIN + 5 * RW + c0 + 8);
            float o[16]; float ss = 0.f;
#pragma unroll
            for (int q = 0; q < 8; ++q) { const unsigned hw = (q < 4) ? h0[q & 3] : h1[q & 3], pw = (q < 4) ? p0[q & 3] : p1[q & 3], yw = (q < 4) ? y0[q & 3] : y1[q & 3];
                const float ha = bflo(hw) + bflo(pw) * cr[2 * q], hb = bfhi(hw) + bfhi(pw) * cr[2 * q + 1];
                o[2 * q] = ha * gelu_tanh_(bflo(yw)); o[2 * q + 1] = hb * gelu_tanh_(bfhi(yw)); ss += o[2 * q] * o[2 * q] + o[2 * q + 1] * o[2 * q + 1]; }
            const float rstd = rsqrtf(wave_sum(ss) * (1.0f / LW) + EPS);
            u32x4 w0, w1;
#pragma unroll
            for (int q = 0; q < 4; ++q) { w0[q] = pk2(o[2 * q] * rstd * beta_l[2 * q], o[2 * q + 1] * rstd * beta_l[2 * q + 1]); w1[q] = pk2(o[8 + 2 * q] * rstd * beta_l[8 + 2 * q], o[9 + 2 * q] * rstd * beta_l[9 + 2 * q]); }
            *(u32x4*)(cat + (size_t)t * DM + RW + c0) = w0; *(u32x4*)(cat + (size_t)t * DM + RW + c0 + 8) = w1;
        }
    }
    __syncthreads();
}

constexpr int HAP = 2056;
template <bool DRY> __device__ __forceinline__ void p6_item(Ctx& F, int item) {
    const int tid = F.tid, lane = F.lane, w = F.wave, fr = lane & 15, fq = lane >> 4;
    const int t0 = item * 64, b = t0 / SEQ;
    LAS bf16* hA = (LAS bf16*)F.lds;
    LAS float* lgt = (LAS float*)(F.lds + 16 * HAP * 2);
    LAS unsigned char* selE = (LAS unsigned char*)(F.lds + 16 * HAP * 2 + 8 * 16 * 65 * 4); LAS unsigned char* selL = selE + 512; LAS unsigned* wcnt = (LAS unsigned*)(selL + 512); LAS unsigned* gb = wcnt + 512;
    const bf16* x1 = (const bf16*)(F.ws + WS_X1); const float* mod = (const float*)(F.ws + WS_MOD) + (size_t)b * 6 * DM; bf16* h2 = (bf16*)(F.ws + WS_H); unsigned char* h8 = F.ws + WS_H8;
    const bf16* Wr = (const bf16*)(F.ws + WS_WR);
    int* eidx = (int*)(F.ws + WS_EIDX); float* wsel = (float*)(F.ws + WS_WSEL); int* slot = (int*)(F.ws + (DRY ? WS_DEST : WS_SLOT)); unsigned* cnt = (unsigned*)(F.ws + WS_CTL) + CW_CNT + (DRY ? 4096 : 0);
    f32x4 gg[4][2];
#pragma unroll
    for (int j = 0; j < 4; ++j)
#pragma unroll
        for (int h = 0; h < 2; ++h) { const int c = 8 * lane + 512 * j + 4 * h; gg[j][h] = *(const f32x4*)((const float*)F.in[17] + c) * (*(const f32x4*)(mod + 4 * DM + c) + 1.0f); }
    const float brl = ((const float*)F.in[19])[lane]; const int g = lane >> 3;
    unsigned lc = 0u;
    bf16x8 bw[2][4];
#pragma unroll
    for (int ks = 0; ks < 2; ++ks)
#pragma unroll
        for (int et = 0; et < 4; ++et) bw[ks][et] = *(const bf16x8*)(Wr + (size_t)(16 * et + fr) * DM + 256 * w + 32 * ks + 8 * fq);
    u32x4 xq[2][4];
#pragma unroll
    for (int i = 0; i < 2; ++i)
#pragma unroll
        for (int j = 0; j < 4; ++j) xq[i][j] = *(const u32x4*)(x1 + (size_t)(t0 + 2 * w + i) * DM + 8 * lane + 512 * j);
    __syncthreads();
#pragma unroll 1
    for (int ps = 0; ps < 4; ++ps) {
#pragma unroll
        for (int i = 0; i < 2; ++i) { const int rl = 2 * w + i, t = t0 + 16 * ps + rl;
            f32x4 v[4][2]; float ss = 0.f;
#pragma unroll
            for (int j = 0; j < 4; ++j) { const u32x4 xw = xq[i][j]; v[j][0] = (f32x4){bflo(xw.x), bfhi(xw.x), bflo(xw.y), bfhi(xw.y)}; v[j][1] = (f32x4){bflo(xw.z), bfhi(xw.z), bflo(xw.w), bfhi(xw.w)};
#pragma unroll
                for (int h = 0; h < 2; ++h) ss += (v[j][h].x * v[j][h].x + v[j][h].y * v[j][h].y) + (v[j][h].z * v[j][h].z + v[j][h].w * v[j][h].w); }
            const float rstd = rsqrtf(wave_sum(ss) * (1.0f / DM) + EPS);
#pragma unroll
            for (int j = 0; j < 4; ++j) { const f32x4 o0 = v[j][0] * rstd * gg[j][0] + *(const f32x4*)(mod + 3 * DM + 8 * lane + 512 * j), o1 = v[j][1] * rstd * gg[j][1] + *(const f32x4*)(mod + 3 * DM + 8 * lane + 512 * j + 4);
                u32x4 wv; wv.x = pk2(o0.x, o0.y); wv.y = pk2(o0.z, o0.w); wv.z = pk2(o1.x, o1.y); wv.w = pk2(o1.z, o1.w);
                *(LAS u32x4*)(hA + rl * HAP + 8 * lane + 512 * j) = wv;
                u32x2 w8; w8.x = pk4_fp8(o0.x * SC_H8, o0.y * SC_H8, o0.z * SC_H8, o0.w * SC_H8); w8.y = pk4_fp8(o1.x * SC_H8, o1.y * SC_H8, o1.z * SC_H8, o1.w * SC_H8);
                *(u32x2*)(h8 + (size_t)t * DM + 8 * lane + 512 * j) = w8; }
            __builtin_amdgcn_sched_barrier(0); }
        __syncthreads();
        {
            f32x4 acc[4];
#pragma unroll
            for (int et = 0; et < 4; ++et) acc[et] = (f32x4){0.f, 0.f, 0.f, 0.f};
            bf16x8 bw2[6][4];
#pragma unroll
            for (int ks = 0; ks < 6; ++ks)
#pragma unroll
                for (int et = 0; et < 4; ++et) bw2[ks][et] = *(const bf16x8*)(Wr + (size_t)(16 * et + fr) * DM + 256 * w + 64 + 32 * ks + 8 * fq);
#pragma unroll
            for (int ks = 0; ks < 2; ++ks) { const bf16x8 a = *(const LAS bf16x8*)(hA + fr * HAP + 256 * w + 32 * ks + 8 * fq);
#pragma unroll
                for (int et = 0; et < 4; ++et) acc[et] = __builtin_amdgcn_mfma_f32_16x16x32_bf16(a, bw[ks][et], acc[et], 0, 0, 0); }
#pragma unroll
            for (int ks = 0; ks < 6; ++ks) { const bf16x8 a = *(const LAS bf16x8*)(hA + fr * HAP + 256 * w + 64 + 32 * ks + 8 * fq);
#pragma unroll
                for (int et = 0; et < 4; ++et) acc[et] = __builtin_amdgcn_mfma_f32_16x16x32_bf16(a, bw2[ks][et], acc[et], 0, 0, 0); }
#pragma unroll
            for (int et = 0; et < 4; ++et)
#pragma unroll
                for (int rr = 0; rr < 4; ++rr) lgt[(w * 16 + 4 * fq + rr) * 65 + 16 * et + fr] = acc[et][rr];
        }
        __syncthreads();
        if (ps + 1 < 4) {
#pragma unroll
            for (int i = 0; i < 2; ++i)
#pragma unroll
                for (int j = 0; j < 4; ++j) xq[i][j] = *(const u32x4*)(x1 + (size_t)(t0 + 16 * (ps + 1) + 2 * w + i) * DM + 8 * lane + 512 * j); }
#pragma unroll 1
        for (int i = 0; i < 2; ++i) {
            const int tl = 2 * w + i, tt = 16 * ps + tl; float z = 0.f;
#pragma unroll
            for (int w2 = 0; w2 < 8; ++w2) z += lgt[(w2 * 16 + tl) * 65 + lane];
            const float s = sigmoidf_(z); const float bsc = s + brl;
            float m1 = bsc; m1 = fmaxf(m1, __shfl_xor(m1, 1)); m1 = fmaxf(m1, __shfl_xor(m1, 2)); m1 = fmaxf(m1, __shfl_xor(m1, 4));
            const unsigned long long eq = __ballot(bsc == m1); const unsigned gm = (unsigned)(eq >> (8 * g)) & 0xffu;
            const bool first = (lane & 7) == (__builtin_ctz(gm | 0x100u) & 7);
            float m2 = first ? -3.0e38f : bsc; m2 = fmaxf(m2, __shfl_xor(m2, 1)); m2 = fmaxf(m2, __shfl_xor(m2, 2)); m2 = fmaxf(m2, __shfl_xor(m2, 4));
            const float gs = m1 + m2;
            int rank_g = 0;
#pragma unroll
            for (int g2 = 0; g2 < 8; ++g2) { const float o = __int_as_float(__builtin_amdgcn_readlane(__float_as_int(gs), 8 * g2)); rank_g += (o > gs || (o == gs && g2 < g)) ? 1 : 0; }
            const bool selg = rank_g < 4;
            const float key = selg ? bsc : -3.0e38f;
            int rank = 0;
#pragma unroll
            for (int e2 = 0; e2 < 64; ++e2) { const float o = __int_as_float(__builtin_amdgcn_readlane(__float_as_int(key), e2)); rank += (o > key || (o == key && e2 < lane)) ? 1 : 0; }
            const bool chosen = selg && rank < 8;
            const float wsum = wave_sum(chosen ? s : 0.f);
            if (chosen) { const int t = t0 + tt; eidx[t * 8 + rank] = lane; wsel[t * 8 + rank] = s * (2.5f / wsum); selE[tt * 8 + rank] = (unsigned char)lane; selL[tt * 8 + rank] = (unsigned char)lc; }
            lc += chosen ? 1u : 0u;
        }
        __syncthreads();
    }
    wcnt[w * 64 + lane] = lc;
    __syncthreads();
    if (w == 0) { unsigned tot = 0u;
#pragma unroll
        for (int w2 = 0; w2 < 8; ++w2) tot += wcnt[w2 * 64 + lane];
        gb[lane] = tot ? __hip_atomic_fetch_add(cnt + 32 * lane, tot, __ATOMIC_RELAXED, __HIP_MEMORY_SCOPE_AGENT) : 0u; }
    __syncthreads();
    { const int tok = tid >> 3, k = tid & 7, e = selE[tok * 8 + k], wt = (tok & 15) >> 1; unsigned off = gb[e] + selL[tok * 8 + k];
        for (int w2 = 0; w2 < wt; ++w2) off += wcnt[w2 * 64 + e];
        slot[(t0 + tok) * 8 + k] = (int)off; if (!DRY) ((int*)(F.ws + WS_TOKOF))[(size_t)e * T + off] = t0 + tok; }
    __syncthreads();
}

__device__ __forceinline__ void p10_final(Ctx& F, bool have_tables) {
    const int gw = F.vcu * NWAVES + F.wave, NGW = F.G * NWAVES, lane = F.lane;
    const bf16* x1 = (const bf16*)(F.ws + WS_X1); const unsigned char* y = F.ws + WS_Y; const int* eidx = (const int*)(F.ws + WS_EIDX); const int* slot = (const int*)(F.ws + WS_SLOT); const float* wsel = (const float*)(F.ws + WS_WSEL); const float* gf = (const float*)F.in[24];
    LAS int* ps = (LAS int*)F.lds; const unsigned* cnt = (const unsigned*)(F.ws + WS_CTL) + CW_CNT;
    __syncthreads();
    if (have_tables) { if (F.tid < NE) ps[F.tid] = moe_tables(F).tp[F.tid] * 256; }
    else { if (F.tid < NE) ps[64 + F.tid] = (((int)ld_agent(cnt + 32 * F.tid) + 255) >> 8) << 8;
        __syncthreads();
        if (F.tid < NE) { int acc = 0; for (int e = 0; e < F.tid; ++e) acc += ps[64 + e]; ps[F.tid] = acc; } }
    __syncthreads();
    for (int t = gw; t < T; t += NGW) { const int b = t / SEQ; const float* gt2 = (const float*)(F.ws + WS_MOD) + (size_t)b * 6 * DM + 5 * DM;
        int rows[9]; float wk[9];
#pragma unroll
        for (int k = 0; k < 8; ++k) { rows[k] = ps[ld_agent_i(eidx + t * 8 + k)] + ld_agent_i(slot + t * 8 + k); wk[k] = wsel[t * 8 + k] * (1.0f / SC_Y); }
        rows[8] = NR_ROUTED + t; wk[8] = 1.0f / SC_Y;
        float ss = 0.f; f32x4 v[4][2];
#pragma unroll
        for (int j = 0; j < 4; ++j) { const int c = 8 * lane + 512 * j; float s[8];
#pragma unroll
            for (int q = 0; q < 8; ++q) s[q] = 0.f;
#pragma unroll
            for (int k = 0; k < 9; ++k) { const u32x2 yv = *(const u32x2*)(y + (size_t)rows[k] * DM + c);
#pragma unroll
                for (int q = 0; q < 2; ++q) { const f32x2 lo = __builtin_amdgcn_cvt_pk_f32_fp8((int)yv[q], false), hi = __builtin_amdgcn_cvt_pk_f32_fp8((int)yv[q], true);
                    s[4 * q] += wk[k] * lo.x; s[4 * q + 1] += wk[k] * lo.y; s[4 * q + 2] += wk[k] * hi.x; s[4 * q + 3] += wk[k] * hi.y; } }
            const u32x4 xw = *(const u32x4*)(x1 + (size_t)t * DM + c);
#pragma unroll
            for (int hh = 0; hh < 2; ++hh) { const f32x4 xv = hh ? (f32x4){bflo(xw.z), bfhi(xw.z), bflo(xw.w), bfhi(xw.w)} : (f32x4){bflo(xw.x), bfhi(xw.x), bflo(xw.y), bfhi(xw.y)}, gv = *(const f32x4*)(gt2 + c + 4 * hh);
                v[j][hh] = xv + gv * (f32x4){s[4 * hh], s[4 * hh + 1], s[4 * hh + 2], s[4 * hh + 3]};
                ss += (v[j][hh].x * v[j][hh].x + v[j][hh].y * v[j][hh].y) + (v[j][hh].z * v[j][hh].z + v[j][hh].w * v[j][hh].w); } }
        const float rstd = rsqrtf(wave_sum(ss) * (1.0f / DM) + EPS);
#pragma unroll
        for (int j = 0; j < 4; ++j)
#pragma unroll
            for (int hh = 0; hh < 2; ++hh) { const int c = 8 * lane + 512 * j + 4 * hh; *(f32x4*)(F.out + (size_t)t * DM + c) = v[j][hh] * rstd * *(const f32x4*)(gf + c); }
    }
}

__global__ void __launch_bounds__(NWAVES * 64, 2) fwd_kernel(Args args) {
    extern __shared__ __attribute__((aligned(16))) unsigned char lds_raw[];
    Ctx F;
    F.lds = (LAS unsigned char*)lds_raw; F.ws = args.ws; F.in = args.in; F.out = args.out;
    F.tid = threadIdx.x; F.lane = F.tid & 63; F.wave = __builtin_amdgcn_readfirstlane(F.tid >> 6);
    F.G = gridDim.x; { const int bx = blockIdx.x; F.vcu = (F.G % 8 == 0) ? (bx % 8) * (F.G / 8) + bx / 8 : bx; }
    if (F.tid < 16) ((LAS unsigned*)(F.lds + MISC_OFF))[F.tid] = 0u;
    __syncthreads();
    unsigned* ctl = (unsigned*)(F.ws + WS_CTL);
#if N_LAUNCHES == 1
    XcdBarrier bar = xcd_barrier_post(ctl + CW_BAR, (volatile LAS unsigned*)(F.lds + MISC_OFF));
#define GRID_BAR() xcd_barrier(bar)
#else
#define GRID_BAR() do { } while (0)
#endif
    const int lo = args.ph_lo, hi = args.ph_hi;
#define IN(k) (lo <= (k) && (k) < hi)
#define BOTH(k) (IN(k) && IN((k) + 1))
    const int NIT = F.G;

#define REP(k) _Pragma("unroll") for (int rep_ = 0; rep_ < ((PROBE_PHASE == (k)) ? 2 : 1); ++rep_)
    if (IN(0)) { p0_adaln(F); p0_prologue(F); if (BOTH(0)) p0_wait_mod(F); }
    if (IN(1)) { REP(1) { p1_norm(F); } if (BOTH(1)) GRID_BAR(); if (PROBE_PHASE == 100) { GRID_BAR(); GRID_BAR(); GRID_BAR(); GRID_BAR(); } }
    if (IN(2)) {
        if (F.vcu & 1) p2_convert_experts(F);
        REP(2) {
        g8::DenseOrder S; S.init(F.ws + WS_H, F.ws + WS_WIN, T, NIN, DM * 2, F.G, (int)blockIdx.x);
        EpiProj E{(bf16*)(F.ws + WS_PROJ)};
        g8::gemm_phase<EpiProj, g8::DenseOrder>(F.lds, DM * 2, S, E);
        }
        if (!(F.vcu & 1)) p2_convert_experts(F);
        if (BOTH(2)) GRID_BAR();
    }
    if (IN(3)) {
        for (int it = F.vcu; it < NB * 8 * 4 * ((PROBE_PHASE == 31) ? 2 : 1); it += NIT) ret_item(F, it & 255);
        {
            LruIn La, Lb; int it = F.vcu; const int NL = NB * 16 * 8 * ((PROBE_PHASE == 32) ? 2 : 1);
            __syncthreads();
            if (it < NL) lru_issue(F, it & 1023, La);
            while (it < NL) {
                if (it + NIT < NL) lru_issue(F, (it + NIT) & 1023, Lb);
                lru_body(F, it & 1023, La); it += NIT;
                if (it >= NL) break;
                if (it + NIT < NL) lru_issue(F, (it + NIT) & 1023, La);
                lru_body(F, it & 1023, Lb); it += NIT;
            }
        }
        if (BOTH(3)) GRID_BAR();
    }
    if (IN(4)) { REP(4) { for (int it = F.vcu; it < T / 64; it += NIT) p4_item(F, it); } if (BOTH(4)) GRID_BAR(); }
    if (IN(5)) {
        REP(5) {
        g8::DenseOrder S; S.init(F.ws + WS_CAT, F.ws + WS_WOUT, T, DM, DM * 2, F.G, (int)blockIdx.x);
        EpiWout E{(const float*)F.in[0], (const float*)(F.ws + WS_MOD), (bf16*)(F.ws + WS_X1)};
        g8::gemm_phase<EpiWout, g8::DenseOrder>(F.lds, DM * 2, S, E);
        }
        if (BOTH(5)) GRID_BAR();
    }
    if (IN(6)) { for (int it = F.vcu; it < T / 64; it += NIT) p6_item<false>(F, it); if (PROBE_PHASE == 6) { for (int it = F.vcu; it < T / 64; it += NIT) p6_item<true>(F, it); } if (BOTH(6)) GRID_BAR(); }
    int ntiles = 0;
    if (IN(8)) {
        REP(8) {
        ntiles = moe_build_tables(F);
        MoeOrder<1> S; S.init(F, ntiles); S.fill_tokens(F);
        EpiSwiglu E{F.ws + WS_ACT};
        g8::gemm_phase<EpiSwiglu, MoeOrder<1>, true>(F.lds, DM, S, E);
        }
        if (BOTH(8)) GRID_BAR();
    }
    if (IN(9)) {
        REP(9) {
        if (!IN(8)) ntiles = moe_build_tables(F);
        MoeOrder<2> S; S.init(F, ntiles);
        EpiDown E{F.ws + WS_Y};
        g8::gemm_phase<EpiDown, MoeOrder<2>, true>(F.lds, EH, S, E);
        }
        if (BOTH(9)) GRID_BAR();
    }
    if (IN(10)) { REP(10) { p10_final(F, IN(8)); } }
#undef REP
#undef IN
#undef BOTH
}

extern "C" void kernel_launch(void* const* d_in, const int* in_sizes, int n_in, void* d_out, int out_size, void* d_ws, size_t ws_size, hipStream_t stream) {
    static int grid = 0;
    if (grid == 0) {
        if (n_in != 25 || out_size != T * DM || ws_size < WS_END) { fprintf(stderr, "kernel_launch: unexpected problem (n_in %d, out %d, ws %zu)\n", n_in, out_size, ws_size); grid = -1; return; }
        int dev = 0, cus = 0, per_cu = 0;
        if (hipGetDevice(&dev) != hipSuccess || hipDeviceGetAttribute(&cus, hipDeviceAttributeMultiprocessorCount, dev) != hipSuccess) { grid = -1; return; }
        if (hipFuncSetAttribute((const void*)fwd_kernel, hipFuncAttributeMaxDynamicSharedMemorySize, LDS_BYTES) != hipSuccess) { fprintf(stderr, "kernel_launch: hipFuncSetAttribute failed\n"); grid = -1; return; }
        if (hipOccupancyMaxActiveBlocksPerMultiprocessor(&per_cu, (const void*)fwd_kernel, NWAVES * 64, LDS_BYTES) != hipSuccess || per_cu < 1) { fprintf(stderr, "kernel_launch: occupancy query says %d\n", per_cu); }
        (void)hipGetLastError();
        grid = cus;
    }
    if (grid < 0) return;
    (void)hipMemsetAsync((char*)d_ws + WS_CTL, 0, CTL_ZERO_BYTES, stream);
    Args a{};
    for (int i = 0; i < 25; ++i) a.in[i] = d_in[i];
    a.out = (float*)d_out; a.ws = (unsigned char*)d_ws;
#if N_LAUNCHES == 1
    a.ph_lo = 0; a.ph_hi = 11;
    hipLaunchKernelGGL(fwd_kernel, dim3(grid), dim3(NWAVES * 64), LDS_BYTES, stream, a);
#else
    for (int p = 0; p < 11; ++p) { a.ph_lo = p; a.ph_hi = p + 1; hipLaunchKernelGGL(fwd_kernel, dim3(grid), dim3(NWAVES * 64), LDS_BYTES, stream, a); }
#endif
}
```

```cpp
#include <hip/hip_runtime.h>
#include <cstdio>
#include <cstdint>

#ifndef PROBE_PHASE
#define PROBE_PHASE -1
#endif
#ifndef N_LAUNCHES
#define N_LAUNCHES 1
#endif

#define LAS __attribute__((address_space(3)))
typedef unsigned short bf16;
typedef short bf16x8 __attribute__((ext_vector_type(8)));
typedef float f32x4 __attribute__((ext_vector_type(4)));
typedef float f32x2 __attribute__((ext_vector_type(2)));
typedef unsigned u32x4 __attribute__((ext_vector_type(4)));
typedef unsigned u32x2 __attribute__((ext_vector_type(2)));
typedef int i32x4 __attribute__((ext_vector_type(4)));
typedef int i32x8 __attribute__((ext_vector_type(8)));

constexpr int NB = 8, SEQ = 2048, DM = 2048, T = NB * SEQ;
constexpr int NIN = 6144, RW = 1024, LW = 1024, NE = 64, EH = 512, TOPK = 8;
constexpr int NR_ROUTED = T * TOPK + NE * 256;
constexpr int NR = NR_ROUTED + T;
constexpr int NWAVES = 8;
constexpr float EPS = 1e-6f;
constexpr float SC_H8 = 16.0f, SC_WEI = 64.0f, SC_ACT = 8.0f, SC_WEO = 4.0f, SC_Y = 32.0f;

constexpr size_t MiB = 1u << 20;
constexpr size_t WS_CTL = 0, CTL_ZERO_BYTES = 2 * MiB;
constexpr size_t WS_MOD = 1 * MiB;
constexpr size_t WS_ROPE = 2 * MiB;
constexpr size_t WS_WIN = 10 * MiB;
constexpr size_t WS_WOUT = 34 * MiB;
constexpr size_t WS_WR = 42 * MiB;
constexpr size_t WS_WA = WS_WR + 256 * 1024;
constexpr size_t WS_WX = WS_WA + 256 * 1024;
constexpr size_t WS_WEI = 44 * MiB;
constexpr size_t WS_H8 = 176 * MiB;
constexpr size_t WS_WEO = 304 * MiB;
constexpr size_t WS_H = 434 * MiB;
constexpr size_t WS_X1 = 500 * MiB;
constexpr size_t WS_EIDX = 628 * MiB;
constexpr size_t WS_WSEL = WS_EIDX + 512 * 1024;
constexpr size_t WS_SLOT = WS_WSEL + 512 * 1024;
constexpr size_t WS_DEST = WS_SLOT + 512 * 1024;
constexpr size_t WS_RTOK = WS_DEST + 512 * 1024;
constexpr size_t WS_RW = WS_RTOK + 640 * 1024;
constexpr size_t WS_AGGA = 632 * MiB;
constexpr size_t WS_AGGB = WS_AGGA + 512 * 1024;
constexpr size_t WS_ACT = 634 * MiB;
constexpr size_t WS_PROJ = 794 * MiB;
constexpr size_t WS_RETO = 986 * MiB;
constexpr size_t WS_HLOC = 1050 * MiB;
constexpr size_t WS_PLOC = 1082 * MiB;
constexpr size_t WS_CAT = 1114 * MiB;
constexpr size_t WS_Y = 794 * MiB;
constexpr size_t WS_TOKOF = 1434 * MiB;
constexpr size_t WS_END = 1438 * MiB;
constexpr int CW_BAR = 4096;
constexpr int CW_CNT = 8192;
constexpr int CW_MODCNT = 16384;

constexpr int RING_BYTES = 131072;
constexpr int LDS_BYTES = 163840;
constexpr int TOKL_OFF = 147456, TOKL_UNITS = 12;
constexpr int TT_OFF = 137216;
constexpr int MISC_OFF = LDS_BYTES - 256;
static_assert(TT_OFF + (2 * 704 + 80 + 68) * 4 <= TOKL_OFF && TOKL_OFF + TOKL_UNITS * 1024 <= MISC_OFF, "LDS map");
constexpr int MAXTILES = 704;

__device__ __forceinline__ unsigned pk2(float lo, float hi) { unsigned r; asm volatile("v_cvt_pk_bf16_f32 %0, %1, %2" : "=v"(r) : "v"(lo), "v"(hi)); return r; }
typedef __bf16 bf16x2_t __attribute__((ext_vector_type(2)));
__device__ __forceinline__ unsigned pk2c(float lo, float hi) { const bf16x2_t r = __builtin_convertvector((f32x2){lo, hi}, bf16x2_t); return __builtin_bit_cast(unsigned, r); }
__device__ __forceinline__ bf16 f2bf(float f) { return __builtin_bit_cast(bf16, (__bf16)f); }
__device__ __forceinline__ float bf2f(bf16 b) { return __uint_as_float(((unsigned)b) << 16); }
__device__ __forceinline__ float bflo(unsigned w) { return __uint_as_float(w << 16); }
__device__ __forceinline__ float bfhi(unsigned w) { return __uint_as_float(w & 0xffff0000u); }
__device__ __forceinline__ float wave_sum(float v) {
#pragma unroll
    for (int o = 1; o < 64; o <<= 1) v += __shfl_xor(v, o);
    return v;
}
__device__ __forceinline__ float sigmoidf_(float x) { return __builtin_amdgcn_rcpf(1.0f + __expf(-x)); }
__device__ __forceinline__ float siluf_(float x) { return x * __builtin_amdgcn_rcpf(1.0f + __expf(-x)); }
__device__ __forceinline__ float gelu_tanh_(float x) { const float u = 0.7978845608028654f * (x + 0.044715f * x * x * x); const float e = __expf(2.0f * u); const float th = 1.0f - 2.0f * __builtin_amdgcn_rcpf(e + 1.0f); return 0.5f * x * (1.0f + th); }
__device__ __forceinline__ unsigned ld_agent(const unsigned* p) { return __hip_atomic_load(p, __ATOMIC_RELAXED, __HIP_MEMORY_SCOPE_AGENT); }
__device__ __forceinline__ int ld_agent_i(const int* p) { return (int)__hip_atomic_load((const unsigned*)p, __ATOMIC_RELAXED, __HIP_MEMORY_SCOPE_AGENT); }
__device__ __forceinline__ float clamp448(float x) { return __builtin_amdgcn_fmed3f(x, -448.0f, 448.0f); }
__device__ __forceinline__ unsigned pk4_fp8(float a, float b, float c, float d) { int w = 0; w = __builtin_amdgcn_cvt_pk_fp8_f32(clamp448(a), clamp448(b), w, false); w = __builtin_amdgcn_cvt_pk_fp8_f32(clamp448(c), clamp448(d), w, true); return (unsigned)w; }
#define LDS_WAIT() asm volatile("s_waitcnt lgkmcnt(0)" ::: "memory")
#define VM_WAIT() asm volatile("s_waitcnt vmcnt(0)" ::: "memory")

#define XB_TMO      128
#define XB_XCNT(j)  (256  + 64 * (j))
#define XB_XSUB(j)  (1280 + 64 * (j))
#define XB_XGEN(j)  (2304 + 64 * (j))
#define XB_TOP      3328
#define XB_TOPGEN   3392
#define XCD_BAR_WORDS 3456
#define XB_SPIN_CAP (1u << 18)
__device__ __forceinline__ unsigned xb_ld(unsigned* p)              { return __hip_atomic_load(p, __ATOMIC_RELAXED, __HIP_MEMORY_SCOPE_AGENT); }
__device__ __forceinline__ unsigned xb_add(unsigned* p, unsigned v) { return __hip_atomic_fetch_add(p, v, __ATOMIC_RELAXED, __HIP_MEMORY_SCOPE_AGENT); }
__device__ __forceinline__ unsigned xb_xcc_id() { return (unsigned)__builtin_amdgcn_s_getreg((3 << 11) | 20) & 0xFu; }
#define XB_SPIN(cond, bar) do { unsigned _sp = 0; while (cond) { __builtin_amdgcn_s_sleep(1); \
    if ((++_sp & 255u) == 0u) { if (xb_ld(&(bar)[XB_TMO])) break; if (_sp > XB_SPIN_CAP) { atomicAdd(&(bar)[XB_TMO], 1u); break; } } } } while (0)
struct XcdBarrier { unsigned* bar; unsigned x; volatile LAS unsigned* st; };
__device__ __forceinline__ XcdBarrier xcd_barrier_post(unsigned* bar, volatile LAS unsigned* st) {
    XcdBarrier b; b.bar = bar; b.x = xb_xcc_id(); b.st = st;
    if (threadIdx.x == 0) (void)xb_add(&bar[XB_XCNT(b.x)], 1u);
    return b;
}
__device__ __forceinline__ void xcd_barrier_complete(unsigned* bar, unsigned x, unsigned& nloc, unsigned& nx) {
    const unsigned G = gridDim.x * gridDim.y * gridDim.z;
    unsigned sum, cnt, mine, sp = 0u;
    for (;;) {
        sum = 0u; cnt = 0u; mine = 0u;
#pragma unroll
        for (unsigned j = 0; j < 16; ++j) { const unsigned c = xb_ld(&bar[XB_XCNT(j)]); sum += c; cnt += (c > 0u) ? 1u : 0u; mine = (j == x) ? c : mine; }
        if (sum == G) break;
        __builtin_amdgcn_s_sleep(1);
        if ((++sp & 255u) == 0u) { if (xb_ld(&bar[XB_TMO])) break; if (sp > XB_SPIN_CAP) { atomicAdd(&bar[XB_TMO], 1u); break; } }
    }
    nloc = mine > 0u ? mine : 1u; nx = cnt > 0u ? cnt : 1u;
}
__device__ __forceinline__ void xcd_barrier(const XcdBarrier& b) {
    asm volatile("s_waitcnt vmcnt(0)" ::: "memory");
    __syncthreads();
    if (threadIdx.x == 0) {
        unsigned* bar = b.bar;
        __builtin_amdgcn_s_waitcnt(0);
        unsigned nloc = b.st[0], nx = b.st[1];
        if (nloc == 0u) { xcd_barrier_complete(bar, b.x, nloc, nx); b.st[0] = nloc; b.st[1] = nx; }
        const unsigned old = xb_add(&bar[XB_XSUB(b.x)], 1u);
        const unsigned gen = old / nloc;
        if (old + 1u == (gen + 1u) * nloc) {
            __builtin_amdgcn_fence(__ATOMIC_RELEASE, "agent");
            asm volatile("s_waitcnt vmcnt(0)" ::: "memory");
            const unsigned og = xb_add(&bar[XB_TOP], 1u);
            const unsigned tg = og / nx;
            if (og + 1u == (tg + 1u) * nx) xb_add(&bar[XB_TOPGEN], 1u);
            else XB_SPIN(xb_ld(&bar[XB_TOPGEN]) == tg, bar);
            __builtin_amdgcn_fence(__ATOMIC_ACQUIRE, "agent");
            xb_add(&bar[XB_XGEN(b.x)], 1u);
            asm volatile("s_waitcnt vmcnt(0)" ::: "memory");
        } else {
            XB_SPIN(xb_ld(&bar[XB_XGEN(b.x)]) == gen, bar);
            __builtin_amdgcn_fence(__ATOMIC_ACQUIRE, "agent");
            asm volatile("s_waitcnt vmcnt(0)" ::: "memory");
        }
    }
    __syncthreads();
}

namespace g8 {
constexpr int BM = 256, BK = 64, HALF = 128, HTB = HALF * BK * 2, NXCD = 8, WGM = 8;
__device__ __forceinline__ int lds_byte(int r, int c) { const int st = (r >> 4) * 2 + (c >> 5), rr = r & 15, cc = c & 31, ob = rr * 64 + cc * 2; return st * 1024 + (ob ^ (((ob >> 9) & 1) << 5)); }
__device__ __forceinline__ void stage_rc(int b, int& R, int& C) { const int st = b / 1024, sb = b % 1024, swz = sb ^ (((sb >> 9) & 1) << 5); R = (st >> 1) * 16 + swz / 64; C = (st & 1) * 32 + (swz % 64) / 2; }
__device__ __forceinline__ int perm32(int rho) { const int n = rho >> 4, i = rho & 15; return 8 * (i >> 2) + 4 * n + (i & 3); }

struct Unit { const char* A; const char* B; unsigned vA0[2], vA1[2]; int r0, pn, e, rend; };

template <class Epi, class Sched, bool F8 = false>
__device__ __forceinline__ void gemm_phase(LAS unsigned char* lds, const int pitch, const Sched& S, const Epi& E) {
    const int tid = threadIdx.x, wid = __builtin_amdgcn_readfirstlane(tid >> 6), lane = tid & 63, wr = wid >> 2, wc = wid & 3, fr = lane & 15, fq = lane >> 4;
    const int nt = pitch / 128;
    unsigned voffB[2], voffB1[2];
#pragma unroll
    for (int i = 0; i < 2; ++i) { int R, C; stage_rc(tid * 16 + i * 8192, R, C); const int p = perm32(R & 31);
        if constexpr (Epi::P16) { const int base = 64 * (R >> 5) + 16 * (p >> 3) + (p & 7); voffB[i] = (unsigned)(base * pitch + C * 2); voffB1[i] = (unsigned)((base + 8) * pitch + C * 2); }
        else { const int Rb = Epi::PERM ? ((R & ~31) + p) : R; voffB[i] = (unsigned)(Rb * pitch + C * 2); voffB1[i] = voffB[i] + (unsigned)(HALF * pitch); } }
    const size_t kstep = 128;
    const size_t hstepB = (size_t)HALF * pitch;
    const unsigned ldsw = (unsigned)wid * 1024u;
    const int aoff = lds_byte(wr * 64 + fr, fq * 8), boff = lds_byte(wc * 32 + fr, fq * 8);
#define G8_SA(b, h) (((b) * 2 + (h)) * HTB)
#define G8_SB(b, h) ((4 + (b) * 2 + (h)) * HTB)
#define G8_STAGE(bufoff, gbase, voff) do { _Pragma("unroll") for (int _i = 0; _i < 2; ++_i) \
        __builtin_amdgcn_global_load_lds((const unsigned*)((const char*)(gbase) + (voff)[_i]), (LAS unsigned*)(lds + (bufoff) + ldsw + _i * 8192), 16, 0, 0); } while (0)
#define G8_LDA(dst, b, h) do { _Pragma("unroll") for (int m = 0; m < 4; ++m) _Pragma("unroll") for (int k = 0; k < 2; ++k) dst[m][k] = *(const LAS bf16x8*)(lds + G8_SA(b, h) + aoff + m * 2048 + k * 1024); } while (0)
#define G8_LDB(dst, b, h) do { _Pragma("unroll") for (int n = 0; n < 2; ++n) _Pragma("unroll") for (int k = 0; k < 2; ++k) dst[n][k] = *(const LAS bf16x8*)(lds + G8_SB(b, h) + boff + n * 2048 + k * 1024); } while (0)
#define G8_CAT(x) __builtin_shufflevector(__builtin_bit_cast(i32x4, x[0]), __builtin_bit_cast(i32x4, x[1]), 0, 1, 2, 3, 4, 5, 6, 7)
#define G8_MMA(ai, bj, At, Bt) do { __builtin_amdgcn_s_setprio(1); _Pragma("unroll") for (int m = 0; m < 4; ++m) _Pragma("unroll") for (int n = 0; n < 2; ++n) { \
        if constexpr (F8) acc[ai][bj][m][n] = __builtin_amdgcn_mfma_scale_f32_16x16x128_f8f6f4(G8_CAT(Bt[n]), G8_CAT(At[m]), acc[ai][bj][m][n], 0, 0, 0, 0x7f7f7f7f, 0, 0x7f7f7f7f); \
        else { _Pragma("unroll") for (int k = 0; k < 2; ++k) acc[ai][bj][m][n] = __builtin_amdgcn_mfma_f32_16x16x32_bf16(Bt[n][k], At[m][k], acc[ai][bj][m][n], 0, 0, 0); } } \
        __builtin_amdgcn_s_setprio(0); } while (0)
#define G8_WAIT_V(n) asm volatile("s_waitcnt vmcnt(" #n ")" ::: "memory")
#define G8_WAIT_L(n) asm volatile("s_waitcnt lgkmcnt(" #n ")" ::: "memory")
#define G8_BAR __builtin_amdgcn_s_barrier()
#define G8_SCHED __builtin_amdgcn_sched_barrier(0)
    Unit cur, nxt; int ui = 0;
    if (!S.next(0, cur)) return;
    f32x4 acc[2][2][4][2];
#pragma unroll
    for (int a = 0; a < 2; ++a)
#pragma unroll
        for (int b = 0; b < 2; ++b)
#pragma unroll
            for (int m = 0; m < 4; ++m)
#pragma unroll
                for (int n = 0; n < 2; ++n) acc[a][b][m][n] = (f32x4){0.f, 0.f, 0.f, 0.f};
    bf16x8 At[4][2], B0[2][2], B1[2][2];
    const char* cA = cur.A; const char* cB = cur.B;
    G8_STAGE(G8_SB(0, 0), cB, voffB); G8_STAGE(G8_SB(0, 1), cB, voffB1); G8_STAGE(G8_SA(0, 0), cA, cur.vA0); G8_STAGE(G8_SA(0, 1), cA, cur.vA1);
    if (wr == 1) G8_BAR;
    G8_WAIT_V(2); G8_BAR;
    G8_STAGE(G8_SB(1, 0), cB + kstep, voffB); G8_STAGE(G8_SA(1, 0), cA + kstep, cur.vA0); G8_STAGE(G8_SB(1, 1), cB + kstep, voffB1);
    G8_WAIT_V(6); G8_BAR;
    for (;;) {
        const bool has_next = S.next(ui + 1, nxt);
        if (!has_next) nxt = cur;
        const char* nA = nxt.A; const char* nB = nxt.B;
#pragma unroll 1
        for (int t = 0; t < nt; t += 2) {
            const bool last = (t == nt - 2);
            const char* a1 = cA + (size_t)(t + 1) * kstep;
            const char* a2 = last ? nA : cA + (size_t)(t + 2) * kstep; const char* b2 = last ? nB : cB + (size_t)(t + 2) * kstep;
            const char* a3 = a2 + kstep; const char* b3 = b2 + kstep;
            G8_LDB(B0, 0, 0); G8_LDB(B1, 0, 1); G8_SCHED; G8_LDA(At, 0, 0); G8_STAGE(G8_SA(1, 1), a1, cur.vA1);
            if (last) { cur.vA0[0] = nxt.vA0[0]; cur.vA0[1] = nxt.vA0[1]; cur.vA1[0] = nxt.vA1[0]; cur.vA1[1] = nxt.vA1[1]; }
            G8_WAIT_V(8); G8_WAIT_L(0); G8_BAR; G8_MMA(0, 0, At, B0); G8_MMA(0, 1, At, B1); G8_BAR; G8_SCHED;
            G8_LDA(At, 0, 1); G8_STAGE(G8_SB(0, 0), b2, voffB); G8_STAGE(G8_SB(0, 1), b2, voffB1); G8_STAGE(G8_SA(0, 0), a2, cur.vA0);
            G8_WAIT_V(8); G8_WAIT_L(0); G8_BAR; G8_MMA(1, 0, At, B0); G8_MMA(1, 1, At, B1); G8_BAR; G8_SCHED;
            G8_LDB(B0, 1, 0); G8_LDB(B1, 1, 1); G8_SCHED; G8_LDA(At, 1, 0); G8_STAGE(G8_SA(0, 1), a2, cur.vA1);
            G8_WAIT_V(8); G8_WAIT_L(0); G8_BAR; G8_MMA(0, 0, At, B0); G8_MMA(0, 1, At, B1); G8_BAR; G8_SCHED;
            G8_LDA(At, 1, 1); G8_STAGE(G8_SB(1, 0), b3, voffB); G8_STAGE(G8_SB(1, 1), b3, voffB1); G8_STAGE(G8_SA(1, 0), a3, cur.vA0);
            G8_WAIT_V(8); G8_WAIT_L(0); G8_BAR; G8_MMA(1, 0, At, B0); G8_MMA(1, 1, At, B1); G8_BAR; G8_SCHED;
        }
        if (wr == 0) G8_BAR;
        E(acc, cur, wr, wc, fr, fq);
        if (!has_next) break;
#pragma unroll
        for (int a = 0; a < 2; ++a)
#pragma unroll
            for (int b = 0; b < 2; ++b)
#pragma unroll
                for (int m = 0; m < 4; ++m)
#pragma unroll
                    for (int n = 0; n < 2; ++n) acc[a][b][m][n] = (f32x4){0.f, 0.f, 0.f, 0.f};
        cur = nxt; cA = nA; cB = nB; ++ui;
        if (wr == 1) G8_BAR;
    }
    G8_WAIT_V(0);
    G8_BAR;
#undef G8_SA
#undef G8_SB
#undef G8_STAGE
#undef G8_LDA
#undef G8_CAT
#undef G8_LDB
#undef G8_MMA
#undef G8_WAIT_V
#undef G8_WAIT_L
#undef G8_BAR
#undef G8_SCHED
}

struct DenseOrder {
    const char* A; const char* Bt; int pitch; int nM, nN, nwg, G, c;
    __device__ void init(const void* A_, const void* Bt_, int M, int N, int pitch_, int G_, int c_) { A = (const char*)A_; Bt = (const char*)Bt_; pitch = pitch_; nM = M / BM; nN = N / BM; nwg = nM * nN; G = G_; c = c_; }
    __device__ __forceinline__ bool next(int i, Unit& u) const {
        const long L = (long)i * G + c; if (L >= nwg) return false;
        int R[2], C[2]; stage_rc((int)threadIdx.x * 16, R[0], C[0]); stage_rc((int)threadIdx.x * 16 + 8192, R[1], C[1]);
        int wgid = (int)L; { const int q = nwg / NXCD, r = nwg % NXCD, xcd = wgid % NXCD, off = wgid / NXCD; wgid = (xcd < r ? xcd * (q + 1) : r * (q + 1) + (xcd - r) * q) + off; }
        const int nig = WGM * nN, gid = wgid / nig, fm = gid * WGM, gsz = (nM - fm) < WGM ? (nM - fm) : WGM;
        const int pm = fm + ((wgid % nig) % gsz), pn = (wgid % nig) / gsz;
        u.A = A + (size_t)pm * BM * pitch; u.B = Bt + (size_t)pn * BM * pitch;
#pragma unroll
        for (int j = 0; j < 2; ++j) { u.vA0[j] = (unsigned)(R[j] * pitch + C[j] * 2); u.vA1[j] = (unsigned)((R[j] + HALF) * pitch + C[j] * 2); }
        u.r0 = pm * BM; u.pn = pn; u.e = 0; u.rend = 0; return true;
    }
};
}

struct Args { const void* in[25]; float* out; unsigned char* ws; int ph_lo, ph_hi; };
struct Ctx {
    LAS unsigned char* lds; unsigned char* ws; const void* const* in; float* out;
    int tid, lane, wave, vcu, G;
};

__device__ __forceinline__ void p0_adaln(Ctx& F) {
    LAS float* sc = (LAS float*)F.lds;
    LAS float* red = (LAS float*)(F.lds + 65536);
    const float* cvec = (const float*)F.in[1]; const float* wada = (const float*)F.in[3]; const float* bada = (const float*)F.in[4]; float* mod = (float*)(F.ws + WS_MOD);
    __syncthreads();
    for (int i = F.tid; i < NB * DM; i += NWAVES * 64) sc[i] = siluf_(cvec[i]);
    __syncthreads();
    for (int cb = F.vcu; cb < 6 * DM / 48; cb += F.G) {
        const int n0 = cb * 48, l = F.lane < 48 ? F.lane : 47, k0 = F.wave * 256;
        float acc[8];
#pragma unroll
        for (int b = 0; b < 8; ++b) acc[b] = 0.f;
        const float* col = wada + (size_t)k0 * (6 * DM) + n0 + l;
#pragma unroll 1
        for (int kk = 0; kk < 256; kk += 32) { float wv[32];
#pragma unroll
            for (int u = 0; u < 32; ++u) wv[u] = col[(size_t)(kk + u) * (6 * DM)];
#pragma unroll
            for (int u = 0; u < 32; ++u)
#pragma unroll
                for (int b = 0; b < 8; ++b) acc[b] += sc[b * DM + k0 + kk + u] * wv[u]; }
        if (F.lane < 48) {
#pragma unroll
            for (int b = 0; b < 8; ++b) red[(F.wave * 8 + b) * 48 + F.lane] = acc[b]; }
        __syncthreads();
        if (F.tid < 384) { const int b = F.tid / 48, cc = F.tid % 48; float s = bada[n0 + cc];
#pragma unroll
            for (int w = 0; w < 8; ++w) s += red[(w * 8 + b) * 48 + cc];
            __hip_atomic_store(mod + (size_t)b * 6 * DM + n0 + cc, s, __ATOMIC_RELAXED, __HIP_MEMORY_SCOPE_AGENT); }
        VM_WAIT();
        __syncthreads();
    }
    if (F.tid == 0) __hip_atomic_fetch_add((unsigned*)(F.ws + WS_CTL) + CW_MODCNT, 1u, __ATOMIC_RELAXED, __HIP_MEMORY_SCOPE_AGENT);
}
__device__ __forceinline__ void p0_wait_mod(Ctx& F) {
    if (F.tid == 0) { unsigned* ctl = (unsigned*)(F.ws + WS_CTL); unsigned sp = 0u;
        while (ld_agent(ctl + CW_MODCNT) < (unsigned)F.G) { __builtin_amdgcn_s_sleep(2); if (++sp > (1u << 20)) { atomicAdd(ctl + CW_BAR + XB_TMO, 1u); break; } }
        __builtin_amdgcn_fence(__ATOMIC_ACQUIRE, "agent");
        asm volatile("s_waitcnt vmcnt(0)" ::: "memory"); }
    __syncthreads();
}
template <bool F8>
__device__ __forceinline__ void p0_transpose_item(const float* W, int K, int N, void* WT, int out_row0, int k0, int n0, float scale, LAS float* scr, int lane) {
    f32x4 v[16];
#pragma unroll
    for (int i = 0; i < 16; ++i) v[i] = *(const f32x4*)(W + (size_t)(k0 + 4 * i + (lane >> 4)) * N + n0 + 4 * (lane & 15));
#pragma unroll
    for (int i = 0; i < 16; ++i) { LAS float* d = scr + (4 * i + (lane >> 4)) * 65 + 4 * (lane & 15); d[0] = v[i].x; d[1] = v[i].y; d[2] = v[i].z; d[3] = v[i].w; }
    LDS_WAIT(); asm volatile("" ::: "memory");
    if (!F8) {
        const int c = lane & 7;
#pragma unroll
        for (int j = 0; j < 8; ++j) { const int n = (lane >> 3) + 8 * j; const LAS float* s = scr + (8 * c) * 65 + n;
            u32x4 o; o.x = pk2(s[0 * 65], s[1 * 65]); o.y = pk2(s[2 * 65], s[3 * 65]); o.z = pk2(s[4 * 65], s[5 * 65]); o.w = pk2(s[6 * 65], s[7 * 65]);
            *(u32x4*)((bf16*)WT + (size_t)(out_row0 + n) * K + k0 + 8 * c) = o; }
    } else {
        const int c = lane & 3;
#pragma unroll
        for (int j = 0; j < 4; ++j) { const int n = (lane >> 2) + 16 * j; const LAS float* s = scr + (16 * c) * 65 + n; int o[4];
#pragma unroll
            for (int q = 0; q < 4; ++q) { int wv = 0; wv = __builtin_amdgcn_cvt_pk_fp8_f32(s[(4 * q) * 65] * scale, s[(4 * q + 1) * 65] * scale, wv, false); wv = __builtin_amdgcn_cvt_pk_fp8_f32(s[(4 * q + 2) * 65] * scale, s[(4 * q + 3) * 65] * scale, wv, true); o[q] = wv; }
            *(u32x4*)((unsigned char*)WT + (size_t)(out_row0 + n) * K + k0 + 16 * c) = (u32x4){(unsigned)o[0], (unsigned)o[1], (unsigned)o[2], (unsigned)o[3]}; }
    }
    LDS_WAIT(); asm volatile("" ::: "memory");
}
struct CvItem { const float* src; unsigned char* dst; int N, K; float scale; };
__device__ __forceinline__ CvItem cv_decode(const void* const* in, unsigned char* ws, int r) {
    constexpr int I_EI = 32 * 16, I_EO = 8 * 32; CvItem c;
    if (r < 65 * I_EI) { const int e = r / I_EI, q = r % I_EI, kb = q / 16, nb = q % 16, n0 = 64 * nb, j = n0 & 511, up = n0 >> 9;
        const float* W = (e < 64) ? (const float*)in[20] + (size_t)e * DM * 1024 : (const float*)in[22];
        c.src = W + (size_t)(64 * kb) * 1024 + n0; c.N = 1024; c.K = DM; c.scale = SC_WEI;
        c.dst = ws + WS_WEI + (size_t)e * 1024 * DM + (size_t)((j >> 7) * 256 + up * 128 + (j & 127)) * DM + 64 * kb; }
    else { r -= 65 * I_EI; const int e = r / I_EO, q = r % I_EO, kb = q / 32, nb = q % 32;
        const float* W = (e < 64) ? (const float*)in[21] + (size_t)e * EH * DM : (const float*)in[23];
        c.src = W + (size_t)(64 * kb) * DM + 64 * nb; c.N = DM; c.K = EH; c.scale = SC_WEO;
        c.dst = ws + WS_WEO + (size_t)e * DM * EH + (size_t)(64 * nb) * EH + 64 * kb; }
    return c;
}
__device__ __forceinline__ void p2_convert_experts(Ctx& F) {
    const int gw = F.vcu * NWAVES + F.wave, NGW = F.G * NWAVES, lane = F.lane, li = lane & 15, lg = lane >> 4;
    constexpr int NCV = 65 * (32 * 16 + 8 * 32);
    int it = gw; CvItem cur; f32x4 v[16];
    const int krow = 16 * (li >> 2) + (li & 3);
#define CV_LOAD(c) do { _Pragma("unroll") for (int nh = 0; nh < 2; ++nh) _Pragma("unroll") for (int q = 0; q < 4; ++q) { const float* p_ = (c).src + (size_t)(krow + 4 * q) * (c).N + 32 * nh + 8 * lg; \
        v[(nh * 4 + q) * 2] = *(const f32x4*)p_; v[(nh * 4 + q) * 2 + 1] = *(const f32x4*)(p_ + 4); } } while (0)
    if (it < NCV) { cur = cv_decode(F.in, F.ws, it); CV_LOAD(cur); }
    while (it < NCV) {
        bf16x8 a[2][4];
#pragma unroll
        for (int nh = 0; nh < 2; ++nh)
#pragma unroll
            for (int q = 0; q < 4; ++q) { const f32x4 lo = v[(nh * 4 + q) * 2], hi = v[(nh * 4 + q) * 2 + 1];
                const u32x4 pk = (u32x4){pk2c(lo.x, lo.y), pk2c(lo.z, lo.w), pk2c(hi.x, hi.y), pk2c(hi.z, hi.w)}; a[nh][q] = __builtin_bit_cast(bf16x8, pk); }
        const CvItem me = cur; const int nit = it + NGW;
        if (nit < NCV) { cur = cv_decode(F.in, F.ws, nit); CV_LOAD(cur); }
        const unsigned sbits = (unsigned)f2bf(me.scale);
#pragma unroll
        for (int h = 0; h < 2; ++h) {
            u32x4 sel = (u32x4){0u, 0u, 0u, 0u}; { const int d = 16 * h + li - 8 * lg; if (d >= 0 && d < 8) { const unsigned wv = (d & 1) ? (sbits << 16) : sbits; if ((d >> 1) == 0) sel.x = wv; else if ((d >> 1) == 1) sel.y = wv; else if ((d >> 1) == 2) sel.z = wv; else sel.w = wv; } }
            const bf16x8 bs = __builtin_bit_cast(bf16x8, sel);
#pragma unroll
            for (int nh = 0; nh < 2; ++nh) { unsigned o[4];
#pragma unroll
                for (int q = 0; q < 4; ++q) { const f32x4 d = __builtin_amdgcn_mfma_f32_16x16x32_bf16(a[nh][q], bs, (f32x4){0.f, 0.f, 0.f, 0.f}, 0, 0, 0); o[q] = pk4_fp8(d[0], d[1], d[2], d[3]); }
                *(u32x4*)(me.dst + (size_t)(32 * nh + 16 * h + li) * me.K + 16 * lg) = (u32x4){o[0], o[1], o[2], o[3]}; }
        }
        it = nit;
    }
#undef CV_LOAD
}
__device__ __forceinline__ void p0_prologue(Ctx& F) {
    LAS float* scr = (LAS float*)(F.lds + F.wave * 16640);
    const int gw = F.vcu * NWAVES + F.wave, NGW = F.G * NWAVES, lane = F.lane;
    unsigned char* ws = F.ws;
    constexpr int I_IN = 32 * 96, I_OUT = 32 * 32, I_R = 32 * 1, I_G = 2 * 2;
    constexpr int NTR = I_IN + I_OUT + I_R + 16 * I_G;
    for (int it = gw; it < NTR; it += NGW) {
        int r = it;
        if (r < I_IN) { const int kb = r / 96, nb = r % 96; p0_transpose_item<false>((const float*)F.in[6], DM, NIN, ws + WS_WIN, 64 * nb, 64 * kb, 64 * nb, 1.f, scr, lane); continue; } r -= I_IN;
        if (r < I_OUT) { const int kb = r / 32, nb = r % 32; p0_transpose_item<false>((const float*)F.in[16], DM, DM, ws + WS_WOUT, 64 * nb, 64 * kb, 64 * nb, 1.f, scr, lane); continue; } r -= I_OUT;
        if (r < I_R) { const int kb = r; p0_transpose_item<false>((const float*)F.in[18], DM, NE, ws + WS_WR, 0, 64 * kb, 0, 1.f, scr, lane); continue; } r -= I_R;
        { const int m = r / I_G, q = r % I_G, kb = q / 2, nb = q % 2, g = m & 7;
          const float* W = ((m < 8) ? (const float*)F.in[9] : (const float*)F.in[11]) + (size_t)g * 128 * 128;
          p0_transpose_item<false>(W, 128, 128, (bf16*)(ws + (m < 8 ? WS_WA : WS_WX)) + (size_t)g * 128 * 128, 64 * nb, 64 * kb, 64 * nb, 1.f, scr, lane); }
    }
    {
        const int* pos = (const int*)F.in[2]; unsigned* rt = (unsigned*)(ws + WS_ROPE);
        for (int it = gw; it < T * 64 / 512; it += NGW) {
#pragma unroll 1
            for (int q = 0; q < 8; ++q) { const int idx = it * 512 + q * 64 + lane, t = idx >> 6, i = idx & 63;
                const double inv = exp(-9.210340371976184 * (double)i / 64.0); const double ang = (double)pos[t] * inv; double sn, cs; sincos(ang, &sn, &cs);
                rt[idx] = pk2c((float)cs, (float)sn); }
        }
    }
    if (gw == 0) { u32x4* z = (u32x4*)((bf16*)(ws + WS_H) + (size_t)T * DM); for (int i = lane; i < DM * 2 / 16; i += 64) z[i] = (u32x4){0u, 0u, 0u, 0u};
        u32x4* z8 = (u32x4*)(ws + WS_H8 + (size_t)T * DM); for (int i = lane; i < DM / 16; i += 64) z8[i] = (u32x4){0u, 0u, 0u, 0u}; }
}

template <bool W8, bool INBF>
__device__ __forceinline__ void norm_mod_row(const void* xrow_, const float* g, const float* sc, const float* sh, bf16* orow, unsigned char* orow8, int lane) {
    f32x4 v[4][2]; float ss = 0.f;
#pragma unroll
    for (int j = 0; j < 4; ++j) {
        if constexpr (INBF) { const u32x4 w = *(const u32x4*)((const bf16*)xrow_ + 8 * lane + 512 * j); v[j][0] = (f32x4){bflo(w.x), bfhi(w.x), bflo(w.y), bfhi(w.y)}; v[j][1] = (f32x4){bflo(w.z), bfhi(w.z), bflo(w.w), bfhi(w.w)}; }
        else { v[j][0] = *(const f32x4*)((const float*)xrow_ + 8 * lane + 512 * j); v[j][1] = *(const f32x4*)((const float*)xrow_ + 8 * lane + 512 * j + 4); }
#pragma unroll
        for (int h = 0; h < 2; ++h) ss += (v[j][h].x * v[j][h].x + v[j][h].y * v[j][h].y) + (v[j][h].z * v[j][h].z + v[j][h].w * v[j][h].w); }
    const float rstd = rsqrtf(wave_sum(ss) * (1.0f / DM) + EPS);
#pragma unroll
    for (int j = 0; j < 4; ++j) { f32x4 o[2];
#pragma unroll
        for (int h = 0; h < 2; ++h) { const int c = 8 * lane + 512 * j + 4 * h; const f32x4 gg = *(const f32x4*)(g + c), s1 = *(const f32x4*)(sc + c), s0 = *(const f32x4*)(sh + c);
            o[h] = (v[j][h] * rstd * gg) * (s1 + 1.0f) + s0; }
        u32x4 w; w.x = pk2(o[0].x, o[0].y); w.y = pk2(o[0].z, o[0].w); w.z = pk2(o[1].x, o[1].y); w.w = pk2(o[1].z, o[1].w);
        *(u32x4*)(orow + 8 * lane + 512 * j) = w;
        if constexpr (W8) { u32x2 w8; w8.x = pk4_fp8(o[0].x * SC_H8, o[0].y * SC_H8, o[0].z * SC_H8, o[0].w * SC_H8); w8.y = pk4_fp8(o[1].x * SC_H8, o[1].y * SC_H8, o[1].z * SC_H8, o[1].w * SC_H8); *(u32x2*)(orow8 + 8 * lane + 512 * j) = w8; } }
}
__device__ __forceinline__ void p1_norm(Ctx& F) {
    const int gw = F.vcu * NWAVES + F.wave, NGW = F.G * NWAVES;
    const float* x = (const float*)F.in[0]; const float* g = (const float*)F.in[5]; const float* mod = (const float*)(F.ws + WS_MOD); bf16* h = (bf16*)(F.ws + WS_H);
    for (int m = gw; m < T; m += NGW) { const int b = m / SEQ; norm_mod_row<false, false>(x + (size_t)m * DM, g, mod + (size_t)b * 6 * DM + DM, mod + (size_t)b * 6 * DM, h + (size_t)m * DM, nullptr, F.lane); }
}

struct EpiProj {
    static constexpr bool PERM = true, P16 = false;
    bf16* O;
    __device__ __forceinline__ void operator()(const f32x4 (&acc)[2][2][4][2], const g8::Unit& u, int wr, int wc, int fr, int fq) const {
        const int row0 = u.r0 + wr * 64 + fr, col0 = u.pn * 256 + wc * 32 + 8 * fq;
#pragma unroll
        for (int ai = 0; ai < 2; ++ai)
#pragma unroll
            for (int m = 0; m < 4; ++m) { bf16* rowp = O + (size_t)(row0 + ai * 128 + m * 16) * NIN + col0;
#pragma unroll
                for (int bj = 0; bj < 2; ++bj) { const f32x4 v0 = acc[ai][bj][m][0], v1 = acc[ai][bj][m][1];
                    u32x4 w; w.x = pk2c(v0[0], v0[1]); w.y = pk2c(v0[2], v0[3]); w.z = pk2c(v1[0], v1[1]); w.w = pk2c(v1[2], v1[3]);
                    *(u32x4*)(rowp + bj * 128) = w; } }
    }
};
struct EpiWout {
    static constexpr bool PERM = true, P16 = false;
    const float* x; const float* mod; bf16* x1;
    __device__ __forceinline__ void operator()(const f32x4 (&acc)[2][2][4][2], const g8::Unit& u, int wr, int wc, int fr, int fq) const {
        const int row0 = u.r0 + wr * 64 + fr, col0 = u.pn * 256 + wc * 32 + 8 * fq; const int b = u.r0 / SEQ;
        const float* gt = mod + (size_t)b * 6 * DM + 2 * DM;
        f32x4 gv[2][2];
#pragma unroll
        for (int bj = 0; bj < 2; ++bj)
#pragma unroll
            for (int n = 0; n < 2; ++n) gv[bj][n] = *(const f32x4*)(gt + col0 + bj * 128 + n * 4);
#pragma unroll
        for (int ai = 0; ai < 2; ++ai)
#pragma unroll
            for (int m = 0; m < 4; ++m) { const size_t off = (size_t)(row0 + ai * 128 + m * 16) * DM + col0;
#pragma unroll
                for (int bj = 0; bj < 2; ++bj) { const f32x4 v0 = *(const f32x4*)(x + off + bj * 128) + gv[bj][0] * acc[ai][bj][m][0], v1 = *(const f32x4*)(x + off + bj * 128 + 4) + gv[bj][1] * acc[ai][bj][m][1];
                    u32x4 w; w.x = pk2(v0[0], v0[1]); w.y = pk2(v0[2], v0[3]); w.z = pk2(v1[0], v1[1]); w.w = pk2(v1[2], v1[3]);
                    *(u32x4*)(x1 + off + bj * 128) = w; }
                asm volatile("" ::: "memory"); }
    }
};
struct EpiSwiglu {
    static constexpr bool PERM = true, P16 = false;
    unsigned char* act;
    __device__ __forceinline__ void operator()(const f32x4 (&acc)[2][2][4][2], const g8::Unit& u, int wr, int wc, int fr, int fq) const {
        const int row0 = u.r0 + wr * 64 + fr, col0 = u.pn * 128 + wc * 32 + 8 * fq;
#pragma unroll
        for (int ai = 0; ai < 2; ++ai)
#pragma unroll
            for (int m = 0; m < 4; ++m) { float o[8];
#pragma unroll
                for (int n = 0; n < 2; ++n)
#pragma unroll
                    for (int j = 0; j < 4; ++j) { const float g = acc[ai][0][m][n][j] * (1.0f / (SC_H8 * SC_WEI)), up = acc[ai][1][m][n][j] * (SC_ACT / (SC_H8 * SC_WEI)); o[4 * n + j] = g * __builtin_amdgcn_rcpf(1.0f + __expf(-g)) * up; }
                u32x2 w; w.x = pk4_fp8(o[0], o[1], o[2], o[3]); w.y = pk4_fp8(o[4], o[5], o[6], o[7]);
                *(u32x2*)(act + (size_t)(row0 + ai * 128 + m * 16) * EH + col0) = w; }
    }
};
struct EpiDown {
    static constexpr bool PERM = true, P16 = true;
    unsigned char* y;
    __device__ __forceinline__ void operator()(const f32x4 (&acc)[2][2][4][2], const g8::Unit& u, int wr, int wc, int fr, int fq) const {
        const int row0 = u.r0 + wr * 64 + fr, col0 = u.pn * 256 + wc * 64 + 16 * fq; constexpr float sc = SC_Y / (SC_ACT * SC_WEO); static_assert(sc == 1.0f, "scales chosen so that y needs no multiply");
#pragma unroll
        for (int ai = 0; ai < 2; ++ai)
#pragma unroll
            for (int m = 0; m < 4; ++m) { u32x4 w;
                { const f32x4 v0 = acc[ai][0][m][0], v1 = acc[ai][0][m][1], v2 = acc[ai][1][m][0], v3 = acc[ai][1][m][1];
                  w.x = pk4_fp8(v0[0], v0[1], v0[2], v0[3]); w.y = pk4_fp8(v1[0], v1[1], v1[2], v1[3]); w.z = pk4_fp8(v2[0], v2[1], v2[2], v2[3]); w.w = pk4_fp8(v3[0], v3[1], v3[2], v3[3]); }
                *(u32x4*)(y + (size_t)(row0 + ai * 128 + m * 16) * DM + col0) = w; }
    }
};

struct MoeTables { LAS int* row0; LAS int* te; LAS int* pend; LAS int* tp; };
__device__ __forceinline__ MoeTables moe_tables(Ctx& F) { MoeTables M; M.row0 = (LAS int*)(F.lds + TT_OFF); M.te = M.row0 + MAXTILES; M.pend = M.te + MAXTILES; M.tp = M.pend + 80; return M; }
__device__ __forceinline__ int moe_build_tables(Ctx& F) {
    MoeTables M = moe_tables(F);
    const unsigned* cnt = (const unsigned*)(F.ws + WS_CTL) + CW_CNT;
    __syncthreads();
    if (F.tid < NE) M.row0[F.tid] = (int)ld_agent(cnt + 32 * F.tid);
    __syncthreads();
    if (F.tid == 0) { int tiles = 0;
        for (int e = 0; e < NE; ++e) { const int c = M.row0[e]; M.tp[e] = tiles; M.pend[e] = tiles * 256 + c; tiles += (c + 255) >> 8; }
        M.tp[NE] = NR_ROUTED / 256; M.pend[NE] = NR; M.tp[NE + 1] = NR_ROUTED / 256 + T / 256; M.tp[NE + 2] = tiles; }
    __syncthreads();
    const int rt = M.tp[NE + 2];
    for (int tau = F.tid; tau < rt; tau += NWAVES * 64) { int e = 0; while (e + 1 < NE && M.tp[e + 1] <= tau) ++e; M.te[tau] = e; M.row0[tau] = tau * 256; }
    for (int s = F.tid; s < T / 256; s += NWAVES * 64) { M.te[rt + s] = NE; M.row0[rt + s] = NR_ROUTED + s * 256; }
    __syncthreads();
    return rt + T / 256;
}
template <int PHASE>
struct MoeOrder {
    MoeTables M; const char* A; const char* W; const int* row_tok; LAS unsigned char* lds_tok; int U, CH, x, j;
    static constexpr int NPN = (PHASE == 1) ? 4 : 8;
    __device__ void init(Ctx& F, int ntiles) { M = moe_tables(F); U = ntiles * NPN; CH = (U + 7) / 8; x = F.vcu / (F.G / 8); j = F.vcu % (F.G / 8);
        A = (const char*)(F.ws + (PHASE == 1 ? WS_H8 : WS_ACT)); W = (const char*)(F.ws + (PHASE == 1 ? WS_WEI : WS_WEO)); row_tok = (const int*)(F.ws + WS_TOKOF); lds_tok = F.lds + TOKL_OFF; }
    __device__ __forceinline__ void fill_tokens(Ctx& F) const {
        for (int i = 0; i < TOKL_UNITS; ++i) { const int q = i * 32 + j; const int L = x * CH + q; if (q >= CH || L >= U) break;
            const int tile = L / NPN; const int e = M.te[tile], r0 = M.row0[tile], rend = M.pend[e];
            if (F.tid < 256) { const int ra = r0 + F.tid; int tk;
                if (e == NE) tk = ra - NR_ROUTED; else tk = (ra < rend) ? ld_agent_i(row_tok + (size_t)e * T + (ra - M.tp[e] * 256)) : T;
                ((LAS int*)lds_tok)[i * 256 + F.tid] = tk; } }
        __syncthreads();
    }
    __device__ __forceinline__ bool next(int i, g8::Unit& u) const {
        const int q = i * 32 + j; const int L = x * CH + q; if (q >= CH || L >= U) return false;
        int R[2], C[2]; g8::stage_rc((int)threadIdx.x * 16, R[0], C[0]); g8::stage_rc((int)threadIdx.x * 16 + 8192, R[1], C[1]);
        const int tile = L / NPN, pn = L % NPN;
        const int e = __builtin_amdgcn_readfirstlane(M.te[tile]), r0 = __builtin_amdgcn_readfirstlane(M.row0[tile]), rend = __builtin_amdgcn_readfirstlane(M.pend[e]);
        u.r0 = r0; u.pn = pn; u.e = e; u.rend = rend; u.A = A;
        if (PHASE == 1) {
            u.B = W + ((size_t)e * 1024 + (size_t)pn * 256) * DM;
#pragma unroll
            for (int k = 0; k < 2; ++k) { const int ra = r0 + R[k], rb = ra + 128; int ta, tb;
                if (e == NE) { ta = ra - NR_ROUTED; tb = rb - NR_ROUTED; }
                else { const LAS int* tl = (const LAS int*)(lds_tok) + (i % TOKL_UNITS) * 256; ta = tl[R[k]]; tb = tl[R[k] + 128]; }
                u.vA0[k] = (unsigned)(ta * DM + C[k] * 2); u.vA1[k] = (unsigned)(tb * DM + C[k] * 2); }
        } else {
            u.B = W + ((size_t)e * DM + (size_t)pn * 256) * EH;
#pragma unroll
            for (int k = 0; k < 2; ++k) { u.vA0[k] = (unsigned)((r0 + R[k]) * EH + C[k] * 2); u.vA1[k] = (unsigned)((r0 + R[k] + 128) * EH + C[k] * 2); }
        }
        asm volatile("" : "+v"(u.vA0[0]), "+v"(u.vA0[1]), "+v"(u.vA1[0]), "+v"(u.vA1[1]));
        return true;
    }
};

__device__ __forceinline__ bf16x8 tr_pair(unsigned a0, unsigned a1) { u32x2 r0, r1; asm volatile("ds_read_b64_tr_b16 %0, %2\n\tds_read_b64_tr_b16 %1, %3\n\ts_waitcnt lgkmcnt(0)" : "=&v"(r0), "=&v"(r1) : "v"(a0), "v"(a1) : "memory"); return __builtin_bit_cast(bf16x8, (u32x4){r0.x, r0.y, r1.x, r1.y}); }
__device__ __forceinline__ void tr_quad(bf16x8 (&o)[4], unsigned a0, unsigned a1, unsigned a2, unsigned a3, unsigned d1) {
    u32x2 r0, r1, r2, r3, r4, r5, r6, r7; const unsigned b0 = a0 + d1, b1 = a1 + d1, b2 = a2 + d1, b3 = a3 + d1;
    asm volatile("ds_read_b64_tr_b16 %0, %8\n\tds_read_b64_tr_b16 %1, %9\n\tds_read_b64_tr_b16 %2, %10\n\tds_read_b64_tr_b16 %3, %11\n\tds_read_b64_tr_b16 %4, %12\n\tds_read_b64_tr_b16 %5, %13\n\tds_read_b64_tr_b16 %6, %14\n\tds_read_b64_tr_b16 %7, %15\n\ts_waitcnt lgkmcnt(0)"
        : "=&v"(r0), "=&v"(r1), "=&v"(r2), "=&v"(r3), "=&v"(r4), "=&v"(r5), "=&v"(r6), "=&v"(r7) : "v"(a0), "v"(b0), "v"(a1), "v"(b1), "v"(a2), "v"(b2), "v"(a3), "v"(b3) : "memory");
    o[0] = __builtin_bit_cast(bf16x8, (u32x4){r0.x, r0.y, r1.x, r1.y}); o[1] = __builtin_bit_cast(bf16x8, (u32x4){r2.x, r2.y, r3.x, r3.y});
    o[2] = __builtin_bit_cast(bf16x8, (u32x4){r4.x, r4.y, r5.x, r5.y}); o[3] = __builtin_bit_cast(bf16x8, (u32x4){r6.x, r6.y, r7.x, r7.y}); }
constexpr int LP = 136;
template <int NET> __device__ __forceinline__ void ret_item(Ctx& F, int item) {
    const int tid = F.tid, lane = F.lane, w = F.wave, fr = lane & 15, fq = lane >> 4;
    constexpr int EW = 16 * NET, NEB = 128 / EW, VP = EW + 8;
    const int b = item / (8 * NEB), h = (item / NEB) & 7, eb = item % NEB;
    LAS bf16* qL = (LAS bf16*)(F.lds); LAS bf16* kL = qL + 128 * LP; LAS bf16* vL = kL + 128 * LP; LAS bf16* vdL = vL + 128 * VP; LAS bf16* STL = vdL + 128 * VP;
    const unsigned trq = (unsigned)((lane & 15) >> 2), trp = (unsigned)(lane & 3);
    const unsigned kLb = (unsigned)(size_t)kL + trq * (LP * 2) + 8u * trp + (unsigned)(16 * w) * 2u, vLb = (unsigned)(size_t)vL + trq * (VP * 2) + 8u * trp, vdLb = (unsigned)(size_t)vdL + trq * (VP * 2) + 8u * trp;
    const bf16* proj = (const bf16*)(F.ws + WS_PROJ); const unsigned* rope = (const unsigned*)(F.ws + WS_ROPE); float* reto = (float*)(F.ws + WS_RETO);
    const float lg = log1pf(-exp2f(-5.0f - (float)h)), lg2 = lg * 1.4426950408889634f, dec = __expf(lg * 128.0f);
    f32x4 st[NET];
#pragma unroll
    for (int et = 0; et < NET; ++et) st[et] = (f32x4){0.f, 0.f, 0.f, 0.f};
    __syncthreads();
    for (int i = tid; i < EW * LP; i += NWAVES * 64) STL[i] = 0;
    const int r = tid >> 2, qd = tid & 3, j0 = 16 * qd;
    const float kdec = __builtin_amdgcn_exp2f(lg2 * (float)(127 - r));
    u32x4 q1[2], q2[2], k1[2], k2[2], vv[NET / 2], cs4[4];
#define RET_LOAD(nn) do { const bf16* p_ = proj + (size_t)(b * SEQ + (nn) * 128 + r) * NIN + h * 128; const unsigned* c_ = rope + (size_t)(b * SEQ + (nn) * 128 + r) * 64 + j0; \
        q1[0] = *(const u32x4*)(p_ + j0); q1[1] = *(const u32x4*)(p_ + j0 + 8); q2[0] = *(const u32x4*)(p_ + 64 + j0); q2[1] = *(const u32x4*)(p_ + 64 + j0 + 8); \
        k1[0] = *(const u32x4*)(p_ + RW + j0); k1[1] = *(const u32x4*)(p_ + RW + j0 + 8); k2[0] = *(const u32x4*)(p_ + RW + 64 + j0); k2[1] = *(const u32x4*)(p_ + RW + 64 + j0 + 8); \
        _Pragma("unroll") for (int vi_ = 0; vi_ < NET / 2; ++vi_) vv[vi_] = *(const u32x4*)(p_ + 2 * RW + eb * EW + qd * (EW / 4) + 8 * vi_); \
        _Pragma("unroll") for (int jj_ = 0; jj_ < 4; ++jj_) cs4[jj_] = *(const u32x4*)(c_ + 4 * jj_); } while (0)
    RET_LOAD(0);
#pragma unroll 1
    for (int n = 0; n < 16; ++n) {
        const int t0 = b * SEQ + n * 128;
        __syncthreads();
        {
#pragma unroll
            for (int hh = 0; hh < 2; ++hh) { unsigned oq1[4], oq2[4], ok1[4], ok2[4];
#pragma unroll
                for (int c = 0; c < 4; ++c) { float a[2], bq[2], ka[2], kb[2];
#pragma unroll
                    for (int z = 0; z < 2; ++z) { const int jj = hh * 8 + c * 2 + z; const unsigned cw_ = cs4[jj >> 2][jj & 3]; const f32x2 sc = (f32x2){bflo(cw_), bfhi(cw_)};
                        const float x1 = z ? bfhi(q1[hh][c]) : bflo(q1[hh][c]), x2 = z ? bfhi(q2[hh][c]) : bflo(q2[hh][c]);
                        const float y1 = z ? bfhi(k1[hh][c]) : bflo(k1[hh][c]), y2 = z ? bfhi(k2[hh][c]) : bflo(k2[hh][c]);
                        a[z] = (x1 * sc.x - x2 * sc.y) * 0.08838834764831845f; bq[z] = (x2 * sc.x + x1 * sc.y) * 0.08838834764831845f;
                        ka[z] = y1 * sc.x - y2 * sc.y; kb[z] = y2 * sc.x + y1 * sc.y;
                    }
                    oq1[c] = pk2(a[0], a[1]); oq2[c] = pk2(bq[0], bq[1]); ok1[c] = pk2(ka[0], ka[1]); ok2[c] = pk2(kb[0], kb[1]); }
                *(LAS u32x4*)(qL + r * LP + j0 + hh * 8) = (u32x4){oq1[0], oq1[1], oq1[2], oq1[3]}; *(LAS u32x4*)(qL + r * LP + 64 + j0 + hh * 8) = (u32x4){oq2[0], oq2[1], oq2[2], oq2[3]};
                *(LAS u32x4*)(kL + r * LP + j0 + hh * 8) = (u32x4){ok1[0], ok1[1], ok1[2], ok1[3]}; *(LAS u32x4*)(kL + r * LP + 64 + j0 + hh * 8) = (u32x4){ok2[0], ok2[1], ok2[2], ok2[3]}; }
#pragma unroll
            for (int vi = 0; vi < NET / 2; ++vi) { unsigned vd[4];
#pragma unroll
                for (int c = 0; c < 4; ++c) vd[c] = pk2(bflo(vv[vi][c]) * kdec, bfhi(vv[vi][c]) * kdec);
                *(LAS u32x4*)(vL + r * VP + qd * (EW / 4) + 8 * vi) = vv[vi]; *(LAS u32x4*)(vdL + r * VP + qd * (EW / 4) + 8 * vi) = (u32x4){vd[0], vd[1], vd[2], vd[3]}; }
        }
        if (n + 1 < 16) RET_LOAD(n + 1);
        __syncthreads();
        f32x4 sacc[8];
#pragma unroll
        for (int mt = 0; mt < 8; ++mt) sacc[mt] = (f32x4){0.f, 0.f, 0.f, 0.f};
#pragma unroll
        for (int ks = 0; ks < 4; ++ks) { const bf16x8 bq = *(const LAS bf16x8*)(qL + (16 * w + fr) * LP + 32 * ks + 8 * fq);
#pragma unroll
            for (int mt = 0; mt < 8; ++mt) { const bf16x8 ak = *(const LAS bf16x8*)(kL + (16 * mt + fr) * LP + 32 * ks + 8 * fq); sacc[mt] = __builtin_amdgcn_mfma_f32_16x16x32_bf16(ak, bq, sacc[mt], 0, 0, 0); } }
        const int c = 16 * w + fr;
        bf16x8 pb[4];
#pragma unroll
        for (int sk = 0; sk < 4; ++sk) { unsigned pw[4];
#pragma unroll
            for (int hlf = 0; hlf < 2; ++hlf) { const int mt = 2 * sk + hlf; float pv[4];
#pragma unroll
                for (int rr = 0; rr < 4; ++rr) { const int m = 16 * mt + 4 * fq + rr; pv[rr] = (c >= m) ? sacc[mt][rr] * __builtin_amdgcn_exp2f(lg2 * (float)(c - m)) : 0.f; }
                pw[2 * hlf] = pk2(pv[0], pv[1]); pw[2 * hlf + 1] = pk2(pv[2], pv[3]); }
            pb[sk] = __builtin_bit_cast(bf16x8, (u32x4){pw[0], pw[1], pw[2], pw[3]}); }
        { bf16x8 bqf[4];
#pragma unroll
          for (int ks = 0; ks < 4; ++ks) bqf[ks] = *(const LAS bf16x8*)(qL + (16 * w + fr) * LP + 32 * ks + 8 * fq);
          const float qd = __builtin_amdgcn_exp2f(lg2 * (float)(c + 1));
#pragma unroll
          for (int et = 0; et < NET; ++et) { f32x4 oi = (f32x4){0.f, 0.f, 0.f, 0.f}, oc = (f32x4){0.f, 0.f, 0.f, 0.f};
            bf16x8 avq[4]; const unsigned a0 = vLb + (unsigned)((4 * fq) * (VP * 2) + 32 * et); tr_quad(avq, a0, a0 + 32 * (VP * 2), a0 + 64 * (VP * 2), a0 + 96 * (VP * 2), 16 * (VP * 2));
#pragma unroll
            for (int ks = 0; ks < 4; ++ks) { const bf16x8 as = *(const LAS bf16x8*)(STL + (16 * et + fr) * LP + 32 * ks + 8 * fq);
                oi = __builtin_amdgcn_mfma_f32_16x16x32_bf16(avq[ks], pb[ks], oi, 0, 0, 0); oc = __builtin_amdgcn_mfma_f32_16x16x32_bf16(as, bqf[ks], oc, 0, 0, 0); }
            *(f32x4*)(reto + (size_t)(t0 + c) * RW + h * 128 + eb * EW + 16 * et + 4 * fq) = oi + oc * qd; } }
        __syncthreads();
#pragma unroll
        for (int et = 0; et < NET; ++et) st[et] = st[et] * dec;
        { bf16x8 bkq[4];
          { const unsigned k0 = kLb + (unsigned)((8 * fq) * (LP * 2)); tr_quad(bkq, k0, k0 + 32 * (LP * 2), k0 + 64 * (LP * 2), k0 + 96 * (LP * 2), 4 * (LP * 2)); }
#pragma unroll
          for (int et = 0; et < NET; ++et) { bf16x8 vq[4]; const unsigned v0 = vdLb + (unsigned)((8 * fq) * (VP * 2) + 32 * et); tr_quad(vq, v0, v0 + 32 * (VP * 2), v0 + 64 * (VP * 2), v0 + 96 * (VP * 2), 4 * (VP * 2));
#pragma unroll
            for (int ks = 0; ks < 4; ++ks) st[et] = __builtin_amdgcn_mfma_f32_16x16x32_bf16(vq[ks], bkq[ks], st[et], 0, 0, 0); } }
#pragma unroll
        for (int et = 0; et < NET; ++et)
#pragma unroll
            for (int rr = 0; rr < 4; ++rr) STL[(16 * et + 4 * fq + rr) * LP + 16 * w + fr] = f2bf(st[et][rr]);
    }
#undef RET_LOAD
    __syncthreads();
}

struct LruIn { bf16x8 bA[4], bX[4]; unsigned xr[19]; f32x2 w0, w1, w2, w3, bc; float bav, bxv, lamv; };
__device__ __forceinline__ void lru_issue(Ctx& F, int item, LruIn& L) {
    const int lane = F.lane, w = F.wave, fr = lane & 15, fq = lane >> 4;
    const int b = item >> 7, n = (item >> 3) & 15, g = item & 7; const int ch = g * 128 + 2 * lane;
    const bf16* Wa = (const bf16*)(F.ws + WS_WA) + (size_t)g * 128 * 128 + (size_t)(16 * w + fr) * 128 + 8 * fq; const bf16* Wx = (const bf16*)(F.ws + WS_WX) + (size_t)g * 128 * 128 + (size_t)(16 * w + fr) * 128 + 8 * fq;
#pragma unroll
    for (int ks = 0; ks < 4; ++ks) { L.bA[ks] = *(const bf16x8*)(Wa + 32 * ks); L.bX[ks] = *(const bf16x8*)(Wx + 32 * ks); }
    const float* wconv = (const float*)F.in[7];
    L.w0 = *(const f32x2*)(wconv + ch); L.w1 = *(const f32x2*)(wconv + LW + ch); L.w2 = *(const f32x2*)(wconv + 2 * LW + ch); L.w3 = *(const f32x2*)(wconv + 3 * LW + ch); L.bc = *(const f32x2*)((const float*)F.in[8] + ch);
    const int cj = g * 128 + 16 * w + fr; L.bav = ((const float*)F.in[10])[cj]; L.bxv = ((const float*)F.in[12])[cj]; L.lamv = ((const float*)F.in[13])[cj];
    const int s0 = n * 128 + 16 * w; const bf16* p = (const bf16*)(F.ws + WS_PROJ) + (size_t)(b * SEQ) * NIN + 4 * RW + ch;
#pragma unroll
    for (int i = 0; i < 19; ++i) { const int sp = s0 - 3 + i; L.xr[i] = (sp >= 0) ? *(const unsigned*)(p + (size_t)sp * NIN) : 0u; }
}
__device__ __forceinline__ void lru_body(Ctx& F, int item, const LruIn& L) {
    const int lane = F.lane, w = F.wave, fr = lane & 15, fq = lane >> 4;
    const int b = item >> 7, n = (item >> 3) & 15, g = item & 7;
    LAS bf16* xcL = (LAS bf16*)(F.lds); LAS float* aL = (LAS float*)(F.lds + 34816); LAS bf16* mL = (LAS bf16*)(F.lds + 34816 + 65536); LAS float* segA = (LAS float*)(F.lds + 34816 + 65536 + 32768); LAS float* segB = segA + 1024;
    const int cp = lane, sg = w, ch = g * 128 + 2 * cp;
    float xc[16][2];
#pragma unroll
    for (int i = 0; i < 16; ++i) {
        xc[i][0] = L.bc.x + L.w0.x * bflo(L.xr[i]) + L.w1.x * bflo(L.xr[i + 1]) + L.w2.x * bflo(L.xr[i + 2]) + L.w3.x * bflo(L.xr[i + 3]);
        xc[i][1] = L.bc.y + L.w0.y * bfhi(L.xr[i]) + L.w1.y * bfhi(L.xr[i + 1]) + L.w2.y * bfhi(L.xr[i + 2]) + L.w3.y * bfhi(L.xr[i + 3]);
        *(LAS unsigned*)(xcL + (16 * sg + i) * LP + 2 * cp) = pk2(xc[i][0], xc[i][1]); }
    __syncthreads();
    {
        const int j = 16 * w + fr; const float bav = L.bav, bxv = L.bxv, sp8 = -8.0f * log1pf(__expf(-L.lamv));
#pragma unroll 2
        for (int tt = 0; tt < 8; ++tt) { f32x4 ra = (f32x4){0.f, 0.f, 0.f, 0.f}, rx = (f32x4){0.f, 0.f, 0.f, 0.f};
#pragma unroll
            for (int ks = 0; ks < 4; ++ks) { const bf16x8 a = *(const LAS bf16x8*)(xcL + (16 * tt + fr) * LP + 32 * ks + 8 * fq);
                ra = __builtin_amdgcn_mfma_f32_16x16x32_bf16(a, L.bA[ks], ra, 0, 0, 0); rx = __builtin_amdgcn_mfma_f32_16x16x32_bf16(a, L.bX[ks], rx, 0, 0, 0); }
#pragma unroll
            for (int rr = 0; rr < 4; ++rr) { const int t = 16 * tt + 4 * fq + rr;
                const float rgt = __builtin_amdgcn_rcpf(1.0f + __expf(-(ra[rr] + bav))), igt = __builtin_amdgcn_rcpf(1.0f + __expf(-(rx[rr] + bxv)));
                const float av = __expf(sp8 * rgt); const float mu = __builtin_amdgcn_sqrtf(fmaxf(1.0f - av * av, 0.f)) * igt;
                aL[t * 128 + j] = av; mL[t * 128 + j] = f2bf(mu); } }
    }
    __syncthreads();
    {
        float h0 = 0.f, h1 = 0.f, P0 = 1.f, P1 = 1.f;
#pragma unroll
        for (int i = 0; i < 16; ++i) { const int t = 16 * sg + i; const f32x2 av = *(const LAS f32x2*)(aL + t * 128 + 2 * cp); const unsigned mw = *(const LAS unsigned*)(mL + t * 128 + 2 * cp);
            h0 = av.x * h0 + bflo(mw) * xc[i][0]; h1 = av.y * h1 + bfhi(mw) * xc[i][1]; P0 *= av.x; P1 *= av.y; }
        *(LAS f32x2*)(segA + sg * 128 + 2 * cp) = (f32x2){P0, P1}; *(LAS f32x2*)(segB + sg * 128 + 2 * cp) = (f32x2){h0, h1};
    }
    __syncthreads();
    {
        float c0 = 0.f, c1 = 0.f, Q0 = 1.f, Q1 = 1.f;
        for (int s = 0; s < sg; ++s) { const f32x2 A = *(const LAS f32x2*)(segA + s * 128 + 2 * cp), Bv = *(const LAS f32x2*)(segB + s * 128 + 2 * cp); c0 = A.x * c0 + Bv.x; c1 = A.y * c1 + Bv.y; Q0 *= A.x; Q1 *= A.y; }
        bf16* hl = (bf16*)(F.ws + WS_HLOC) + (size_t)(b * SEQ + n * 128 + 16 * sg) * LW + ch; bf16* pl = (bf16*)(F.ws + WS_PLOC) + (size_t)(b * SEQ + n * 128 + 16 * sg) * LW + ch;
        float h0 = c0, h1 = c1, P0 = Q0, P1 = Q1;
#pragma unroll
        for (int i = 0; i < 16; ++i) { const int t = 16 * sg + i; const f32x2 av = *(const LAS f32x2*)(aL + t * 128 + 2 * cp); const unsigned mw = *(const LAS unsigned*)(mL + t * 128 + 2 * cp);
            h0 = av.x * h0 + bflo(mw) * xc[i][0]; h1 = av.y * h1 + bfhi(mw) * xc[i][1]; P0 *= av.x; P1 *= av.y;
            *(unsigned*)(hl + (size_t)i * LW) = pk2(h0, h1); *(unsigned*)(pl + (size_t)i * LW) = pk2(P0, P1); }
        if (sg == 7) { *(f32x2*)((float*)(F.ws + WS_AGGA) + (size_t)(b * 16 + n) * LW + ch) = (f32x2){P0, P1}; *(f32x2*)((float*)(F.ws + WS_AGGB) + (size_t)(b * 16 + n) * LW + ch) = (f32x2){h0, h1}; }
    }
    __syncthreads();
}

__device__ __forceinline__ void p4_item(Ctx& F, int item) {
    const int tid = F.tid, lane = F.lane, w = F.wave;
    const int b = item >> 5, n = (item & 31) >> 1;
    LAS float* carry = (LAS float*)F.lds;
    const float* aggA = (const float*)(F.ws + WS_AGGA); const float* aggB = (const float*)(F.ws + WS_AGGB);
    __syncthreads();
#pragma unroll
    for (int q = 0; q < 2; ++q) { const int ch = tid + 512 * q; float cin = 0.f;
        for (int jn = 0; jn < n; ++jn) cin = aggA[(size_t)(b * 16 + jn) * LW + ch] * cin + aggB[(size_t)(b * 16 + jn) * LW + ch];
        carry[ch] = cin; }
    __syncthreads();
    const bf16* proj = (const bf16*)(F.ws + WS_PROJ); const float* reto = (const float*)(F.ws + WS_RETO); const bf16* hl = (const bf16*)(F.ws + WS_HLOC); const bf16* pl = (const bf16*)(F.ws + WS_PLOC);
    bf16* cat = (bf16*)(F.ws + WS_CAT); const int c0 = 16 * lane;
    float beta_r[16], beta_l[16], cr[16];
#pragma unroll
    for (int q = 0; q < 4; ++q) { const f32x4 a = *(const f32x4*)((const float*)F.in[14] + c0 + 4 * q), bq = *(const f32x4*)((const float*)F.in[15] + c0 + 4 * q); const f32x4 cq = *(const LAS f32x4*)(carry + c0 + 4 * q);
        beta_r[4 * q] = a.x; beta_r[4 * q + 1] = a.y; beta_r[4 * q + 2] = a.z; beta_r[4 * q + 3] = a.w; beta_l[4 * q] = bq.x; beta_l[4 * q + 1] = bq.y; beta_l[4 * q + 2] = bq.z; beta_l[4 * q + 3] = bq.w;
        cr[4 * q] = cq.x; cr[4 * q + 1] = cq.y; cr[4 * q + 2] = cq.z; cr[4 * q + 3] = cq.w; }
#pragma unroll 2
    for (int rr = 0; rr < 8; ++rr) {
        const int t = item * 64 + 8 * w + rr;
        {
            float o[16];
#pragma unroll
            for (int q = 0; q < 4; ++q) { const f32x4 v = *(const f32x4*)(reto + (size_t)t * RW + c0 + 4 * q); o[4 * q] = v.x; o[4 * q + 1] = v.y; o[4 * q + 2] = v.z; o[4 * q + 3] = v.w; }
            float s = 0.f;
#pragma unroll
            for (int q = 0; q < 16; ++q) s += o[q];
            s += __shfl_xor(s, 1); s += __shfl_xor(s, 2); s += __shfl_xor(s, 4);
            const float mu = s * (1.0f / 128.0f); float vq = 0.f;
#pragma unroll
            for (int q = 0; q < 16; ++q) { o[q] -= mu; vq += o[q] * o[q]; }
            vq += __shfl_xor(vq, 1); vq += __shfl_xor(vq, 2); vq += __shfl_xor(vq, 4);
            const float rs = rsqrtf(vq * (1.0f / 128.0f) + EPS);
            const u32x4 g0 = *(const u32x4*)(proj + (size_t)t * NIN + 3 * RW + c0), g1 = *(const u32x4*)(proj + (size_t)t * NIN + 3 * RW + c0 + 8);
            float ss = 0.f;
#pragma unroll
            for (int q = 0; q < 8; ++q) { const unsigned gw_ = (q < 4) ? g0[q & 3] : g1[q & 3]; const float ga = bflo(gw_), gb = bfhi(gw_);
                o[2 * q] = siluf_(ga) * (o[2 * q] * rs); o[2 * q + 1] = siluf_(gb) * (o[2 * q + 1] * rs); ss += o[2 * q] * o[2 * q] + o[2 * q + 1] * o[2 * q + 1]; }
            const float rstd = rsqrtf(wave_sum(ss) * (1.0f / RW) + EPS);
            u32x4 w0, w1;
#pragma unroll
            for (int q = 0; q < 4; ++q) { w0[q] = pk2(o[2 * q] * rstd * beta_r[2 * q], o[2 * q + 1] * rstd * beta_r[2 * q + 1]); w1[q] = pk2(o[8 + 2 * q] * rstd * beta_r[8 + 2 * q], o[9 + 2 * q] * rstd * beta_r[9 + 2 * q]); }
            *(u32x4*)(cat + (size_t)t * DM + c0) = w0; *(u32x4*)(cat + (size_t)t * DM + c0 + 8) = w1;
        }
        {
            const u32x4 h0 = *(const u32x4*)(hl + (size_t)t * LW + c0), h1 = *(const u32x4*)(hl + (size_t)t * LW + c0 + 8), p0 = *(const u32x4*)(pl + (size_t)t * LW + c0), p1 = *(const u32x4*)(pl + (size_t)t * LW + c0 + 8);
            const u32x4 y0 = *(const u32x4*)(proj + (size_t)t * NIN + 5 * RW + c0), y1 = *(const u32x4*)(proj + (size_t)t * NIN + 5 * RW + c0 + 8);
            float o[16]; float ss = 0.f;
#pragma unroll
            for (int q = 0; q < 8; ++q) { const unsigned hw = (q < 4) ? h0[q & 3] : h1[q & 3], pw = (q < 4) ? p0[q & 3] : p1[q & 3], yw = (q < 4) ? y0[q & 3] : y1[q & 3];
                const float ha = bflo(hw) + bflo(pw) * cr[2 * q], hb = bfhi(hw) + bfhi(pw) * cr[2 * q + 1];
                o[2 * q] = ha * gelu_tanh_(bflo(yw)); o[2 * q + 1] = hb * gelu_tanh_(bfhi(yw)); ss += o[2 * q] * o[2 * q] + o[2 * q + 1] * o[2 * q + 1]; }
            const float rstd = rsqrtf(wave_sum(ss) * (1.0f / LW) + EPS);
            u32x4 w0, w1;
#pragma unroll
            for (int q = 0; q < 4; ++q) { w0[q] = pk2(o[2 * q] * rstd * beta_l[2 * q], o[2 * q + 1] * rstd * beta_l[2 * q + 1]); w1[q] = pk2(o[8 + 2 * q] * rstd * beta_l[8 + 2 * q], o[9 + 2 * q] * rstd * beta_l[9 + 2 * q]); }
            *(u32x4*)(cat + (size_t)t * DM + RW + c0) = w0; *(u32x4*)(cat + (size_t)t * DM + RW + c0 + 8) = w1;
        }
    }
    __syncthreads();
}

constexpr int HAP = 2056;
template <bool DRY> __device__ __forceinline__ void p6_item(Ctx& F, int item) {
    const int tid = F.tid, lane = F.lane, w = F.wave, fr = lane & 15, fq = lane >> 4;
    const int t0 = item * 64, b = t0 / SEQ;
    LAS bf16* hA = (LAS bf16*)F.lds;
    LAS float* lgt = (LAS float*)(F.lds + 16 * HAP * 2);
    LAS unsigned char* selE = (LAS unsigned char*)(F.lds + 16 * HAP * 2 + 8 * 16 * 65 * 4); LAS unsigned char* selL = selE + 512; LAS unsigned* wcnt = (LAS unsigned*)(selL + 512); LAS unsigned* gb = wcnt + 512;
    const bf16* x1 = (const bf16*)(F.ws + WS_X1); const float* mod = (const float*)(F.ws + WS_MOD) + (size_t)b * 6 * DM; bf16* h2 = (bf16*)(F.ws + WS_H); unsigned char* h8 = F.ws + WS_H8;
    const bf16* Wr = (const bf16*)(F.ws + WS_WR);
    int* eidx = (int*)(F.ws + WS_EIDX); float* wsel = (float*)(F.ws + WS_WSEL); int* slot = (int*)(F.ws + (DRY ? WS_DEST : WS_SLOT)); unsigned* cnt = (unsigned*)(F.ws + WS_CTL) + CW_CNT + (DRY ? 4096 : 0);
    f32x4 gg[4][2];
#pragma unroll
    for (int j = 0; j < 4; ++j)
#pragma unroll
        for (int h = 0; h < 2; ++h) { const int c = 8 * lane + 512 * j + 4 * h; gg[j][h] = *(const f32x4*)((const float*)F.in[17] + c) * (*(const f32x4*)(mod + 4 * DM + c) + 1.0f); }
    const float brl = ((const float*)F.in[19])[lane]; const int g = lane >> 3;
    unsigned lc = 0u;
    bf16x8 bw[2][4];
#pragma unroll
    for (int ks = 0; ks < 2; ++ks)
#pragma unroll
        for (int et = 0; et < 4; ++et) bw[ks][et] = *(const bf16x8*)(Wr + (size_t)(16 * et + fr) * DM + 256 * w + 32 * ks + 8 * fq);
    u32x4 xq[2][4];
#pragma unroll
    for (int i = 0; i < 2; ++i)
#pragma unroll
        for (int j = 0; j < 4; ++j) xq[i][j] = *(const u32x4*)(x1 + (size_t)(t0 + 2 * w + i) * DM + 8 * lane + 512 * j);
    __syncthreads();
#pragma unroll 1
    for (int ps = 0; ps < 4; ++ps) {
#pragma unroll
        for (int i = 0; i < 2; ++i) { const int rl = 2 * w + i, t = t0 + 16 * ps + rl;
            f32x4 v[4][2]; float ss = 0.f;
#pragma unroll
            for (int j = 0; j < 4; ++j) { const u32x4 xw = xq[i][j]; v[j][0] = (f32x4){bflo(xw.x), bfhi(xw.x), bflo(xw.y), bfhi(xw.y)}; v[j][1] = (f32x4){bflo(xw.z), bfhi(xw.z), bflo(xw.w), bfhi(xw.w)};
#pragma unroll
                for (int h = 0; h < 2; ++h) ss += (v[j][h].x * v[j][h].x + v[j][h].y * v[j][h].y) + (v[j][h].z * v[j][h].z + v[j][h].w * v[j][h].w); }
            const float rstd = rsqrtf(wave_sum(ss) * (1.0f / DM) + EPS);
#pragma unroll
            for (int j = 0; j < 4; ++j) { const f32x4 o0 = v[j][0] * rstd * gg[j][0] + *(const f32x4*)(mod + 3 * DM + 8 * lane + 512 * j), o1 = v[j][1] * rstd * gg[j][1] + *(const f32x4*)(mod + 3 * DM + 8 * lane + 512 * j + 4);
                u32x4 wv; wv.x = pk2(o0.x, o0.y); wv.y = pk2(o0.z, o0.w); wv.z = pk2(o1.x, o1.y); wv.w = pk2(o1.z, o1.w);
                *(LAS u32x4*)(hA + rl * HAP + 8 * lane + 512 * j) = wv;
                u32x2 w8; w8.x = pk4_fp8(o0.x * SC_H8, o0.y * SC_H8, o0.z * SC_H8, o0.w * SC_H8); w8.y = pk4_fp8(o1.x * SC_H8, o1.y * SC_H8, o1.z * SC_H8, o1.w * SC_H8);
                *(u32x2*)(h8 + (size_t)t * DM + 8 * lane + 512 * j) = w8; }
            __builtin_amdgcn_sched_barrier(0); }
        __syncthreads();
        {
            f32x4 acc[4];
#pragma unroll
            for (int et = 0; et < 4; ++et) acc[et] = (f32x4){0.f, 0.f, 0.f, 0.f};
            bf16x8 bw2[6][4];
#pragma unroll
            for (int ks = 0; ks < 6; ++ks)
#pragma unroll
                for (int et = 0; et < 4; ++et) bw2[ks][et] = *(const bf16x8*)(Wr + (size_t)(16 * et + fr) * DM + 256 * w + 64 + 32 * ks + 8 * fq);
#pragma unroll
            for (int ks = 0; ks < 2; ++ks) { const bf16x8 a = *(const LAS bf16x8*)(hA + fr * HAP + 256 * w + 32 * ks + 8 * fq);
#pragma unroll
                for (int et = 0; et < 4; ++et) acc[et] = __builtin_amdgcn_mfma_f32_16x16x32_bf16(a, bw[ks][et], acc[et], 0, 0, 0); }
#pragma unroll
            for (int ks = 0; ks < 6; ++ks) { const bf16x8 a = *(const LAS bf16x8*)(hA + fr * HAP + 256 * w + 64 + 32 * ks + 8 * fq);
#pragma unroll
                for (int et = 0; et < 4; ++et) acc[et] = __builtin_amdgcn_mfma_f32_16x16x32_bf16(a, bw2[ks][et], acc[et], 0, 0, 0); }
#pragma unroll
            for (int et = 0; et < 4; ++et)
#pragma unroll
                for (int rr = 0; rr < 4; ++rr) lgt[(w * 16 + 4 * fq + rr) * 65 + 16 * et + fr] = acc[et][rr];
        }
        __syncthreads();
        if (ps + 1 < 4) {
#pragma unroll
            for (int i = 0; i < 2; ++i)
#pragma unroll
                for (int j = 0; j < 4; ++j) xq[i][j] = *(const u32x4*)(x1 + (size_t)(t0 + 16 * (ps + 1) + 2 * w + i) * DM + 8 * lane + 512 * j); }
#pragma unroll 1
        for (int i = 0; i < 2; ++i) {
            const int tl = 2 * w + i, tt = 16 * ps + tl; float z = 0.f;
#pragma unroll
            for (int w2 = 0; w2 < 8; ++w2) z += lgt[(w2 * 16 + tl) * 65 + lane];
            const float s = sigmoidf_(z); const float bsc = s + brl;
            float m1 = bsc; m1 = fmaxf(m1, __shfl_xor(m1, 1)); m1 = fmaxf(m1, __shfl_xor(m1, 2)); m1 = fmaxf(m1, __shfl_xor(m1, 4));
            const unsigned long long eq = __ballot(bsc == m1); const unsigned gm = (unsigned)(eq >> (8 * g)) & 0xffu;
            const bool first = (lane & 7) == (__builtin_ctz(gm | 0x100u) & 7);
            float m2 = first ? -3.0e38f : bsc; m2 = fmaxf(m2, __shfl_xor(m2, 1)); m2 = fmaxf(m2, __shfl_xor(m2, 2)); m2 = fmaxf(m2, __shfl_xor(m2, 4));
            const float gs = m1 + m2;
            int rank_g = 0;
#pragma unroll
            for (int g2 = 0; g2 < 8; ++g2) { const float o = __int_as_float(__builtin_amdgcn_readlane(__float_as_int(gs), 8 * g2)); rank_g += (o > gs || (o == gs && g2 < g)) ? 1 : 0; }
            const bool selg = rank_g < 4;
            const float key = selg ? bsc : -3.0e38f;
            int rank = 0;
#pragma unroll
            for (int e2 = 0; e2 < 64; ++e2) { const float o = __int_as_float(__builtin_amdgcn_readlane(__float_as_int(key), e2)); rank += (o > key || (o == key && e2 < lane)) ? 1 : 0; }
            const bool chosen = selg && rank < 8;
            const float wsum = wave_sum(chosen ? s : 0.f);
            if (chosen) { const int t = t0 + tt; eidx[t * 8 + rank] = lane; wsel[t * 8 + rank] = s * (2.5f / wsum); selE[tt * 8 + rank] = (unsigned char)lane; selL[tt * 8 + rank] = (unsigned char)lc; }
            lc += chosen ? 1u : 0u;
        }
        __syncthreads();
    }
    wcnt[w * 64 + lane] = lc;
    __syncthreads();
    if (w == 0) { unsigned tot = 0u;
#pragma unroll
        for (int w2 = 0; w2 < 8; ++w2) tot += wcnt[w2 * 64 + lane];
        gb[lane] = tot ? __hip_atomic_fetch_add(cnt + 32 * lane, tot, __ATOMIC_RELAXED, __HIP_MEMORY_SCOPE_AGENT) : 0u; }
    __syncthreads();
    { const int tok = tid >> 3, k = tid & 7, e = selE[tok * 8 + k], wt = (tok & 15) >> 1; unsigned off = gb[e] + selL[tok * 8 + k];
        for (int w2 = 0; w2 < wt; ++w2) off += wcnt[w2 * 64 + e];
        slot[(t0 + tok) * 8 + k] = (int)off; if (!DRY) ((int*)(F.ws + WS_TOKOF))[(size_t)e * T + off] = t0 + tok; }
    __syncthreads();
}

__device__ __forceinline__ void p10_final(Ctx& F, bool have_tables) {
    const int gw = F.vcu * NWAVES + F.wave, NGW = F.G * NWAVES, lane = F.lane;
    const bf16* x1 = (const bf16*)(F.ws + WS_X1); const unsigned char* y = F.ws + WS_Y; const int* eidx = (const int*)(F.ws + WS_EIDX); const int* slot = (const int*)(F.ws + WS_SLOT); const float* wsel = (const float*)(F.ws + WS_WSEL); const float* gf = (const float*)F.in[24];
    LAS int* ps = (LAS int*)F.lds; const unsigned* cnt = (const unsigned*)(F.ws + WS_CTL) + CW_CNT;
    __syncthreads();
    if (have_tables) { if (F.tid < NE) ps[F.tid] = moe_tables(F).tp[F.tid] * 256; }
    else { if (F.tid < NE) ps[64 + F.tid] = (((int)ld_agent(cnt + 32 * F.tid) + 255) >> 8) << 8;
        __syncthreads();
        if (F.tid < NE) { int acc = 0; for (int e = 0; e < F.tid; ++e) acc += ps[64 + e]; ps[F.tid] = acc; } }
    __syncthreads();
    for (int t = gw; t < T; t += NGW) { const int b = t / SEQ; const float* gt2 = (const float*)(F.ws + WS_MOD) + (size_t)b * 6 * DM + 5 * DM;
        int rows[9]; float wk[9];
#pragma unroll
        for (int k = 0; k < 8; ++k) { rows[k] = ps[ld_agent_i(eidx + t * 8 + k)] + ld_agent_i(slot + t * 8 + k); wk[k] = wsel[t * 8 + k] * (1.0f / SC_Y); }
        rows[8] = NR_ROUTED + t; wk[8] = 1.0f / SC_Y;
        float ss = 0.f; f32x4 v[4][2];
#pragma unroll
        for (int j = 0; j < 4; ++j) { const int c = 8 * lane + 512 * j; float s[8];
#pragma unroll
            for (int q = 0; q < 8; ++q) s[q] = 0.f;
#pragma unroll
            for (int k = 0; k < 9; ++k) { const u32x2 yv = *(const u32x2*)(y + (size_t)rows[k] * DM + c);
#pragma unroll
                for (int q = 0; q < 2; ++q) { const f32x2 lo = __builtin_amdgcn_cvt_pk_f32_fp8((int)yv[q], false), hi = __builtin_amdgcn_cvt_pk_f32_fp8((int)yv[q], true);
                    s[4 * q] += wk[k] * lo.x; s[4 * q + 1] += wk[k] * lo.y; s[4 * q + 2] += wk[k] * hi.x; s[4 * q + 3] += wk[k] * hi.y; } }
            const u32x4 xw = *(const u32x4*)(x1 + (size_t)t * DM + c);
#pragma unroll
            for (int hh = 0; hh < 2; ++hh) { const f32x4 xv = hh ? (f32x4){bflo(xw.z), bfhi(xw.z), bflo(xw.w), bfhi(xw.w)} : (f32x4){bflo(xw.x), bfhi(xw.x), bflo(xw.y), bfhi(xw.y)}, gv = *(const f32x4*)(gt2 + c + 4 * hh);
                v[j][hh] = xv + gv * (f32x4){s[4 * hh], s[4 * hh + 1], s[4 * hh + 2], s[4 * hh + 3]};
                ss += (v[j][hh].x * v[j][hh].x + v[j][hh].y * v[j][hh].y) + (v[j][hh].z * v[j][hh].z + v[j][hh].w * v[j][hh].w); } }
        const float rstd = rsqrtf(wave_sum(ss) * (1.0f / DM) + EPS);
#pragma unroll
        for (int j = 0; j < 4; ++j)
#pragma unroll
            for (int hh = 0; hh < 2; ++hh) { const int c = 8 * lane + 512 * j + 4 * hh; *(f32x4*)(F.out + (size_t)t * DM + c) = v[j][hh] * rstd * *(const f32x4*)(gf + c); }
    }
}

__global__ void __launch_bounds__(NWAVES * 64, 2) fwd_kernel(Args args) {
    extern __shared__ __attribute__((aligned(16))) unsigned char lds_raw[];
    Ctx F;
    F.lds = (LAS unsigned char*)lds_raw; F.ws = args.ws; F.in = args.in; F.out = args.out;
    F.tid = threadIdx.x; F.lane = F.tid & 63; F.wave = __builtin_amdgcn_readfirstlane(F.tid >> 6);
    F.G = gridDim.x; { const int bx = blockIdx.x; F.vcu = (F.G % 8 == 0) ? (bx % 8) * (F.G / 8) + bx / 8 : bx; }
    if (F.tid < 16) ((LAS unsigned*)(F.lds + MISC_OFF))[F.tid] = 0u;
    __syncthreads();
    unsigned* ctl = (unsigned*)(F.ws + WS_CTL);
#if N_LAUNCHES == 1
    XcdBarrier bar = xcd_barrier_post(ctl + CW_BAR, (volatile LAS unsigned*)(F.lds + MISC_OFF));
#define GRID_BAR() xcd_barrier(bar)
#else
#define GRID_BAR() do { } while (0)
#endif
    const int lo = args.ph_lo, hi = args.ph_hi;
#define IN(k) (lo <= (k) && (k) < hi)
#define BOTH(k) (IN(k) && IN((k) + 1))
    const int NIT = F.G;

#define REP(k) _Pragma("unroll") for (int rep_ = 0; rep_ < ((PROBE_PHASE == (k)) ? 2 : 1); ++rep_)
    if (IN(0)) { p0_adaln(F); p0_prologue(F); if (BOTH(0)) p0_wait_mod(F); }
    if (IN(1)) { REP(1) { p1_norm(F); } if (BOTH(1)) GRID_BAR(); if (PROBE_PHASE == 100) { GRID_BAR(); GRID_BAR(); GRID_BAR(); GRID_BAR(); } }
    if (IN(2)) {
        if (F.vcu & 1) p2_convert_experts(F);
        REP(2) {
        g8::DenseOrder S; S.init(F.ws + WS_H, F.ws + WS_WIN, T, NIN, DM * 2, F.G, (int)blockIdx.x);
        EpiProj E{(bf16*)(F.ws + WS_PROJ)};
        g8::gemm_phase<EpiProj, g8::DenseOrder>(F.lds, DM * 2, S, E);
        }
        if (!(F.vcu & 1)) p2_convert_experts(F);
        if (BOTH(2)) GRID_BAR();
    }
    if (IN(3)) {
        {
            const bool split = (F.G & 1) == 0; const int hw = split ? (F.vcu >> 1) : F.vcu, HS = split ? (F.G >> 1) : F.G;
            if (!split || (F.vcu & 1) == 0) { for (int it = hw; it < NB * 8 * 2; it += HS) ret_item<4>(F, it); }
            if (!split || (F.vcu & 1) == 1) { LruIn La, Lb; int it = hw; const int NL = NB * 16 * 8;
                __syncthreads();
                if (it < NL) lru_issue(F, it, La);
                while (it < NL) {
                    if (it + HS < NL) lru_issue(F, it + HS, Lb);
                    lru_body(F, it, La); it += HS;
                    if (it >= NL) break;
                    if (it + HS < NL) lru_issue(F, it + HS, La);
                    lru_body(F, it, Lb); it += HS;
                } }
        }
        if (BOTH(3)) GRID_BAR();
    }
    if (IN(4)) { REP(4) { for (int it = F.vcu; it < T / 64; it += NIT) p4_item(F, it); } if (BOTH(4)) GRID_BAR(); }
    if (IN(5)) {
        REP(5) {
        g8::DenseOrder S; S.init(F.ws + WS_CAT, F.ws + WS_WOUT, T, DM, DM * 2, F.G, (int)blockIdx.x);
        EpiWout E{(const float*)F.in[0], (const float*)(F.ws + WS_MOD), (bf16*)(F.ws + WS_X1)};
        g8::gemm_phase<EpiWout, g8::DenseOrder>(F.lds, DM * 2, S, E);
        }
        if (BOTH(5)) GRID_BAR();
    }
    if (IN(6)) { for (int it = F.vcu; it < T / 64; it += NIT) p6_item<false>(F, it); if (PROBE_PHASE == 6) { for (int it = F.vcu; it < T / 64; it += NIT) p6_item<true>(F, it); } if (BOTH(6)) GRID_BAR(); }
    int ntiles = 0;
    if (IN(8)) {
        REP(8) {
        ntiles = moe_build_tables(F);
        MoeOrder<1> S; S.init(F, ntiles); S.fill_tokens(F);
        EpiSwiglu E{F.ws + WS_ACT};
        g8::gemm_phase<EpiSwiglu, MoeOrder<1>, true>(F.lds, DM, S, E);
        }
        if (BOTH(8)) GRID_BAR();
    }
    if (IN(9)) {
        REP(9) {
        if (!IN(8)) ntiles = moe_build_tables(F);
        MoeOrder<2> S; S.init(F, ntiles);
        EpiDown E{F.ws + WS_Y};
        g8::gemm_phase<EpiDown, MoeOrder<2>, true>(F.lds, EH, S, E);
        }
        if (BOTH(9)) GRID_BAR();
    }
    if (IN(10)) { REP(10) { p10_final(F, IN(8)); } }
#undef REP
#undef IN
#undef BOTH
}

extern "C" void kernel_launch(void* const* d_in, const int* in_sizes, int n_in, void* d_out, int out_size, void* d_ws, size_t ws_size, hipStream_t stream) {
    static int grid = 0;
    if (grid == 0) {
        if (n_in != 25 || out_size != T * DM || ws_size < WS_END) { fprintf(stderr, "kernel_launch: unexpected problem (n_in %d, out %d, ws %zu)\n", n_in, out_size, ws_size); grid = -1; return; }
        int dev = 0, cus = 0, per_cu = 0;
        if (hipGetDevice(&dev) != hipSuccess || hipDeviceGetAttribute(&cus, hipDeviceAttributeMultiprocessorCount, dev) != hipSuccess) { grid = -1; return; }
        if (hipFuncSetAttribute((const void*)fwd_kernel, hipFuncAttributeMaxDynamicSharedMemorySize, LDS_BYTES) != hipSuccess) { fprintf(stderr, "kernel_launch: hipFuncSetAttribute failed\n"); grid = -1; return; }
        if (hipOccupancyMaxActiveBlocksPerMultiprocessor(&per_cu, (const void*)fwd_kernel, NWAVES * 64, LDS_BYTES) != hipSuccess || per_cu < 1) { fprintf(stderr, "kernel_launch: occupancy query says %d\n", per_cu); }
        (void)hipGetLastError();
        grid = cus;
    }
    if (grid < 0) return;
    (void)hipMemsetAsync((char*)d_ws + WS_CTL, 0, CTL_ZERO_BYTES, stream);
    Args a{};
    for (int i = 0; i < 25; ++i) a.in[i] = d_in[i];
    a.out = (float*)d_out; a.ws = (unsigned char*)d_ws;
#if N_LAUNCHES == 1
    a.ph_lo = 0; a.ph_hi = 11;
    hipLaunchKernelGGL(fwd_kernel, dim3(grid), dim3(NWAVES * 64), LDS_BYTES, stream, a);
#else
    for (int p = 0; p < 11; ++p) { a.ph_lo = p; a.ph_hi = p + 1; hipLaunchKernelGGL(fwd_kernel, dim3(grid), dim3(NWAVES * 64), LDS_BYTES, stream, a); }
#endif
}
```

```cpp
#include <hip/hip_runtime.h>
#include <cstdio>
#include <cstdint>

#ifndef PROBE_PHASE
#define PROBE_PHASE -1
#endif
#ifndef N_LAUNCHES
#define N_LAUNCHES 1
#endif

#define LAS __attribute__((address_space(3)))
typedef unsigned short bf16;
typedef short bf16x8 __attribute__((ext_vector_type(8)));
typedef float f32x4 __attribute__((ext_vector_type(4)));
typedef float f32x2 __attribute__((ext_vector_type(2)));
typedef unsigned u32x4 __attribute__((ext_vector_type(4)));
typedef unsigned u32x2 __attribute__((ext_vector_type(2)));
typedef int i32x4 __attribute__((ext_vector_type(4)));
typedef int i32x8 __attribute__((ext_vector_type(8)));

constexpr int NB = 8, SEQ = 2048, DM = 2048, T = NB * SEQ;
constexpr int NIN = 6144, RW = 1024, LW = 1024, NE = 64, EH = 512, TOPK = 8;
constexpr int NR_ROUTED = T * TOPK + NE * 256;
constexpr int NR = NR_ROUTED + T;
constexpr int NWAVES = 8;
constexpr float EPS = 1e-6f;
constexpr float SC_H8 = 16.0f, SC_WEI = 64.0f, SC_ACT = 8.0f, SC_WEO = 4.0f, SC_Y = 32.0f;

constexpr size_t MiB = 1u << 20;
constexpr size_t WS_CTL = 0, CTL_ZERO_BYTES = 2 * MiB;
constexpr size_t WS_MOD = 1 * MiB;
constexpr size_t WS_ROPE = 2 * MiB;
constexpr size_t WS_WIN = 10 * MiB;
constexpr size_t WS_WOUT = 34 * MiB;
constexpr size_t WS_WR = 42 * MiB;
constexpr size_t WS_WA = WS_WR + 256 * 1024;
constexpr size_t WS_WX = WS_WA + 256 * 1024;
constexpr size_t WS_WEI = 44 * MiB;
constexpr size_t WS_H8 = 176 * MiB;
constexpr size_t WS_WEO = 304 * MiB;
constexpr size_t WS_H = 434 * MiB;
constexpr size_t WS_X1 = 500 * MiB;
constexpr size_t WS_EIDX = 628 * MiB;
constexpr size_t WS_WSEL = WS_EIDX + 512 * 1024;
constexpr size_t WS_SLOT = WS_WSEL + 512 * 1024;
constexpr size_t WS_DEST = WS_SLOT + 512 * 1024;
constexpr size_t WS_RTOK = WS_DEST + 512 * 1024;
constexpr size_t WS_RW = WS_RTOK + 640 * 1024;
constexpr size_t WS_AGGA = 632 * MiB;
constexpr size_t WS_AGGB = WS_AGGA + 512 * 1024;
constexpr size_t WS_ACT = 634 * MiB;
constexpr size_t WS_PROJ = 794 * MiB;
constexpr size_t WS_RETO = 986 * MiB;
constexpr size_t WS_HLOC = 1050 * MiB;
constexpr size_t WS_PLOC = 1082 * MiB;
constexpr size_t WS_CAT = 1114 * MiB;
constexpr size_t WS_Y = 794 * MiB;
constexpr size_t WS_TOKOF = 1434 * MiB;
constexpr size_t WS_END = 1438 * MiB;
constexpr int CW_BAR = 4096;
constexpr int CW_CNT = 8192;
constexpr int CW_MODCNT = 16384;

constexpr int RING_BYTES = 131072;
constexpr int LDS_BYTES = 163840;
constexpr int TOKL_OFF = 147456, TOKL_UNITS = 12;
constexpr int TT_OFF = 137216;
constexpr int MISC_OFF = LDS_BYTES - 256;
static_assert(TT_OFF + (2 * 704 + 80 + 68) * 4 <= TOKL_OFF && TOKL_OFF + TOKL_UNITS * 1024 <= MISC_OFF, "LDS map");
constexpr int MAXTILES = 704;

__device__ __forceinline__ unsigned pk2(float lo, float hi) { unsigned r; asm volatile("v_cvt_pk_bf16_f32 %0, %1, %2" : "=v"(r) : "v"(lo), "v"(hi)); return r; }
typedef __bf16 bf16x2_t __attribute__((ext_vector_type(2)));
__device__ __forceinline__ unsigned pk2c(float lo, float hi) { const bf16x2_t r = __builtin_convertvector((f32x2){lo, hi}, bf16x2_t); return __builtin_bit_cast(unsigned, r); }
__device__ __forceinline__ bf16 f2bf(float f) { return __builtin_bit_cast(bf16, (__bf16)f); }
__device__ __forceinline__ float bf2f(bf16 b) { return __uint_as_float(((unsigned)b) << 16); }
__device__ __forceinline__ float bflo(unsigned w) { return __uint_as_float(w << 16); }
__device__ __forceinline__ float bfhi(unsigned w) { return __uint_as_float(w & 0xffff0000u); }
__device__ __forceinline__ float wave_sum(float v) {
#pragma unroll
    for (int o = 1; o < 64; o <<= 1) v += __shfl_xor(v, o);
    return v;
}
__device__ __forceinline__ float sigmoidf_(float x) { return __builtin_amdgcn_rcpf(1.0f + __expf(-x)); }
__device__ __forceinline__ float siluf_(float x) { return x * __builtin_amdgcn_rcpf(1.0f + __expf(-x)); }
__device__ __forceinline__ float gelu_tanh_(float x) { const float u = 0.7978845608028654f * (x + 0.044715f * x * x * x); const float e = __expf(2.0f * u); const float th = 1.0f - 2.0f * __builtin_amdgcn_rcpf(e + 1.0f); return 0.5f * x * (1.0f + th); }
__device__ __forceinline__ unsigned ld_agent(const unsigned* p) { return __hip_atomic_load(p, __ATOMIC_RELAXED, __HIP_MEMORY_SCOPE_AGENT); }
__device__ __forceinline__ int ld_agent_i(const int* p) { return (int)__hip_atomic_load((const unsigned*)p, __ATOMIC_RELAXED, __HIP_MEMORY_SCOPE_AGENT); }
__device__ __forceinline__ float clamp448(float x) { return __builtin_amdgcn_fmed3f(x, -448.0f, 448.0f); }
__device__ __forceinline__ unsigned pk4_fp8(float a, float b, float c, float d) { int w = 0; w = __builtin_amdgcn_cvt_pk_fp8_f32(clamp448(a), clamp448(b), w, false); w = __builtin_amdgcn_cvt_pk_fp8_f32(clamp448(c), clamp448(d), w, true); return (unsigned)w; }
#define LDS_WAIT() asm volatile("s_waitcnt lgkmcnt(0)" ::: "memory")
#define VM_WAIT() asm volatile("s_waitcnt vmcnt(0)" ::: "memory")

#define XB_TMO      128
#define XB_XCNT(j)  (256  + 64 * (j))
#define XB_XSUB(j)  (1280 + 64 * (j))
#define XB_XGEN(j)  (2304 + 64 * (j))
#define XB_TOP      3328
#define XB_TOPGEN   3392
#define XCD_BAR_WORDS 3456
#define XB_SPIN_CAP (1u << 18)
__device__ __forceinline__ unsigned xb_ld(unsigned* p)              { return __hip_atomic_load(p, __ATOMIC_RELAXED, __HIP_MEMORY_SCOPE_AGENT); }
__device__ __forceinline__ unsigned xb_add(unsigned* p, unsigned v) { return __hip_atomic_fetch_add(p, v, __ATOMIC_RELAXED, __HIP_MEMORY_SCOPE_AGENT); }
__device__ __forceinline__ unsigned xb_xcc_id() { return (unsigned)__builtin_amdgcn_s_getreg((3 << 11) | 20) & 0xFu; }
#define XB_SPIN(cond, bar) do { unsigned _sp = 0; while (cond) { __builtin_amdgcn_s_sleep(1); \
    if ((++_sp & 255u) == 0u) { if (xb_ld(&(bar)[XB_TMO])) break; if (_sp > XB_SPIN_CAP) { atomicAdd(&(bar)[XB_TMO], 1u); break; } } } } while (0)
struct XcdBarrier { unsigned* bar; unsigned x; volatile LAS unsigned* st; };
__device__ __forceinline__ XcdBarrier xcd_barrier_post(unsigned* bar, volatile LAS unsigned* st) {
    XcdBarrier b; b.bar = bar; b.x = xb_xcc_id(); b.st = st;
    if (threadIdx.x == 0) (void)xb_add(&bar[XB_XCNT(b.x)], 1u);
    return b;
}
__device__ __forceinline__ void xcd_barrier_complete(unsigned* bar, unsigned x, unsigned& nloc, unsigned& nx) {
    const unsigned G = gridDim.x * gridDim.y * gridDim.z;
    unsigned sum, cnt, mine, sp = 0u;
    for (;;) {
        sum = 0u; cnt = 0u; mine = 0u;
#pragma unroll
        for (unsigned j = 0; j < 16; ++j) { const unsigned c = xb_ld(&bar[XB_XCNT(j)]); sum += c; cnt += (c > 0u) ? 1u : 0u; mine = (j == x) ? c : mine; }
        if (sum == G) break;
        __builtin_amdgcn_s_sleep(1);
        if ((++sp & 255u) == 0u) { if (xb_ld(&bar[XB_TMO])) break; if (sp > XB_SPIN_CAP) { atomicAdd(&bar[XB_TMO], 1u); break; } }
    }
    nloc = mine > 0u ? mine : 1u; nx = cnt > 0u ? cnt : 1u;
}
__device__ __forceinline__ void xcd_barrier(const XcdBarrier& b) {
    asm volatile("s_waitcnt vmcnt(0)" ::: "memory");
    __syncthreads();
    if (threadIdx.x == 0) {
        unsigned* bar = b.bar;
        __builtin_amdgcn_s_waitcnt(0);
        unsigned nloc = b.st[0], nx = b.st[1];
        if (nloc == 0u) { xcd_barrier_complete(bar, b.x, nloc, nx); b.st[0] = nloc; b.st[1] = nx; }
        const unsigned old = xb_add(&bar[XB_XSUB(b.x)], 1u);
        const unsigned gen = old / nloc;
        if (old + 1u == (gen + 1u) * nloc) {
            __builtin_amdgcn_fence(__ATOMIC_RELEASE, "agent");
            asm volatile("s_waitcnt vmcnt(0)" ::: "memory");
            const unsigned og = xb_add(&bar[XB_TOP], 1u);
            const unsigned tg = og / nx;
            if (og + 1u == (tg + 1u) * nx) xb_add(&bar[XB_TOPGEN], 1u);
            else XB_SPIN(xb_ld(&bar[XB_TOPGEN]) == tg, bar);
            __builtin_amdgcn_fence(__ATOMIC_ACQUIRE, "agent");
            xb_add(&bar[XB_XGEN(b.x)], 1u);
            asm volatile("s_waitcnt vmcnt(0)" ::: "memory");
        } else {
            XB_SPIN(xb_ld(&bar[XB_XGEN(b.x)]) == gen, bar);
            __builtin_amdgcn_fence(__ATOMIC_ACQUIRE, "agent");
            asm volatile("s_waitcnt vmcnt(0)" ::: "memory");
        }
    }
    __syncthreads();
}

namespace g8 {
constexpr int BM = 256, BK = 64, HALF = 128, HTB = HALF * BK * 2, NXCD = 8, WGM = 8;
__device__ __forceinline__ int lds_byte(int r, int c) { const int st = (r >> 4) * 2 + (c >> 5), rr = r & 15, cc = c & 31, ob = rr * 64 + cc * 2; return st * 1024 + (ob ^ (((ob >> 9) & 1) << 5)); }
__device__ __forceinline__ void stage_rc(int b, int& R, int& C) { const int st = b / 1024, sb = b % 1024, swz = sb ^ (((sb >> 9) & 1) << 5); R = (st >> 1) * 16 + swz / 64; C = (st & 1) * 32 + (swz % 64) / 2; }
__device__ __forceinline__ int perm32(int rho) { const int n = rho >> 4, i = rho & 15; return 8 * (i >> 2) + 4 * n + (i & 3); }

struct Unit { const char* A; const char* B; unsigned vA0[2], vA1[2]; int r0, pn, e, rend; };

template <class Epi, class Sched, bool F8 = false>
__device__ __forceinline__ void gemm_phase(LAS unsigned char* lds, const int pitch, const Sched& S, const Epi& E) {
    const int tid = threadIdx.x, wid = __builtin_amdgcn_readfirstlane(tid >> 6), lane = tid & 63, wr = wid >> 2, wc = wid & 3, fr = lane & 15, fq = lane >> 4;
    const int nt = pitch / 128;
    unsigned voffB[2], voffB1[2];
#pragma unroll
    for (int i = 0; i < 2; ++i) { int R, C; stage_rc(tid * 16 + i * 8192, R, C); const int p = perm32(R & 31);
        if constexpr (Epi::P16) { const int base = 64 * (R >> 5) + 16 * (p >> 3) + (p & 7); voffB[i] = (unsigned)(base * pitch + C * 2); voffB1[i] = (unsigned)((base + 8) * pitch + C * 2); }
        else { const int Rb = Epi::PERM ? ((R & ~31) + p) : R; voffB[i] = (unsigned)(Rb * pitch + C * 2); voffB1[i] = voffB[i] + (unsigned)(HALF * pitch); } }
    const size_t kstep = 128;
    const size_t hstepB = (size_t)HALF * pitch;
    const unsigned ldsw = (unsigned)wid * 1024u;
    const int aoff = lds_byte(wr * 64 + fr, fq * 8), boff = lds_byte(wc * 32 + fr, fq * 8);
#define G8_SA(b, h) (((b) * 2 + (h)) * HTB)
#define G8_SB(b, h) ((4 + (b) * 2 + (h)) * HTB)
#define G8_STAGE(bufoff, gbase, voff) do { _Pragma("unroll") for (int _i = 0; _i < 2; ++_i) \
        __builtin_amdgcn_global_load_lds((const unsigned*)((const char*)(gbase) + (voff)[_i]), (LAS unsigned*)(lds + (bufoff) + ldsw + _i * 8192), 16, 0, 0); } while (0)
#define G8_LDA(dst, b, h) do { _Pragma("unroll") for (int m = 0; m < 4; ++m) _Pragma("unroll") for (int k = 0; k < 2; ++k) dst[m][k] = *(const LAS bf16x8*)(lds + G8_SA(b, h) + aoff + m * 2048 + k * 1024); } while (0)
#define G8_LDB(dst, b, h) do { _Pragma("unroll") for (int n = 0; n < 2; ++n) _Pragma("unroll") for (int k = 0; k < 2; ++k) dst[n][k] = *(const LAS bf16x8*)(lds + G8_SB(b, h) + boff + n * 2048 + k * 1024); } while (0)
#define G8_CAT(x) __builtin_shufflevector(__builtin_bit_cast(i32x4, x[0]), __builtin_bit_cast(i32x4, x[1]), 0, 1, 2, 3, 4, 5, 6, 7)
#define G8_MMA(ai, bj, At, Bt) do { __builtin_amdgcn_s_setprio(1); _Pragma("unroll") for (int m = 0; m < 4; ++m) _Pragma("unroll") for (int n = 0; n < 2; ++n) { \
        if constexpr (F8) acc[ai][bj][m][n] = __builtin_amdgcn_mfma_scale_f32_16x16x128_f8f6f4(G8_CAT(Bt[n]), G8_CAT(At[m]), acc[ai][bj][m][n], 0, 0, 0, 0x7f7f7f7f, 0, 0x7f7f7f7f); \
        else { _Pragma("unroll") for (int k = 0; k < 2; ++k) acc[ai][bj][m][n] = __builtin_amdgcn_mfma_f32_16x16x32_bf16(Bt[n][k], At[m][k], acc[ai][bj][m][n], 0, 0, 0); } } \
        __builtin_amdgcn_s_setprio(0); } while (0)
#define G8_WAIT_V(n) asm volatile("s_waitcnt vmcnt(" #n ")" ::: "memory")
#define G8_WAIT_L(n) asm volatile("s_waitcnt lgkmcnt(" #n ")" ::: "memory")
#define G8_BAR __builtin_amdgcn_s_barrier()
#define G8_SCHED __builtin_amdgcn_sched_barrier(0)
    Unit cur, nxt; int ui = 0;
    if (!S.next(0, cur)) return;
    f32x4 acc[2][2][4][2];
#pragma unroll
    for (int a = 0; a < 2; ++a)
#pragma unroll
        for (int b = 0; b < 2; ++b)
#pragma unroll
            for (int m = 0; m < 4; ++m)
#pragma unroll
                for (int n = 0; n < 2; ++n) acc[a][b][m][n] = (f32x4){0.f, 0.f, 0.f, 0.f};
    bf16x8 At[4][2], B0[2][2], B1[2][2];
    const char* cA = cur.A; const char* cB = cur.B;
    G8_STAGE(G8_SB(0, 0), cB, voffB); G8_STAGE(G8_SB(0, 1), cB, voffB1); G8_STAGE(G8_SA(0, 0), cA, cur.vA0); G8_STAGE(G8_SA(0, 1), cA, cur.vA1);
    if (wr == 1) G8_BAR;
    G8_WAIT_V(2); G8_BAR;
    G8_STAGE(G8_SB(1, 0), cB + kstep, voffB); G8_STAGE(G8_SA(1, 0), cA + kstep, cur.vA0); G8_STAGE(G8_SB(1, 1), cB + kstep, voffB1);
    G8_WAIT_V(6); G8_BAR;
    for (;;) {
        const bool has_next = S.next(ui + 1, nxt);
        if (!has_next) nxt = cur;
        const char* nA = nxt.A; const char* nB = nxt.B;
#pragma unroll 1
        for (int t = 0; t < nt; t += 2) {
            const bool last = (t == nt - 2);
            const char* a1 = cA + (size_t)(t + 1) * kstep;
            const char* a2 = last ? nA : cA + (size_t)(t + 2) * kstep; const char* b2 = last ? nB : cB + (size_t)(t + 2) * kstep;
            const char* a3 = a2 + kstep; const char* b3 = b2 + kstep;
            G8_LDB(B0, 0, 0); G8_LDB(B1, 0, 1); G8_SCHED; G8_LDA(At, 0, 0); G8_STAGE(G8_SA(1, 1), a1, cur.vA1);
            if (last) { cur.vA0[0] = nxt.vA0[0]; cur.vA0[1] = nxt.vA0[1]; cur.vA1[0] = nxt.vA1[0]; cur.vA1[1] = nxt.vA1[1]; }
            G8_WAIT_V(8); G8_WAIT_L(0); G8_BAR; G8_MMA(0, 0, At, B0); G8_MMA(0, 1, At, B1); G8_BAR; G8_SCHED;
            G8_LDA(At, 0, 1); G8_STAGE(G8_SB(0, 0), b2, voffB); G8_STAGE(G8_SB(0, 1), b2, voffB1); G8_STAGE(G8_SA(0, 0), a2, cur.vA0);
            G8_WAIT_V(8); G8_WAIT_L(0); G8_BAR; G8_MMA(1, 0, At, B0); G8_MMA(1, 1, At, B1); G8_BAR; G8_SCHED;
            G8_LDB(B0, 1, 0); G8_LDB(B1, 1, 1); G8_SCHED; G8_LDA(At, 1, 0); G8_STAGE(G8_SA(0, 1), a2, cur.vA1);
            G8_WAIT_V(8); G8_WAIT_L(0); G8_BAR; G8_MMA(0, 0, At, B0); G8_MMA(0, 1, At, B1); G8_BAR; G8_SCHED;
            G8_LDA(At, 1, 1); G8_STAGE(G8_SB(1, 0), b3, voffB); G8_STAGE(G8_SB(1, 1), b3, voffB1); G8_STAGE(G8_SA(1, 0), a3, cur.vA0);
            G8_WAIT_V(8); G8_WAIT_L(0); G8_BAR; G8_MMA(1, 0, At, B0); G8_MMA(1, 1, At, B1); G8_BAR; G8_SCHED;
        }
        if (wr == 0) G8_BAR;
        E(acc, cur, wr, wc, fr, fq);
        if (!has_next) break;
#pragma unroll
        for (int a = 0; a < 2; ++a)
#pragma unroll
            for (int b = 0; b < 2; ++b)
#pragma unroll
                for (int m = 0; m < 4; ++m)
#pragma unroll
                    for (int n = 0; n < 2; ++n) acc[a][b][m][n] = (f32x4){0.f, 0.f, 0.f, 0.f};
        cur = nxt; cA = nA; cB = nB; ++ui;
        if (wr == 1) G8_BAR;
    }
    G8_WAIT_V(0);
    G8_BAR;
#undef G8_SA
#undef G8_SB
#undef G8_STAGE
#undef G8_LDA
#undef G8_CAT
#undef G8_LDB
#undef G8_MMA
#undef G8_WAIT_V
#undef G8_WAIT_L
#undef G8_BAR
#undef G8_SCHED
}

struct DenseOrder {
    const char* A; const char* Bt; int pitch; int nM, nN, nwg, G, c;
    __device__ void init(const void* A_, const void* Bt_, int M, int N, int pitch_, int G_, int c_) { A = (const char*)A_; Bt = (const char*)Bt_; pitch = pitch_; nM = M / BM; nN = N / BM; nwg = nM * nN; G = G_; c = c_; }
    __device__ __forceinline__ bool next(int i, Unit& u) const {
        const long L = (long)i * G + c; if (L >= nwg) return false;
        int R[2], C[2]; stage_rc((int)threadIdx.x * 16, R[0], C[0]); stage_rc((int)threadIdx.x * 16 + 8192, R[1], C[1]);
        int wgid = (int)L; { const int q = nwg / NXCD, r = nwg % NXCD, xcd = wgid % NXCD, off = wgid / NXCD; wgid = (xcd < r ? xcd * (q + 1) : r * (q + 1) + (xcd - r) * q) + off; }
        const int nig = WGM * nN, gid = wgid / nig, fm = gid * WGM, gsz = (nM - fm) < WGM ? (nM - fm) : WGM;
        const int pm = fm + ((wgid % nig) % gsz), pn = (wgid % nig) / gsz;
        u.A = A + (size_t)pm * BM * pitch; u.B = Bt + (size_t)pn * BM * pitch;
#pragma unroll
        for (int j = 0; j < 2; ++j) { u.vA0[j] = (unsigned)(R[j] * pitch + C[j] * 2); u.vA1[j] = (unsigned)((R[j] + HALF) * pitch + C[j] * 2); }
        u.r0 = pm * BM; u.pn = pn; u.e = 0; u.rend = 0; return true;
    }
};
}

struct Args { const void* in[25]; float* out; unsigned char* ws; int ph_lo, ph_hi; };
struct Ctx {
    LAS unsigned char* lds; unsigned char* ws; const void* const* in; float* out;
    int tid, lane, wave, vcu, G;
};

__device__ __forceinline__ void p0_adaln(Ctx& F) {
    LAS float* sc = (LAS float*)F.lds;
    LAS float* red = (LAS float*)(F.lds + 65536);
    const float* cvec = (const float*)F.in[1]; const float* wada = (const float*)F.in[3]; const float* bada = (const float*)F.in[4]; float* mod = (float*)(F.ws + WS_MOD);
    __syncthreads();
    for (int i = F.tid; i < NB * DM; i += NWAVES * 64) sc[i] = siluf_(cvec[i]);
    __syncthreads();
    for (int cb = F.vcu; cb < 6 * DM / 48; cb += F.G) {
        const int n0 = cb * 48, l = F.lane < 48 ? F.lane : 47, k0 = F.wave * 256;
        float acc[8];
#pragma unroll
        for (int b = 0; b < 8; ++b) acc[b] = 0.f;
        const float* col = wada + (size_t)k0 * (6 * DM) + n0 + l;
#pragma unroll 1
        for (int kk = 0; kk < 256; kk += 32) { float wv[32];
#pragma unroll
            for (int u = 0; u < 32; ++u) wv[u] = col[(size_t)(kk + u) * (6 * DM)];
#pragma unroll
            for (int u = 0; u < 32; ++u)
#pragma unroll
                for (int b = 0; b < 8; ++b) acc[b] += sc[b * DM + k0 + kk + u] * wv[u]; }
        if (F.lane < 48) {
#pragma unroll
            for (int b = 0; b < 8; ++b) red[(F.wave * 8 + b) * 48 + F.lane] = acc[b]; }
        __syncthreads();
        if (F.tid < 384) { const int b = F.tid / 48, cc = F.tid % 48; float s = bada[n0 + cc];
#pragma unroll
            for (int w = 0; w < 8; ++w) s += red[(w * 8 + b) * 48 + cc];
            __hip_atomic_store(mod + (size_t)b * 6 * DM + n0 + cc, s, __ATOMIC_RELAXED, __HIP_MEMORY_SCOPE_AGENT); }
        VM_WAIT();
        __syncthreads();
    }
    if (F.tid == 0) __hip_atomic_fetch_add((unsigned*)(F.ws + WS_CTL) + CW_MODCNT, 1u, __ATOMIC_RELAXED, __HIP_MEMORY_SCOPE_AGENT);
}
__device__ __forceinline__ void p0_wait_mod(Ctx& F) {
    if (F.tid == 0) { unsigned* ctl = (unsigned*)(F.ws + WS_CTL); unsigned sp = 0u;
        while (ld_agent(ctl + CW_MODCNT) < (unsigned)F.G) { __builtin_amdgcn_s_sleep(2); if (++sp > (1u << 20)) { atomicAdd(ctl + CW_BAR + XB_TMO, 1u); break; } }
        __builtin_amdgcn_fence(__ATOMIC_ACQUIRE, "agent");
        asm volatile("s_waitcnt vmcnt(0)" ::: "memory"); }
    __syncthreads();
}
template <bool F8>
__device__ __forceinline__ void p0_transpose_item(const float* W, int K, int N, void* WT, int out_row0, int k0, int n0, float scale, LAS float* scr, int lane) {
    f32x4 v[16];
#pragma unroll
    for (int i = 0; i < 16; ++i) v[i] = *(const f32x4*)(W + (size_t)(k0 + 4 * i + (lane >> 4)) * N + n0 + 4 * (lane & 15));
#pragma unroll
    for (int i = 0; i < 16; ++i) { LAS float* d = scr + (4 * i + (lane >> 4)) * 65 + 4 * (lane & 15); d[0] = v[i].x; d[1] = v[i].y; d[2] = v[i].z; d[3] = v[i].w; }
    LDS_WAIT(); asm volatile("" ::: "memory");
    if (!F8) {
        const int c = lane & 7;
#pragma unroll
        for (int j = 0; j < 8; ++j) { const int n = (lane >> 3) + 8 * j; const LAS float* s = scr + (8 * c) * 65 + n;
            u32x4 o; o.x = pk2(s[0 * 65], s[1 * 65]); o.y = pk2(s[2 * 65], s[3 * 65]); o.z = pk2(s[4 * 65], s[5 * 65]); o.w = pk2(s[6 * 65], s[7 * 65]);
            *(u32x4*)((bf16*)WT + (size_t)(out_row0 + n) * K + k0 + 8 * c) = o; }
    } else {
        const int c = lane & 3;
#pragma unroll
        for (int j = 0; j < 4; ++j) { const int n = (lane >> 2) + 16 * j; const LAS float* s = scr + (16 * c) * 65 + n; int o[4];
#pragma unroll
            for (int q = 0; q < 4; ++q) { int wv = 0; wv = __builtin_amdgcn_cvt_pk_fp8_f32(s[(4 * q) * 65] * scale, s[(4 * q + 1) * 65] * scale, wv, false); wv = __builtin_amdgcn_cvt_pk_fp8_f32(s[(4 * q + 2) * 65] * scale, s[(4 * q + 3) * 65] * scale, wv, true); o[q] = wv; }
            *(u32x4*)((unsigned char*)WT + (size_t)(out_row0 + n) * K + k0 + 16 * c) = (u32x4){(unsigned)o[0], (unsigned)o[1], (unsigned)o[2], (unsigned)o[3]}; }
    }
    LDS_WAIT(); asm volatile("" ::: "memory");
}
struct CvItem { const float* src; unsigned char* dst; int N, K; float scale; };
__device__ __forceinline__ CvItem cv_decode(const void* const* in, unsigned char* ws, int r) {
    constexpr int I_EI = 32 * 16, I_EO = 8 * 32; CvItem c;
    if (r < 65 * I_EI) { const int e = r / I_EI, q = r % I_EI, kb = q / 16, nb = q % 16, n0 = 64 * nb, j = n0 & 511, up = n0 >> 9;
        const float* W = (e < 64) ? (const float*)in[20] + (size_t)e * DM * 1024 : (const float*)in[22];
        c.src = W + (size_t)(64 * kb) * 1024 + n0; c.N = 1024; c.K = DM; c.scale = SC_WEI;
        c.dst = ws + WS_WEI + (size_t)e * 1024 * DM + (size_t)((j >> 7) * 256 + up * 128 + (j & 127)) * DM + 64 * kb; }
    else { r -= 65 * I_EI; const int e = r / I_EO, q = r % I_EO, kb = q / 32, nb = q % 32;
        const float* W = (e < 64) ? (const float*)in[21] + (size_t)e * EH * DM : (const float*)in[23];
        c.src = W + (size_t)(64 * kb) * DM + 64 * nb; c.N = DM; c.K = EH; c.scale = SC_WEO;
        c.dst = ws + WS_WEO + (size_t)e * DM * EH + (size_t)(64 * nb) * EH + 64 * kb; }
    return c;
}
__device__ __forceinline__ void p2_convert_experts(Ctx& F) {
    const int gw = F.vcu * NWAVES + F.wave, NGW = F.G * NWAVES, lane = F.lane, li = lane & 15, lg = lane >> 4;
    constexpr int NCV = 65 * (32 * 16 + 8 * 32);
    int it = gw; CvItem cur; f32x4 v[16];
    const int krow = 16 * (li >> 2) + (li & 3);
#define CV_LOAD(c) do { _Pragma("unroll") for (int nh = 0; nh < 2; ++nh) _Pragma("unroll") for (int q = 0; q < 4; ++q) { const float* p_ = (c).src + (size_t)(krow + 4 * q) * (c).N + 32 * nh + 8 * lg; \
        v[(nh * 4 + q) * 2] = *(const f32x4*)p_; v[(nh * 4 + q) * 2 + 1] = *(const f32x4*)(p_ + 4); } } while (0)
    if (it < NCV) { cur = cv_decode(F.in, F.ws, it); CV_LOAD(cur); }
    while (it < NCV) {
        bf16x8 a[2][4];
#pragma unroll
        for (int nh = 0; nh < 2; ++nh)
#pragma unroll
            for (int q = 0; q < 4; ++q) { const f32x4 lo = v[(nh * 4 + q) * 2], hi = v[(nh * 4 + q) * 2 + 1];
                const u32x4 pk = (u32x4){pk2c(lo.x, lo.y), pk2c(lo.z, lo.w), pk2c(hi.x, hi.y), pk2c(hi.z, hi.w)}; a[nh][q] = __builtin_bit_cast(bf16x8, pk); }
        const CvItem me = cur; const int nit = it + NGW;
        if (nit < NCV) { cur = cv_decode(F.in, F.ws, nit); CV_LOAD(cur); }
        const unsigned sbits = (unsigned)f2bf(me.scale);
#pragma unroll
        for (int h = 0; h < 2; ++h) {
            u32x4 sel = (u32x4){0u, 0u, 0u, 0u}; { const int d = 16 * h + li - 8 * lg; if (d >= 0 && d < 8) { const unsigned wv = (d & 1) ? (sbits << 16) : sbits; if ((d >> 1) == 0) sel.x = wv; else if ((d >> 1) == 1) sel.y = wv; else if ((d >> 1) == 2) sel.z = wv; else sel.w = wv; } }
            const bf16x8 bs = __builtin_bit_cast(bf16x8, sel);
#pragma unroll
            for (int nh = 0; nh < 2; ++nh) { unsigned o[4];
#pragma unroll
                for (int q = 0; q < 4; ++q) { const f32x4 d = __builtin_amdgcn_mfma_f32_16x16x32_bf16(a[nh][q], bs, (f32x4){0.f, 0.f, 0.f, 0.f}, 0, 0, 0); o[q] = pk4_fp8(d[0], d[1], d[2], d[3]); }
                *(u32x4*)(me.dst + (size_t)(32 * nh + 16 * h + li) * me.K + 16 * lg) = (u32x4){o[0], o[1], o[2], o[3]}; }
        }
        it = nit;
    }
#undef CV_LOAD
}
__device__ __forceinline__ void p0_prologue(Ctx& F) {
    LAS float* scr = (LAS float*)(F.lds + F.wave * 16640);
    const int gw = F.vcu * NWAVES + F.wave, NGW = F.G * NWAVES, lane = F.lane;
    unsigned char* ws = F.ws;
    constexpr int I_IN = 32 * 96, I_OUT = 32 * 32, I_R = 32 * 1, I_G = 2 * 2;
    constexpr int NTR = I_IN + I_OUT + I_R + 16 * I_G;
    for (int it = gw; it < NTR; it += NGW) {
        int r = it;
        if (r < I_IN) { const int kb = r / 96, nb = r % 96; p0_transpose_item<false>((const float*)F.in[6], DM, NIN, ws + WS_WIN, 64 * nb, 64 * kb, 64 * nb, 1.f, scr, lane); continue; } r -= I_IN;
        if (r < I_OUT) { const int kb = r / 32, nb = r % 32; p0_transpose_item<false>((const float*)F.in[16], DM, DM, ws + WS_WOUT, 64 * nb, 64 * kb, 64 * nb, 1.f, scr, lane); continue; } r -= I_OUT;
        if (r < I_R) { const int kb = r; p0_transpose_item<false>((const float*)F.in[18], DM, NE, ws + WS_WR, 0, 64 * kb, 0, 1.f, scr, lane); continue; } r -= I_R;
        { const int m = r / I_G, q = r % I_G, kb = q / 2, nb = q % 2, g = m & 7;
          const float* W = ((m < 8) ? (const float*)F.in[9] : (const float*)F.in[11]) + (size_t)g * 128 * 128;
          p0_transpose_item<false>(W, 128, 128, (bf16*)(ws + (m < 8 ? WS_WA : WS_WX)) + (size_t)g * 128 * 128, 64 * nb, 64 * kb, 64 * nb, 1.f, scr, lane); }
    }
    {
        const int* pos = (const int*)F.in[2]; unsigned* rt = (unsigned*)(ws + WS_ROPE);
        const double invrev = exp(-9.210340371976184 * (double)lane / 64.0) * 0.15915494309189535;
        for (int it = gw; it < T * 64 / 512; it += NGW) {
#pragma unroll
            for (int q = 0; q < 8; ++q) { const int idx = it * 512 + q * 64 + lane, t = idx >> 6;
                const double rev = (double)pos[t] * invrev; const float fr_ = (float)(rev - floor(rev));
                rt[idx] = pk2c(__builtin_amdgcn_cosf(fr_), __builtin_amdgcn_sinf(fr_)); }
        }
    }
    if (gw == 0) { u32x4* z = (u32x4*)((bf16*)(ws + WS_H) + (size_t)T * DM); for (int i = lane; i < DM * 2 / 16; i += 64) z[i] = (u32x4){0u, 0u, 0u, 0u};
        u32x4* z8 = (u32x4*)(ws + WS_H8 + (size_t)T * DM); for (int i = lane; i < DM / 16; i += 64) z8[i] = (u32x4){0u, 0u, 0u, 0u}; }
}

template <bool W8, bool INBF>
__device__ __forceinline__ void norm_mod_row(const void* xrow_, const float* g, const float* sc, const float* sh, bf16* orow, unsigned char* orow8, int lane) {
    f32x4 v[4][2]; float ss = 0.f;
#pragma unroll
    for (int j = 0; j < 4; ++j) {
        if constexpr (INBF) { const u32x4 w = *(const u32x4*)((const bf16*)xrow_ + 8 * lane + 512 * j); v[j][0] = (f32x4){bflo(w.x), bfhi(w.x), bflo(w.y), bfhi(w.y)}; v[j][1] = (f32x4){bflo(w.z), bfhi(w.z), bflo(w.w), bfhi(w.w)}; }
        else { v[j][0] = *(const f32x4*)((const float*)xrow_ + 8 * lane + 512 * j); v[j][1] = *(const f32x4*)((const float*)xrow_ + 8 * lane + 512 * j + 4); }
#pragma unroll
        for (int h = 0; h < 2; ++h) ss += (v[j][h].x * v[j][h].x + v[j][h].y * v[j][h].y) + (v[j][h].z * v[j][h].z + v[j][h].w * v[j][h].w); }
    const float rstd = rsqrtf(wave_sum(ss) * (1.0f / DM) + EPS);
#pragma unroll
    for (int j = 0; j < 4; ++j) { f32x4 o[2];
#pragma unroll
        for (int h = 0; h < 2; ++h) { const int c = 8 * lane + 512 * j + 4 * h; const f32x4 gg = *(const f32x4*)(g + c), s1 = *(const f32x4*)(sc + c), s0 = *(const f32x4*)(sh + c);
            o[h] = (v[j][h] * rstd * gg) * (s1 + 1.0f) + s0; }
        u32x4 w; w.x = pk2(o[0].x, o[0].y); w.y = pk2(o[0].z, o[0].w); w.z = pk2(o[1].x, o[1].y); w.w = pk2(o[1].z, o[1].w);
        *(u32x4*)(orow + 8 * lane + 512 * j) = w;
        if constexpr (W8) { u32x2 w8; w8.x = pk4_fp8(o[0].x * SC_H8, o[0].y * SC_H8, o[0].z * SC_H8, o[0].w * SC_H8); w8.y = pk4_fp8(o[1].x * SC_H8, o[1].y * SC_H8, o[1].z * SC_H8, o[1].w * SC_H8); *(u32x2*)(orow8 + 8 * lane + 512 * j) = w8; } }
}
__device__ __forceinline__ void p1_norm(Ctx& F) {
    const int gw = F.vcu * NWAVES + F.wave, NGW = F.G * NWAVES;
    const float* x = (const float*)F.in[0]; const float* g = (const float*)F.in[5]; const float* mod = (const float*)(F.ws + WS_MOD); bf16* h = (bf16*)(F.ws + WS_H);
    for (int m = gw; m < T; m += NGW) { const int b = m / SEQ; norm_mod_row<false, false>(x + (size_t)m * DM, g, mod + (size_t)b * 6 * DM + DM, mod + (size_t)b * 6 * DM, h + (size_t)m * DM, nullptr, F.lane); }
}

struct EpiProj {
    static constexpr bool PERM = true, P16 = false;
    bf16* O;
    __device__ __forceinline__ void operator()(const f32x4 (&acc)[2][2][4][2], const g8::Unit& u, int wr, int wc, int fr, int fq) const {
        const int row0 = u.r0 + wr * 64 + fr, col0 = u.pn * 256 + wc * 32 + 8 * fq;
#pragma unroll
        for (int ai = 0; ai < 2; ++ai)
#pragma unroll
            for (int m = 0; m < 4; ++m) { bf16* rowp = O + (size_t)(row0 + ai * 128 + m * 16) * NIN + col0;
#pragma unroll
                for (int bj = 0; bj < 2; ++bj) { const f32x4 v0 = acc[ai][bj][m][0], v1 = acc[ai][bj][m][1];
                    u32x4 w; w.x = pk2c(v0[0], v0[1]); w.y = pk2c(v0[2], v0[3]); w.z = pk2c(v1[0], v1[1]); w.w = pk2c(v1[2], v1[3]);
                    *(u32x4*)(rowp + bj * 128) = w; } }
    }
};
struct EpiWout {
    static constexpr bool PERM = true, P16 = false;
    const float* x; const float* mod; bf16* x1;
    __device__ __forceinline__ void operator()(const f32x4 (&acc)[2][2][4][2], const g8::Unit& u, int wr, int wc, int fr, int fq) const {
        const int row0 = u.r0 + wr * 64 + fr, col0 = u.pn * 256 + wc * 32 + 8 * fq; const int b = u.r0 / SEQ;
        const float* gt = mod + (size_t)b * 6 * DM + 2 * DM;
        f32x4 gv[2][2];
#pragma unroll
        for (int bj = 0; bj < 2; ++bj)
#pragma unroll
            for (int n = 0; n < 2; ++n) gv[bj][n] = *(const f32x4*)(gt + col0 + bj * 128 + n * 4);
#pragma unroll
        for (int ai = 0; ai < 2; ++ai)
#pragma unroll
            for (int m = 0; m < 4; ++m) { const size_t off = (size_t)(row0 + ai * 128 + m * 16) * DM + col0;
#pragma unroll
                for (int bj = 0; bj < 2; ++bj) { const f32x4 v0 = *(const f32x4*)(x + off + bj * 128) + gv[bj][0] * acc[ai][bj][m][0], v1 = *(const f32x4*)(x + off + bj * 128 + 4) + gv[bj][1] * acc[ai][bj][m][1];
                    u32x4 w; w.x = pk2(v0[0], v0[1]); w.y = pk2(v0[2], v0[3]); w.z = pk2(v1[0], v1[1]); w.w = pk2(v1[2], v1[3]);
                    *(u32x4*)(x1 + off + bj * 128) = w; }
                asm volatile("" ::: "memory"); }
    }
};
struct EpiSwiglu {
    static constexpr bool PERM = true, P16 = false;
    unsigned char* act;
    __device__ __forceinline__ void operator()(const f32x4 (&acc)[2][2][4][2], const g8::Unit& u, int wr, int wc, int fr, int fq) const {
        const int row0 = u.r0 + wr * 64 + fr, col0 = u.pn * 128 + wc * 32 + 8 * fq;
#pragma unroll
        for (int ai = 0; ai < 2; ++ai)
#pragma unroll
            for (int m = 0; m < 4; ++m) { float o[8];
#pragma unroll
                for (int n = 0; n < 2; ++n)
#pragma unroll
                    for (int j = 0; j < 4; ++j) { const float g = acc[ai][0][m][n][j] * (1.0f / (SC_H8 * SC_WEI)), up = acc[ai][1][m][n][j] * (SC_ACT / (SC_H8 * SC_WEI)); o[4 * n + j] = g * __builtin_amdgcn_rcpf(1.0f + __expf(-g)) * up; }
                u32x2 w; w.x = pk4_fp8(o[0], o[1], o[2], o[3]); w.y = pk4_fp8(o[4], o[5], o[6], o[7]);
                *(u32x2*)(act + (size_t)(row0 + ai * 128 + m * 16) * EH + col0) = w; }
    }
};
struct EpiDown {
    static constexpr bool PERM = true, P16 = true;
    unsigned char* y;
    __device__ __forceinline__ void operator()(const f32x4 (&acc)[2][2][4][2], const g8::Unit& u, int wr, int wc, int fr, int fq) const {
        const int row0 = u.r0 + wr * 64 + fr, col0 = u.pn * 256 + wc * 64 + 16 * fq; constexpr float sc = SC_Y / (SC_ACT * SC_WEO); static_assert(sc == 1.0f, "scales chosen so that y needs no multiply");
#pragma unroll
        for (int ai = 0; ai < 2; ++ai)
#pragma unroll
            for (int m = 0; m < 4; ++m) { u32x4 w;
                { const f32x4 v0 = acc[ai][0][m][0], v1 = acc[ai][0][m][1], v2 = acc[ai][1][m][0], v3 = acc[ai][1][m][1];
                  w.x = pk4_fp8(v0[0], v0[1], v0[2], v0[3]); w.y = pk4_fp8(v1[0], v1[1], v1[2], v1[3]); w.z = pk4_fp8(v2[0], v2[1], v2[2], v2[3]); w.w = pk4_fp8(v3[0], v3[1], v3[2], v3[3]); }
                *(u32x4*)(y + (size_t)(row0 + ai * 128 + m * 16) * DM + col0) = w; }
    }
};

struct MoeTables { LAS int* row0; LAS int* te; LAS int* pend; LAS int* tp; };
__device__ __forceinline__ MoeTables moe_tables(Ctx& F) { MoeTables M; M.row0 = (LAS int*)(F.lds + TT_OFF); M.te = M.row0 + MAXTILES; M.pend = M.te + MAXTILES; M.tp = M.pend + 80; return M; }
__device__ __forceinline__ int moe_build_tables(Ctx& F) {
    MoeTables M = moe_tables(F);
    const unsigned* cnt = (const unsigned*)(F.ws + WS_CTL) + CW_CNT;
    __syncthreads();
    if (F.tid < NE) M.row0[F.tid] = (int)ld_agent(cnt + 32 * F.tid);
    __syncthreads();
    if (F.tid == 0) { int tiles = 0;
        for (int e = 0; e < NE; ++e) { const int c = M.row0[e]; M.tp[e] = tiles; M.pend[e] = tiles * 256 + c; tiles += (c + 255) >> 8; }
        M.tp[NE] = NR_ROUTED / 256; M.pend[NE] = NR; M.tp[NE + 1] = NR_ROUTED / 256 + T / 256; M.tp[NE + 2] = tiles; }
    __syncthreads();
    const int rt = M.tp[NE + 2];
    for (int tau = F.tid; tau < rt; tau += NWAVES * 64) { int e = 0; while (e + 1 < NE && M.tp[e + 1] <= tau) ++e; M.te[tau] = e; M.row0[tau] = tau * 256; }
    for (int s = F.tid; s < T / 256; s += NWAVES * 64) { M.te[rt + s] = NE; M.row0[rt + s] = NR_ROUTED + s * 256; }
    __syncthreads();
    return rt + T / 256;
}
template <int PHASE>
struct MoeOrder {
    MoeTables M; const char* A; const char* W; const int* row_tok; LAS unsigned char* lds_tok; int U, CH, x, j;
    static constexpr int NPN = (PHASE == 1) ? 4 : 8;
    __device__ void init(Ctx& F, int ntiles) { M = moe_tables(F); U = ntiles * NPN; CH = (U + 7) / 8; x = F.vcu / (F.G / 8); j = F.vcu % (F.G / 8);
        A = (const char*)(F.ws + (PHASE == 1 ? WS_H8 : WS_ACT)); W = (const char*)(F.ws + (PHASE == 1 ? WS_WEI : WS_WEO)); row_tok = (const int*)(F.ws + WS_TOKOF); lds_tok = F.lds + TOKL_OFF; }
    __device__ __forceinline__ void fill_tokens(Ctx& F) const {
        for (int i = 0; i < TOKL_UNITS; ++i) { const int q = i * 32 + j; const int L = x * CH + q; if (q >= CH || L >= U) break;
            const int tile = L / NPN; const int e = M.te[tile], r0 = M.row0[tile], rend = M.pend[e];
            if (F.tid < 256) { const int ra = r0 + F.tid; int tk;
                if (e == NE) tk = ra - NR_ROUTED; else tk = (ra < rend) ? ld_agent_i(row_tok + (size_t)e * T + (ra - M.tp[e] * 256)) : T;
                ((LAS int*)lds_tok)[i * 256 + F.tid] = tk; } }
        __syncthreads();
    }
    __device__ __forceinline__ bool next(int i, g8::Unit& u) const {
        const int q = i * 32 + j; const int L = x * CH + q; if (q >= CH || L >= U) return false;
        int R[2], C[2]; g8::stage_rc((int)threadIdx.x * 16, R[0], C[0]); g8::stage_rc((int)threadIdx.x * 16 + 8192, R[1], C[1]);
        const int tile = L / NPN, pn = L % NPN;
        const int e = __builtin_amdgcn_readfirstlane(M.te[tile]), r0 = __builtin_amdgcn_readfirstlane(M.row0[tile]), rend = __builtin_amdgcn_readfirstlane(M.pend[e]);
        u.r0 = r0; u.pn = pn; u.e = e; u.rend = rend; u.A = A;
        if (PHASE == 1) {
            u.B = W + ((size_t)e * 1024 + (size_t)pn * 256) * DM;
#pragma unroll
            for (int k = 0; k < 2; ++k) { const int ra = r0 + R[k], rb = ra + 128; int ta, tb;
                if (e == NE) { ta = ra - NR_ROUTED; tb = rb - NR_ROUTED; }
                else { const LAS int* tl = (const LAS int*)(lds_tok) + (i % TOKL_UNITS) * 256; ta = tl[R[k]]; tb = tl[R[k] + 128]; }
                u.vA0[k] = (unsigned)(ta * DM + C[k] * 2); u.vA1[k] = (unsigned)(tb * DM + C[k] * 2); }
        } else {
            u.B = W + ((size_t)e * DM + (size_t)pn * 256) * EH;
#pragma unroll
            for (int k = 0; k < 2; ++k) { u.vA0[k] = (unsigned)((r0 + R[k]) * EH + C[k] * 2); u.vA1[k] = (unsigned)((r0 + R[k] + 128) * EH + C[k] * 2); }
        }
        asm volatile("" : "+v"(u.vA0[0]), "+v"(u.vA0[1]), "+v"(u.vA1[0]), "+v"(u.vA1[1]));
        return true;
    }
};

__device__ __forceinline__ bf16x8 tr_pair(unsigned a0, unsigned a1) { u32x2 r0, r1; asm volatile("ds_read_b64_tr_b16 %0, %2\n\tds_read_b64_tr_b16 %1, %3\n\ts_waitcnt lgkmcnt(0)" : "=&v"(r0), "=&v"(r1) : "v"(a0), "v"(a1) : "memory"); return __builtin_bit_cast(bf16x8, (u32x4){r0.x, r0.y, r1.x, r1.y}); }
__device__ __forceinline__ void tr_quad(bf16x8 (&o)[4], unsigned a0, unsigned a1, unsigned a2, unsigned a3, unsigned d1) {
    u32x2 r0, r1, r2, r3, r4, r5, r6, r7; const unsigned b0 = a0 + d1, b1 = a1 + d1, b2 = a2 + d1, b3 = a3 + d1;
    asm volatile("ds_read_b64_tr_b16 %0, %8\n\tds_read_b64_tr_b16 %1, %9\n\tds_read_b64_tr_b16 %2, %10\n\tds_read_b64_tr_b16 %3, %11\n\tds_read_b64_tr_b16 %4, %12\n\tds_read_b64_tr_b16 %5, %13\n\tds_read_b64_tr_b16 %6, %14\n\tds_read_b64_tr_b16 %7, %15\n\ts_waitcnt lgkmcnt(0)"
        : "=&v"(r0), "=&v"(r1), "=&v"(r2), "=&v"(r3), "=&v"(r4), "=&v"(r5), "=&v"(r6), "=&v"(r7) : "v"(a0), "v"(b0), "v"(a1), "v"(b1), "v"(a2), "v"(b2), "v"(a3), "v"(b3) : "memory");
    o[0] = __builtin_bit_cast(bf16x8, (u32x4){r0.x, r0.y, r1.x, r1.y}); o[1] = __builtin_bit_cast(bf16x8, (u32x4){r2.x, r2.y, r3.x, r3.y});
    o[2] = __builtin_bit_cast(bf16x8, (u32x4){r4.x, r4.y, r5.x, r5.y}); o[3] = __builtin_bit_cast(bf16x8, (u32x4){r6.x, r6.y, r7.x, r7.y}); }
constexpr int LP = 136;
template <int NET> __device__ __forceinline__ void ret_item(Ctx& F, int item) {
    const int tid = F.tid, lane = F.lane, w = F.wave, fr = lane & 15, fq = lane >> 4;
    constexpr int EW = 16 * NET, NEB = 128 / EW, VP = EW + 8;
    const int b = item / (8 * NEB), h = (item / NEB) & 7, eb = item % NEB;
    LAS bf16* qL = (LAS bf16*)(F.lds); LAS bf16* kL = qL + 128 * LP; LAS bf16* vL = kL + 128 * LP; LAS bf16* vdL = vL + 128 * VP; LAS bf16* STL = vdL + 128 * VP;
    const unsigned trq = (unsigned)((lane & 15) >> 2), trp = (unsigned)(lane & 3);
    const unsigned kLb = (unsigned)(size_t)kL + trq * (LP * 2) + 8u * trp + (unsigned)(16 * w) * 2u, vLb = (unsigned)(size_t)vL + trq * (VP * 2) + 8u * trp, vdLb = (unsigned)(size_t)vdL + trq * (VP * 2) + 8u * trp;
    const bf16* proj = (const bf16*)(F.ws + WS_PROJ); const unsigned* rope = (const unsigned*)(F.ws + WS_ROPE); float* reto = (float*)(F.ws + WS_RETO);
    const float lg = log1pf(-exp2f(-5.0f - (float)h)), lg2 = lg * 1.4426950408889634f, dec = __expf(lg * 128.0f);
    f32x4 st[NET];
#pragma unroll
    for (int et = 0; et < NET; ++et) st[et] = (f32x4){0.f, 0.f, 0.f, 0.f};
    __syncthreads();
    for (int i = tid; i < EW * LP; i += NWAVES * 64) STL[i] = 0;
    const int r = tid >> 2, qd = tid & 3, j0 = 16 * qd;
    const float kdec = __builtin_amdgcn_exp2f(lg2 * (float)(127 - r));
    u32x4 q1[2], q2[2], k1[2], k2[2], vv[NET / 2], cs4[4];
#define RET_LOAD(nn) do { const bf16* p_ = proj + (size_t)(b * SEQ + (nn) * 128 + r) * NIN + h * 128; const unsigned* c_ = rope + (size_t)(b * SEQ + (nn) * 128 + r) * 64 + j0; \
        q1[0] = *(const u32x4*)(p_ + j0); q1[1] = *(const u32x4*)(p_ + j0 + 8); q2[0] = *(const u32x4*)(p_ + 64 + j0); q2[1] = *(const u32x4*)(p_ + 64 + j0 + 8); \
        k1[0] = *(const u32x4*)(p_ + RW + j0); k1[1] = *(const u32x4*)(p_ + RW + j0 + 8); k2[0] = *(const u32x4*)(p_ + RW + 64 + j0); k2[1] = *(const u32x4*)(p_ + RW + 64 + j0 + 8); \
        _Pragma("unroll") for (int vi_ = 0; vi_ < NET / 2; ++vi_) vv[vi_] = *(const u32x4*)(p_ + 2 * RW + eb * EW + qd * (EW / 4) + 8 * vi_); \
        _Pragma("unroll") for (int jj_ = 0; jj_ < 4; ++jj_) cs4[jj_] = *(const u32x4*)(c_ + 4 * jj_); } while (0)
    RET_LOAD(0);
#pragma unroll 1
    for (int n = 0; n < 16; ++n) {
        const int t0 = b * SEQ + n * 128;
        __syncthreads();
        {
#pragma unroll
            for (int hh = 0; hh < 2; ++hh) { unsigned oq1[4], oq2[4], ok1[4], ok2[4];
#pragma unroll
                for (int c = 0; c < 4; ++c) { float a[2], bq[2], ka[2], kb[2];
#pragma unroll
                    for (int z = 0; z < 2; ++z) { const int jj = hh * 8 + c * 2 + z; const unsigned cw_ = cs4[jj >> 2][jj & 3]; const f32x2 sc = (f32x2){bflo(cw_), bfhi(cw_)};
                        const float x1 = z ? bfhi(q1[hh][c]) : bflo(q1[hh][c]), x2 = z ? bfhi(q2[hh][c]) : bflo(q2[hh][c]);
                        const float y1 = z ? bfhi(k1[hh][c]) : bflo(k1[hh][c]), y2 = z ? bfhi(k2[hh][c]) : bflo(k2[hh][c]);
                        a[z] = (x1 * sc.x - x2 * sc.y) * 0.08838834764831845f; bq[z] = (x2 * sc.x + x1 * sc.y) * 0.08838834764831845f;
                        ka[z] = y1 * sc.x - y2 * sc.y; kb[z] = y2 * sc.x + y1 * sc.y;
                    }
                    oq1[c] = pk2(a[0], a[1]); oq2[c] = pk2(bq[0], bq[1]); ok1[c] = pk2(ka[0], ka[1]); ok2[c] = pk2(kb[0], kb[1]); }
                *(LAS u32x4*)(qL + r * LP + j0 + hh * 8) = (u32x4){oq1[0], oq1[1], oq1[2], oq1[3]}; *(LAS u32x4*)(qL + r * LP + 64 + j0 + hh * 8) = (u32x4){oq2[0], oq2[1], oq2[2], oq2[3]};
                *(LAS u32x4*)(kL + r * LP + j0 + hh * 8) = (u32x4){ok1[0], ok1[1], ok1[2], ok1[3]}; *(LAS u32x4*)(kL + r * LP + 64 + j0 + hh * 8) = (u32x4){ok2[0], ok2[1], ok2[2], ok2[3]}; }
#pragma unroll
            for (int vi = 0; vi < NET / 2; ++vi) { unsigned vd[4];
#pragma unroll
                for (int c = 0; c < 4; ++c) vd[c] = pk2(bflo(vv[vi][c]) * kdec, bfhi(vv[vi][c]) * kdec);
                *(LAS u32x4*)(vL + r * VP + qd * (EW / 4) + 8 * vi) = vv[vi]; *(LAS u32x4*)(vdL + r * VP + qd * (EW / 4) + 8 * vi) = (u32x4){vd[0], vd[1], vd[2], vd[3]}; }
        }
        if (n + 1 < 16) RET_LOAD(n + 1);
        __syncthreads();
        f32x4 sacc[8];
#pragma unroll
        for (int mt = 0; mt < 8; ++mt) sacc[mt] = (f32x4){0.f, 0.f, 0.f, 0.f};
#pragma unroll
        for (int ks = 0; ks < 4; ++ks) { const bf16x8 bq = *(const LAS bf16x8*)(qL + (16 * w + fr) * LP + 32 * ks + 8 * fq);
#pragma unroll
            for (int mt = 0; mt < 8; ++mt) { const bf16x8 ak = *(const LAS bf16x8*)(kL + (16 * mt + fr) * LP + 32 * ks + 8 * fq); sacc[mt] = __builtin_amdgcn_mfma_f32_16x16x32_bf16(ak, bq, sacc[mt], 0, 0, 0); } }
        const int c = 16 * w + fr;
        bf16x8 pb[4];
#pragma unroll
        for (int sk = 0; sk < 4; ++sk) { unsigned pw[4];
#pragma unroll
            for (int hlf = 0; hlf < 2; ++hlf) { const int mt = 2 * sk + hlf; float pv[4];
#pragma unroll
                for (int rr = 0; rr < 4; ++rr) { const int m = 16 * mt + 4 * fq + rr; pv[rr] = (c >= m) ? sacc[mt][rr] * __builtin_amdgcn_exp2f(lg2 * (float)(c - m)) : 0.f; }
                pw[2 * hlf] = pk2(pv[0], pv[1]); pw[2 * hlf + 1] = pk2(pv[2], pv[3]); }
            pb[sk] = __builtin_bit_cast(bf16x8, (u32x4){pw[0], pw[1], pw[2], pw[3]}); }
        { bf16x8 bqf[4];
#pragma unroll
          for (int ks = 0; ks < 4; ++ks) bqf[ks] = *(const LAS bf16x8*)(qL + (16 * w + fr) * LP + 32 * ks + 8 * fq);
          const float qd = __builtin_amdgcn_exp2f(lg2 * (float)(c + 1));
#pragma unroll
          for (int et = 0; et < NET; ++et) { f32x4 oi = (f32x4){0.f, 0.f, 0.f, 0.f}, oc = (f32x4){0.f, 0.f, 0.f, 0.f};
            bf16x8 avq[4]; const unsigned a0 = vLb + (unsigned)((4 * fq) * (VP * 2) + 32 * et); tr_quad(avq, a0, a0 + 32 * (VP * 2), a0 + 64 * (VP * 2), a0 + 96 * (VP * 2), 16 * (VP * 2));
#pragma unroll
            for (int ks = 0; ks < 4; ++ks) { const bf16x8 as = *(const LAS bf16x8*)(STL + (16 * et + fr) * LP + 32 * ks + 8 * fq);
                oi = __builtin_amdgcn_mfma_f32_16x16x32_bf16(avq[ks], pb[ks], oi, 0, 0, 0); oc = __builtin_amdgcn_mfma_f32_16x16x32_bf16(as, bqf[ks], oc, 0, 0, 0); }
            *(f32x4*)(reto + (size_t)(t0 + c) * RW + h * 128 + eb * EW + 16 * et + 4 * fq) = oi + oc * qd; } }
        __syncthreads();
#pragma unroll
        for (int et = 0; et < NET; ++et) st[et] = st[et] * dec;
        { bf16x8 bkq[4];
          { const unsigned k0 = kLb + (unsigned)((8 * fq) * (LP * 2)); tr_quad(bkq, k0, k0 + 32 * (LP * 2), k0 + 64 * (LP * 2), k0 + 96 * (LP * 2), 4 * (LP * 2)); }
#pragma unroll
          for (int et = 0; et < NET; ++et) { bf16x8 vq[4]; const unsigned v0 = vdLb + (unsigned)((8 * fq) * (VP * 2) + 32 * et); tr_quad(vq, v0, v0 + 32 * (VP * 2), v0 + 64 * (VP * 2), v0 + 96 * (VP * 2), 4 * (VP * 2));
#pragma unroll
            for (int ks = 0; ks < 4; ++ks) st[et] = __builtin_amdgcn_mfma_f32_16x16x32_bf16(vq[ks], bkq[ks], st[et], 0, 0, 0); } }
#pragma unroll
        for (int et = 0; et < NET; ++et)
#pragma unroll
            for (int rr = 0; rr < 4; ++rr) STL[(16 * et + 4 * fq + rr) * LP + 16 * w + fr] = f2bf(st[et][rr]);
    }
#undef RET_LOAD
    __syncthreads();
}

struct LruIn { bf16x8 bA[4], bX[4]; unsigned xr[19]; f32x2 w0, w1, w2, w3, bc; float bav, bxv, lamv; };
__device__ __forceinline__ void lru_issue(Ctx& F, int item, LruIn& L) {
    const int lane = F.lane, w = F.wave, fr = lane & 15, fq = lane >> 4;
    const int b = item >> 7, n = (item >> 3) & 15, g = item & 7; const int ch = g * 128 + 2 * lane;
    const bf16* Wa = (const bf16*)(F.ws + WS_WA) + (size_t)g * 128 * 128 + (size_t)(16 * w + fr) * 128 + 8 * fq; const bf16* Wx = (const bf16*)(F.ws + WS_WX) + (size_t)g * 128 * 128 + (size_t)(16 * w + fr) * 128 + 8 * fq;
#pragma unroll
    for (int ks = 0; ks < 4; ++ks) { L.bA[ks] = *(const bf16x8*)(Wa + 32 * ks); L.bX[ks] = *(const bf16x8*)(Wx + 32 * ks); }
    const float* wconv = (const float*)F.in[7];
    L.w0 = *(const f32x2*)(wconv + ch); L.w1 = *(const f32x2*)(wconv + LW + ch); L.w2 = *(const f32x2*)(wconv + 2 * LW + ch); L.w3 = *(const f32x2*)(wconv + 3 * LW + ch); L.bc = *(const f32x2*)((const float*)F.in[8] + ch);
    const int cj = g * 128 + 16 * w + fr; L.bav = ((const float*)F.in[10])[cj]; L.bxv = ((const float*)F.in[12])[cj]; L.lamv = ((const float*)F.in[13])[cj];
    const int s0 = n * 128 + 16 * w; const bf16* p = (const bf16*)(F.ws + WS_PROJ) + (size_t)(b * SEQ) * NIN + 4 * RW + ch;
#pragma unroll
    for (int i = 0; i < 19; ++i) { const int sp = s0 - 3 + i; L.xr[i] = (sp >= 0) ? *(const unsigned*)(p + (size_t)sp * NIN) : 0u; }
}
__device__ __forceinline__ void lru_body(Ctx& F, int item, const LruIn& L) {
    const int lane = F.lane, w = F.wave, fr = lane & 15, fq = lane >> 4;
    const int b = item >> 7, n = (item >> 3) & 15, g = item & 7;
    LAS bf16* xcL = (LAS bf16*)(F.lds); LAS float* aL = (LAS float*)(F.lds + 34816); LAS bf16* mL = (LAS bf16*)(F.lds + 34816 + 65536); LAS float* segA = (LAS float*)(F.lds + 34816 + 65536 + 32768); LAS float* segB = segA + 1024;
    const int cp = lane, sg = w, ch = g * 128 + 2 * cp;
    float xc[16][2];
#pragma unroll
    for (int i = 0; i < 16; ++i) {
        xc[i][0] = L.bc.x + L.w0.x * bflo(L.xr[i]) + L.w1.x * bflo(L.xr[i + 1]) + L.w2.x * bflo(L.xr[i + 2]) + L.w3.x * bflo(L.xr[i + 3]);
        xc[i][1] = L.bc.y + L.w0.y * bfhi(L.xr[i]) + L.w1.y * bfhi(L.xr[i + 1]) + L.w2.y * bfhi(L.xr[i + 2]) + L.w3.y * bfhi(L.xr[i + 3]);
        *(LAS unsigned*)(xcL + (16 * sg + i) * LP + 2 * cp) = pk2(xc[i][0], xc[i][1]); }
    __syncthreads();
    {
        const int j = 16 * w + fr; const float bav = L.bav, bxv = L.bxv, sp8 = -8.0f * log1pf(__expf(-L.lamv));
#pragma unroll 2
        for (int tt = 0; tt < 8; ++tt) { f32x4 ra = (f32x4){0.f, 0.f, 0.f, 0.f}, rx = (f32x4){0.f, 0.f, 0.f, 0.f};
#pragma unroll
            for (int ks = 0; ks < 4; ++ks) { const bf16x8 a = *(const LAS bf16x8*)(xcL + (16 * tt + fr) * LP + 32 * ks + 8 * fq);
                ra = __builtin_amdgcn_mfma_f32_16x16x32_bf16(a, L.bA[ks], ra, 0, 0, 0); rx = __builtin_amdgcn_mfma_f32_16x16x32_bf16(a, L.bX[ks], rx, 0, 0, 0); }
#pragma unroll
            for (int rr = 0; rr < 4; ++rr) { const int t = 16 * tt + 4 * fq + rr;
                const float rgt = __builtin_amdgcn_rcpf(1.0f + __expf(-(ra[rr] + bav))), igt = __builtin_amdgcn_rcpf(1.0f + __expf(-(rx[rr] + bxv)));
                const float av = __expf(sp8 * rgt); const float mu = __builtin_amdgcn_sqrtf(fmaxf(1.0f - av * av, 0.f)) * igt;
                aL[t * 128 + j] = av; mL[t * 128 + j] = f2bf(mu); } }
    }
    __syncthreads();
    {
        float h0 = 0.f, h1 = 0.f, P0 = 1.f, P1 = 1.f;
#pragma unroll
        for (int i = 0; i < 16; ++i) { const int t = 16 * sg + i; const f32x2 av = *(const LAS f32x2*)(aL + t * 128 + 2 * cp); const unsigned mw = *(const LAS unsigned*)(mL + t * 128 + 2 * cp);
            h0 = av.x * h0 + bflo(mw) * xc[i][0]; h1 = av.y * h1 + bfhi(mw) * xc[i][1]; P0 *= av.x; P1 *= av.y; }
        *(LAS f32x2*)(segA + sg * 128 + 2 * cp) = (f32x2){P0, P1}; *(LAS f32x2*)(segB + sg * 128 + 2 * cp) = (f32x2){h0, h1};
    }
    __syncthreads();
    {
        float c0 = 0.f, c1 = 0.f, Q0 = 1.f, Q1 = 1.f;
        for (int s = 0; s < sg; ++s) { const f32x2 A = *(const LAS f32x2*)(segA + s * 128 + 2 * cp), Bv = *(const LAS f32x2*)(segB + s * 128 + 2 * cp); c0 = A.x * c0 + Bv.x; c1 = A.y * c1 + Bv.y; Q0 *= A.x; Q1 *= A.y; }
        bf16* hl = (bf16*)(F.ws + WS_HLOC) + (size_t)(b * SEQ + n * 128 + 16 * sg) * LW + ch; bf16* pl = (bf16*)(F.ws + WS_PLOC) + (size_t)(b * SEQ + n * 128 + 16 * sg) * LW + ch;
        float h0 = c0, h1 = c1, P0 = Q0, P1 = Q1;
#pragma unroll
        for (int i = 0; i < 16; ++i) { const int t = 16 * sg + i; const f32x2 av = *(const LAS f32x2*)(aL + t * 128 + 2 * cp); const unsigned mw = *(const LAS unsigned*)(mL + t * 128 + 2 * cp);
            h0 = av.x * h0 + bflo(mw) * xc[i][0]; h1 = av.y * h1 + bfhi(mw) * xc[i][1]; P0 *= av.x; P1 *= av.y;
            *(unsigned*)(hl + (size_t)i * LW) = pk2(h0, h1); *(unsigned*)(pl + (size_t)i * LW) = pk2(P0, P1); }
        if (sg == 7) { *(f32x2*)((float*)(F.ws + WS_AGGA) + (size_t)(b * 16 + n) * LW + ch) = (f32x2){P0, P1}; *(f32x2*)((float*)(F.ws + WS_AGGB) + (size_t)(b * 16 + n) * LW + ch) = (f32x2){h0, h1}; }
    }
    __syncthreads();
}

__device__ __forceinline__ void p4_item(Ctx& F, int item) {
    const int tid = F.tid, lane = F.lane, w = F.wave;
    const int b = item >> 5, n = (item & 31) >> 1;
    LAS float* carry = (LAS float*)F.lds;
    const float* aggA = (const float*)(F.ws + WS_AGGA); const float* aggB = (const float*)(F.ws + WS_AGGB);
    __syncthreads();
#pragma unroll
    for (int q = 0; q < 2; ++q) { const int ch = tid + 512 * q; float cin = 0.f;
        for (int jn = 0; jn < n; ++jn) cin = aggA[(size_t)(b * 16 + jn) * LW + ch] * cin + aggB[(size_t)(b * 16 + jn) * LW + ch];
        carry[ch] = cin; }
    __syncthreads();
    const bf16* proj = (const bf16*)(F.ws + WS_PROJ); const float* reto = (const float*)(F.ws + WS_RETO); const bf16* hl = (const bf16*)(F.ws + WS_HLOC); const bf16* pl = (const bf16*)(F.ws + WS_PLOC);
    bf16* cat = (bf16*)(F.ws + WS_CAT); const int c0 = 16 * lane;
    float beta_r[16], beta_l[16], cr[16];
#pragma unroll
    for (int q = 0; q < 4; ++q) { const f32x4 a = *(const f32x4*)((const float*)F.in[14] + c0 + 4 * q), bq = *(const f32x4*)((const float*)F.in[15] + c0 + 4 * q); const f32x4 cq = *(const LAS f32x4*)(carry + c0 + 4 * q);
        beta_r[4 * q] = a.x; beta_r[4 * q + 1] = a.y; beta_r[4 * q + 2] = a.z; beta_r[4 * q + 3] = a.w; beta_l[4 * q] = bq.x; beta_l[4 * q + 1] = bq.y; beta_l[4 * q + 2] = bq.z; beta_l[4 * q + 3] = bq.w;
        cr[4 * q] = cq.x; cr[4 * q + 1] = cq.y; cr[4 * q + 2] = cq.z; cr[4 * q + 3] = cq.w; }
#pragma unroll 2
    for (int rr = 0; rr < 8; ++rr) {
        const int t = item * 64 + 8 * w + rr;
        {
            float o[16];
#pragma unroll
            for (int q = 0; q < 4; ++q) { const f32x4 v = *(const f32x4*)(reto + (size_t)t * RW + c0 + 4 * q); o[4 * q] = v.x; o[4 * q + 1] = v.y; o[4 * q + 2] = v.z; o[4 * q + 3] = v.w; }
            float s = 0.f;
#pragma unroll
            for (int q = 0; q < 16; ++q) s += o[q];
            s += __shfl_xor(s, 1); s += __shfl_xor(s, 2); s += __shfl_xor(s, 4);
            const float mu = s * (1.0f / 128.0f); float vq = 0.f;
#pragma unroll
            for (int q = 0; q < 16; ++q) { o[q] -= mu; vq += o[q] * o[q]; }
            vq += __shfl_xor(vq, 1); vq += __shfl_xor(vq, 2); vq += __shfl_xor(vq, 4);
            const float rs = rsqrtf(vq * (1.0f / 128.0f) + EPS);
            const u32x4 g0 = *(const u32x4*)(proj + (size_t)t * NIN + 3 * RW + c0), g1 = *(const u32x4*)(proj + (size_t)t * NIN + 3 * RW + c0 + 8);
            float ss = 0.f;
#pragma unroll
            for (int q = 0; q < 8; ++q) { const unsigned gw_ = (q < 4) ? g0[q & 3] : g1[q & 3]; const float ga = bflo(gw_), gb = bfhi(gw_);
                o[2 * q] = siluf_(ga) * (o[2 * q] * rs); o[2 * q + 1] = siluf_(gb) * (o[2 * q + 1] * rs); ss += o[2 * q] * o[2 * q] + o[2 * q + 1] * o[2 * q + 1]; }
            const float rstd = rsqrtf(wave_sum(ss) * (1.0f / RW) + EPS);
            u32x4 w0, w1;
#pragma unroll
            for (int q = 0; q < 4; ++q) { w0[q] = pk2(o[2 * q] * rstd * beta_r[2 * q], o[2 * q + 1] * rstd * beta_r[2 * q + 1]); w1[q] = pk2(o[8 + 2 * q] * rstd * beta_r[8 + 2 * q], o[9 + 2 * q] * rstd * beta_r[9 + 2 * q]); }
            *(u32x4*)(cat + (size_t)t * DM + c0) = w0; *(u32x4*)(cat + (size_t)t * DM + c0 + 8) = w1;
        }
        {
            const u32x4 h0 = *(const u32x4*)(hl + (size_t)t * LW + c0), h1 = *(const u32x4*)(hl + (size_t)t * LW + c0 + 8), p0 = *(const u32x4*)(pl + (size_t)t * LW + c0), p1 = *(const u32x4*)(pl + (size_t)t * LW + c0 + 8);
            const u32x4 y0 = *(const u32x4*)(proj + (size_t)t * NIN + 5 * RW + c0), y1 = *(const u32x4*)(proj + (size_t)t * NIN + 5 * RW + c0 + 8);
            float o[16]; float ss = 0.f;
#pragma unroll
            for (int q = 0; q < 8; ++q) { const unsigned hw = (q < 4) ? h0[q & 3] : h1[q & 3], pw = (q < 4) ? p0[q & 3] : p1[q & 3], yw = (q < 4) ? y0[q & 3] : y1[q & 3];
                const float ha = bflo(hw) + bflo(pw) * cr[2 * q], hb = bfhi(hw) + bfhi(pw) * cr[2 * q + 1];
                o[2 * q] = ha * gelu_tanh_(bflo(yw)); o[2 * q + 1] = hb * gelu_tanh_(bfhi(yw)); ss += o[2 * q] * o[2 * q] + o[2 * q + 1] * o[2 * q + 1]; }
            const float rstd = rsqrtf(wave_sum(ss) * (1.0f / LW) + EPS);
            u32x4 w0, w1;
#pragma unroll
            for (int q = 0; q < 4; ++q) { w0[q] = pk2(o[2 * q] * rstd * beta_l[2 * q], o[2 * q + 1] * rstd * beta_l[2 * q + 1]); w1[q] = pk2(o[8 + 2 * q] * rstd * beta_l[8 + 2 * q], o[9 + 2 * q] * rstd * beta_l[9 + 2 * q]); }
            *(u32x4*)(cat + (size_t)t * DM + RW + c0) = w0; *(u32x4*)(cat + (size_t)t * DM + RW + c0 + 8) = w1;
        }
    }
    __syncthreads();
}

constexpr int HAP = 2056;
template <bool DRY> __device__ __forceinline__ void p6_item(Ctx& F, int item) {
    const int tid = F.tid, lane = F.lane, w = F.wave, fr = lane & 15, fq = lane >> 4;
    const int t0 = item * 64, b = t0 / SEQ;
    LAS bf16* hA = (LAS bf16*)F.lds;
    LAS float* lgt = (LAS float*)(F.lds + 16 * HAP * 2);
    LAS unsigned char* selE = (LAS unsigned char*)(F.lds + 16 * HAP * 2 + 8 * 16 * 65 * 4); LAS unsigned char* selL = selE + 512; LAS unsigned* wcnt = (LAS unsigned*)(selL + 512); LAS unsigned* gb = wcnt + 512;
    const bf16* x1 = (const bf16*)(F.ws + WS_X1); const float* mod = (const float*)(F.ws + WS_MOD) + (size_t)b * 6 * DM; bf16* h2 = (bf16*)(F.ws + WS_H); unsigned char* h8 = F.ws + WS_H8;
    const bf16* Wr = (const bf16*)(F.ws + WS_WR);
    int* eidx = (int*)(F.ws + WS_EIDX); float* wsel = (float*)(F.ws + WS_WSEL); int* slot = (int*)(F.ws + (DRY ? WS_DEST : WS_SLOT)); unsigned* cnt = (unsigned*)(F.ws + WS_CTL) + CW_CNT + (DRY ? 4096 : 0);
    f32x4 gg[4][2];
#pragma unroll
    for (int j = 0; j < 4; ++j)
#pragma unroll
        for (int h = 0; h < 2; ++h) { const int c = 8 * lane + 512 * j + 4 * h; gg[j][h] = *(const f32x4*)((const float*)F.in[17] + c) * (*(const f32x4*)(mod + 4 * DM + c) + 1.0f); }
    const float brl = ((const float*)F.in[19])[lane]; const int g = lane >> 3;
    unsigned lc = 0u;
    bf16x8 bw[2][4];
#pragma unroll
    for (int ks = 0; ks < 2; ++ks)
#pragma unroll
        for (int et = 0; et < 4; ++et) bw[ks][et] = *(const bf16x8*)(Wr + (size_t)(16 * et + fr) * DM + 256 * w + 32 * ks + 8 * fq);
    u32x4 xq[2][4];
#pragma unroll
    for (int i = 0; i < 2; ++i)
#pragma unroll
        for (int j = 0; j < 4; ++j) xq[i][j] = *(const u32x4*)(x1 + (size_t)(t0 + 2 * w + i) * DM + 8 * lane + 512 * j);
    __syncthreads();
#pragma unroll 1
    for (int ps = 0; ps < 4; ++ps) {
#pragma unroll
        for (int i = 0; i < 2; ++i) { const int rl = 2 * w + i, t = t0 + 16 * ps + rl;
            f32x4 v[4][2]; float ss = 0.f;
#pragma unroll
            for (int j = 0; j < 4; ++j) { const u32x4 xw = xq[i][j]; v[j][0] = (f32x4){bflo(xw.x), bfhi(xw.x), bflo(xw.y), bfhi(xw.y)}; v[j][1] = (f32x4){bflo(xw.z), bfhi(xw.z), bflo(xw.w), bfhi(xw.w)};
#pragma unroll
                for (int h = 0; h < 2; ++h) ss += (v[j][h].x * v[j][h].x + v[j][h].y * v[j][h].y) + (v[j][h].z * v[j][h].z + v[j][h].w * v[j][h].w); }
            const float rstd = rsqrtf(wave_sum(ss) * (1.0f / DM) + EPS);
#pragma unroll
            for (int j = 0; j < 4; ++j) { const f32x4 o0 = v[j][0] * rstd * gg[j][0] + *(const f32x4*)(mod + 3 * DM + 8 * lane + 512 * j), o1 = v[j][1] * rstd * gg[j][1] + *(const f32x4*)(mod + 3 * DM + 8 * lane + 512 * j + 4);
                u32x4 wv; wv.x = pk2(o0.x, o0.y); wv.y = pk2(o0.z, o0.w); wv.z = pk2(o1.x, o1.y); wv.w = pk2(o1.z, o1.w);
                *(LAS u32x4*)(hA + rl * HAP + 8 * lane + 512 * j) = wv;
                u32x2 w8; w8.x = pk4_fp8(o0.x * SC_H8, o0.y * SC_H8, o0.z * SC_H8, o0.w * SC_H8); w8.y = pk4_fp8(o1.x * SC_H8, o1.y * SC_H8, o1.z * SC_H8, o1.w * SC_H8);
                *(u32x2*)(h8 + (size_t)t * DM + 8 * lane + 512 * j) = w8; }
            __builtin_amdgcn_sched_barrier(0); }
        __syncthreads();
        {
            f32x4 acc[4];
#pragma unroll
            for (int et = 0; et < 4; ++et) acc[et] = (f32x4){0.f, 0.f, 0.f, 0.f};
            bf16x8 bw2[6][4];
#pragma unroll
            for (int ks = 0; ks < 6; ++ks)
#pragma unroll
                for (int et = 0; et < 4; ++et) bw2[ks][et] = *(const bf16x8*)(Wr + (size_t)(16 * et + fr) * DM + 256 * w + 64 + 32 * ks + 8 * fq);
#pragma unroll
            for (int ks = 0; ks < 2; ++ks) { const bf16x8 a = *(const LAS bf16x8*)(hA + fr * HAP + 256 * w + 32 * ks + 8 * fq);
#pragma unroll
                for (int et = 0; et < 4; ++et) acc[et] = __builtin_amdgcn_mfma_f32_16x16x32_bf16(a, bw[ks][et], acc[et], 0, 0, 0); }
#pragma unroll
            for (int ks = 0; ks < 6; ++ks) { const bf16x8 a = *(const LAS bf16x8*)(hA + fr * HAP + 256 * w + 64 + 32 * ks + 8 * fq);
#pragma unroll
                for (int et = 0; et < 4; ++et) acc[et] = __builtin_amdgcn_mfma_f32_16x16x32_bf16(a, bw2[ks][et], acc[et], 0, 0, 0); }
#pragma unroll
            for (int et = 0; et < 4; ++et)
#pragma unroll
                for (int rr = 0; rr < 4; ++rr) lgt[(w * 16 + 4 * fq + rr) * 65 + 16 * et + fr] = acc[et][rr];
        }
        __syncthreads();
        if (ps + 1 < 4) {
#pragma unroll
            for (int i = 0; i < 2; ++i)
#pragma unroll
                for (int j = 0; j < 4; ++j) xq[i][j] = *(const u32x4*)(x1 + (size_t)(t0 + 16 * (ps + 1) + 2 * w + i) * DM + 8 * lane + 512 * j); }
#pragma unroll 1
        for (int i = 0; i < 2; ++i) {
            const int tl = 2 * w + i, tt = 16 * ps + tl; float z = 0.f;
#pragma unroll
            for (int w2 = 0; w2 < 8; ++w2) z += lgt[(w2 * 16 + tl) * 65 + lane];
            const float s = sigmoidf_(z); const float bsc = s + brl;
            float m1 = bsc; m1 = fmaxf(m1, __shfl_xor(m1, 1)); m1 = fmaxf(m1, __shfl_xor(m1, 2)); m1 = fmaxf(m1, __shfl_xor(m1, 4));
            const unsigned long long eq = __ballot(bsc == m1); const unsigned gm = (unsigned)(eq >> (8 * g)) & 0xffu;
            const bool first = (lane & 7) == (__builtin_ctz(gm | 0x100u) & 7);
            float m2 = first ? -3.0e38f : bsc; m2 = fmaxf(m2, __shfl_xor(m2, 1)); m2 = fmaxf(m2, __shfl_xor(m2, 2)); m2 = fmaxf(m2, __shfl_xor(m2, 4));
            const float gs = m1 + m2;
            int rank_g = 0;
#pragma unroll
            for (int g2 = 0; g2 < 8; ++g2) { const float o = __int_as_float(__builtin_amdgcn_readlane(__float_as_int(gs), 8 * g2)); rank_g += (o > gs || (o == gs && g2 < g)) ? 1 : 0; }
            const bool selg = rank_g < 4;
            const float key = selg ? bsc : -3.0e38f;
            int rank = 0;
#pragma unroll
            for (int e2 = 0; e2 < 64; ++e2) { const float o = __int_as_float(__builtin_amdgcn_readlane(__float_as_int(key), e2)); rank += (o > key || (o == key && e2 < lane)) ? 1 : 0; }
            const bool chosen = selg && rank < 8;
            const float wsum = wave_sum(chosen ? s : 0.f);
            if (chosen) { const int t = t0 + tt; eidx[t * 8 + rank] = lane; wsel[t * 8 + rank] = s * (2.5f / wsum); selE[tt * 8 + rank] = (unsigned char)lane; selL[tt * 8 + rank] = (unsigned char)lc; }
            lc += chosen ? 1u : 0u;
        }
        __syncthreads();
    }
    wcnt[w * 64 + lane] = lc;
    __syncthreads();
    if (w == 0) { unsigned tot = 0u;
#pragma unroll
        for (int w2 = 0; w2 < 8; ++w2) tot += wcnt[w2 * 64 + lane];
        gb[lane] = tot ? __hip_atomic_fetch_add(cnt + 32 * lane, tot, __ATOMIC_RELAXED, __HIP_MEMORY_SCOPE_AGENT) : 0u; }
    __syncthreads();
    { const int tok = tid >> 3, k = tid & 7, e = selE[tok * 8 + k], wt = (tok & 15) >> 1; unsigned off = gb[e] + selL[tok * 8 + k];
        for (int w2 = 0; w2 < wt; ++w2) off += wcnt[w2 * 64 + e];
        slot[(t0 + tok) * 8 + k] = (int)off; if (!DRY) ((int*)(F.ws + WS_TOKOF))[(size_t)e * T + off] = t0 + tok; }
    __syncthreads();
}

__device__ __forceinline__ void p10_final(Ctx& F, bool have_tables) {
    const int gw = F.vcu * NWAVES + F.wave, NGW = F.G * NWAVES, lane = F.lane;
    const bf16* x1 = (const bf16*)(F.ws + WS_X1); const unsigned char* y = F.ws + WS_Y; const int* eidx = (const int*)(F.ws + WS_EIDX); const int* slot = (const int*)(F.ws + WS_SLOT); const float* wsel = (const float*)(F.ws + WS_WSEL); const float* gf = (const float*)F.in[24];
    LAS int* ps = (LAS int*)F.lds; const unsigned* cnt = (const unsigned*)(F.ws + WS_CTL) + CW_CNT;
    __syncthreads();
    if (have_tables) { if (F.tid < NE) ps[F.tid] = moe_tables(F).tp[F.tid] * 256; }
    else { if (F.tid < NE) ps[64 + F.tid] = (((int)ld_agent(cnt + 32 * F.tid) + 255) >> 8) << 8;
        __syncthreads();
        if (F.tid < NE) { int acc = 0; for (int e = 0; e < F.tid; ++e) acc += ps[64 + e]; ps[F.tid] = acc; } }
    __syncthreads();
    for (int t = gw; t < T; t += NGW) { const int b = t / SEQ; const float* gt2 = (const float*)(F.ws + WS_MOD) + (size_t)b * 6 * DM + 5 * DM;
        int rows[9]; float wk[9];
#pragma unroll
        for (int k = 0; k < 8; ++k) { rows[k] = ps[ld_agent_i(eidx + t * 8 + k)] + ld_agent_i(slot + t * 8 + k); wk[k] = wsel[t * 8 + k] * (1.0f / SC_Y); }
        rows[8] = NR_ROUTED + t; wk[8] = 1.0f / SC_Y;
        float ss = 0.f; f32x4 v[4][2];
#pragma unroll
        for (int j = 0; j < 4; ++j) { const int c = 8 * lane + 512 * j; float s[8];
#pragma unroll
            for (int q = 0; q < 8; ++q) s[q] = 0.f;
#pragma unroll
            for (int k = 0; k < 9; ++k) { const u32x2 yv = *(const u32x2*)(y + (size_t)rows[k] * DM + c);
#pragma unroll
                for (int q = 0; q < 2; ++q) { const f32x2 lo = __builtin_amdgcn_cvt_pk_f32_fp8((int)yv[q], false), hi = __builtin_amdgcn_cvt_pk_f32_fp8((int)yv[q], true);
                    s[4 * q] += wk[k] * lo.x; s[4 * q + 1] += wk[k] * lo.y; s[4 * q + 2] += wk[k] * hi.x; s[4 * q + 3] += wk[k] * hi.y; } }
            const u32x4 xw = *(const u32x4*)(x1 + (size_t)t * DM + c);
#pragma unroll
            for (int hh = 0; hh < 2; ++hh) { const f32x4 xv = hh ? (f32x4){bflo(xw.z), bfhi(xw.z), bflo(xw.w), bfhi(xw.w)} : (f32x4){bflo(xw.x), bfhi(xw.x), bflo(xw.y), bfhi(xw.y)}, gv = *(const f32x4*)(gt2 + c + 4 * hh);
                v[j][hh] = xv + gv * (f32x4){s[4 * hh], s[4 * hh + 1], s[4 * hh + 2], s[4 * hh + 3]};
                ss += (v[j][hh].x * v[j][hh].x + v[j][hh].y * v[j][hh].y) + (v[j][hh].z * v[j][hh].z + v[j][hh].w * v[j][hh].w); } }
        const float rstd = rsqrtf(wave_sum(ss) * (1.0f / DM) + EPS);
#pragma unroll
        for (int j = 0; j < 4; ++j)
#pragma unroll
            for (int hh = 0; hh < 2; ++hh) { const int c = 8 * lane + 512 * j + 4 * hh; *(f32x4*)(F.out + (size_t)t * DM + c) = v[j][hh] * rstd * *(const f32x4*)(gf + c); }
    }
}

__global__ void __launch_bounds__(NWAVES * 64, 2) fwd_kernel(Args args) {
    extern __shared__ __attribute__((aligned(16))) unsigned char lds_raw[];
    Ctx F;
    F.lds = (LAS unsigned char*)lds_raw; F.ws = args.ws; F.in = args.in; F.out = args.out;
    F.tid = threadIdx.x; F.lane = F.tid & 63; F.wave = __builtin_amdgcn_readfirstlane(F.tid >> 6);
    F.G = gridDim.x; { const int bx = blockIdx.x; F.vcu = (F.G % 8 == 0) ? (bx % 8) * (F.G / 8) + bx / 8 : bx; }
    if (F.tid < 16) ((LAS unsigned*)(F.lds + MISC_OFF))[F.tid] = 0u;
    __syncthreads();
    unsigned* ctl = (unsigned*)(F.ws + WS_CTL);
#if N_LAUNCHES == 1
    XcdBarrier bar = xcd_barrier_post(ctl + CW_BAR, (volatile LAS unsigned*)(F.lds + MISC_OFF));
#define GRID_BAR() xcd_barrier(bar)
#else
#define GRID_BAR() do { } while (0)
#endif
    const int lo = args.ph_lo, hi = args.ph_hi;
#define IN(k) (lo <= (k) && (k) < hi)
#define BOTH(k) (IN(k) && IN((k) + 1))
    const int NIT = F.G;

#define REP(k) _Pragma("unroll") for (int rep_ = 0; rep_ < ((PROBE_PHASE == (k)) ? 2 : 1); ++rep_)
    if (IN(0)) { p0_adaln(F); p0_prologue(F); if (BOTH(0)) p0_wait_mod(F); }
    if (IN(1)) { REP(1) { p1_norm(F); } if (BOTH(1)) GRID_BAR(); if (PROBE_PHASE == 100) { GRID_BAR(); GRID_BAR(); GRID_BAR(); GRID_BAR(); } }
    if (IN(2)) {
        if (F.vcu & 1) p2_convert_experts(F);
        REP(2) {
        g8::DenseOrder S; S.init(F.ws + WS_H, F.ws + WS_WIN, T, NIN, DM * 2, F.G, (int)blockIdx.x);
        EpiProj E{(bf16*)(F.ws + WS_PROJ)};
        g8::gemm_phase<EpiProj, g8::DenseOrder>(F.lds, DM * 2, S, E);
        }
        if (!(F.vcu & 1)) p2_convert_experts(F);
        if (BOTH(2)) GRID_BAR();
    }
    if (IN(3)) {
        {
            const bool split = (F.G & 1) == 0; const int hw = split ? (F.vcu >> 1) : F.vcu, HS = split ? (F.G >> 1) : F.G;
            if (!split || (F.vcu & 1) == 0) { for (int it = hw; it < NB * 8 * 2; it += HS) ret_item<4>(F, it); }
            if (!split || (F.vcu & 1) == 1) { LruIn La, Lb; int it = hw; const int NL = NB * 16 * 8;
                __syncthreads();
                if (it < NL) lru_issue(F, it, La);
                while (it < NL) {
                    if (it + HS < NL) lru_issue(F, it + HS, Lb);
                    lru_body(F, it, La); it += HS;
                    if (it >= NL) break;
                    if (it + HS < NL) lru_issue(F, it + HS, La);
                    lru_body(F, it, Lb); it += HS;
                } }
        }
        if (BOTH(3)) GRID_BAR();
    }
    if (IN(4)) { REP(4) { for (int it = F.vcu; it < T / 64; it += NIT) p4_item(F, it); } if (BOTH(4)) GRID_BAR(); }
    if (IN(5)) {
        REP(5) {
        g8::DenseOrder S; S.init(F.ws + WS_CAT, F.ws + WS_WOUT, T, DM, DM * 2, F.G, (int)blockIdx.x);
        EpiWout E{(const float*)F.in[0], (const float*)(F.ws + WS_MOD), (bf16*)(F.ws + WS_X1)};
        g8::gemm_phase<EpiWout, g8::DenseOrder>(F.lds, DM * 2, S, E);
        }
        if (BOTH(5)) GRID_BAR();
    }
    if (IN(6)) { for (int it = F.vcu; it < T / 64; it += NIT) p6_item<false>(F, it); if (PROBE_PHASE == 6) { for (int it = F.vcu; it < T / 64; it += NIT) p6_item<true>(F, it); } if (BOTH(6)) GRID_BAR(); }
    int ntiles = 0;
    if (IN(8)) {
        REP(8) {
        ntiles = moe_build_tables(F);
        MoeOrder<1> S; S.init(F, ntiles); S.fill_tokens(F);
        EpiSwiglu E{F.ws + WS_ACT};
        g8::gemm_phase<EpiSwiglu, MoeOrder<1>, true>(F.lds, DM, S, E);
        }
        if (BOTH(8)) GRID_BAR();
    }
    if (IN(9)) {
        REP(9) {
        if (!IN(8)) ntiles = moe_build_tables(F);
        MoeOrder<2> S; S.init(F, ntiles);
        EpiDown E{F.ws + WS_Y};
        g8::gemm_phase<EpiDown, MoeOrder<2>, true>(F.lds, EH, S, E);
        }
        if (BOTH(9)) GRID_BAR();
    }
    if (IN(10)) { REP(10) { p10_final(F, IN(8)); } }
#undef REP
#undef IN
#undef BOTH
}

extern "C" void kernel_launch(void* const* d_in, const int* in_sizes, int n_in, void* d_out, int out_size, void* d_ws, size_t ws_size, hipStream_t stream) {
    static int grid = 0;
    if (grid == 0) {
        if (n_in != 25 || out_size != T * DM || ws_size < WS_END) { fprintf(stderr, "kernel_launch: unexpected problem (n_in %d, out %d, ws %zu)\n", n_in, out_size, ws_size); grid = -1; return; }
        int dev = 0, cus = 0, per_cu = 0;
        if (hipGetDevice(&dev) != hipSuccess || hipDeviceGetAttribute(&cus, hipDeviceAttributeMultiprocessorCount, dev) != hipSuccess) { grid = -1; return; }
        if (hipFuncSetAttribute((const void*)fwd_kernel, hipFuncAttributeMaxDynamicSharedMemorySize, LDS_BYTES) != hipSuccess) { fprintf(stderr, "kernel_launch: hipFuncSetAttribute failed\n"); grid = -1; return; }
        if (hipOccupancyMaxActiveBlocksPerMultiprocessor(&per_cu, (const void*)fwd_kernel, NWAVES * 64, LDS_BYTES) != hipSuccess || per_cu < 1) { fprintf(stderr, "kernel_launch: occupancy query says %d\n", per_cu); }
        (void)hipGetLastError();
        grid = cus;
    }
    if (grid < 0) return;
    (void)hipMemsetAsync((char*)d_ws + WS_CTL, 0, CTL_ZERO_BYTES, stream);
    Args a{};
    for (int i = 0; i < 25; ++i) a.in[i] = d_in[i];
    a.out = (float*)d_out; a.ws = (unsigned char*)d_ws;
#if N_LAUNCHES == 1
    a.ph_lo = 0; a.ph_hi = 11;
    hipLaunchKernelGGL(fwd_kernel, dim3(grid), dim3(NWAVES * 64), LDS_BYTES, stream, a);
#else
    for (int p = 0; p < 11; ++p) { a.ph_lo = p; a.ph_hi = p + 1; hipLaunchKernelGGL(fwd_kernel, dim3(grid), dim3(NWAVES * 64), LDS_BYTES, stream, a); }
#endif
}
```

```cpp
#include <hip/hip_runtime.h>
#include <cstdio>
#include <cstdint>

#ifndef PROBE_PHASE
#define PROBE_PHASE -1
#endif
#ifndef N_LAUNCHES
#define N_LAUNCHES 1
#endif

#define LAS __attribute__((address_space(3)))
typedef unsigned short bf16;
typedef short bf16x8 __attribute__((ext_vector_type(8)));
typedef float f32x4 __attribute__((ext_vector_type(4)));
typedef float f32x2 __attribute__((ext_vector_type(2)));
typedef unsigned u32x4 __attribute__((ext_vector_type(4)));
typedef unsigned u32x2 __attribute__((ext_vector_type(2)));
typedef int i32x4 __attribute__((ext_vector_type(4)));
typedef int i32x8 __attribute__((ext_vector_type(8)));

constexpr int NB = 8, SEQ = 2048, DM = 2048, T = NB * SEQ;
constexpr int NIN = 6144, RW = 1024, LW = 1024, NE = 64, EH = 512, TOPK = 8;
constexpr int NR_ROUTED = T * TOPK + NE * 256;
constexpr int NR = NR_ROUTED + T;
constexpr int NWAVES = 8;
constexpr float EPS = 1e-6f;
constexpr float SC_H8 = 16.0f, SC_WEI = 64.0f, SC_ACT = 8.0f, SC_WEO = 4.0f, SC_Y = 32.0f;

constexpr size_t MiB = 1u << 20;
constexpr size_t WS_CTL = 0, CTL_ZERO_BYTES = 2 * MiB;
constexpr size_t WS_MOD = 1 * MiB;
constexpr size_t WS_ROPE = 2 * MiB;
constexpr size_t WS_WIN = 10 * MiB;
constexpr size_t WS_WOUT = 34 * MiB;
constexpr size_t WS_WR = 42 * MiB;
constexpr size_t WS_WA = WS_WR + 256 * 1024;
constexpr size_t WS_WX = WS_WA + 256 * 1024;
constexpr size_t WS_WEI = 44 * MiB;
constexpr size_t WS_H8 = 176 * MiB;
constexpr size_t WS_WEO = 304 * MiB;
constexpr size_t WS_H = 434 * MiB;
constexpr size_t WS_X1 = 500 * MiB;
constexpr size_t WS_EIDX = 628 * MiB;
constexpr size_t WS_WSEL = WS_EIDX + 512 * 1024;
constexpr size_t WS_SLOT = WS_WSEL + 512 * 1024;
constexpr size_t WS_DEST = WS_SLOT + 512 * 1024;
constexpr size_t WS_RTOK = WS_DEST + 512 * 1024;
constexpr size_t WS_RW = WS_RTOK + 640 * 1024;
constexpr size_t WS_AGGA = 632 * MiB;
constexpr size_t WS_AGGB = WS_AGGA + 512 * 1024;
constexpr size_t WS_ACT = 634 * MiB;
constexpr size_t WS_PROJ = 794 * MiB;
constexpr size_t WS_RETO = 986 * MiB;
constexpr size_t WS_HLOC = 1050 * MiB;
constexpr size_t WS_PLOC = 1082 * MiB;
constexpr size_t WS_CAT = 1114 * MiB;
constexpr size_t WS_Y = 794 * MiB;
constexpr size_t WS_TOKOF = 1434 * MiB;
constexpr size_t WS_END = 1438 * MiB;
constexpr int CW_BAR = 4096;
constexpr int CW_CNT = 8192;
constexpr int CW_MODCNT = 16384;

constexpr int RING_BYTES = 131072;
constexpr int LDS_BYTES = 163840;
constexpr int TOKL_OFF = 147456, TOKL_UNITS = 12;
constexpr int TT_OFF = 137216;
constexpr int MISC_OFF = LDS_BYTES - 256;
static_assert(TT_OFF + (2 * 704 + 80 + 68) * 4 <= TOKL_OFF && TOKL_OFF + TOKL_UNITS * 1024 <= MISC_OFF, "LDS map");
constexpr int MAXTILES = 704;

__device__ __forceinline__ unsigned pk2(float lo, float hi) { unsigned r; asm volatile("v_cvt_pk_bf16_f32 %0, %1, %2" : "=v"(r) : "v"(lo), "v"(hi)); return r; }
typedef __bf16 bf16x2_t __attribute__((ext_vector_type(2)));
__device__ __forceinline__ unsigned pk2c(float lo, float hi) { const bf16x2_t r = __builtin_convertvector((f32x2){lo, hi}, bf16x2_t); return __builtin_bit_cast(unsigned, r); }
__device__ __forceinline__ bf16 f2bf(float f) { return __builtin_bit_cast(bf16, (__bf16)f); }
__device__ __forceinline__ float bf2f(bf16 b) { return __uint_as_float(((unsigned)b) << 16); }
__device__ __forceinline__ float bflo(unsigned w) { return __uint_as_float(w << 16); }
__device__ __forceinline__ float bfhi(unsigned w) { return __uint_as_float(w & 0xffff0000u); }
__device__ __forceinline__ float wave_sum(float v) {
#pragma unroll
    for (int o = 1; o < 64; o <<= 1) v += __shfl_xor(v, o);
    return v;
}
__device__ __forceinline__ float sigmoidf_(float x) { return __builtin_amdgcn_rcpf(1.0f + __expf(-x)); }
__device__ __forceinline__ float siluf_(float x) { return x * __builtin_amdgcn_rcpf(1.0f + __expf(-x)); }
__device__ __forceinline__ float gelu_tanh_(float x) { const float u = 0.7978845608028654f * (x + 0.044715f * x * x * x); const float e = __expf(2.0f * u); const float th = 1.0f - 2.0f * __builtin_amdgcn_rcpf(e + 1.0f); return 0.5f * x * (1.0f + th); }
__device__ __forceinline__ unsigned ld_agent(const unsigned* p) { return __hip_atomic_load(p, __ATOMIC_RELAXED, __HIP_MEMORY_SCOPE_AGENT); }
__device__ __forceinline__ int ld_agent_i(const int* p) { return (int)__hip_atomic_load((const unsigned*)p, __ATOMIC_RELAXED, __HIP_MEMORY_SCOPE_AGENT); }
__device__ __forceinline__ float clamp448(float x) { return __builtin_amdgcn_fmed3f(x, -448.0f, 448.0f); }
__device__ __forceinline__ unsigned pk4_fp8(float a, float b, float c, float d) { int w = 0; w = __builtin_amdgcn_cvt_pk_fp8_f32(clamp448(a), clamp448(b), w, false); w = __builtin_amdgcn_cvt_pk_fp8_f32(clamp448(c), clamp448(d), w, true); return (unsigned)w; }
#define LDS_WAIT() asm volatile("s_waitcnt lgkmcnt(0)" ::: "memory")
#define VM_WAIT() asm volatile("s_waitcnt vmcnt(0)" ::: "memory")

#define XB_TMO      128
#define XB_XCNT(j)  (256  + 64 * (j))
#define XB_XSUB(j)  (1280 + 64 * (j))
#define XB_XGEN(j)  (2304 + 64 * (j))
#define XB_TOP      3328
#define XB_TOPGEN   3392
#define XCD_BAR_WORDS 3456
#define XB_SPIN_CAP (1u << 18)
__device__ __forceinline__ unsigned xb_ld(unsigned* p)              { return __hip_atomic_load(p, __ATOMIC_RELAXED, __HIP_MEMORY_SCOPE_AGENT); }
__device__ __forceinline__ unsigned xb_add(unsigned* p, unsigned v) { return __hip_atomic_fetch_add(p, v, __ATOMIC_RELAXED, __HIP_MEMORY_SCOPE_AGENT); }
__device__ __forceinline__ unsigned xb_xcc_id() { return (unsigned)__builtin_amdgcn_s_getreg((3 << 11) | 20) & 0xFu; }
#define XB_SPIN(cond, bar) do { unsigned _sp = 0; while (cond) { __builtin_amdgcn_s_sleep(1); \
    if ((++_sp & 255u) == 0u) { if (xb_ld(&(bar)[XB_TMO])) break; if (_sp > XB_SPIN_CAP) { atomicAdd(&(bar)[XB_TMO], 1u); break; } } } } while (0)
struct XcdBarrier { unsigned* bar; unsigned x; volatile LAS unsigned* st; };
__device__ __forceinline__ XcdBarrier xcd_barrier_post(unsigned* bar, volatile LAS unsigned* st) {
    XcdBarrier b; b.bar = bar; b.x = xb_xcc_id(); b.st = st;
    if (threadIdx.x == 0) (void)xb_add(&bar[XB_XCNT(b.x)], 1u);
    return b;
}
__device__ __forceinline__ void xcd_barrier_complete(unsigned* bar, unsigned x, unsigned& nloc, unsigned& nx) {
    const unsigned G = gridDim.x * gridDim.y * gridDim.z;
    unsigned sum, cnt, mine, sp = 0u;
    for (;;) {
        sum = 0u; cnt = 0u; mine = 0u;
#pragma unroll
        for (unsigned j = 0; j < 16; ++j) { const unsigned c = xb_ld(&bar[XB_XCNT(j)]); sum += c; cnt += (c > 0u) ? 1u : 0u; mine = (j == x) ? c : mine; }
        if (sum == G) break;
        __builtin_amdgcn_s_sleep(1);
        if ((++sp & 255u) == 0u) { if (xb_ld(&bar[XB_TMO])) break; if (sp > XB_SPIN_CAP) { atomicAdd(&bar[XB_TMO], 1u); break; } }
    }
    nloc = mine > 0u ? mine : 1u; nx = cnt > 0u ? cnt : 1u;
}
__device__ __forceinline__ void xcd_barrier(const XcdBarrier& b) {
    asm volatile("s_waitcnt vmcnt(0)" ::: "memory");
    __syncthreads();
    if (threadIdx.x == 0) {
        unsigned* bar = b.bar;
        __builtin_amdgcn_s_waitcnt(0);
        unsigned nloc = b.st[0], nx = b.st[1];
        if (nloc == 0u) { xcd_barrier_complete(bar, b.x, nloc, nx); b.st[0] = nloc; b.st[1] = nx; }
        const unsigned old = xb_add(&bar[XB_XSUB(b.x)], 1u);
        const unsigned gen = old / nloc;
        if (old + 1u == (gen + 1u) * nloc) {
            __builtin_amdgcn_fence(__ATOMIC_RELEASE, "agent");
            asm volatile("s_waitcnt vmcnt(0)" ::: "memory");
            const unsigned og = xb_add(&bar[XB_TOP], 1u);
            const unsigned tg = og / nx;
            if (og + 1u == (tg + 1u) * nx) xb_add(&bar[XB_TOPGEN], 1u);
            else XB_SPIN(xb_ld(&bar[XB_TOPGEN]) == tg, bar);
            __builtin_amdgcn_fence(__ATOMIC_ACQUIRE, "agent");
            xb_add(&bar[XB_XGEN(b.x)], 1u);
            asm volatile("s_waitcnt vmcnt(0)" ::: "memory");
        } else {
            XB_SPIN(xb_ld(&bar[XB_XGEN(b.x)]) == gen, bar);
            __builtin_amdgcn_fence(__ATOMIC_ACQUIRE, "agent");
            asm volatile("s_waitcnt vmcnt(0)" ::: "memory");
        }
    }
    __syncthreads();
}

namespace g8 {
constexpr int BM = 256, BK = 64, HALF = 128, HTB = HALF * BK * 2, NXCD = 8, WGM = 8;
__device__ __forceinline__ int lds_byte(int r, int c) { const int st = (r >> 4) * 2 + (c >> 5), rr = r & 15, cc = c & 31, ob = rr * 64 + cc * 2; return st * 1024 + (ob ^ (((ob >> 9) & 1) << 5)); }
__device__ __forceinline__ void stage_rc(int b, int& R, int& C) { const int st = b / 1024, sb = b % 1024, swz = sb ^ (((sb >> 9) & 1) << 5); R = (st >> 1) * 16 + swz / 64; C = (st & 1) * 32 + (swz % 64) / 2; }
__device__ __forceinline__ int perm32(int rho) { const int n = rho >> 4, i = rho & 15; return 8 * (i >> 2) + 4 * n + (i & 3); }

struct Unit { const char* A; const char* B; unsigned vA0[2], vA1[2]; int r0, pn, e, rend; };

template <class Epi, class Sched, bool F8 = false>
__device__ __forceinline__ void gemm_phase(LAS unsigned char* lds, const int pitch, const Sched& S, const Epi& E) {
    const int tid = threadIdx.x, wid = __builtin_amdgcn_readfirstlane(tid >> 6), lane = tid & 63, wr = wid >> 2, wc = wid & 3, fr = lane & 15, fq = lane >> 4;
    const int nt = pitch / 128;
    unsigned voffB[2], voffB1[2];
#pragma unroll
    for (int i = 0; i < 2; ++i) { int R, C; stage_rc(tid * 16 + i * 8192, R, C); const int p = perm32(R & 31);
        if constexpr (Epi::P16) { const int base = 64 * (R >> 5) + 16 * (p >> 3) + (p & 7); voffB[i] = (unsigned)(base * pitch + C * 2); voffB1[i] = (unsigned)((base + 8) * pitch + C * 2); }
        else { const int Rb = Epi::PERM ? ((R & ~31) + p) : R; voffB[i] = (unsigned)(Rb * pitch + C * 2); voffB1[i] = voffB[i] + (unsigned)(HALF * pitch); } }
    const size_t kstep = 128;
    const size_t hstepB = (size_t)HALF * pitch;
    const unsigned ldsw = (unsigned)wid * 1024u;
    const int aoff = lds_byte(wr * 64 + fr, fq * 8), boff = lds_byte(wc * 32 + fr, fq * 8);
#define G8_SA(b, h) (((b) * 2 + (h)) * HTB)
#define G8_SB(b, h) ((4 + (b) * 2 + (h)) * HTB)
#define G8_STAGE(bufoff, gbase, voff) do { _Pragma("unroll") for (int _i = 0; _i < 2; ++_i) \
        __builtin_amdgcn_global_load_lds((const unsigned*)((const char*)(gbase) + (voff)[_i]), (LAS unsigned*)(lds + (bufoff) + ldsw + _i * 8192), 16, 0, 0); } while (0)
#define G8_LDA(dst, b, h) do { _Pragma("unroll") for (int m = 0; m < 4; ++m) _Pragma("unroll") for (int k = 0; k < 2; ++k) dst[m][k] = *(const LAS bf16x8*)(lds + G8_SA(b, h) + aoff + m * 2048 + k * 1024); } while (0)
#define G8_LDB(dst, b, h) do { _Pragma("unroll") for (int n = 0; n < 2; ++n) _Pragma("unroll") for (int k = 0; k < 2; ++k) dst[n][k] = *(const LAS bf16x8*)(lds + G8_SB(b, h) + boff + n * 2048 + k * 1024); } while (0)
#define G8_CAT(x) __builtin_shufflevector(__builtin_bit_cast(i32x4, x[0]), __builtin_bit_cast(i32x4, x[1]), 0, 1, 2, 3, 4, 5, 6, 7)
#define G8_MMA(ai, bj, At, Bt) do { __builtin_amdgcn_s_setprio(1); _Pragma("unroll") for (int m = 0; m < 4; ++m) _Pragma("unroll") for (int n = 0; n < 2; ++n) { \
        if constexpr (F8) acc[ai][bj][m][n] = __builtin_amdgcn_mfma_scale_f32_16x16x128_f8f6f4(G8_CAT(Bt[n]), G8_CAT(At[m]), acc[ai][bj][m][n], 0, 0, 0, 0x7f7f7f7f, 0, 0x7f7f7f7f); \
        else { _Pragma("unroll") for (int k = 0; k < 2; ++k) acc[ai][bj][m][n] = __builtin_amdgcn_mfma_f32_16x16x32_bf16(Bt[n][k], At[m][k], acc[ai][bj][m][n], 0, 0, 0); } } \
        __builtin_amdgcn_s_setprio(0); } while (0)
#define G8_WAIT_V(n) asm volatile("s_waitcnt vmcnt(" #n ")" ::: "memory")
#define G8_WAIT_L(n) asm volatile("s_waitcnt lgkmcnt(" #n ")" ::: "memory")
#define G8_BAR __builtin_amdgcn_s_barrier()
#define G8_SCHED __builtin_amdgcn_sched_barrier(0)
    Unit cur, nxt; int ui = 0;
    if (!S.next(0, cur)) return;
    f32x4 acc[2][2][4][2];
#pragma unroll
    for (int a = 0; a < 2; ++a)
#pragma unroll
        for (int b = 0; b < 2; ++b)
#pragma unroll
            for (int m = 0; m < 4; ++m)
#pragma unroll
                for (int n = 0; n < 2; ++n) acc[a][b][m][n] = (f32x4){0.f, 0.f, 0.f, 0.f};
    bf16x8 At[4][2], B0[2][2], B1[2][2];
    const char* cA = cur.A; const char* cB = cur.B;
    G8_STAGE(G8_SB(0, 0), cB, voffB); G8_STAGE(G8_SB(0, 1), cB, voffB1); G8_STAGE(G8_SA(0, 0), cA, cur.vA0); G8_STAGE(G8_SA(0, 1), cA, cur.vA1);
    if (wr == 1) G8_BAR;
    G8_WAIT_V(2); G8_BAR;
    G8_STAGE(G8_SB(1, 0), cB + kstep, voffB); G8_STAGE(G8_SA(1, 0), cA + kstep, cur.vA0); G8_STAGE(G8_SB(1, 1), cB + kstep, voffB1);
    G8_WAIT_V(6); G8_BAR;
    for (;;) {
        const bool has_next = S.next(ui + 1, nxt);
        if (!has_next) nxt = cur;
        const char* nA = nxt.A; const char* nB = nxt.B;
#pragma unroll 1
        for (int t = 0; t < nt; t += 2) {
            const bool last = (t == nt - 2);
            const char* a1 = cA + (size_t)(t + 1) * kstep;
            const char* a2 = last ? nA : cA + (size_t)(t + 2) * kstep; const char* b2 = last ? nB : cB + (size_t)(t + 2) * kstep;
            const char* a3 = a2 + kstep; const char* b3 = b2 + kstep;
            G8_LDB(B0, 0, 0); G8_LDB(B1, 0, 1); G8_SCHED; G8_LDA(At, 0, 0); G8_STAGE(G8_SA(1, 1), a1, cur.vA1);
            if (last) { cur.vA0[0] = nxt.vA0[0]; cur.vA0[1] = nxt.vA0[1]; cur.vA1[0] = nxt.vA1[0]; cur.vA1[1] = nxt.vA1[1]; }
            G8_WAIT_V(8); G8_WAIT_L(0); G8_BAR; G8_MMA(0, 0, At, B0); G8_MMA(0, 1, At, B1); G8_BAR; G8_SCHED;
            G8_LDA(At, 0, 1); G8_STAGE(G8_SB(0, 0), b2, voffB); G8_STAGE(G8_SB(0, 1), b2, voffB1); G8_STAGE(G8_SA(0, 0), a2, cur.vA0);
            G8_WAIT_V(8); G8_WAIT_L(0); G8_BAR; G8_MMA(1, 0, At, B0); G8_MMA(1, 1, At, B1); G8_BAR; G8_SCHED;
            G8_LDB(B0, 1, 0); G8_LDB(B1, 1, 1); G8_SCHED; G8_LDA(At, 1, 0); G8_STAGE(G8_SA(0, 1), a2, cur.vA1);
            G8_WAIT_V(8); G8_WAIT_L(0); G8_BAR; G8_MMA(0, 0, At, B0); G8_MMA(0, 1, At, B1); G8_BAR; G8_SCHED;
            G8_LDA(At, 1, 1); G8_STAGE(G8_SB(1, 0), b3, voffB); G8_STAGE(G8_SB(1, 1), b3, voffB1); G8_STAGE(G8_SA(1, 0), a3, cur.vA0);
            G8_WAIT_V(8); G8_WAIT_L(0); G8_BAR; G8_MMA(1, 0, At, B0); G8_MMA(1, 1, At, B1); G8_BAR; G8_SCHED;
        }
        if (wr == 0) G8_BAR;
        E(acc, cur, wr, wc, fr, fq);
        if (!has_next) break;
#pragma unroll
        for (int a = 0; a < 2; ++a)
#pragma unroll
            for (int b = 0; b < 2; ++b)
#pragma unroll
                for (int m = 0; m < 4; ++m)
#pragma unroll
                    for (int n = 0; n < 2; ++n) acc[a][b][m][n] = (f32x4){0.f, 0.f, 0.f, 0.f};
        cur = nxt; cA = nA; cB = nB; ++ui;
        if (wr == 1) G8_BAR;
    }
    G8_WAIT_V(0);
    G8_BAR;
#undef G8_SA
#undef G8_SB
#undef G8_STAGE
#undef G8_LDA
#undef G8_CAT
#undef G8_LDB
#undef G8_MMA
#undef G8_WAIT_V
#undef G8_WAIT_L
#undef G8_BAR
#undef G8_SCHED
}

struct DenseOrder {
    const char* A; const char* Bt; int pitch; int nM, nN, nwg, G, c;
    __device__ void init(const void* A_, const void* Bt_, int M, int N, int pitch_, int G_, int c_) { A = (const char*)A_; Bt = (const char*)Bt_; pitch = pitch_; nM = M / BM; nN = N / BM; nwg = nM * nN; G = G_; c = c_; }
    __device__ __forceinline__ bool next(int i, Unit& u) const {
        const long L = (long)i * G + c; if (L >= nwg) return false;
        int R[2], C[2]; stage_rc((int)threadIdx.x * 16, R[0], C[0]); stage_rc((int)threadIdx.x * 16 + 8192, R[1], C[1]);
        int wgid = (int)L; { const int q = nwg / NXCD, r = nwg % NXCD, xcd = wgid % NXCD, off = wgid / NXCD; wgid = (xcd < r ? xcd * (q + 1) : r * (q + 1) + (xcd - r) * q) + off; }
        const int nig = WGM * nN, gid = wgid / nig, fm = gid * WGM, gsz = (nM - fm) < WGM ? (nM - fm) : WGM;
        const int pm = fm + ((wgid % nig) % gsz), pn = (wgid % nig) / gsz;
        u.A = A + (size_t)pm * BM * pitch; u.B = Bt + (size_t)pn * BM * pitch;
#pragma unroll
        for (int j = 0; j < 2; ++j) { u.vA0[j] = (unsigned)(R[j] * pitch + C[j] * 2); u.vA1[j] = (unsigned)((R[j] + HALF) * pitch + C[j] * 2); }
        u.r0 = pm * BM; u.pn = pn; u.e = 0; u.rend = 0; return true;
    }
};
}

struct Args { const void* in[25]; float* out; unsigned char* ws; int ph_lo, ph_hi; };
struct Ctx {
    LAS unsigned char* lds; unsigned char* ws; const void* const* in; float* out;
    int tid, lane, wave, vcu, G;
};

__device__ __forceinline__ void p0_adaln(Ctx& F) {
    LAS float* sc = (LAS float*)F.lds;
    LAS float* red = (LAS float*)(F.lds + 65536);
    const float* cvec = (const float*)F.in[1]; const float* wada = (const float*)F.in[3]; const float* bada = (const float*)F.in[4]; float* mod = (float*)(F.ws + WS_MOD);
    __syncthreads();
    for (int i = F.tid; i < NB * DM; i += NWAVES * 64) sc[i] = siluf_(cvec[i]);
    __syncthreads();
    for (int cb = F.vcu; cb < 6 * DM / 48; cb += F.G) {
        const int n0 = cb * 48, l = F.lane < 48 ? F.lane : 47, k0 = F.wave * 256;
        float acc[8];
#pragma unroll
        for (int b = 0; b < 8; ++b) acc[b] = 0.f;
        const float* col = wada + (size_t)k0 * (6 * DM) + n0 + l;
#pragma unroll 1
        for (int kk = 0; kk < 256; kk += 32) { float wv[32];
#pragma unroll
            for (int u = 0; u < 32; ++u) wv[u] = col[(size_t)(kk + u) * (6 * DM)];
#pragma unroll
            for (int u = 0; u < 32; ++u)
#pragma unroll
                for (int b = 0; b < 8; ++b) acc[b] += sc[b * DM + k0 + kk + u] * wv[u]; }
        if (F.lane < 48) {
#pragma unroll
            for (int b = 0; b < 8; ++b) red[(F.wave * 8 + b) * 48 + F.lane] = acc[b]; }
        __syncthreads();
        if (F.tid < 384) { const int b = F.tid / 48, cc = F.tid % 48; float s = bada[n0 + cc];
#pragma unroll
            for (int w = 0; w < 8; ++w) s += red[(w * 8 + b) * 48 + cc];
            __hip_atomic_store(mod + (size_t)b * 6 * DM + n0 + cc, s, __ATOMIC_RELAXED, __HIP_MEMORY_SCOPE_AGENT); }
        VM_WAIT();
        __syncthreads();
    }
    if (F.tid == 0) __hip_atomic_fetch_add((unsigned*)(F.ws + WS_CTL) + CW_MODCNT, 1u, __ATOMIC_RELAXED, __HIP_MEMORY_SCOPE_AGENT);
}
__device__ __forceinline__ void p0_wait_mod(Ctx& F) {
    if (F.tid == 0) { unsigned* ctl = (unsigned*)(F.ws + WS_CTL); unsigned sp = 0u;
        while (ld_agent(ctl + CW_MODCNT) < (unsigned)F.G) { __builtin_amdgcn_s_sleep(2); if (++sp > (1u << 20)) { atomicAdd(ctl + CW_BAR + XB_TMO, 1u); break; } }
        __builtin_amdgcn_fence(__ATOMIC_ACQUIRE, "agent");
        asm volatile("s_waitcnt vmcnt(0)" ::: "memory"); }
    __syncthreads();
}
template <bool F8>
__device__ __forceinline__ void p0_transpose_item(const float* W, int K, int N, void* WT, int out_row0, int k0, int n0, float scale, LAS float* scr, int lane) {
    f32x4 v[16];
#pragma unroll
    for (int i = 0; i < 16; ++i) v[i] = *(const f32x4*)(W + (size_t)(k0 + 4 * i + (lane >> 4)) * N + n0 + 4 * (lane & 15));
#pragma unroll
    for (int i = 0; i < 16; ++i) { LAS float* d = scr + (4 * i + (lane >> 4)) * 65 + 4 * (lane & 15); d[0] = v[i].x; d[1] = v[i].y; d[2] = v[i].z; d[3] = v[i].w; }
    LDS_WAIT(); asm volatile("" ::: "memory");
    if (!F8) {
        const int c = lane & 7;
#pragma unroll
        for (int j = 0; j < 8; ++j) { const int n = (lane >> 3) + 8 * j; const LAS float* s = scr + (8 * c) * 65 + n;
            u32x4 o; o.x = pk2(s[0 * 65], s[1 * 65]); o.y = pk2(s[2 * 65], s[3 * 65]); o.z = pk2(s[4 * 65], s[5 * 65]); o.w = pk2(s[6 * 65], s[7 * 65]);
            *(u32x4*)((bf16*)WT + (size_t)(out_row0 + n) * K + k0 + 8 * c) = o; }
    } else {
        const int c = lane & 3;
#pragma unroll
        for (int j = 0; j < 4; ++j) { const int n = (lane >> 2) + 16 * j; const LAS float* s = scr + (16 * c) * 65 + n; int o[4];
#pragma unroll
            for (int q = 0; q < 4; ++q) { int wv = 0; wv = __builtin_amdgcn_cvt_pk_fp8_f32(s[(4 * q) * 65] * scale, s[(4 * q + 1) * 65] * scale, wv, false); wv = __builtin_amdgcn_cvt_pk_fp8_f32(s[(4 * q + 2) * 65] * scale, s[(4 * q + 3) * 65] * scale, wv, true); o[q] = wv; }
            *(u32x4*)((unsigned char*)WT + (size_t)(out_row0 + n) * K + k0 + 16 * c) = (u32x4){(unsigned)o[0], (unsigned)o[1], (unsigned)o[2], (unsigned)o[3]}; }
    }
    LDS_WAIT(); asm volatile("" ::: "memory");
}
struct CvItem { const float* src; unsigned char* dst; int N, K; float scale; };
__device__ __forceinline__ CvItem cv_decode(const void* const* in, unsigned char* ws, int r) {
    constexpr int I_EI = 32 * 16, I_EO = 8 * 32; CvItem c;
    if (r < 65 * I_EI) { const int e = r / I_EI, q = r % I_EI, kb = q / 16, nb = q % 16, n0 = 64 * nb, j = n0 & 511, up = n0 >> 9;
        const float* W = (e < 64) ? (const float*)in[20] + (size_t)e * DM * 1024 : (const float*)in[22];
        c.src = W + (size_t)(64 * kb) * 1024 + n0; c.N = 1024; c.K = DM; c.scale = SC_WEI;
        c.dst = ws + WS_WEI + (size_t)e * 1024 * DM + (size_t)((j >> 7) * 256 + up * 128 + (j & 127)) * DM + 64 * kb; }
    else { r -= 65 * I_EI; const int e = r / I_EO, q = r % I_EO, kb = q / 32, nb = q % 32;
        const float* W = (e < 64) ? (const float*)in[21] + (size_t)e * EH * DM : (const float*)in[23];
        c.src = W + (size_t)(64 * kb) * DM + 64 * nb; c.N = DM; c.K = EH; c.scale = SC_WEO;
        c.dst = ws + WS_WEO + (size_t)e * DM * EH + (size_t)(64 * nb) * EH + 64 * kb; }
    return c;
}
__device__ __forceinline__ void p2_convert_experts(Ctx& F) {
    const int gw = F.vcu * NWAVES + F.wave, NGW = F.G * NWAVES, lane = F.lane, li = lane & 15, lg = lane >> 4;
    constexpr int NCV = 65 * (32 * 16 + 8 * 32);
    int it = gw; CvItem cur; f32x4 v[16];
    const int krow = 16 * (li >> 2) + (li & 3);
#define CV_LOAD(c) do { _Pragma("unroll") for (int nh = 0; nh < 2; ++nh) _Pragma("unroll") for (int q = 0; q < 4; ++q) { const float* p_ = (c).src + (size_t)(krow + 4 * q) * (c).N + 32 * nh + 8 * lg; \
        v[(nh * 4 + q) * 2] = *(const f32x4*)p_; v[(nh * 4 + q) * 2 + 1] = *(const f32x4*)(p_ + 4); } } while (0)
    if (it < NCV) { cur = cv_decode(F.in, F.ws, it); CV_LOAD(cur); }
    while (it < NCV) {
        bf16x8 a[2][4];
#pragma unroll
        for (int nh = 0; nh < 2; ++nh)
#pragma unroll
            for (int q = 0; q < 4; ++q) { const f32x4 lo = v[(nh * 4 + q) * 2], hi = v[(nh * 4 + q) * 2 + 1];
                const u32x4 pk = (u32x4){pk2c(lo.x, lo.y), pk2c(lo.z, lo.w), pk2c(hi.x, hi.y), pk2c(hi.z, hi.w)}; a[nh][q] = __builtin_bit_cast(bf16x8, pk); }
        const CvItem me = cur; const int nit = it + NGW;
        if (nit < NCV) { cur = cv_decode(F.in, F.ws, nit); CV_LOAD(cur); }
        const unsigned sbits = (unsigned)f2bf(me.scale);
#pragma unroll
        for (int h = 0; h < 2; ++h) {
            u32x4 sel = (u32x4){0u, 0u, 0u, 0u}; { const int d = 16 * h + li - 8 * lg; if (d >= 0 && d < 8) { const unsigned wv = (d & 1) ? (sbits << 16) : sbits; if ((d >> 1) == 0) sel.x = wv; else if ((d >> 1) == 1) sel.y = wv; else if ((d >> 1) == 2) sel.z = wv; else sel.w = wv; } }
            const bf16x8 bs = __builtin_bit_cast(bf16x8, sel);
#pragma unroll
            for (int nh = 0; nh < 2; ++nh) { unsigned o[4];
#pragma unroll
                for (int q = 0; q < 4; ++q) { const f32x4 d = __builtin_amdgcn_mfma_f32_16x16x32_bf16(a[nh][q], bs, (f32x4){0.f, 0.f, 0.f, 0.f}, 0, 0, 0); o[q] = pk4_fp8(d[0], d[1], d[2], d[3]); }
                *(u32x4*)(me.dst + (size_t)(32 * nh + 16 * h + li) * me.K + 16 * lg) = (u32x4){o[0], o[1], o[2], o[3]}; }
        }
        it = nit;
    }
#undef CV_LOAD
}
__device__ __forceinline__ void p0_prologue(Ctx& F) {
    LAS float* scr = (LAS float*)(F.lds + F.wave * 16640);
    const int gw = F.vcu * NWAVES + F.wave, NGW = F.G * NWAVES, lane = F.lane;
    unsigned char* ws = F.ws;
    constexpr int I_IN = 32 * 96, I_OUT = 32 * 32, I_R = 32 * 1, I_G = 2 * 2;
    constexpr int NTR = I_IN + I_OUT + I_R + 16 * I_G;
    for (int it = gw; it < NTR; it += NGW) {
        int r = it;
        if (r < I_IN) { const int kb = r / 96, nb = r % 96; p0_transpose_item<false>((const float*)F.in[6], DM, NIN, ws + WS_WIN, 64 * nb, 64 * kb, 64 * nb, 1.f, scr, lane); continue; } r -= I_IN;
        if (r < I_OUT) { const int kb = r / 32, nb = r % 32; p0_transpose_item<false>((const float*)F.in[16], DM, DM, ws + WS_WOUT, 64 * nb, 64 * kb, 64 * nb, 1.f, scr, lane); continue; } r -= I_OUT;
        if (r < I_R) { const int kb = r; p0_transpose_item<false>((const float*)F.in[18], DM, NE, ws + WS_WR, 0, 64 * kb, 0, 1.f, scr, lane); continue; } r -= I_R;
        { const int m = r / I_G, q = r % I_G, kb = q / 2, nb = q % 2, g = m & 7;
          const float* W = ((m < 8) ? (const float*)F.in[9] : (const float*)F.in[11]) + (size_t)g * 128 * 128;
          p0_transpose_item<false>(W, 128, 128, (bf16*)(ws + (m < 8 ? WS_WA : WS_WX)) + (size_t)g * 128 * 128, 64 * nb, 64 * kb, 64 * nb, 1.f, scr, lane); }
    }
    {
        const int* pos = (const int*)F.in[2]; unsigned* rt = (unsigned*)(ws + WS_ROPE);
        const double invrev = exp(-9.210340371976184 * (double)lane / 64.0) * 0.15915494309189535;
        for (int it = gw; it < T * 64 / 512; it += NGW) {
#pragma unroll
            for (int q = 0; q < 8; ++q) { const int idx = it * 512 + q * 64 + lane, t = idx >> 6;
                const double rev = (double)pos[t] * invrev; const float fr_ = (float)(rev - floor(rev));
                rt[idx] = pk2c(__builtin_amdgcn_cosf(fr_), __builtin_amdgcn_sinf(fr_)); }
        }
    }
    if (gw == 0) { u32x4* z = (u32x4*)((bf16*)(ws + WS_H) + (size_t)T * DM); for (int i = lane; i < DM * 2 / 16; i += 64) z[i] = (u32x4){0u, 0u, 0u, 0u};
        u32x4* z8 = (u32x4*)(ws + WS_H8 + (size_t)T * DM); for (int i = lane; i < DM / 16; i += 64) z8[i] = (u32x4){0u, 0u, 0u, 0u}; }
}

template <bool W8, bool INBF>
__device__ __forceinline__ void norm_mod_row(const void* xrow_, const float* g, const float* sc, const float* sh, bf16* orow, unsigned char* orow8, int lane) {
    f32x4 v[4][2]; float ss = 0.f;
#pragma unroll
    for (int j = 0; j < 4; ++j) {
        if constexpr (INBF) { const u32x4 w = *(const u32x4*)((const bf16*)xrow_ + 8 * lane + 512 * j); v[j][0] = (f32x4){bflo(w.x), bfhi(w.x), bflo(w.y), bfhi(w.y)}; v[j][1] = (f32x4){bflo(w.z), bfhi(w.z), bflo(w.w), bfhi(w.w)}; }
        else { v[j][0] = *(const f32x4*)((const float*)xrow_ + 8 * lane + 512 * j); v[j][1] = *(const f32x4*)((const float*)xrow_ + 8 * lane + 512 * j + 4); }
#pragma unroll
        for (int h = 0; h < 2; ++h) ss += (v[j][h].x * v[j][h].x + v[j][h].y * v[j][h].y) + (v[j][h].z * v[j][h].z + v[j][h].w * v[j][h].w); }
    const float rstd = rsqrtf(wave_sum(ss) * (1.0f / DM) + EPS);
#pragma unroll
    for (int j = 0; j < 4; ++j) { f32x4 o[2];
#pragma unroll
        for (int h = 0; h < 2; ++h) { const int c = 8 * lane + 512 * j + 4 * h; const f32x4 gg = *(const f32x4*)(g + c), s1 = *(const f32x4*)(sc + c), s0 = *(const f32x4*)(sh + c);
            o[h] = (v[j][h] * rstd * gg) * (s1 + 1.0f) + s0; }
        u32x4 w; w.x = pk2(o[0].x, o[0].y); w.y = pk2(o[0].z, o[0].w); w.z = pk2(o[1].x, o[1].y); w.w = pk2(o[1].z, o[1].w);
        *(u32x4*)(orow + 8 * lane + 512 * j) = w;
        if constexpr (W8) { u32x2 w8; w8.x = pk4_fp8(o[0].x * SC_H8, o[0].y * SC_H8, o[0].z * SC_H8, o[0].w * SC_H8); w8.y = pk4_fp8(o[1].x * SC_H8, o[1].y * SC_H8, o[1].z * SC_H8, o[1].w * SC_H8); *(u32x2*)(orow8 + 8 * lane + 512 * j) = w8; } }
}
__device__ __forceinline__ void p1_norm(Ctx& F) {
    const int gw = F.vcu * NWAVES + F.wave, NGW = F.G * NWAVES;
    const float* x = (const float*)F.in[0]; const float* g = (const float*)F.in[5]; const float* mod = (const float*)(F.ws + WS_MOD); bf16* h = (bf16*)(F.ws + WS_H);
    for (int m = gw; m < T; m += NGW) { const int b = m / SEQ; norm_mod_row<false, false>(x + (size_t)m * DM, g, mod + (size_t)b * 6 * DM + DM, mod + (size_t)b * 6 * DM, h + (size_t)m * DM, nullptr, F.lane); }
}

struct EpiProj {
    static constexpr bool PERM = true, P16 = false;
    bf16* O;
    __device__ __forceinline__ void operator()(const f32x4 (&acc)[2][2][4][2], const g8::Unit& u, int wr, int wc, int fr, int fq) const {
        const int row0 = u.r0 + wr * 64 + fr, col0 = u.pn * 256 + wc * 32 + 8 * fq;
#pragma unroll
        for (int ai = 0; ai < 2; ++ai)
#pragma unroll
            for (int m = 0; m < 4; ++m) { bf16* rowp = O + (size_t)(row0 + ai * 128 + m * 16) * NIN + col0;
#pragma unroll
                for (int bj = 0; bj < 2; ++bj) { const f32x4 v0 = acc[ai][bj][m][0], v1 = acc[ai][bj][m][1];
                    u32x4 w; w.x = pk2c(v0[0], v0[1]); w.y = pk2c(v0[2], v0[3]); w.z = pk2c(v1[0], v1[1]); w.w = pk2c(v1[2], v1[3]);
                    *(u32x4*)(rowp + bj * 128) = w; } }
    }
};
struct EpiWout {
    static constexpr bool PERM = true, P16 = false;
    const float* x; const float* mod; bf16* x1;
    __device__ __forceinline__ void operator()(const f32x4 (&acc)[2][2][4][2], const g8::Unit& u, int wr, int wc, int fr, int fq) const {
        const int row0 = u.r0 + wr * 64 + fr, col0 = u.pn * 256 + wc * 32 + 8 * fq; const int b = u.r0 / SEQ;
        const float* gt = mod + (size_t)b * 6 * DM + 2 * DM;
        f32x4 gv[2][2];
#pragma unroll
        for (int bj = 0; bj < 2; ++bj)
#pragma unroll
            for (int n = 0; n < 2; ++n) gv[bj][n] = *(const f32x4*)(gt + col0 + bj * 128 + n * 4);
#pragma unroll
        for (int ai = 0; ai < 2; ++ai)
#pragma unroll
            for (int m = 0; m < 4; ++m) { const size_t off = (size_t)(row0 + ai * 128 + m * 16) * DM + col0;
#pragma unroll
                for (int bj = 0; bj < 2; ++bj) { const f32x4 v0 = *(const f32x4*)(x + off + bj * 128) + gv[bj][0] * acc[ai][bj][m][0], v1 = *(const f32x4*)(x + off + bj * 128 + 4) + gv[bj][1] * acc[ai][bj][m][1];
                    u32x4 w; w.x = pk2(v0[0], v0[1]); w.y = pk2(v0[2], v0[3]); w.z = pk2(v1[0], v1[1]); w.w = pk2(v1[2], v1[3]);
                    *(u32x4*)(x1 + off + bj * 128) = w; }
                asm volatile("" ::: "memory"); }
    }
};
struct EpiSwiglu {
    static constexpr bool PERM = true, P16 = false;
    unsigned char* act;
    __device__ __forceinline__ void operator()(const f32x4 (&acc)[2][2][4][2], const g8::Unit& u, int wr, int wc, int fr, int fq) const {
        const int row0 = u.r0 + wr * 64 + fr, col0 = u.pn * 128 + wc * 32 + 8 * fq;
#pragma unroll
        for (int ai = 0; ai < 2; ++ai)
#pragma unroll
            for (int mp = 0; mp < 2; ++mp) { u32x2 w[2];
#pragma unroll
                for (int mm = 0; mm < 2; ++mm) { const int m = 2 * mp + mm; float o[8];
#pragma unroll
                    for (int n = 0; n < 2; ++n)
#pragma unroll
                        for (int j = 0; j < 4; ++j) { const float g = acc[ai][0][m][n][j] * (1.0f / (SC_H8 * SC_WEI)), up = acc[ai][1][m][n][j] * (SC_ACT / (SC_H8 * SC_WEI)); o[4 * n + j] = g * __builtin_amdgcn_rcpf(1.0f + __expf(-g)) * up; }
                    w[mm].x = pk4_fp8(o[0], o[1], o[2], o[3]); w[mm].y = pk4_fp8(o[4], o[5], o[6], o[7]); }
                const auto r0_ = __builtin_amdgcn_permlane16_swap(w[0].x, w[1].x, false, false); const auto r1_ = __builtin_amdgcn_permlane16_swap(w[0].y, w[1].y, false, false);
                const int m = 2 * mp + (fq & 1), col = col0 - 8 * (fq & 1);
                *(u32x4*)(act + (size_t)(row0 + ai * 128 + m * 16) * EH + col) = (u32x4){r0_[0], r1_[0], r0_[1], r1_[1]}; }
    }
};
struct EpiDown {
    static constexpr bool PERM = true, P16 = true;
    unsigned char* y;
    __device__ __forceinline__ void operator()(const f32x4 (&acc)[2][2][4][2], const g8::Unit& u, int wr, int wc, int fr, int fq) const {
        const int row0 = u.r0 + wr * 64 + fr, col0 = u.pn * 256 + wc * 64 + 16 * fq; constexpr float sc = SC_Y / (SC_ACT * SC_WEO); static_assert(sc == 1.0f, "scales chosen so that y needs no multiply");
#pragma unroll
        for (int ai = 0; ai < 2; ++ai)
#pragma unroll
            for (int m = 0; m < 4; ++m) { u32x4 w;
                { const f32x4 v0 = acc[ai][0][m][0], v1 = acc[ai][0][m][1], v2 = acc[ai][1][m][0], v3 = acc[ai][1][m][1];
                  w.x = pk4_fp8(v0[0], v0[1], v0[2], v0[3]); w.y = pk4_fp8(v1[0], v1[1], v1[2], v1[3]); w.z = pk4_fp8(v2[0], v2[1], v2[2], v2[3]); w.w = pk4_fp8(v3[0], v3[1], v3[2], v3[3]); }
                *(u32x4*)(y + (size_t)(row0 + ai * 128 + m * 16) * DM + col0) = w; }
    }
};

struct MoeTables { LAS int* row0; LAS int* te; LAS int* pend; LAS int* tp; };
__device__ __forceinline__ MoeTables moe_tables(Ctx& F) { MoeTables M; M.row0 = (LAS int*)(F.lds + TT_OFF); M.te = M.row0 + MAXTILES; M.pend = M.te + MAXTILES; M.tp = M.pend + 80; return M; }
__device__ __forceinline__ int moe_build_tables(Ctx& F) {
    MoeTables M = moe_tables(F);
    const unsigned* cnt = (const unsigned*)(F.ws + WS_CTL) + CW_CNT;
    __syncthreads();
    if (F.tid < NE) M.row0[F.tid] = (int)ld_agent(cnt + 32 * F.tid);
    __syncthreads();
    if (F.tid == 0) { int tiles = 0;
        for (int e = 0; e < NE; ++e) { const int c = M.row0[e]; M.tp[e] = tiles; M.pend[e] = tiles * 256 + c; tiles += (c + 255) >> 8; }
        M.tp[NE] = NR_ROUTED / 256; M.pend[NE] = NR; M.tp[NE + 1] = NR_ROUTED / 256 + T / 256; M.tp[NE + 2] = tiles; }
    __syncthreads();
    const int rt = M.tp[NE + 2];
    for (int tau = F.tid; tau < rt; tau += NWAVES * 64) { int e = 0; while (e + 1 < NE && M.tp[e + 1] <= tau) ++e; M.te[tau] = e; M.row0[tau] = tau * 256; }
    for (int s = F.tid; s < T / 256; s += NWAVES * 64) { M.te[rt + s] = NE; M.row0[rt + s] = NR_ROUTED + s * 256; }
    __syncthreads();
    return rt + T / 256;
}
template <int PHASE>
struct MoeOrder {
    MoeTables M; const char* A; const char* W; const int* row_tok; LAS unsigned char* lds_tok; int U, CH, x, j;
    static constexpr int NPN = (PHASE == 1) ? 4 : 8;
    __device__ void init(Ctx& F, int ntiles) { M = moe_tables(F); U = ntiles * NPN; CH = (U + 7) / 8; x = F.vcu / (F.G / 8); j = F.vcu % (F.G / 8);
        A = (const char*)(F.ws + (PHASE == 1 ? WS_H8 : WS_ACT)); W = (const char*)(F.ws + (PHASE == 1 ? WS_WEI : WS_WEO)); row_tok = (const int*)(F.ws + WS_TOKOF); lds_tok = F.lds + TOKL_OFF; }
    __device__ __forceinline__ void fill_tokens(Ctx& F) const {
        for (int i = 0; i < TOKL_UNITS; ++i) { const int q = i * 32 + j; const int L = x * CH + q; if (q >= CH || L >= U) break;
            const int tile = L / NPN; const int e = M.te[tile], r0 = M.row0[tile], rend = M.pend[e];
            if (F.tid < 256) { const int ra = r0 + F.tid; int tk;
                if (e == NE) tk = ra - NR_ROUTED; else tk = (ra < rend) ? ld_agent_i(row_tok + (size_t)e * T + (ra - M.tp[e] * 256)) : T;
                ((LAS int*)lds_tok)[i * 256 + F.tid] = tk; } }
        __syncthreads();
    }
    __device__ __forceinline__ bool next(int i, g8::Unit& u) const {
        const int q = i * 32 + j; const int L = x * CH + q; if (q >= CH || L >= U) return false;
        int R[2], C[2]; g8::stage_rc((int)threadIdx.x * 16, R[0], C[0]); g8::stage_rc((int)threadIdx.x * 16 + 8192, R[1], C[1]);
        const int tile = L / NPN, pn = L % NPN;
        const int e = __builtin_amdgcn_readfirstlane(M.te[tile]), r0 = __builtin_amdgcn_readfirstlane(M.row0[tile]), rend = __builtin_amdgcn_readfirstlane(M.pend[e]);
        u.r0 = r0; u.pn = pn; u.e = e; u.rend = rend; u.A = A;
        if (PHASE == 1) {
            u.B = W + ((size_t)e * 1024 + (size_t)pn * 256) * DM;
#pragma unroll
            for (int k = 0; k < 2; ++k) { const int ra = r0 + R[k], rb = ra + 128; int ta, tb;
                if (e == NE) { ta = ra - NR_ROUTED; tb = rb - NR_ROUTED; }
                else { const LAS int* tl = (const LAS int*)(lds_tok) + (i % TOKL_UNITS) * 256; ta = tl[R[k]]; tb = tl[R[k] + 128]; }
                u.vA0[k] = (unsigned)(ta * DM + C[k] * 2); u.vA1[k] = (unsigned)(tb * DM + C[k] * 2); }
        } else {
            u.B = W + ((size_t)e * DM + (size_t)pn * 256) * EH;
#pragma unroll
            for (int k = 0; k < 2; ++k) { u.vA0[k] = (unsigned)((r0 + R[k]) * EH + C[k] * 2); u.vA1[k] = (unsigned)((r0 + R[k] + 128) * EH + C[k] * 2); }
        }
        asm volatile("" : "+v"(u.vA0[0]), "+v"(u.vA0[1]), "+v"(u.vA1[0]), "+v"(u.vA1[1]));
        return true;
    }
};

__device__ __forceinline__ bf16x8 tr_pair(unsigned a0, unsigned a1) { u32x2 r0, r1; asm volatile("ds_read_b64_tr_b16 %0, %2\n\tds_read_b64_tr_b16 %1, %3\n\ts_waitcnt lgkmcnt(0)" : "=&v"(r0), "=&v"(r1) : "v"(a0), "v"(a1) : "memory"); return __builtin_bit_cast(bf16x8, (u32x4){r0.x, r0.y, r1.x, r1.y}); }
__device__ __forceinline__ void tr_quad(bf16x8 (&o)[4], unsigned a0, unsigned a1, unsigned a2, unsigned a3, unsigned d1) {
    u32x2 r0, r1, r2, r3, r4, r5, r6, r7; const unsigned b0 = a0 + d1, b1 = a1 + d1, b2 = a2 + d1, b3 = a3 + d1;
    asm volatile("ds_read_b64_tr_b16 %0, %8\n\tds_read_b64_tr_b16 %1, %9\n\tds_read_b64_tr_b16 %2, %10\n\tds_read_b64_tr_b16 %3, %11\n\tds_read_b64_tr_b16 %4, %12\n\tds_read_b64_tr_b16 %5, %13\n\tds_read_b64_tr_b16 %6, %14\n\tds_read_b64_tr_b16 %7, %15\n\ts_waitcnt lgkmcnt(0)"
        : "=&v"(r0), "=&v"(r1), "=&v"(r2), "=&v"(r3), "=&v"(r4), "=&v"(r5), "=&v"(r6), "=&v"(r7) : "v"(a0), "v"(b0), "v"(a1), "v"(b1), "v"(a2), "v"(b2), "v"(a3), "v"(b3) : "memory");
    o[0] = __builtin_bit_cast(bf16x8, (u32x4){r0.x, r0.y, r1.x, r1.y}); o[1] = __builtin_bit_cast(bf16x8, (u32x4){r2.x, r2.y, r3.x, r3.y});
    o[2] = __builtin_bit_cast(bf16x8, (u32x4){r4.x, r4.y, r5.x, r5.y}); o[3] = __builtin_bit_cast(bf16x8, (u32x4){r6.x, r6.y, r7.x, r7.y}); }
constexpr int LP = 136;
template <int NET> __device__ __forceinline__ void ret_item(Ctx& F, int item) {
    const int tid = F.tid, lane = F.lane, w = F.wave, fr = lane & 15, fq = lane >> 4;
    constexpr int EW = 16 * NET, NEB = 128 / EW, VP = EW + 8;
    const int b = item / (8 * NEB), h = (item / NEB) & 7, eb = item % NEB;
    LAS bf16* qL = (LAS bf16*)(F.lds); LAS bf16* kL = qL + 128 * LP; LAS bf16* vL = kL + 128 * LP; LAS bf16* vdL = vL + 128 * VP; LAS bf16* STL = vdL + 128 * VP;
    const unsigned trq = (unsigned)((lane & 15) >> 2), trp = (unsigned)(lane & 3);
    const unsigned kLb = (unsigned)(size_t)kL + trq * (LP * 2) + 8u * trp + (unsigned)(16 * w) * 2u, vLb = (unsigned)(size_t)vL + trq * (VP * 2) + 8u * trp, vdLb = (unsigned)(size_t)vdL + trq * (VP * 2) + 8u * trp;
    const bf16* proj = (const bf16*)(F.ws + WS_PROJ); const unsigned* rope = (const unsigned*)(F.ws + WS_ROPE); float* reto = (float*)(F.ws + WS_RETO);
    const float lg = log1pf(-exp2f(-5.0f - (float)h)), lg2 = lg * 1.4426950408889634f, dec = __expf(lg * 128.0f);
    f32x4 st[NET];
#pragma unroll
    for (int et = 0; et < NET; ++et) st[et] = (f32x4){0.f, 0.f, 0.f, 0.f};
    __syncthreads();
    for (int i = tid; i < EW * LP; i += NWAVES * 64) STL[i] = 0;
    const int r = tid >> 2, qd = tid & 3, j0 = 16 * qd;
    const float kdec = __builtin_amdgcn_exp2f(lg2 * (float)(127 - r));
    u32x4 q1[2], q2[2], k1[2], k2[2], vv[NET / 2], cs4[4];
#define RET_LOAD(nn) do { const bf16* p_ = proj + (size_t)(b * SEQ + (nn) * 128 + r) * NIN + h * 128; const unsigned* c_ = rope + (size_t)(b * SEQ + (nn) * 128 + r) * 64 + j0; \
        q1[0] = *(const u32x4*)(p_ + j0); q1[1] = *(const u32x4*)(p_ + j0 + 8); q2[0] = *(const u32x4*)(p_ + 64 + j0); q2[1] = *(const u32x4*)(p_ + 64 + j0 + 8); \
        k1[0] = *(const u32x4*)(p_ + RW + j0); k1[1] = *(const u32x4*)(p_ + RW + j0 + 8); k2[0] = *(const u32x4*)(p_ + RW + 64 + j0); k2[1] = *(const u32x4*)(p_ + RW + 64 + j0 + 8); \
        _Pragma("unroll") for (int vi_ = 0; vi_ < NET / 2; ++vi_) vv[vi_] = *(const u32x4*)(p_ + 2 * RW + eb * EW + qd * (EW / 4) + 8 * vi_); \
        _Pragma("unroll") for (int jj_ = 0; jj_ < 4; ++jj_) cs4[jj_] = *(const u32x4*)(c_ + 4 * jj_); } while (0)
    RET_LOAD(0);
#pragma unroll 1
    for (int n = 0; n < 16; ++n) {
        const int t0 = b * SEQ + n * 128;
        __syncthreads();
        {
#pragma unroll
            for (int hh = 0; hh < 2; ++hh) { unsigned oq1[4], oq2[4], ok1[4], ok2[4];
#pragma unroll
                for (int c = 0; c < 4; ++c) { float a[2], bq[2], ka[2], kb[2];
#pragma unroll
                    for (int z = 0; z < 2; ++z) { const int jj = hh * 8 + c * 2 + z; const unsigned cw_ = cs4[jj >> 2][jj & 3]; const f32x2 sc = (f32x2){bflo(cw_), bfhi(cw_)};
                        const float x1 = z ? bfhi(q1[hh][c]) : bflo(q1[hh][c]), x2 = z ? bfhi(q2[hh][c]) : bflo(q2[hh][c]);
                        const float y1 = z ? bfhi(k1[hh][c]) : bflo(k1[hh][c]), y2 = z ? bfhi(k2[hh][c]) : bflo(k2[hh][c]);
                        a[z] = (x1 * sc.x - x2 * sc.y) * 0.08838834764831845f; bq[z] = (x2 * sc.x + x1 * sc.y) * 0.08838834764831845f;
                        ka[z] = y1 * sc.x - y2 * sc.y; kb[z] = y2 * sc.x + y1 * sc.y;
                    }
                    oq1[c] = pk2(a[0], a[1]); oq2[c] = pk2(bq[0], bq[1]); ok1[c] = pk2(ka[0], ka[1]); ok2[c] = pk2(kb[0], kb[1]); }
                *(LAS u32x4*)(qL + r * LP + j0 + hh * 8) = (u32x4){oq1[0], oq1[1], oq1[2], oq1[3]}; *(LAS u32x4*)(qL + r * LP + 64 + j0 + hh * 8) = (u32x4){oq2[0], oq2[1], oq2[2], oq2[3]};
                *(LAS u32x4*)(kL + r * LP + j0 + hh * 8) = (u32x4){ok1[0], ok1[1], ok1[2], ok1[3]}; *(LAS u32x4*)(kL + r * LP + 64 + j0 + hh * 8) = (u32x4){ok2[0], ok2[1], ok2[2], ok2[3]}; }
#pragma unroll
            for (int vi = 0; vi < NET / 2; ++vi) { unsigned vd[4];
#pragma unroll
                for (int c = 0; c < 4; ++c) vd[c] = pk2(bflo(vv[vi][c]) * kdec, bfhi(vv[vi][c]) * kdec);
                *(LAS u32x4*)(vL + r * VP + qd * (EW / 4) + 8 * vi) = vv[vi]; *(LAS u32x4*)(vdL + r * VP + qd * (EW / 4) + 8 * vi) = (u32x4){vd[0], vd[1], vd[2], vd[3]}; }
        }
        if (n + 1 < 16) RET_LOAD(n + 1);
        __syncthreads();
        f32x4 sacc[8];
#pragma unroll
        for (int mt = 0; mt < 8; ++mt) sacc[mt] = (f32x4){0.f, 0.f, 0.f, 0.f};
#pragma unroll
        for (int ks = 0; ks < 4; ++ks) { const bf16x8 bq = *(const LAS bf16x8*)(qL + (16 * w + fr) * LP + 32 * ks + 8 * fq);
#pragma unroll
            for (int mt = 0; mt < 8; ++mt) { const bf16x8 ak = *(const LAS bf16x8*)(kL + (16 * mt + fr) * LP + 32 * ks + 8 * fq); sacc[mt] = __builtin_amdgcn_mfma_f32_16x16x32_bf16(ak, bq, sacc[mt], 0, 0, 0); } }
        const int c = 16 * w + fr;
        bf16x8 pb[4];
#pragma unroll
        for (int sk = 0; sk < 4; ++sk) { unsigned pw[4];
#pragma unroll
            for (int hlf = 0; hlf < 2; ++hlf) { const int mt = 2 * sk + hlf; float pv[4];
#pragma unroll
                for (int rr = 0; rr < 4; ++rr) { const int m = 16 * mt + 4 * fq + rr; pv[rr] = (c >= m) ? sacc[mt][rr] * __builtin_amdgcn_exp2f(lg2 * (float)(c - m)) : 0.f; }
                pw[2 * hlf] = pk2(pv[0], pv[1]); pw[2 * hlf + 1] = pk2(pv[2], pv[3]); }
            pb[sk] = __builtin_bit_cast(bf16x8, (u32x4){pw[0], pw[1], pw[2], pw[3]}); }
        { bf16x8 bqf[4];
#pragma unroll
          for (int ks = 0; ks < 4; ++ks) bqf[ks] = *(const LAS bf16x8*)(qL + (16 * w + fr) * LP + 32 * ks + 8 * fq);
          const float qd = __builtin_amdgcn_exp2f(lg2 * (float)(c + 1));
#pragma unroll
          for (int et = 0; et < NET; ++et) { f32x4 oi = (f32x4){0.f, 0.f, 0.f, 0.f}, oc = (f32x4){0.f, 0.f, 0.f, 0.f};
            bf16x8 avq[4]; const unsigned a0 = vLb + (unsigned)((4 * fq) * (VP * 2) + 32 * et); tr_quad(avq, a0, a0 + 32 * (VP * 2), a0 + 64 * (VP * 2), a0 + 96 * (VP * 2), 16 * (VP * 2));
#pragma unroll
            for (int ks = 0; ks < 4; ++ks) { const bf16x8 as = *(const LAS bf16x8*)(STL + (16 * et + fr) * LP + 32 * ks + 8 * fq);
                oi = __builtin_amdgcn_mfma_f32_16x16x32_bf16(avq[ks], pb[ks], oi, 0, 0, 0); oc = __builtin_amdgcn_mfma_f32_16x16x32_bf16(as, bqf[ks], oc, 0, 0, 0); }
            *(f32x4*)(reto + (size_t)(t0 + c) * RW + h * 128 + eb * EW + 16 * et + 4 * fq) = oi + oc * qd; } }
        __syncthreads();
#pragma unroll
        for (int et = 0; et < NET; ++et) st[et] = st[et] * dec;
        { bf16x8 bkq[4];
          { const unsigned k0 = kLb + (unsigned)((8 * fq) * (LP * 2)); tr_quad(bkq, k0, k0 + 32 * (LP * 2), k0 + 64 * (LP * 2), k0 + 96 * (LP * 2), 4 * (LP * 2)); }
#pragma unroll
          for (int et = 0; et < NET; ++et) { bf16x8 vq[4]; const unsigned v0 = vdLb + (unsigned)((8 * fq) * (VP * 2) + 32 * et); tr_quad(vq, v0, v0 + 32 * (VP * 2), v0 + 64 * (VP * 2), v0 + 96 * (VP * 2), 4 * (VP * 2));
#pragma unroll
            for (int ks = 0; ks < 4; ++ks) st[et] = __builtin_amdgcn_mfma_f32_16x16x32_bf16(vq[ks], bkq[ks], st[et], 0, 0, 0); } }
#pragma unroll
        for (int et = 0; et < NET; ++et)
#pragma unroll
            for (int rr = 0; rr < 4; ++rr) STL[(16 * et + 4 * fq + rr) * LP + 16 * w + fr] = f2bf(st[et][rr]);
    }
#undef RET_LOAD
    __syncthreads();
}

struct LruIn { bf16x8 bA[4], bX[4]; unsigned xr[19]; f32x2 w0, w1, w2, w3, bc; float bav, bxv, lamv; };
__device__ __forceinline__ void lru_issue(Ctx& F, int item, LruIn& L) {
    const int lane = F.lane, w = F.wave, fr = lane & 15, fq = lane >> 4;
    const int b = item >> 7, n = (item >> 3) & 15, g = item & 7; const int ch = g * 128 + 2 * lane;
    const bf16* Wa = (const bf16*)(F.ws + WS_WA) + (size_t)g * 128 * 128 + (size_t)(16 * w + fr) * 128 + 8 * fq; const bf16* Wx = (const bf16*)(F.ws + WS_WX) + (size_t)g * 128 * 128 + (size_t)(16 * w + fr) * 128 + 8 * fq;
#pragma unroll
    for (int ks = 0; ks < 4; ++ks) { L.bA[ks] = *(const bf16x8*)(Wa + 32 * ks); L.bX[ks] = *(const bf16x8*)(Wx + 32 * ks); }
    const float* wconv = (const float*)F.in[7];
    L.w0 = *(const f32x2*)(wconv + ch); L.w1 = *(const f32x2*)(wconv + LW + ch); L.w2 = *(const f32x2*)(wconv + 2 * LW + ch); L.w3 = *(const f32x2*)(wconv + 3 * LW + ch); L.bc = *(const f32x2*)((const float*)F.in[8] + ch);
    const int cj = g * 128 + 16 * w + fr; L.bav = ((const float*)F.in[10])[cj]; L.bxv = ((const float*)F.in[12])[cj]; L.lamv = ((const float*)F.in[13])[cj];
    const int s0 = n * 128 + 16 * w; const bf16* p = (const bf16*)(F.ws + WS_PROJ) + (size_t)(b * SEQ) * NIN + 4 * RW + ch;
#pragma unroll
    for (int i = 0; i < 19; ++i) { const int sp = s0 - 3 + i; L.xr[i] = (sp >= 0) ? *(const unsigned*)(p + (size_t)sp * NIN) : 0u; }
}
__device__ __forceinline__ void lru_body(Ctx& F, int item, const LruIn& L) {
    const int lane = F.lane, w = F.wave, fr = lane & 15, fq = lane >> 4;
    const int b = item >> 7, n = (item >> 3) & 15, g = item & 7;
    LAS bf16* xcL = (LAS bf16*)(F.lds); LAS float* aL = (LAS float*)(F.lds + 34816); LAS bf16* mL = (LAS bf16*)(F.lds + 34816 + 65536); LAS float* segA = (LAS float*)(F.lds + 34816 + 65536 + 32768); LAS float* segB = segA + 1024;
    const int cp = lane, sg = w, ch = g * 128 + 2 * cp;
    float xc[16][2];
#pragma unroll
    for (int i = 0; i < 16; ++i) {
        xc[i][0] = L.bc.x + L.w0.x * bflo(L.xr[i]) + L.w1.x * bflo(L.xr[i + 1]) + L.w2.x * bflo(L.xr[i + 2]) + L.w3.x * bflo(L.xr[i + 3]);
        xc[i][1] = L.bc.y + L.w0.y * bfhi(L.xr[i]) + L.w1.y * bfhi(L.xr[i + 1]) + L.w2.y * bfhi(L.xr[i + 2]) + L.w3.y * bfhi(L.xr[i + 3]);
        *(LAS unsigned*)(xcL + (16 * sg + i) * LP + 2 * cp) = pk2(xc[i][0], xc[i][1]); }
    __syncthreads();
    {
        const int j = 16 * w + fr; const float bav = L.bav, bxv = L.bxv, sp8 = -8.0f * log1pf(__expf(-L.lamv));
#pragma unroll 2
        for (int tt = 0; tt < 8; ++tt) { f32x4 ra = (f32x4){0.f, 0.f, 0.f, 0.f}, rx = (f32x4){0.f, 0.f, 0.f, 0.f};
#pragma unroll
            for (int ks = 0; ks < 4; ++ks) { const bf16x8 a = *(const LAS bf16x8*)(xcL + (16 * tt + fr) * LP + 32 * ks + 8 * fq);
                ra = __builtin_amdgcn_mfma_f32_16x16x32_bf16(a, L.bA[ks], ra, 0, 0, 0); rx = __builtin_amdgcn_mfma_f32_16x16x32_bf16(a, L.bX[ks], rx, 0, 0, 0); }
#pragma unroll
            for (int rr = 0; rr < 4; ++rr) { const int t = 16 * tt + 4 * fq + rr;
                const float rgt = __builtin_amdgcn_rcpf(1.0f + __expf(-(ra[rr] + bav))), igt = __builtin_amdgcn_rcpf(1.0f + __expf(-(rx[rr] + bxv)));
                const float av = __expf(sp8 * rgt); const float mu = __builtin_amdgcn_sqrtf(fmaxf(1.0f - av * av, 0.f)) * igt;
                aL[t * 128 + j] = av; mL[t * 128 + j] = f2bf(mu); } }
    }
    __syncthreads();
    {
        float h0 = 0.f, h1 = 0.f, P0 = 1.f, P1 = 1.f;
#pragma unroll
        for (int i = 0; i < 16; ++i) { const int t = 16 * sg + i; const f32x2 av = *(const LAS f32x2*)(aL + t * 128 + 2 * cp); const unsigned mw = *(const LAS unsigned*)(mL + t * 128 + 2 * cp);
            h0 = av.x * h0 + bflo(mw) * xc[i][0]; h1 = av.y * h1 + bfhi(mw) * xc[i][1]; P0 *= av.x; P1 *= av.y; }
        *(LAS f32x2*)(segA + sg * 128 + 2 * cp) = (f32x2){P0, P1}; *(LAS f32x2*)(segB + sg * 128 + 2 * cp) = (f32x2){h0, h1};
    }
    __syncthreads();
    {
        float c0 = 0.f, c1 = 0.f, Q0 = 1.f, Q1 = 1.f;
        for (int s = 0; s < sg; ++s) { const f32x2 A = *(const LAS f32x2*)(segA + s * 128 + 2 * cp), Bv = *(const LAS f32x2*)(segB + s * 128 + 2 * cp); c0 = A.x * c0 + Bv.x; c1 = A.y * c1 + Bv.y; Q0 *= A.x; Q1 *= A.y; }
        bf16* hl = (bf16*)(F.ws + WS_HLOC) + (size_t)(b * SEQ + n * 128 + 16 * sg) * LW + ch; bf16* pl = (bf16*)(F.ws + WS_PLOC) + (size_t)(b * SEQ + n * 128 + 16 * sg) * LW + ch;
        float h0 = c0, h1 = c1, P0 = Q0, P1 = Q1;
#pragma unroll
        for (int i = 0; i < 16; ++i) { const int t = 16 * sg + i; const f32x2 av = *(const LAS f32x2*)(aL + t * 128 + 2 * cp); const unsigned mw = *(const LAS unsigned*)(mL + t * 128 + 2 * cp);
            h0 = av.x * h0 + bflo(mw) * xc[i][0]; h1 = av.y * h1 + bfhi(mw) * xc[i][1]; P0 *= av.x; P1 *= av.y;
            *(unsigned*)(hl + (size_t)i * LW) = pk2(h0, h1); *(unsigned*)(pl + (size_t)i * LW) = pk2(P0, P1); }
        if (sg == 7) { *(f32x2*)((float*)(F.ws + WS_AGGA) + (size_t)(b * 16 + n) * LW + ch) = (f32x2){P0, P1}; *(f32x2*)((float*)(F.ws + WS_AGGB) + (size_t)(b * 16 + n) * LW + ch) = (f32x2){h0, h1}; }
    }
    __syncthreads();
}

__device__ __forceinline__ void p4_item(Ctx& F, int item) {
    const int tid = F.tid, lane = F.lane, w = F.wave;
    const int b = item >> 5, n = (item & 31) >> 1;
    LAS float* carry = (LAS float*)F.lds;
    const float* aggA = (const float*)(F.ws + WS_AGGA); const float* aggB = (const float*)(F.ws + WS_AGGB);
    __syncthreads();
#pragma unroll
    for (int q = 0; q < 2; ++q) { const int ch = tid + 512 * q; float cin = 0.f;
        for (int jn = 0; jn < n; ++jn) cin = aggA[(size_t)(b * 16 + jn) * LW + ch] * cin + aggB[(size_t)(b * 16 + jn) * LW + ch];
        carry[ch] = cin; }
    __syncthreads();
    const bf16* proj = (const bf16*)(F.ws + WS_PROJ); const float* reto = (const float*)(F.ws + WS_RETO); const bf16* hl = (const bf16*)(F.ws + WS_HLOC); const bf16* pl = (const bf16*)(F.ws + WS_PLOC);
    bf16* cat = (bf16*)(F.ws + WS_CAT); const int c0 = 16 * lane;
    float beta_r[16], beta_l[16], cr[16];
#pragma unroll
    for (int q = 0; q < 4; ++q) { const f32x4 a = *(const f32x4*)((const float*)F.in[14] + c0 + 4 * q), bq = *(const f32x4*)((const float*)F.in[15] + c0 + 4 * q); const f32x4 cq = *(const LAS f32x4*)(carry + c0 + 4 * q);
        beta_r[4 * q] = a.x; beta_r[4 * q + 1] = a.y; beta_r[4 * q + 2] = a.z; beta_r[4 * q + 3] = a.w; beta_l[4 * q] = bq.x; beta_l[4 * q + 1] = bq.y; beta_l[4 * q + 2] = bq.z; beta_l[4 * q + 3] = bq.w;
        cr[4 * q] = cq.x; cr[4 * q + 1] = cq.y; cr[4 * q + 2] = cq.z; cr[4 * q + 3] = cq.w; }
#pragma unroll 2
    for (int rr = 0; rr < 8; ++rr) {
        const int t = item * 64 + 8 * w + rr;
        {
            float o[16];
#pragma unroll
            for (int q = 0; q < 4; ++q) { const f32x4 v = *(const f32x4*)(reto + (size_t)t * RW + c0 + 4 * q); o[4 * q] = v.x; o[4 * q + 1] = v.y; o[4 * q + 2] = v.z; o[4 * q + 3] = v.w; }
            float s = 0.f;
#pragma unroll
            for (int q = 0; q < 16; ++q) s += o[q];
            s += __shfl_xor(s, 1); s += __shfl_xor(s, 2); s += __shfl_xor(s, 4);
            const float mu = s * (1.0f / 128.0f); float vq = 0.f;
#pragma unroll
            for (int q = 0; q < 16; ++q) { o[q] -= mu; vq += o[q] * o[q]; }
            vq += __shfl_xor(vq, 1); vq += __shfl_xor(vq, 2); vq += __shfl_xor(vq, 4);
            const float rs = rsqrtf(vq * (1.0f / 128.0f) + EPS);
            const u32x4 g0 = *(const u32x4*)(proj + (size_t)t * NIN + 3 * RW + c0), g1 = *(const u32x4*)(proj + (size_t)t * NIN + 3 * RW + c0 + 8);
            float ss = 0.f;
#pragma unroll
            for (int q = 0; q < 8; ++q) { const unsigned gw_ = (q < 4) ? g0[q & 3] : g1[q & 3]; const float ga = bflo(gw_), gb = bfhi(gw_);
                o[2 * q] = siluf_(ga) * (o[2 * q] * rs); o[2 * q + 1] = siluf_(gb) * (o[2 * q + 1] * rs); ss += o[2 * q] * o[2 * q] + o[2 * q + 1] * o[2 * q + 1]; }
            const float rstd = rsqrtf(wave_sum(ss) * (1.0f / RW) + EPS);
            u32x4 w0, w1;
#pragma unroll
            for (int q = 0; q < 4; ++q) { w0[q] = pk2(o[2 * q] * rstd * beta_r[2 * q], o[2 * q + 1] * rstd * beta_r[2 * q + 1]); w1[q] = pk2(o[8 + 2 * q] * rstd * beta_r[8 + 2 * q], o[9 + 2 * q] * rstd * beta_r[9 + 2 * q]); }
            *(u32x4*)(cat + (size_t)t * DM + c0) = w0; *(u32x4*)(cat + (size_t)t * DM + c0 + 8) = w1;
        }
        {
            const u32x4 h0 = *(const u32x4*)(hl + (size_t)t * LW + c0), h1 = *(const u32x4*)(hl + (size_t)t * LW + c0 + 8), p0 = *(const u32x4*)(pl + (size_t)t * LW + c0), p1 = *(const u32x4*)(pl + (size_t)t * LW + c0 + 8);
            const u32x4 y0 = *(const u32x4*)(proj + (size_t)t * NIN + 5 * RW + c0), y1 = *(const u32x4*)(proj + (size_t)t * NIN + 5 * RW + c0 + 8);
            float o[16]; float ss = 0.f;
#pragma unroll
            for (int q = 0; q < 8; ++q) { const unsigned hw = (q < 4) ? h0[q & 3] : h1[q & 3], pw = (q < 4) ? p0[q & 3] : p1[q & 3], yw = (q < 4) ? y0[q & 3] : y1[q & 3];
                const float ha = bflo(hw) + bflo(pw) * cr[2 * q], hb = bfhi(hw) + bfhi(pw) * cr[2 * q + 1];
                o[2 * q] = ha * gelu_tanh_(bflo(yw)); o[2 * q + 1] = hb * gelu_tanh_(bfhi(yw)); ss += o[2 * q] * o[2 * q] + o[2 * q + 1] * o[2 * q + 1]; }
            const float rstd = rsqrtf(wave_sum(ss) * (1.0f / LW) + EPS);
            u32x4 w0, w1;
#pragma unroll
            for (int q = 0; q < 4; ++q) { w0[q] = pk2(o[2 * q] * rstd * beta_l[2 * q], o[2 * q + 1] * rstd * beta_l[2 * q + 1]); w1[q] = pk2(o[8 + 2 * q] * rstd * beta_l[8 + 2 * q], o[9 + 2 * q] * rstd * beta_l[9 + 2 * q]); }
            *(u32x4*)(cat + (size_t)t * DM + RW + c0) = w0; *(u32x4*)(cat + (size_t)t * DM + RW + c0 + 8) = w1;
        }
    }
    __syncthreads();
}

constexpr int HAP = 2056;
template <bool DRY> __device__ __forceinline__ void p6_item(Ctx& F, int item) {
    const int tid = F.tid, lane = F.lane, w = F.wave, fr = lane & 15, fq = lane >> 4;
    const int t0 = item * 64, b = t0 / SEQ;
    LAS bf16* hA = (LAS bf16*)F.lds;
    LAS float* lgt = (LAS float*)(F.lds + 16 * HAP * 2);
    LAS unsigned char* selE = (LAS unsigned char*)(F.lds + 16 * HAP * 2 + 8 * 16 * 65 * 4); LAS unsigned char* selL = selE + 512; LAS unsigned* wcnt = (LAS unsigned*)(selL + 512); LAS unsigned* gb = wcnt + 512;
    const bf16* x1 = (const bf16*)(F.ws + WS_X1); const float* mod = (const float*)(F.ws + WS_MOD) + (size_t)b * 6 * DM; bf16* h2 = (bf16*)(F.ws + WS_H); unsigned char* h8 = F.ws + WS_H8;
    const bf16* Wr = (const bf16*)(F.ws + WS_WR);
    int* eidx = (int*)(F.ws + WS_EIDX); float* wsel = (float*)(F.ws + WS_WSEL); int* slot = (int*)(F.ws + (DRY ? WS_DEST : WS_SLOT)); unsigned* cnt = (unsigned*)(F.ws + WS_CTL) + CW_CNT + (DRY ? 4096 : 0);
    f32x4 gg[4][2];
#pragma unroll
    for (int j = 0; j < 4; ++j)
#pragma unroll
        for (int h = 0; h < 2; ++h) { const int c = 8 * lane + 512 * j + 4 * h; gg[j][h] = *(const f32x4*)((const float*)F.in[17] + c) * (*(const f32x4*)(mod + 4 * DM + c) + 1.0f); }
    const float brl = ((const float*)F.in[19])[lane]; const int g = lane >> 3;
    unsigned lc = 0u;
    bf16x8 bw[2][4];
#pragma unroll
    for (int ks = 0; ks < 2; ++ks)
#pragma unroll
        for (int et = 0; et < 4; ++et) bw[ks][et] = *(const bf16x8*)(Wr + (size_t)(16 * et + fr) * DM + 256 * w + 32 * ks + 8 * fq);
    u32x4 xq[2][4];
#pragma unroll
    for (int i = 0; i < 2; ++i)
#pragma unroll
        for (int j = 0; j < 4; ++j) xq[i][j] = *(const u32x4*)(x1 + (size_t)(t0 + 2 * w + i) * DM + 8 * lane + 512 * j);
    __syncthreads();
#pragma unroll 1
    for (int ps = 0; ps < 4; ++ps) {
#pragma unroll
        for (int i = 0; i < 2; ++i) { const int rl = 2 * w + i, t = t0 + 16 * ps + rl;
            f32x4 v[4][2]; float ss = 0.f;
#pragma unroll
            for (int j = 0; j < 4; ++j) { const u32x4 xw = xq[i][j]; v[j][0] = (f32x4){bflo(xw.x), bfhi(xw.x), bflo(xw.y), bfhi(xw.y)}; v[j][1] = (f32x4){bflo(xw.z), bfhi(xw.z), bflo(xw.w), bfhi(xw.w)};
#pragma unroll
                for (int h = 0; h < 2; ++h) ss += (v[j][h].x * v[j][h].x + v[j][h].y * v[j][h].y) + (v[j][h].z * v[j][h].z + v[j][h].w * v[j][h].w); }
            const float rstd = rsqrtf(wave_sum(ss) * (1.0f / DM) + EPS);
#pragma unroll
            for (int j = 0; j < 4; ++j) { const f32x4 o0 = v[j][0] * rstd * gg[j][0] + *(const f32x4*)(mod + 3 * DM + 8 * lane + 512 * j), o1 = v[j][1] * rstd * gg[j][1] + *(const f32x4*)(mod + 3 * DM + 8 * lane + 512 * j + 4);
                u32x4 wv; wv.x = pk2(o0.x, o0.y); wv.y = pk2(o0.z, o0.w); wv.z = pk2(o1.x, o1.y); wv.w = pk2(o1.z, o1.w);
                *(LAS u32x4*)(hA + rl * HAP + 8 * lane + 512 * j) = wv;
                u32x2 w8; w8.x = pk4_fp8(o0.x * SC_H8, o0.y * SC_H8, o0.z * SC_H8, o0.w * SC_H8); w8.y = pk4_fp8(o1.x * SC_H8, o1.y * SC_H8, o1.z * SC_H8, o1.w * SC_H8);
                *(u32x2*)(h8 + (size_t)t * DM + 8 * lane + 512 * j) = w8; }
            __builtin_amdgcn_sched_barrier(0); }
        __syncthreads();
        {
            f32x4 acc[4];
#pragma unroll
            for (int et = 0; et < 4; ++et) acc[et] = (f32x4){0.f, 0.f, 0.f, 0.f};
            bf16x8 bw2[6][4];
#pragma unroll
            for (int ks = 0; ks < 6; ++ks)
#pragma unroll
                for (int et = 0; et < 4; ++et) bw2[ks][et] = *(const bf16x8*)(Wr + (size_t)(16 * et + fr) * DM + 256 * w + 64 + 32 * ks + 8 * fq);
#pragma unroll
            for (int ks = 0; ks < 2; ++ks) { const bf16x8 a = *(const LAS bf16x8*)(hA + fr * HAP + 256 * w + 32 * ks + 8 * fq);
#pragma unroll
                for (int et = 0; et < 4; ++et) acc[et] = __builtin_amdgcn_mfma_f32_16x16x32_bf16(a, bw[ks][et], acc[et], 0, 0, 0); }
#pragma unroll
            for (int ks = 0; ks < 6; ++ks) { const bf16x8 a = *(const LAS bf16x8*)(hA + fr * HAP + 256 * w + 64 + 32 * ks + 8 * fq);
#pragma unroll
                for (int et = 0; et < 4; ++et) acc[et] = __builtin_amdgcn_mfma_f32_16x16x32_bf16(a, bw2[ks][et], acc[et], 0, 0, 0); }
#pragma unroll
            for (int et = 0; et < 4; ++et)
#pragma unroll
                for (int rr = 0; rr < 4; ++rr) lgt[(w * 16 + 4 * fq + rr) * 65 + 16 * et + fr] = acc[et][rr];
        }
        __syncthreads();
        if (ps + 1 < 4) {
#pragma unroll
            for (int i = 0; i < 2; ++i)
#pragma unroll
                for (int j = 0; j < 4; ++j) xq[i][j] = *(const u32x4*)(x1 + (size_t)(t0 + 16 * (ps + 1) + 2 * w + i) * DM + 8 * lane + 512 * j); }
#pragma unroll 1
        for (int i = 0; i < 2; ++i) {
            const int tl = 2 * w + i, tt = 16 * ps + tl; float z = 0.f;
#pragma unroll
            for (int w2 = 0; w2 < 8; ++w2) z += lgt[(w2 * 16 + tl) * 65 + lane];
            const float s = sigmoidf_(z); const float bsc = s + brl;
            float m1 = bsc; m1 = fmaxf(m1, __shfl_xor(m1, 1)); m1 = fmaxf(m1, __shfl_xor(m1, 2)); m1 = fmaxf(m1, __shfl_xor(m1, 4));
            const unsigned long long eq = __ballot(bsc == m1); const unsigned gm = (unsigned)(eq >> (8 * g)) & 0xffu;
            const bool first = (lane & 7) == (__builtin_ctz(gm | 0x100u) & 7);
            float m2 = first ? -3.0e38f : bsc; m2 = fmaxf(m2, __shfl_xor(m2, 1)); m2 = fmaxf(m2, __shfl_xor(m2, 2)); m2 = fmaxf(m2, __shfl_xor(m2, 4));
            const float gs = m1 + m2;
            int rank_g = 0;
#pragma unroll
            for (int g2 = 0; g2 < 8; ++g2) { const float o = __int_as_float(__builtin_amdgcn_readlane(__float_as_int(gs), 8 * g2)); rank_g += (o > gs || (o == gs && g2 < g)) ? 1 : 0; }
            const bool selg = rank_g < 4;
            const float key = selg ? bsc : -3.0e38f;
            int rank = 0;
#pragma unroll
            for (int e2 = 0; e2 < 64; ++e2) { const float o = __int_as_float(__builtin_amdgcn_readlane(__float_as_int(key), e2)); rank += (o > key || (o == key && e2 < lane)) ? 1 : 0; }
            const bool chosen = selg && rank < 8;
            const float wsum = wave_sum(chosen ? s : 0.f);
            if (chosen) { const int t = t0 + tt; eidx[t * 8 + rank] = lane; wsel[t * 8 + rank] = s * (2.5f / wsum); selE[tt * 8 + rank] = (unsigned char)lane; selL[tt * 8 + rank] = (unsigned char)lc; }
            lc += chosen ? 1u : 0u;
        }
        __syncthreads();
    }
    wcnt[w * 64 + lane] = lc;
    __syncthreads();
    if (w == 0) { unsigned tot = 0u;
#pragma unroll
        for (int w2 = 0; w2 < 8; ++w2) tot += wcnt[w2 * 64 + lane];
        gb[lane] = tot ? __hip_atomic_fetch_add(cnt + 32 * lane, tot, __ATOMIC_RELAXED, __HIP_MEMORY_SCOPE_AGENT) : 0u; }
    __syncthreads();
    { const int tok = tid >> 3, k = tid & 7, e = selE[tok * 8 + k], wt = (tok & 15) >> 1; unsigned off = gb[e] + selL[tok * 8 + k];
        for (int w2 = 0; w2 < wt; ++w2) off += wcnt[w2 * 64 + e];
        slot[(t0 + tok) * 8 + k] = (int)off; if (!DRY) ((int*)(F.ws + WS_TOKOF))[(size_t)e * T + off] = t0 + tok; }
    __syncthreads();
}

__device__ __forceinline__ void p10_final(Ctx& F, bool have_tables) {
    const int gw = F.vcu * NWAVES + F.wave, NGW = F.G * NWAVES, lane = F.lane;
    const bf16* x1 = (const bf16*)(F.ws + WS_X1); const unsigned char* y = F.ws + WS_Y; const int* eidx = (const int*)(F.ws + WS_EIDX); const int* slot = (const int*)(F.ws + WS_SLOT); const float* wsel = (const float*)(F.ws + WS_WSEL); const float* gf = (const float*)F.in[24];
    LAS int* ps = (LAS int*)F.lds; const unsigned* cnt = (const unsigned*)(F.ws + WS_CTL) + CW_CNT;
    __syncthreads();
    if (have_tables) { if (F.tid < NE) ps[F.tid] = moe_tables(F).tp[F.tid] * 256; }
    else { if (F.tid < NE) ps[64 + F.tid] = (((int)ld_agent(cnt + 32 * F.tid) + 255) >> 8) << 8;
        __syncthreads();
        if (F.tid < NE) { int acc = 0; for (int e = 0; e < F.tid; ++e) acc += ps[64 + e]; ps[F.tid] = acc; } }
    __syncthreads();
    f32x4 gfv[4][2];
#pragma unroll
    for (int j = 0; j < 4; ++j)
#pragma unroll
        for (int hh = 0; hh < 2; ++hh) gfv[j][hh] = *(const f32x4*)(gf + 8 * lane + 512 * j + 4 * hh);
    for (int t = gw; t < T; t += NGW) { const int b = t / SEQ; const float* gt2 = (const float*)(F.ws + WS_MOD) + (size_t)b * 6 * DM + 5 * DM;
        int rows[9]; float wk[9];
        { const i32x4 e0 = *(const i32x4*)(eidx + t * 8), e1 = *(const i32x4*)(eidx + t * 8 + 4), s0 = *(const i32x4*)(slot + t * 8), s1 = *(const i32x4*)(slot + t * 8 + 4);
          const f32x4 w0 = *(const f32x4*)(wsel + t * 8), w1 = *(const f32x4*)(wsel + t * 8 + 4);
#pragma unroll
          for (int k = 0; k < 4; ++k) { rows[k] = ps[e0[k]] + s0[k]; rows[4 + k] = ps[e1[k]] + s1[k]; wk[k] = w0[k] * (1.0f / SC_Y); wk[4 + k] = w1[k] * (1.0f / SC_Y); } }
        rows[8] = NR_ROUTED + t; wk[8] = 1.0f / SC_Y;
        float ss = 0.f; f32x4 v[4][2];
#pragma unroll
        for (int j = 0; j < 4; ++j) { const int c = 8 * lane + 512 * j; float s[8];
#pragma unroll
            for (int q = 0; q < 8; ++q) s[q] = 0.f;
#pragma unroll
            for (int k = 0; k < 9; ++k) { const u32x2 yv = *(const u32x2*)(y + (size_t)rows[k] * DM + c);
#pragma unroll
                for (int q = 0; q < 2; ++q) { const f32x2 lo = __builtin_amdgcn_cvt_pk_f32_fp8((int)yv[q], false), hi = __builtin_amdgcn_cvt_pk_f32_fp8((int)yv[q], true);
                    s[4 * q] += wk[k] * lo.x; s[4 * q + 1] += wk[k] * lo.y; s[4 * q + 2] += wk[k] * hi.x; s[4 * q + 3] += wk[k] * hi.y; } }
            const u32x4 xw = *(const u32x4*)(x1 + (size_t)t * DM + c);
#pragma unroll
            for (int hh = 0; hh < 2; ++hh) { const f32x4 xv = hh ? (f32x4){bflo(xw.z), bfhi(xw.z), bflo(xw.w), bfhi(xw.w)} : (f32x4){bflo(xw.x), bfhi(xw.x), bflo(xw.y), bfhi(xw.y)}, gv = *(const f32x4*)(gt2 + c + 4 * hh);
                v[j][hh] = xv + gv * (f32x4){s[4 * hh], s[4 * hh + 1], s[4 * hh + 2], s[4 * hh + 3]};
                ss += (v[j][hh].x * v[j][hh].x + v[j][hh].y * v[j][hh].y) + (v[j][hh].z * v[j][hh].z + v[j][hh].w * v[j][hh].w); } }
        const float rstd = rsqrtf(wave_sum(ss) * (1.0f / DM) + EPS);
#pragma unroll
        for (int j = 0; j < 4; ++j)
#pragma unroll
            for (int hh = 0; hh < 2; ++hh) { const int c = 8 * lane + 512 * j + 4 * hh; *(f32x4*)(F.out + (size_t)t * DM + c) = v[j][hh] * rstd * gfv[j][hh]; }
    }
}

__global__ void __launch_bounds__(NWAVES * 64, 2) fwd_kernel(Args args) {
    extern __shared__ __attribute__((aligned(16))) unsigned char lds_raw[];
    Ctx F;
    F.lds = (LAS unsigned char*)lds_raw; F.ws = args.ws; F.in = args.in; F.out = args.out;
    F.tid = threadIdx.x; F.lane = F.tid & 63; F.wave = __builtin_amdgcn_readfirstlane(F.tid >> 6);
    F.G = gridDim.x; { const int bx = blockIdx.x; F.vcu = (F.G % 8 == 0) ? (bx % 8) * (F.G / 8) + bx / 8 : bx; }
    if (F.tid < 16) ((LAS unsigned*)(F.lds + MISC_OFF))[F.tid] = 0u;
    __syncthreads();
    unsigned* ctl = (unsigned*)(F.ws + WS_CTL);
#if N_LAUNCHES == 1
    XcdBarrier bar = xcd_barrier_post(ctl + CW_BAR, (volatile LAS unsigned*)(F.lds + MISC_OFF));
#define GRID_BAR() xcd_barrier(bar)
#else
#define GRID_BAR() do { } while (0)
#endif
    const int lo = args.ph_lo, hi = args.ph_hi;
#define IN(k) (lo <= (k) && (k) < hi)
#define BOTH(k) (IN(k) && IN((k) + 1))
    const int NIT = F.G;

#define REP(k) _Pragma("unroll") for (int rep_ = 0; rep_ < ((PROBE_PHASE == (k)) ? 2 : 1); ++rep_)
    if (IN(0)) { p0_adaln(F); p0_prologue(F); if (BOTH(0)) p0_wait_mod(F); }
    if (IN(1)) { REP(1) { p1_norm(F); } if (BOTH(1)) GRID_BAR(); if (PROBE_PHASE == 100) { GRID_BAR(); GRID_BAR(); GRID_BAR(); GRID_BAR(); } }
    if (IN(2)) {
        if (F.vcu & 1) p2_convert_experts(F);
        REP(2) {
        g8::DenseOrder S; S.init(F.ws + WS_H, F.ws + WS_WIN, T, NIN, DM * 2, F.G, (int)blockIdx.x);
        EpiProj E{(bf16*)(F.ws + WS_PROJ)};
        g8::gemm_phase<EpiProj, g8::DenseOrder>(F.lds, DM * 2, S, E);
        }
        if (!(F.vcu & 1)) p2_convert_experts(F);
        if (BOTH(2)) GRID_BAR();
    }
    if (IN(3)) {
        {
            const bool split = (F.G & 1) == 0; const int hw = split ? (F.vcu >> 1) : F.vcu, HS = split ? (F.G >> 1) : F.G;
            if (!split || (F.vcu & 1) == 0) { for (int it = hw; it < NB * 8 * 2; it += HS) ret_item<4>(F, it); }
            if (!split || (F.vcu & 1) == 1) { LruIn La, Lb; int it = hw; const int NL = NB * 16 * 8;
                __syncthreads();
                if (it < NL) lru_issue(F, it, La);
                while (it < NL) {
                    if (it + HS < NL) lru_issue(F, it + HS, Lb);
                    lru_body(F, it, La); it += HS;
                    if (it >= NL) break;
                    if (it + HS < NL) lru_issue(F, it + HS, La);
                    lru_body(F, it, Lb); it += HS;
                } }
        }
        if (BOTH(3)) GRID_BAR();
    }
    if (IN(4)) { REP(4) { for (int it = F.vcu; it < T / 64; it += NIT) p4_item(F, it); } if (BOTH(4)) GRID_BAR(); }
    if (IN(5)) {
        REP(5) {
        g8::DenseOrder S; S.init(F.ws + WS_CAT, F.ws + WS_WOUT, T, DM, DM * 2, F.G, (int)blockIdx.x);
        EpiWout E{(const float*)F.in[0], (const float*)(F.ws + WS_MOD), (bf16*)(F.ws + WS_X1)};
        g8::gemm_phase<EpiWout, g8::DenseOrder>(F.lds, DM * 2, S, E);
        }
        if (BOTH(5)) GRID_BAR();
    }
    if (IN(6)) { for (int it = F.vcu; it < T / 64; it += NIT) p6_item<false>(F, it); if (PROBE_PHASE == 6) { for (int it = F.vcu; it < T / 64; it += NIT) p6_item<true>(F, it); } if (BOTH(6)) GRID_BAR(); }
    int ntiles = 0;
    if (IN(8)) {
        REP(8) {
        ntiles = moe_build_tables(F);
        MoeOrder<1> S; S.init(F, ntiles); S.fill_tokens(F);
        EpiSwiglu E{F.ws + WS_ACT};
        g8::gemm_phase<EpiSwiglu, MoeOrder<1>, true>(F.lds, DM, S, E);
        }
        if (BOTH(8)) GRID_BAR();
    }
    if (IN(9)) {
        REP(9) {
        if (!IN(8)) ntiles = moe_build_tables(F);
        MoeOrder<2> S; S.init(F, ntiles);
        EpiDown E{F.ws + WS_Y};
        g8::gemm_phase<EpiDown, MoeOrder<2>, true>(F.lds, EH, S, E);
        }
        if (BOTH(9)) GRID_BAR();
    }
    if (IN(10)) { REP(10) { p10_final(F, IN(8)); } }
#undef REP
#undef IN
#undef BOTH
}

extern "C" void kernel_launch(void* const* d_in, const int* in_sizes, int n_in, void* d_out, int out_size, void* d_ws, size_t ws_size, hipStream_t stream) {
    static int grid = 0;
    if (grid == 0) {
        if (n_in != 25 || out_size != T * DM || ws_size < WS_END) { fprintf(stderr, "kernel_launch: unexpected problem (n_in %d, out %d, ws %zu)\n", n_in, out_size, ws_size); grid = -1; return; }
        int dev = 0, cus = 0, per_cu = 0;
        if (hipGetDevice(&dev) != hipSuccess || hipDeviceGetAttribute(&cus, hipDeviceAttributeMultiprocessorCount, dev) != hipSuccess) { grid = -1; return; }
        if (hipFuncSetAttribute((const void*)fwd_kernel, hipFuncAttributeMaxDynamicSharedMemorySize, LDS_BYTES) != hipSuccess) { fprintf(stderr, "kernel_launch: hipFuncSetAttribute failed\n"); grid = -1; return; }
        if (hipOccupancyMaxActiveBlocksPerMultiprocessor(&per_cu, (const void*)fwd_kernel, NWAVES * 64, LDS_BYTES) != hipSuccess || per_cu < 1) { fprintf(stderr, "kernel_launch: occupancy query says %d\n", per_cu); }
        (void)hipGetLastError();
        grid = cus;
    }
    if (grid < 0) return;
    (void)hipMemsetAsync((char*)d_ws + WS_CTL, 0, CTL_ZERO_BYTES, stream);
    Args a{};
    for (int i = 0; i < 25; ++i) a.in[i] = d_in[i];
    a.out = (float*)d_out; a.ws = (unsigned char*)d_ws;
#if N_LAUNCHES == 1
    a.ph_lo = 0; a.ph_hi = 11;
    hipLaunchKernelGGL(fwd_kernel, dim3(grid), dim3(NWAVES * 64), LDS_BYTES, stream, a);
#else
    for (int p = 0; p < 11; ++p) { a.ph_lo = p; a.ph_hi = p + 1; hipLaunchKernelGGL(fwd_kernel, dim3(grid), dim3(NWAVES * 64), LDS_BYTES, stream, a); }
#endif
}
```
